# Optimizing an MI355X kernel written in HIP

```python
import math
import jax
import jax.numpy as jnp
from jax import lax
import numpy as np

D_MODEL = 4096
BATCH = 8
SEQ = 2048
DEPTH = 2
DEC_BATCH = 8
DEC_SEQ = 64
PAST_LEN = 1024

CHUNK = 64
N_MEM = 256
N_BRANCH = 4
BRANCH_W = D_MODEL // 4
A_HEAD_DIM = 64
A_HEADS = BRANCH_W // A_HEAD_DIM
A_LORA_W = 64
A_LORA_A = 64
A_SHIFT_W = 3 * BRANCH_W + A_LORA_W + A_LORA_A
B_HEAD_DIM = 128
B_HEADS = BRANCH_W // B_HEAD_DIM
Q_BLOCK = 128
C_CHUNK = 128
C_GROUP_DIM = 128
C_GROUPS = BRANCH_W // C_GROUP_DIM
M_HEADS = 4
M_HEAD_DIM = BRANCH_W // M_HEADS
NORM_EPS = 1e-6
GN_EPS = 64e-5

IN_SIZES = (BRANCH_W, BRANCH_W, BRANCH_W, A_LORA_W, A_LORA_A, BRANCH_W,
            BRANCH_W, BRANCH_W, BRANCH_W, BRANCH_W,
            BRANCH_W, BRANCH_W, BRANCH_W,
            BRANCH_W)
N_IN = sum(IN_SIZES)
IN_SPLITS = tuple(sum(IN_SIZES[:i + 1]) for i in range(len(IN_SIZES) - 1))
A_SPLITS = IN_SPLITS[:4]

kernel_name = 'hybrid_streaming_rwkv7_stickbreak_chunkmlp_step'


def rmsnorm(x, g):
    xf = x.astype(jnp.float32)
    y = xf * lax.rsqrt(jnp.mean(xf * xf, axis=-1, keepdims=True) + NORM_EPS)
    return (y * g.astype(jnp.float32)).astype(x.dtype)


def layernorm(x, w, b):
    xf = x.astype(jnp.float32)
    mu = jnp.mean(xf, axis=-1, keepdims=True)
    var = jnp.mean(jnp.square(xf - mu), axis=-1, keepdims=True)
    return ((xf - mu) * lax.rsqrt(var + NORM_EPS) * w + b).astype(x.dtype)


def rwkv7_scan(s0, r, decay, k, v, kk, a):
    xs = tuple(jnp.moveaxis(u, 1, 0) for u in (r, decay, k, v, kk, a))

    def step(s, inp):
        r_t, d_t, k_t, v_t, kk_t, a_t = inp
        s_kk = jnp.einsum('bhvk,bhk->bhv', s, kk_t)
        s = (s * d_t[:, :, None, :]
             - s_kk[..., None] * (kk_t * a_t)[:, :, None, :]
             + v_t[..., None] * k_t[:, :, None, :])
        y = jnp.einsum('bhvk,bhk->bhv', s, r_t)
        return s, y

    s_fin, y = lax.scan(step, s0.astype(jnp.float32), xs)
    return jnp.moveaxis(y, 0, 1), s_fin


def rwkv7_branch(pa, z, shift_prev, s_prev, mu, w0, w_up, a0, a_up, k_k, k_a, r_k, gn_w, gn_b):
    bsz, t, _ = pa.shape
    f32 = jnp.float32
    prev = jnp.concatenate([shift_prev.astype(pa.dtype), pa[:, :-1]], axis=1)
    xs = pa + mu * (prev - pa)
    r, k, v, wd, ad = jnp.split(xs, A_SPLITS, axis=-1)
    w_log = -jax.nn.softplus(-(w0 + jnp.tanh(wd) @ w_up).astype(f32)) - 0.5
    decay = jnp.exp(-jnp.exp(w_log))
    a = jax.nn.sigmoid((a0 + ad @ a_up).astype(f32))
    hd = lambda u: u.astype(f32).reshape(bsz, t, A_HEADS, A_HEAD_DIM)
    r, k, v, a, decay = hd(r), hd(k), hd(v), hd(a), hd(decay)
    kk = k * k_k.astype(f32)
    kk = kk / jnp.maximum(jnp.sqrt(jnp.sum(kk * kk, axis=-1, keepdims=True)), 1e-12)
    k = k * (1.0 + (a - 1.0) * k_a.astype(f32))
    y, s_new = rwkv7_scan(s_prev, r, decay, k, v, kk, a)
    mean = jnp.mean(y, axis=-1, keepdims=True)
    var = jnp.mean(jnp.square(y - mean), axis=-1, keepdims=True)
    y = (y - mean) * lax.rsqrt(var + GN_EPS) * gn_w.astype(f32) + gn_b.astype(f32)
    y = y + jnp.sum(r * k * r_k.astype(f32), axis=-1, keepdims=True) * v
    o = y.reshape(bsz, t, BRANCH_W).astype(pa.dtype) * jax.nn.silu(z)
    return o, pa[:, -1:], s_new


def stick_breaking(q, k, v, q_pos, k_pos):
    z = jnp.einsum('bqhd,bkhd->bhqk', q, k).astype(jnp.float32) / math.sqrt(q.shape[-1])
    mask = k_pos[None, :] < q_pos[:, None]
    log_beta = jax.nn.log_sigmoid(z)
    log_1m = jnp.where(mask, jax.nn.log_sigmoid(-z), 0.0)
    suffix = lax.cumsum(log_1m, axis=3, reverse=True) - log_1m
    att = jnp.where(mask, jnp.exp(log_beta + suffix), 0.0)
    return jnp.einsum('bhqk,bkhd->bqhd', att.astype(v.dtype), v)


def stick_breaking_blocks(q, k, v):
    bsz, t, nh, hd = q.shape
    nb = t // Q_BLOCK
    qb = jnp.moveaxis(q.reshape(bsz, nb, Q_BLOCK, nh, hd), 1, 0)
    k_pos = jnp.arange(t)

    def one_block(args):
        q_blk, i = args
        q_pos = i * Q_BLOCK + jnp.arange(Q_BLOCK)
        return stick_breaking(q_blk, k, v, q_pos, k_pos)

    out = lax.map(one_block, (qb, jnp.arange(nb)))
    return jnp.moveaxis(out, 0, 1).reshape(bsz, t, nh, hd)


def chunk_mlp(u, v, ws, bs, ln_w, ln_b):
    bsz, t, _ = u.shape
    vn = layernorm(v, ln_w, ln_b)
    clen = min(t, C_CHUNK)
    nc = t // clen
    mask = jnp.tril(jnp.ones((clen, clen), dtype=bool))
    wm = jnp.where(mask, ws[:, :clen, :clen], 0.0)
    vg = vn.reshape(bsz, nc, clen, C_GROUPS, C_GROUP_DIM)
    s = jnp.einsum('gts,bcsgd->bctgd', wm.astype(vg.dtype), vg) + bs[:, :clen].T[None, None, :, :, None]
    return u * s.reshape(bsz, t, BRANCH_W), vn


def memory_kv(mem, g, w_kv):
    bsz, n_mem, _ = mem.shape
    kv = rmsnorm(mem, g) @ w_kv
    k, v = jnp.split(kv, 2, axis=-1)
    shp = (bsz, n_mem, M_HEADS, M_HEAD_DIM)
    return k.reshape(shp), v.reshape(shp)


def memory_attend(q, mk, mv):
    s = jnp.einsum('bthd,bmhd->bhtm', q, mk).astype(jnp.float32) / math.sqrt(M_HEAD_DIM)
    p = jax.nn.softmax(s, axis=-1)
    return jnp.einsum('bhtm,bmhd->bthd', p.astype(mv.dtype), mv)


def trunk_layer(x, mem_k, mem_v, shift_prev, s_prev, past_k, past_v, p):
    bsz, t, _ = x.shape
    h = rmsnorm(x, p['g_pre'])
    proj = h @ p['w_in']
    pa, a_z, b_q, b_k, b_v, b_z, c_u, c_v, c_z, m_q = jnp.split(proj, IN_SPLITS[4:], axis=-1)

    o_a, shift_new, s_new = rwkv7_branch(pa, a_z, shift_prev, s_prev, p['a_mu'], p['a_w0'], p['a_w_up'],
                                         p['a_a0'], p['a_a_up'], p['a_k_k'], p['a_k_a'], p['a_r_k'],
                                         p['a_gn_w'], p['a_gn_b'])

    bh = lambda u: u.reshape(bsz, t, B_HEADS, B_HEAD_DIM)
    q, k_new, v_new = bh(b_q), bh(b_k), bh(b_v)
    if past_k is None:
        o_b = stick_breaking_blocks(q, k_new, v_new)
    else:
        n_past = past_k.shape[1]
        k_all = jnp.concatenate([past_k.astype(k_new.dtype), k_new], axis=1)
        v_all = jnp.concatenate([past_v.astype(v_new.dtype), v_new], axis=1)
        o_b = stick_breaking(q, k_all, v_all, n_past + jnp.arange(t), jnp.arange(n_past + t))
    o_b = o_b.reshape(bsz, t, BRANCH_W) * jax.nn.silu(b_z)

    o_c, vn_c = chunk_mlp(c_u, c_v, p['c_ws'], p['c_bs'], p['c_ln_w'], p['c_ln_b'])
    o_c = o_c * jax.nn.silu(c_z)

    o_m = memory_attend(m_q.reshape(bsz, t, M_HEADS, M_HEAD_DIM), mem_k.astype(x.dtype),
                        mem_v.astype(x.dtype)).reshape(bsz, t, BRANCH_W)

    branches = (o_a, o_b, o_c, o_m)
    merged = sum(jax.nn.sigmoid(h @ p['w_gate'][n] + p['b_gate'][n]) * (o @ p['w_br'][n])
                 for n, o in enumerate(branches))
    out = merged @ p['w_out']
    x = x + rmsnorm(out, p['g_post'])
    return x, shift_new, s_new, k_new, v_new, vn_c


def setup_inputs(seed: int = 0) -> dict:
    key = jax.random.key(seed)
    ks = iter(jax.random.split(key, 40))
    f32 = jnp.float32
    nrm = lambda shape, scale: scale * jax.random.normal(next(ks), shape, f32)
    uni = lambda shape, lo, hi: jax.random.uniform(next(ks), shape, f32, lo, hi)
    W = BRANCH_W
    L = DEPTH
    inp = {}
    inp['x_prompt'] = nrm((BATCH, SEQ, D_MODEL), 1.0)
    inp['x_sample'] = nrm((DEC_BATCH, DEC_SEQ, D_MODEL), 1.0)
    inp['cache_mem_k'] = nrm((L, DEC_BATCH, N_MEM, M_HEADS, M_HEAD_DIM), 1.0)
    inp['cache_mem_v'] = nrm((L, DEC_BATCH, N_MEM, M_HEADS, M_HEAD_DIM), 1.0)
    inp['cache_sb_k'] = nrm((L, DEC_BATCH, PAST_LEN, B_HEADS, B_HEAD_DIM), 1.0)
    inp['cache_sb_v'] = nrm((L, DEC_BATCH, PAST_LEN, B_HEADS, B_HEAD_DIM), 1.0)
    inp['state_rwkv'] = nrm((L, DEC_BATCH, A_HEADS, A_HEAD_DIM, A_HEAD_DIM), 0.5)
    inp['state_shift'] = nrm((L, DEC_BATCH, 1, A_SHIFT_W), 1.0)
    inp['mem_prompt'] = nrm((BATCH, N_MEM, D_MODEL), 1.0)
    inp['g_pre'] = 1.0 + nrm((L, D_MODEL), 0.02)
    inp['g_post'] = 1.0 + nrm((L, D_MODEL), 0.02)
    inp['w_in'] = nrm((L, D_MODEL, N_IN), D_MODEL ** -0.5)
    inp['a_mu'] = uni((L, A_SHIFT_W), 0.0, 1.0)
    inp['a_w0'] = uni((L, W), -5.0, 0.0)
    inp['a_w_up'] = nrm((L, A_LORA_W, W), 0.1 * A_LORA_W ** -0.5)
    inp['a_a0'] = nrm((L, W), 0.1)
    inp['a_a_up'] = nrm((L, A_LORA_A, W), 0.5 * A_LORA_A ** -0.5)
    inp['a_k_k'] = 0.85 + nrm((L, A_HEADS, A_HEAD_DIM), 0.05)
    inp['a_k_a'] = 1.0 + nrm((L, A_HEADS, A_HEAD_DIM), 0.05)
    inp['a_r_k'] = nrm((L, A_HEADS, A_HEAD_DIM), 0.1)
    inp['a_gn_w'] = 1.0 + nrm((L, A_HEADS, A_HEAD_DIM), 0.02)
    inp['a_gn_b'] = nrm((L, A_HEADS, A_HEAD_DIM), 0.02)
    inp['c_ws'] = nrm((L, C_GROUPS, C_CHUNK, C_CHUNK), C_CHUNK ** -0.5)
    inp['c_bs'] = 1.0 + nrm((L, C_GROUPS, C_CHUNK), 0.02)
    inp['c_ln_w'] = 1.0 + nrm((L, W), 0.02)
    inp['c_ln_b'] = nrm((L, W), 0.02)
    inp['g_mem'] = 1.0 + nrm((L, D_MODEL), 0.02)
    inp['w_mem_kv'] = nrm((L, D_MODEL, 2 * W), D_MODEL ** -0.5)
    inp['w_gate'] = nrm((L, N_BRANCH, D_MODEL, D_MODEL), D_MODEL ** -0.5)
    inp['b_gate'] = nrm((L, N_BRANCH, D_MODEL), 0.02)
    inp['w_br'] = nrm((L, N_BRANCH, W, D_MODEL), W ** -0.5)
    inp['w_out'] = nrm((L, D_MODEL, D_MODEL), D_MODEL ** -0.5)
    return inp


def reference(x_prompt, x_sample, cache_mem_k, cache_mem_v, cache_sb_k, cache_sb_v, state_rwkv,
              state_shift, mem_prompt, g_pre, g_post, w_in, a_mu, a_w0, a_w_up, a_a0, a_a_up, a_k_k,
              a_k_a, a_r_k, a_gn_w, a_gn_b, c_ws, c_bs, c_ln_w, c_ln_b, g_mem, w_mem_kv, w_gate,
              b_gate, w_br, w_out):
    bp = x_prompt.shape[0]
    yp, ys = x_prompt, x_sample
    mem_k_p, mem_v_p, sbk_p, sbv_p, rw_p, sh_p = [], [], [], [], [], []
    sbk_s, sbv_s, rw_s, sh_s, cv_s = [], [], [], [], []
    for l in range(DEPTH):
        lp = {'g_pre': g_pre[l], 'g_post': g_post[l], 'w_in': w_in[l], 'a_mu': a_mu[l],
              'a_w0': a_w0[l], 'a_w_up': a_w_up[l], 'a_a0': a_a0[l], 'a_a_up': a_a_up[l],
              'a_k_k': a_k_k[l], 'a_k_a': a_k_a[l], 'a_r_k': a_r_k[l], 'a_gn_w': a_gn_w[l],
              'a_gn_b': a_gn_b[l], 'c_ws': c_ws[l], 'c_bs': c_bs[l], 'c_ln_w': c_ln_w[l],
              'c_ln_b': c_ln_b[l], 'w_gate': w_gate[l], 'b_gate': b_gate[l], 'w_br': w_br[l],
              'w_out': w_out[l]}
        mk, mv = memory_kv(mem_prompt, g_mem[l], w_mem_kv[l])
        shift0 = jnp.zeros((bp, 1, A_SHIFT_W), yp.dtype)
        s0 = jnp.zeros((bp, A_HEADS, A_HEAD_DIM, A_HEAD_DIM), jnp.float32)
        yp, sh, st, kn, vn, _ = trunk_layer(yp, mk, mv, shift0, s0, None, None, lp)
        mem_k_p.append(mk); mem_v_p.append(mv); sbk_p.append(kn); sbv_p.append(vn)
        rw_p.append(st); sh_p.append(sh)
        ys, sh, st, kn, vn, cvn = trunk_layer(ys, cache_mem_k[l], cache_mem_v[l], state_shift[l],
                                              state_rwkv[l], cache_sb_k[l], cache_sb_v[l], lp)
        sbk_s.append(kn); sbv_s.append(vn); rw_s.append(st); sh_s.append(sh); cv_s.append(cvn)
    return (yp, ys,
            jnp.stack(mem_k_p), jnp.stack(mem_v_p), jnp.stack(sbk_p), jnp.stack(sbv_p),
            jnp.stack(rw_p), jnp.stack(sh_p),
            jnp.stack(sbk_s), jnp.stack(sbv_s), jnp.stack(rw_s), jnp.stack(sh_s), jnp.stack(cv_s))
```

```cpp
#include <hip/hip_runtime.h>
#include <cstdio>
#include <cstdint>
namespace pg8 {
#define PG8_LAS __attribute__((address_space(3)))
typedef unsigned short bf16_t;
typedef short bf16x8 __attribute__((ext_vector_type(8)));
typedef float f32x4 __attribute__((ext_vector_type(4)));
typedef unsigned u32x4 __attribute__((ext_vector_type(4)));
constexpr int BM = 256, BK = 64, HALF = 128, HTB = HALF * BK * 2  , STAGE_BYTES = 8 * HTB, NXCD = 8, WGM = 8;

__host__ __device__ __forceinline__ int lds_byte(int r, int c) { const int st = (r >> 4) * 2 + (c >> 5), rr = r & 15, cc = c & 31, ob = rr * 64 + cc * 2; return st * 1024 + (ob ^ (((ob >> 9) & 1) << 5)); }
__host__ __device__ __forceinline__ void stage_rc(int b, int& R, int& C) { const int st = b / 1024, sb = b % 1024, swz = sb ^ (((sb >> 9) & 1) << 5); R = (st >> 1) * 16 + swz / 64; C = (st & 1) * 32 + (swz % 64) / 2; }
__host__ __device__ __forceinline__ int perm32(int rho) { const int n = rho >> 4, i = rho & 15; return 8 * (i >> 2) + 4 * n + (i & 3); }

struct Unit { int pm, pn; };
struct Gemm { const bf16_t* A; const bf16_t* Bt; int M, N, K; };

__device__ __forceinline__ unsigned cvt_pk_bf16(float lo, float hi) { unsigned r; asm volatile("v_cvt_pk_bf16_f32 %0, %1, %2" : "=v"(r) : "v"(lo), "v"(hi)); return r; }
typedef float f32x2 __attribute__((ext_vector_type(2)));
typedef unsigned u32x2 __attribute__((ext_vector_type(2)));
struct StaticOrder {
    int nM, nN, nwg, G, c;
    __host__ __device__ void init(int M, int N, int G_, int c_) { nM = M / BM; nN = N / BM; nwg = nM * nN; G = G_; c = c_; }
    __host__ __device__ __forceinline__ void tile_of(int wgid, int& pm, int& pn) const {
        { const int q = nwg / NXCD, r = nwg % NXCD, xcd = wgid % NXCD, off = wgid / NXCD; wgid = (xcd < r ? xcd * (q + 1) : r * (q + 1) + (xcd - r) * q) + off; }
        const int nig = WGM * nN, gid = wgid / nig, fm = gid * WGM, gsz = (nM - fm) < WGM ? (nM - fm) : WGM;
        pm = fm + ((wgid % nig) % gsz); pn = (wgid % nig) / gsz; }
    __host__ __device__ bool next(int i, Unit& u) const { const long L = (long)i * G + c; if (L >= nwg) return false; tile_of((int)L, u.pm, u.pn); return true; }
    __device__ __forceinline__ void a_ready(const Unit&) const {}
    __device__ __forceinline__ void done(const Unit&) const {}
};
struct SkewOrder : StaticOrder {
    int nslow, rs;
    __host__ __device__ bool next(int i, Unit& u) const {
        long L;
        if (i < rs) L = (long)i * G + c; else { if (c < nslow) return false; L = (long)rs * G + (long)(i - rs) * (G - nslow) + (c - nslow); }
        if (L >= nwg) return false; tile_of((int)L, u.pm, u.pn); return true; }
};
struct BranchOrder : StaticOrder {
    int mtiles, ntiles;
    __host__ __device__ bool next(int i, Unit& u) const { const long L = (long)(i >> 2) * G + c; if (L >= nwg) return false; int pm, pn; tile_of((int)L, pm, pn); const int n = i & 3; u.pm = n * mtiles + pm; u.pn = n * ntiles + pn; return true; }
};
struct MemOrder {
    int G, c;
    __host__ __device__ bool next(int i, Unit& u) const { const long L = (long)i * G + c; if (L >= 128) return false; const int l = (int)L >> 6, t = (int)L & 63; u.pm = l * 8 + (t >> 3); u.pn = l * 8 + (t & 7); return true; }
    __device__ __forceinline__ void a_ready(const Unit&) const {}
    __device__ __forceinline__ void done(const Unit&) const {}
};

struct EpiBf16 {
    static constexpr bool PERM = true, AFTER_DRAIN = false;
    bf16_t* O; int ldc;
    __device__ __forceinline__ void operator()(const f32x4 (&acc)[2][2][4][2], const Unit& u, int wr, int wc, int fr, int fq) const {
        const int row0 = u.pm * BM + wr * 64 + fr, col0 = u.pn * BM + wc * 32 + 8 * fq;
#pragma unroll
        for (int ai = 0; ai < 2; ++ai)
#pragma unroll
            for (int m = 0; m < 4; ++m) { bf16_t* rowp = O + (size_t)(row0 + ai * HALF + m * 16) * ldc + col0;
#pragma unroll
                for (int bj = 0; bj < 2; ++bj) { const f32x4 v0 = acc[ai][bj][m][0], v1 = acc[ai][bj][m][1];
                    u32x4 w; w.x = cvt_pk_bf16(v0[0], v0[1]); w.y = cvt_pk_bf16(v0[2], v0[3]); w.z = cvt_pk_bf16(v1[0], v1[1]); w.w = cvt_pk_bf16(v1[2], v1[3]);
                    *(u32x4*)(rowp + bj * HALF) = w; } }
    }
};
struct EpiF32 {
    static constexpr bool PERM = false, AFTER_DRAIN = false;
    float* C; int ldc;
    __device__ __forceinline__ void operator()(const f32x4 (&acc)[2][2][4][2], const Unit& u, int wr, int wc, int fr, int fq) const {
        const int row0 = u.pm * BM + wr * 64 + fr, col0 = u.pn * BM + wc * 32 + 4 * fq;
#pragma unroll
        for (int ai = 0; ai < 2; ++ai)
#pragma unroll
            for (int m = 0; m < 4; ++m) { float* rowp = C + (size_t)(row0 + ai * HALF + m * 16) * ldc + col0;
#pragma unroll
                for (int bj = 0; bj < 2; ++bj)
#pragma unroll
                    for (int n = 0; n < 2; ++n) *(f32x4*)(rowp + bj * HALF + n * 16) = acc[ai][bj][m][n]; }
    }
};
struct EpiMemKV {
    static constexpr bool PERM = false, AFTER_DRAIN = false;
    float* outk; size_t voff;
    __device__ __forceinline__ void operator()(const f32x4 (&acc)[2][2][4][2], const Unit& u, int wr, int wc, int fr, int fq) const {
        const int l = u.pm >> 3, pm = u.pm & 7, pn = u.pn & 7;
        float* base = outk + (size_t)(pn >> 2) * voff + (size_t)l * 2048 * 1024;
        const int row0 = pm * BM + wr * 64 + fr, col0 = (pn & 3) * BM + wc * 32 + 4 * fq;
#pragma unroll
        for (int ai = 0; ai < 2; ++ai)
#pragma unroll
            for (int m = 0; m < 4; ++m) { float* rowp = base + (size_t)(row0 + ai * HALF + m * 16) * 1024 + col0;
#pragma unroll
                for (int bj = 0; bj < 2; ++bj)
#pragma unroll
                    for (int n = 0; n < 2; ++n) *(f32x4*)(rowp + bj * HALF + n * 16) = acc[ai][bj][m][n]; }
    }
};
__device__ __forceinline__ unsigned sig8(float v, float b) { const float s = __builtin_amdgcn_rcpf(1.0f + __builtin_amdgcn_exp2f(-(v + b) * 1.4426950408889634f)); return (unsigned)(s * 255.0f + 0.5f); }
struct EpiGate8 {
    static constexpr bool PERM = true, AFTER_DRAIN = false;
    unsigned char* G; int ldc; const float* bias;
    __device__ __forceinline__ void operator()(const f32x4 (&acc)[2][2][4][2], const Unit& u, int wr, int wc, int fr, int fq) const {
        const int row0 = u.pm * BM + wr * 64 + fr, col0 = u.pn * BM + wc * 32 + 8 * fq;
#pragma unroll
        for (int bj = 0; bj < 2; ++bj) { const f32x4 b0 = *(const f32x4*)(bias + col0 + bj * HALF), b1 = *(const f32x4*)(bias + col0 + bj * HALF + 4);
#pragma unroll
            for (int ai = 0; ai < 2; ++ai)
#pragma unroll
                for (int m = 0; m < 4; ++m) { unsigned char* rowp = G + (size_t)(row0 + ai * HALF + m * 16) * ldc + col0;
                    const f32x4 v0 = acc[ai][bj][m][0], v1 = acc[ai][bj][m][1];
                    u32x2 w;
                    w.x = sig8(v0[0], b0[0]) | (sig8(v0[1], b0[1]) << 8) | (sig8(v0[2], b0[2]) << 16) | (sig8(v0[3], b0[3]) << 24);
                    w.y = sig8(v1[0], b1[0]) | (sig8(v1[1], b1[1]) << 8) | (sig8(v1[2], b1[2]) << 16) | (sig8(v1[3], b1[3]) << 24);
                    *(u32x2*)(rowp + bj * HALF) = w; } }
    }
};
struct EpiBranch {
    static constexpr bool PERM = true, AFTER_DRAIN = false;
    const unsigned char* G; float* part; bf16_t* merged; int mtiles, ntiles;
    __device__ __forceinline__ void operator()(const f32x4 (&acc)[2][2][4][2], const Unit& u, int wr, int wc, int fr, int fq) const {
        const int n = u.pn / ntiles, pm = u.pm - n * mtiles, pn = u.pn - n * ntiles;
        const int row0 = pm * BM + wr * 64 + fr, col0 = pn * BM + wc * 32 + 8 * fq;
#pragma unroll
        for (int ai = 0; ai < 2; ++ai)
#pragma unroll
            for (int m = 0; m < 4; ++m) { const size_t row = (size_t)(row0 + ai * HALF + m * 16);
#pragma unroll
                for (int bj = 0; bj < 2; ++bj) { const int col = col0 + bj * HALF;
                    const u32x2 g = *(const u32x2*)(G + row * (size_t)(4 * 4096) + (size_t)n * 4096 + col);
                    f32x4 g0, g1; const float k = 1.0f / 255.0f;
                    g0[0] = (float)(g.x & 255u) * k; g0[1] = (float)((g.x >> 8) & 255u) * k; g0[2] = (float)((g.x >> 16) & 255u) * k; g0[3] = (float)(g.x >> 24) * k;
                    g1[0] = (float)(g.y & 255u) * k; g1[1] = (float)((g.y >> 8) & 255u) * k; g1[2] = (float)((g.y >> 16) & 255u) * k; g1[3] = (float)(g.y >> 24) * k;
                    f32x4 v0 = acc[ai][bj][m][0] * g0, v1 = acc[ai][bj][m][1] * g1;
                    float* pp = part + row * 4096 + col;
                    if (n > 0) { v0 += *(const f32x4*)pp; v1 += *(const f32x4*)(pp + 4); }
                    if (n < 3) { *(f32x4*)pp = v0; *(f32x4*)(pp + 4) = v1; }
                    else { u32x4 w; w.x = cvt_pk_bf16(v0[0], v0[1]); w.y = cvt_pk_bf16(v0[2], v0[3]); w.z = cvt_pk_bf16(v1[0], v1[1]); w.w = cvt_pk_bf16(v1[2], v1[3]);
                        *(u32x4*)(merged + row * 4096 + col) = w; } } }
    }
};
template <class Epi, class Sched, bool ALIGN_EPI = false, bool SP2 = false>
__device__ __forceinline__ void gemm_phase(PG8_LAS unsigned char* lds, const Gemm g, const Sched& S, const Epi& E) {
    int tid_l = threadIdx.x; asm volatile("" : "+v"(tid_l));
    const int tid = tid_l, wid = __builtin_amdgcn_readfirstlane(tid >> 6), lane = tid & 63, wr = wid >> 2, wc = wid & 3, fr = lane & 15, fq = lane >> 4;
    const int K = g.K, nt = K / BK;
    unsigned voffA[2], voffB[2];
#pragma unroll
    for (int i = 0; i < 2; ++i) { int R, C; stage_rc(tid * 16 + i * 8192, R, C); const int Rb = Epi::PERM ? ((R & ~31) + perm32(R & 31)) : R;
        voffA[i] = (unsigned)(R * K + C) * 2u; voffB[i] = (unsigned)(Rb * K + C) * 2u; }
    const size_t kstep = (size_t)(BK * 2);
    const size_t hstep = (size_t)HALF * K * 2;
    const size_t tstep = 2 * hstep;
    const unsigned ldsw = (unsigned)wid * 1024u;
    const int aoff = lds_byte(wr * 64 + fr, fq * 8), boff = lds_byte(wc * 32 + fr, fq * 8);
#define PG8_SA(b, h) (((b) * 2 + (h)) * HTB)
#define PG8_SB(b, h) ((4 + (b) * 2 + (h)) * HTB)
#define PG8_STAGE(bufoff, gbase, voff) do { _Pragma("unroll") for (int _i = 0; _i < 2; ++_i) \
        __builtin_amdgcn_global_load_lds((const unsigned*)((const char*)(gbase) + (voff)[_i]), (PG8_LAS unsigned*)(lds + (bufoff) + ldsw + _i * 8192), 16, 0, 0); } while (0)
#define PG8_LDA(dst, b, h) do { _Pragma("unroll") for (int m = 0; m < 4; ++m) _Pragma("unroll") for (int k = 0; k < 2; ++k) dst[m][k] = *(const PG8_LAS bf16x8*)(lds + PG8_SA(b, h) + aoff + m * 2048 + k * 1024); } while (0)
#define PG8_LDB(dst, b, h) do { _Pragma("unroll") for (int n = 0; n < 2; ++n) _Pragma("unroll") for (int k = 0; k < 2; ++k) dst[n][k] = *(const PG8_LAS bf16x8*)(lds + PG8_SB(b, h) + boff + n * 2048 + k * 1024); } while (0)
#define PG8_MMA(ai, bj, At, Bt) do { __builtin_amdgcn_s_setprio(1); _Pragma("unroll") for (int m = 0; m < 4; ++m) _Pragma("unroll") for (int n = 0; n < 2; ++n) _Pragma("unroll") for (int k = 0; k < 2; ++k) \
        acc[ai][bj][m][n] = __builtin_amdgcn_mfma_f32_16x16x32_bf16(Bt[n][k], At[m][k], acc[ai][bj][m][n], 0, 0, 0); __builtin_amdgcn_s_setprio(0); } while (0)
#define PG8_WAIT_V(n) asm volatile("s_waitcnt vmcnt(" #n ")" ::: "memory")
#define PG8_WAIT_L(n) asm volatile("s_waitcnt lgkmcnt(" #n ")" ::: "memory")
#define PG8_BAR __builtin_amdgcn_s_barrier()
#define PG8_SCHED __builtin_amdgcn_sched_barrier(0)
    Unit cur, nxt; int ui = 0;
    if (!S.next(0, cur)) return;
    f32x4 acc[2][2][4][2];
#pragma unroll
    for (int a = 0; a < 2; ++a)
#pragma unroll
        for (int b = 0; b < 2; ++b)
#pragma unroll
            for (int m = 0; m < 4; ++m)
#pragma unroll
                for (int n = 0; n < 2; ++n) acc[a][b][m][n] = (f32x4){0.f, 0.f, 0.f, 0.f};
    bf16x8 At[4][2], B0[2][2], B1[2][2];
    const char* cA = (const char*)g.A + (size_t)cur.pm * tstep; const char* cB = (const char*)g.Bt + (size_t)cur.pn * tstep;
    S.a_ready(cur);
    if constexpr (SP2) {
        PG8_STAGE(PG8_SB(0, 0), cB, voffB); PG8_STAGE(PG8_SB(0, 1), cB + hstep, voffB); PG8_STAGE(PG8_SA(0, 0), cA, voffA); PG8_STAGE(PG8_SA(0, 1), cA + hstep, voffA);
        if (wr == 1) PG8_BAR;
        PG8_WAIT_V(2); PG8_BAR;
        PG8_STAGE(PG8_SB(1, 0), cB + kstep, voffB); PG8_STAGE(PG8_SA(1, 0), cA + kstep, voffA); PG8_STAGE(PG8_SB(1, 1), cB + hstep + kstep, voffB);
        PG8_WAIT_V(6); PG8_BAR;
    } else {
        PG8_STAGE(PG8_SB(0, 0), cB, voffB); PG8_STAGE(PG8_SA(0, 0), cA, voffA); PG8_STAGE(PG8_SB(0, 1), cB + hstep, voffB); PG8_STAGE(PG8_SA(0, 1), cA + hstep, voffA);
        if (wr == 1) PG8_BAR;
        PG8_WAIT_V(4); PG8_BAR;
        PG8_STAGE(PG8_SB(1, 0), cB + kstep, voffB); PG8_STAGE(PG8_SA(1, 0), cA + kstep, voffA); PG8_STAGE(PG8_SB(1, 1), cB + hstep + kstep, voffB);
        PG8_WAIT_V(6); PG8_BAR;
    }
    for (;;) {
        const bool has_next = S.next(ui + 1, nxt);
        const char* nA = has_next ? (const char*)g.A + (size_t)nxt.pm * tstep : cA; const char* nB = has_next ? (const char*)g.Bt + (size_t)nxt.pn * tstep : cB;
        for (int t = 0; t < nt; t += 2) {
            const bool last = (t == nt - 2);
            const char* a1 = cA + (size_t)(t + 1) * kstep;
            const char* a2 = last ? nA : cA + (size_t)(t + 2) * kstep; const char* b2 = last ? nB : cB + (size_t)(t + 2) * kstep;
            const char* a3 = a2 + kstep; const char* b3 = b2 + kstep;
            if (last && has_next) S.a_ready(nxt);
            if constexpr (SP2) {
            PG8_LDB(B0, 0, 0); PG8_LDB(B1, 0, 1); PG8_SCHED; PG8_LDA(At, 0, 0); PG8_STAGE(PG8_SA(1, 1), a1 + hstep, voffA);
            PG8_WAIT_V(8); PG8_WAIT_L(0); PG8_BAR; PG8_MMA(0, 0, At, B0); PG8_MMA(0, 1, At, B1); PG8_BAR; PG8_SCHED;
            PG8_LDA(At, 0, 1); PG8_STAGE(PG8_SB(0, 0), b2, voffB); PG8_STAGE(PG8_SB(0, 1), b2 + hstep, voffB); PG8_STAGE(PG8_SA(0, 0), a2, voffA);
            PG8_WAIT_V(8); PG8_WAIT_L(0); PG8_BAR; PG8_MMA(1, 0, At, B0); PG8_MMA(1, 1, At, B1); PG8_BAR; PG8_SCHED;
            PG8_LDB(B0, 1, 0); PG8_LDB(B1, 1, 1); PG8_SCHED; PG8_LDA(At, 1, 0); PG8_STAGE(PG8_SA(0, 1), a2 + hstep, voffA);
            PG8_WAIT_V(8); PG8_WAIT_L(0); PG8_BAR; PG8_MMA(0, 0, At, B0); PG8_MMA(0, 1, At, B1); PG8_BAR; PG8_SCHED;
            PG8_LDA(At, 1, 1); PG8_STAGE(PG8_SB(1, 0), b3, voffB); PG8_STAGE(PG8_SB(1, 1), b3 + hstep, voffB); PG8_STAGE(PG8_SA(1, 0), a3, voffA);
            PG8_WAIT_V(8); PG8_WAIT_L(0); PG8_BAR; PG8_MMA(1, 0, At, B0); PG8_MMA(1, 1, At, B1); PG8_BAR; PG8_SCHED;
            } else {
            PG8_LDB(B0, 0, 0); PG8_SCHED; PG8_LDA(At, 0, 0); PG8_STAGE(PG8_SA(1, 1), a1 + hstep, voffA);
            PG8_WAIT_L(8); PG8_BAR; PG8_WAIT_L(0); PG8_MMA(0, 0, At, B0); PG8_BAR; PG8_SCHED;
            PG8_LDB(B1, 0, 1); PG8_STAGE(PG8_SB(0, 0), b2, voffB);
            PG8_BAR; PG8_WAIT_L(0); PG8_MMA(0, 1, At, B1); PG8_BAR;
            PG8_LDA(At, 0, 1); PG8_STAGE(PG8_SA(0, 0), a2, voffA);
            PG8_BAR; PG8_WAIT_L(0); PG8_MMA(1, 0, At, B0); PG8_BAR; PG8_SCHED;
            PG8_STAGE(PG8_SB(0, 1), b2 + hstep, voffB);
            PG8_WAIT_V(6); PG8_BAR; PG8_MMA(1, 1, At, B1); PG8_BAR;
            PG8_LDB(B0, 1, 0); PG8_SCHED; PG8_LDA(At, 1, 0); PG8_STAGE(PG8_SA(0, 1), a2 + hstep, voffA);
            PG8_WAIT_L(8); PG8_BAR; PG8_WAIT_L(0); PG8_MMA(0, 0, At, B0); PG8_BAR; PG8_SCHED;
            PG8_LDB(B1, 1, 1); PG8_STAGE(PG8_SB(1, 0), b3, voffB);
            PG8_BAR; PG8_WAIT_L(0); PG8_MMA(0, 1, At, B1); PG8_BAR;
            PG8_LDA(At, 1, 1); PG8_STAGE(PG8_SA(1, 0), a3, voffA);
            PG8_BAR; PG8_WAIT_L(0); PG8_MMA(1, 0, At, B0); PG8_BAR; PG8_SCHED;
            PG8_STAGE(PG8_SB(1, 1), b3 + hstep, voffB);
            PG8_WAIT_V(6); PG8_BAR; PG8_MMA(1, 1, At, B1); PG8_BAR;
            }
        }
        if constexpr (ALIGN_EPI) { if (wr == 0) PG8_BAR; }
        if constexpr (!Epi::AFTER_DRAIN) { E(acc, cur, wr, wc, fr, fq); S.done(cur); }
        if (!has_next) break;
#pragma unroll
        for (int a = 0; a < 2; ++a)
#pragma unroll
            for (int b = 0; b < 2; ++b)
#pragma unroll
                for (int m = 0; m < 4; ++m)
#pragma unroll
                    for (int n = 0; n < 2; ++n) acc[a][b][m][n] = (f32x4){0.f, 0.f, 0.f, 0.f};
        cur = nxt; cA = nA; cB = nB; ++ui;
        if constexpr (ALIGN_EPI) { if (wr == 1) PG8_BAR; }
    }
    PG8_WAIT_V(0);
    if constexpr (!ALIGN_EPI) { if (wr == 0) PG8_BAR; }
    PG8_BAR;
    if constexpr (Epi::AFTER_DRAIN) { E.fused(acc, cur, wr, wc, fr, fq, lds, wid, lane); S.done(cur); }
#undef PG8_SA
#undef PG8_SB
#undef PG8_STAGE
#undef PG8_LDA
#undef PG8_LDB
#undef PG8_MMA
#undef PG8_WAIT_V
#undef PG8_WAIT_L
#undef PG8_BAR
#undef PG8_SCHED
}
}
#define GAS __attribute__((address_space(1)))
#define LAS __attribute__((address_space(3)))
typedef unsigned short bf16;
typedef unsigned v4u __attribute__((ext_vector_type(4)));
typedef float f32x4 __attribute__((ext_vector_type(4)));
typedef short bf16x8 __attribute__((ext_vector_type(8)));
typedef GAS unsigned gu32;
typedef GAS unsigned long long gu64;
#define RLX_AGENT __ATOMIC_RELAXED, __HIP_MEMORY_SCOPE_AGENT
#define LDS_WAIT() asm volatile("s_waitcnt lgkmcnt(0)" ::: "memory")
#define VM_WAIT() asm volatile("s_waitcnt vmcnt(0)" ::: "memory")
__device__ __forceinline__ unsigned long long rt() { return __builtin_amdgcn_s_memrealtime(); }
__device__ __forceinline__ unsigned f2bf(float f) { unsigned u = __builtin_bit_cast(unsigned, f); return (u + 0x7fffu + ((u >> 16) & 1u)) >> 16; }
__device__ __forceinline__ unsigned pk2(float lo, float hi) { return f2bf(lo) | (f2bf(hi) << 16); }

#define XB_TMO      128
#define XB_XCNT(j)  (256  + 64 * (j))
#define XB_XSUB(j)  (1280 + 64 * (j))
#define XB_XGEN(j)  (2304 + 64 * (j))
#define XB_TOP      3328
#define XB_TOPGEN   3392
#define XCD_BAR_WORDS 3456
#define XB_SPIN_CAP (1u << 18)

__device__ __forceinline__ unsigned xb_ld(unsigned* p)              { return __hip_atomic_load(p, __ATOMIC_RELAXED, __HIP_MEMORY_SCOPE_AGENT); }
__device__ __forceinline__ unsigned xb_add(unsigned* p, unsigned v) { return __hip_atomic_fetch_add(p, v, __ATOMIC_RELAXED, __HIP_MEMORY_SCOPE_AGENT); }
__device__ __forceinline__ unsigned xb_xcc_id() { return (unsigned)__builtin_amdgcn_s_getreg((3 << 11) | 20) & 0xFu; }
#define XB_SPIN(cond, bar) do { unsigned _sp = 0; while (cond) { __builtin_amdgcn_s_sleep(1); \
    if ((++_sp & 255u) == 0u) { if (xb_ld(&(bar)[XB_TMO])) break; if (_sp > XB_SPIN_CAP) { atomicAdd(&(bar)[XB_TMO], 1u); break; } } } } while (0)

struct XcdBarrier {
    unsigned* bar; unsigned x;
    volatile LAS unsigned* st;
};

__device__ __forceinline__ XcdBarrier xcd_barrier_post(unsigned* bar, volatile LAS unsigned* st) {
    XcdBarrier b; b.bar = bar; b.x = xb_xcc_id(); b.st = st;
    if (threadIdx.x == 0) (void)xb_add(&bar[XB_XCNT(b.x)], 1u);
    return b;
}
__device__ __forceinline__ void xcd_barrier_complete(unsigned* bar, unsigned x, unsigned& nloc, unsigned& nx) {
    const unsigned G = gridDim.x * gridDim.y * gridDim.z;
    unsigned sum, cnt, mine, sp = 0u;
    for (;;) {
        sum = 0u; cnt = 0u; mine = 0u;
#pragma unroll
        for (unsigned j = 0; j < 16; ++j) { const unsigned c = xb_ld(&bar[XB_XCNT(j)]); sum += c; cnt += (c > 0u) ? 1u : 0u; mine = (j == x) ? c : mine; }
        if (sum == G) break;
        __builtin_amdgcn_s_sleep(1);
        if ((++sp & 255u) == 0u) { if (xb_ld(&bar[XB_TMO])) break; if (sp > XB_SPIN_CAP) { atomicAdd(&bar[XB_TMO], 1u); break; } }
    }
    nloc = mine > 0u ? mine : 1u; nx = cnt > 0u ? cnt : 1u;
}

__device__ __forceinline__ void xcd_barrier(const XcdBarrier& b) {
    asm volatile("s_waitcnt vmcnt(0)" ::: "memory");
    __syncthreads();
    if (threadIdx.x == 0) {
        unsigned* bar = b.bar;
        __builtin_amdgcn_s_waitcnt(0);
        unsigned nloc = b.st[0], nx = b.st[1];
        if (nloc == 0u) { xcd_barrier_complete(bar, b.x, nloc, nx); b.st[0] = nloc; b.st[1] = nx; }
        const unsigned old = xb_add(&bar[XB_XSUB(b.x)], 1u);
        const unsigned gen = old / nloc;
        if (old + 1u == (gen + 1u) * nloc) {
            __builtin_amdgcn_fence(__ATOMIC_RELEASE, "agent");
            asm volatile("s_waitcnt vmcnt(0)" ::: "memory");
            const unsigned og = xb_add(&bar[XB_TOP], 1u);
            const unsigned tg = og / nx;
            if (og + 1u == (tg + 1u) * nx) xb_add(&bar[XB_TOPGEN], 1u);
            else XB_SPIN(xb_ld(&bar[XB_TOPGEN]) == tg, bar);
            __builtin_amdgcn_fence(__ATOMIC_ACQUIRE, "agent");
            xb_add(&bar[XB_XGEN(b.x)], 1u);
            asm volatile("s_waitcnt vmcnt(0)" ::: "memory");
        } else {
            XB_SPIN(xb_ld(&bar[XB_XGEN(b.x)]) == gen, bar);
            __builtin_amdgcn_fence(__ATOMIC_ACQUIRE, "agent");
            asm volatile("s_waitcnt vmcnt(0)" ::: "memory");
        }
    }
    __syncthreads();
}
#define DI __device__ __forceinline__
#define CAS __attribute__((address_space(4)))
typedef unsigned v2u __attribute__((ext_vector_type(2)));
typedef float f32x16 __attribute__((ext_vector_type(16)));
typedef short s16x4 __attribute__((ext_vector_type(4)));

constexpr int DM = 4096, NB = 8, SEQ = 2048, DEPTH = 2, DSEQ = 64, PAST = 1024, KCATN = PAST + DSEQ;
constexpr int NMEM = 256, BW = 1024, AH = 16, AHD = 64, SHW = 3200;
constexpr int BHN = 8, BHD = 128, CGN = 8, CGD = 128, MHN = 4, MHD = 256;
constexpr int NIN = 12416, NINP = 12544;
constexpr int MP = NB * SEQ, MS = NB * DSEQ, MT = MP + MS;
constexpr int PC_R = 0, PC_K = 1024, PC_V = 2048, PC_WD = 3072, PC_AD = 3136, PC_AZ = 3328, PC_BQ = 4352, PC_BK = 5376, PC_BV = 6400, PC_BZ = 7424,
              PC_CU = 8448, PC_CV = 9472, PC_CZ = 10496, PC_MQ = 11520;
constexpr float NORM_EPS = 1e-6f, GN_EPS = 64e-5f;
enum { I_XP = 0, I_XS, I_CMK, I_CMV, I_CSK, I_CSV, I_SRW, I_SSH, I_MEM, I_GPRE, I_GPOST, I_WIN, I_AMU, I_AW0, I_AWUP, I_AA0, I_AAUP, I_AKK, I_AKA, I_ARK,
       I_AGNW, I_AGNB, I_CWS, I_CBS, I_CLNW, I_CLNB, I_GMEM, I_WMEM, I_WGATE, I_BGATE, I_WBR, I_WOUT, N_INPUTS };
constexpr size_t O_YP = 0, O_YS = O_YP + (size_t)MP * DM, O_MK = O_YS + (size_t)MS * DM, O_MV = O_MK + (size_t)DEPTH * NB * NMEM * BW,
    O_SKP = O_MV + (size_t)DEPTH * NB * NMEM * BW, O_SVP = O_SKP + (size_t)DEPTH * MP * BW, O_RWP = O_SVP + (size_t)DEPTH * MP * BW,
    O_SHP = O_RWP + (size_t)DEPTH * NB * AH * 64 * 64, O_SKS = O_SHP + (size_t)DEPTH * NB * SHW, O_SVS = O_SKS + (size_t)DEPTH * MS * BW,
    O_RWS = O_SVS + (size_t)DEPTH * MS * BW, O_SHS = O_RWS + (size_t)DEPTH * NB * AH * 64 * 64, O_CVS = O_SHS + (size_t)DEPTH * NB * SHW,
    O_END = O_CVS + (size_t)DEPTH * MS * BW;
constexpr size_t MiB = 1u << 20;
constexpr size_t WS_CTL = 0, CTL_ZERO_BYTES = 1 * MiB;
constexpr size_t WS_WIN = 1 * MiB, WS_WG = 99 * MiB, WS_WBR = 227 * MiB, WS_WOUT = 259 * MiB, WS_WMEM = 291 * MiB;
constexpr size_t WS_H = 323 * MiB, WS_MEMN = 455 * MiB, WS_PROJ = 487 * MiB, WS_MERGED = WS_PROJ, WS_OUTF = WS_PROJ + 132 * MiB;
constexpr size_t WS_RA = 892 * MiB, WS_RB = 1222 * MiB, WS_SCANV = 1552 * MiB, WS_OALL = 1618 * MiB, WS_VT = 1750 * MiB, WS_VNT = 1782 * MiB;
constexpr size_t R_YRAW_OFF = 264 * MiB;
constexpr size_t WS_KCAT = 1816 * MiB, WS_VTCAT = 1850 * MiB, WS_MKB = 1884 * MiB, WS_MVT = 1892 * MiB, WS_CMK = 1900 * MiB, WS_CMVT = 1908 * MiB;
constexpr size_t WS_WM = 1916 * MiB, WS_BONUS = 1917 * MiB, WS_DBG = 1919 * MiB, WS_END = 1920 * MiB;
static_assert(WS_WIN + (size_t)NINP * DM * 2 <= WS_WG && WS_WG + (size_t)4 * DM * DM * 2 <= WS_WBR && WS_WBR + (size_t)4 * DM * BW * 2 <= WS_WOUT && WS_WOUT + (size_t)DM * DM * 2 <= WS_WMEM, "ws map 1");
static_assert(WS_WMEM + (size_t)DEPTH * 2 * BW * DM * 2 <= WS_H && WS_H + (size_t)MT * DM * 2 <= WS_MEMN && WS_MEMN + (size_t)DEPTH * NB * NMEM * DM * 2 <= WS_PROJ, "ws map 2");
static_assert(WS_PROJ + (size_t)MT * NINP * 2 <= WS_RA && WS_MERGED + (size_t)MT * DM * 2 <= WS_OUTF && WS_OUTF + (size_t)MT * DM * 4 <= WS_RA, "ws map 3");
static_assert(WS_RA + (size_t)MT * AH * 5 * 64 * 4 <= WS_RB && WS_RB + (size_t)MT * AH * 5 * 64 * 4 <= WS_SCANV && (size_t)MT * 4 * DM <= R_YRAW_OFF && R_YRAW_OFF + (size_t)MT * BW * 4 <= WS_RB - WS_RA, "ws map 4");
static_assert(WS_SCANV + (size_t)MT * BW * 4 <= WS_OALL && WS_OALL + (size_t)4 * MT * BW * 2 <= WS_VT && WS_VT + (size_t)MP * BW * 2 <= WS_VNT && WS_VNT + (size_t)136 * 8 * 128 * 128 * 2 <= WS_KCAT, "ws map 5");
static_assert(WS_KCAT + (size_t)DEPTH * NB * KCATN * BW * 2 <= WS_VTCAT && WS_VTCAT + (size_t)DEPTH * NB * KCATN * BW * 2 <= WS_MKB, "ws map 6");
constexpr int CW_TMO = 0, CW_BAR = 4096;
constexpr int LDS_BYTES = 147456, LDSCTL_OFF = 146944;
constexpr int NWAVES = 8, NTHR = 512, GRID = 256;
constexpr int N_PHASES = 2 + 7 * DEPTH;
#define SCAN5P(F, l) ((float*)((F).ws + (((l) & 1) ? WS_RB : WS_RA)))
#define GATESP(F, l) ((F).ws + (((l) & 1) ? WS_RA : WS_RB))
#define YRAWP(F, l) ((float*)((F).ws + (((l) & 1) ? WS_RA : WS_RB) + R_YRAW_OFF))
#define SCANVP(F) ((float*)((F).ws + WS_SCANV))
DI float wave_sum(float v) {
#pragma unroll
    for (int o = 1; o < 64; o <<= 1) v += __shfl_xor(v, o);
    return v;
}
DI float bflo(unsigned w) { return __uint_as_float(w << 16); }
DI float bfhi(unsigned w) { return __uint_as_float(w & 0xffff0000u); }
DI float bf2f(bf16 b) { return __uint_as_float(((unsigned)b) << 16); }
DI float sigmoidf_(float x) { return __builtin_amdgcn_rcpf(1.0f + __expf(-x)); }
DI float siluf_(float x) { return x * sigmoidf_(x); }
DI int crow16(int i, int h) { return (i & 3) + 8 * (i >> 2) + 4 * h; }
#define MFMA32(a, b, c) __builtin_amdgcn_mfma_f32_32x32x16_bf16((a), (b), (c), 0, 0, 0)
DI bf16x8 pack8(float a0, float a1, float a2, float a3, float a4, float a5, float a6, float a7) {
    v4u p; p.x = pk2(a0, a1); p.y = pk2(a2, a3); p.z = pk2(a4, a5); p.w = pk2(a6, a7); return __builtin_bit_cast(bf16x8, p);
}
DI void tr64_f32(const float* src, size_t lds_, bf16* dst, size_t ldd, LAS float* scr, int lane) {
#pragma unroll 4
    for (int i = 0; i < 16; ++i) { const int kk = 4 * i + (lane >> 4); const f32x4 v = *(const GAS f32x4*)(src + (size_t)kk * lds_ + 4 * (lane & 15));
        LAS float* s = scr + kk * 65 + 4 * (lane & 15); s[0] = v.x; s[1] = v.y; s[2] = v.z; s[3] = v.w; }
    LDS_WAIT(); asm volatile("" ::: "memory");
    const int c = lane & 7;
#pragma unroll
    for (int j = 0; j < 8; ++j) { const int n = (lane >> 3) + 8 * j; const LAS float* s = scr + (8 * c) * 65 + n;
        v4u o; o.x = pk2(s[0 * 65], s[1 * 65]); o.y = pk2(s[2 * 65], s[3 * 65]); o.z = pk2(s[4 * 65], s[5 * 65]); o.w = pk2(s[6 * 65], s[7 * 65]);
        *(GAS v4u*)(dst + (size_t)n * ldd + 8 * c) = o; }
    LDS_WAIT(); asm volatile("" ::: "memory");
}
DI void tr64_bf16(const bf16* src, size_t lds_, bf16* dst, size_t ldd, LAS unsigned* scr, int lane) {
#pragma unroll
    for (int i = 0; i < 8; ++i) { const int t = 8 * i + (lane >> 3); const v4u v = *(const GAS v4u*)(src + (size_t)t * lds_ + 8 * (lane & 7));
        LAS unsigned* s = scr + t * 33 + 4 * (lane & 7); s[0] = v.x; s[1] = v.y; s[2] = v.z; s[3] = v.w; }
    LDS_WAIT(); asm volatile("" ::: "memory");
    const int c = lane & 7; const LAS bf16* s16 = (const LAS bf16*)scr;
#pragma unroll
    for (int j = 0; j < 8; ++j) { const int d = (lane >> 3) + 8 * j; const LAS bf16* s = s16 + (8 * c) * 66 + d;
        v4u o; o.x = (unsigned)s[0 * 66] | ((unsigned)s[1 * 66] << 16); o.y = (unsigned)s[2 * 66] | ((unsigned)s[3 * 66] << 16);
        o.z = (unsigned)s[4 * 66] | ((unsigned)s[5 * 66] << 16); o.w = (unsigned)s[6 * 66] | ((unsigned)s[7 * 66] << 16);
        *(GAS v4u*)(dst + (size_t)d * ldd + 8 * c) = o; }
    LDS_WAIT(); asm volatile("" ::: "memory");
}
DI void rms_row_bf16(const float* xrow, const float* g, bf16* orow, int lane) {
    const GAS f32x4* xr = (const GAS f32x4*)xrow + lane; const GAS f32x4* gr = (const GAS f32x4*)g + lane;
    f32x4 v[16]; float s = 0.f;
#pragma unroll
    for (int j = 0; j < 16; ++j) { v[j] = xr[64 * j]; s += (v[j].x * v[j].x + v[j].y * v[j].y) + (v[j].z * v[j].z + v[j].w * v[j].w); }
    const float rstd = 1.0f / sqrtf(wave_sum(s) * (1.0f / DM) + NORM_EPS);
    GAS v2u* o8 = (GAS v2u*)orow + lane;
#pragma unroll
    for (int j = 0; j < 16; ++j) { const f32x4 gg = gr[64 * j]; v2u w; w.x = pk2(v[j].x * rstd * gg.x, v[j].y * rstd * gg.y); w.y = pk2(v[j].z * rstd * gg.z, v[j].w * rstd * gg.w); o8[64 * j] = w; }
}
struct P { const float* in[N_INPUTS]; float* out; unsigned char* ws; int ph_lo, ph_hi, dbg, pad; };
struct Frame {
    LAS unsigned char* lds; int tid, lane, wave, bx, G, gw, ngw;
    float* out; unsigned char* ws;
};
DI const float* xrow_in(const P& p, int row) { return row < MP ? p.in[I_XP] + (size_t)row * DM : p.in[I_XS] + (size_t)(row - MP) * DM; }

#define FOR_ITEMS(it, n, id, nid, rot) for (int it = ((id) - (rot) + (nid)) % (nid); it < (n); it += (nid))
#define ROT_ADV(rot, n, nid) rot = (int)(((long)(rot) + (long)(n)) % (nid))

DI void conv_weight(const Frame& F, const float* Wsrc, int K, int N, bf16* WT, int split_n, int split_shift, int& rot) {
    LAS float* scr = (LAS float*)(F.lds + F.wave * 16640);
    const int nb = N / 64, nitems = (K / 64) * nb;
    FOR_ITEMS(it, nitems, F.gw, F.ngw, rot) { const int kb = it / nb, n0 = (it % nb) * 64, k0 = kb * 64; const int ro = n0 + (n0 >= split_n ? split_shift : 0);
        tr64_f32(Wsrc + (size_t)k0 * N + n0, (size_t)N, WT + (size_t)ro * K + k0, (size_t)K, scr, F.lane); }
    ROT_ADV(rot, nitems, F.ngw);
}
DI void conv_layer_win(const P& p, const Frame& F, int l, int& rot) { conv_weight(F, p.in[I_WIN] + (size_t)l * DM * NIN, DM, NIN, ((bf16*)(F.ws + WS_WIN)), 3200, 128, rot); }
DI void conv_layer_wgate(const P& p, const Frame& F, int l, int& rot) { for (int n = 0; n < 4; ++n) conv_weight(F, p.in[I_WGATE] + (size_t)(l * 4 + n) * DM * DM, DM, DM, ((bf16*)(F.ws + WS_WG)) + (size_t)n * DM * DM, 1 << 30, 0, rot); }
DI void conv_layer_wbr(const P& p, const Frame& F, int l, int& rot) { for (int n = 0; n < 4; ++n) conv_weight(F, p.in[I_WBR] + (size_t)(l * 4 + n) * BW * DM, BW, DM, ((bf16*)(F.ws + WS_WBR)) + (size_t)n * DM * BW, 1 << 30, 0, rot); }
DI void conv_layer_wout(const P& p, const Frame& F, int l, int& rot) { conv_weight(F, p.in[I_WOUT] + (size_t)l * DM * DM, DM, DM, ((bf16*)(F.ws + WS_WOUT)), 1 << 30, 0, rot); }
DI void ph_prologue(const P& p, const Frame& F) {
    int rot = 0;
    conv_layer_win(p, F, 0, rot); conv_layer_wgate(p, F, 0, rot); conv_layer_wbr(p, F, 0, rot); conv_layer_wout(p, F, 0, rot);
    for (int l = 0; l < DEPTH; ++l) conv_weight(F, p.in[I_WMEM] + (size_t)l * DM * 2 * BW, DM, 2 * BW, ((bf16*)(F.ws + WS_WMEM)) + (size_t)l * 2 * BW * DM, 1 << 30, 0, rot);
    LAS float* scr = (LAS float*)(F.lds + F.wave * 16640);
    {
        const int nitems = DEPTH * NB * BHN * (PAST / 64) * (BHD / 64);
        FOR_ITEMS(it, nitems, F.gw, F.ngw, rot) { const int dt = it & 1, pt = (it >> 1) & 15, h = (it >> 5) & 7, lb = it >> 8;
            tr64_f32(p.in[I_CSV] + ((size_t)lb * PAST + pt * 64) * BW + h * BHD + dt * 64, (size_t)BW, ((bf16*)(F.ws + WS_VTCAT)) + ((size_t)(lb * BHN + h) * BHD + dt * 64) * KCATN + pt * 64, (size_t)KCATN, scr, F.lane); }
        ROT_ADV(rot, nitems, F.ngw);
    }
    {
        const int nitems = DEPTH * NB * MHN * 4 * 4;
        FOR_ITEMS(it, nitems, F.gw, F.ngw, rot) { const int dt = it & 3, mt = (it >> 2) & 3, hm = (it >> 4) & 3, lb = it >> 6;
            tr64_f32(p.in[I_CMV] + ((size_t)lb * NMEM + mt * 64) * BW + hm * MHD + dt * 64, (size_t)BW, ((bf16*)(F.ws + WS_CMVT)) + ((size_t)(lb * MHN + hm) * MHD + dt * 64) * NMEM + mt * 64, (size_t)NMEM, scr, F.lane); }
        ROT_ADV(rot, nitems, F.ngw);
    }
    const int gt = F.bx * NTHR + F.tid, ngt = F.G * NTHR;
    for (long i = gt; i < (long)DEPTH * NB * PAST * (BW / 8); i += ngt) { const int c8 = (int)(i & 127); const long r = i >> 7; const int pos = (int)(r & (PAST - 1)); const long lb = r >> 10;
        const GAS f32x4* s = (const GAS f32x4*)(p.in[I_CSK] + (size_t)r * BW + c8 * 8); const f32x4 a = s[0], b = s[1];
        v4u o; o.x = pk2(a.x, a.y); o.y = pk2(a.z, a.w); o.z = pk2(b.x, b.y); o.w = pk2(b.z, b.w);
        *(GAS v4u*)(((bf16*)(F.ws + WS_KCAT)) + ((size_t)lb * KCATN + pos) * BW + c8 * 8) = o; }
    for (long i = gt; i < (long)DEPTH * NB * NMEM * (BW / 8); i += ngt) { const GAS f32x4* s = (const GAS f32x4*)(p.in[I_CMK] + (size_t)i * 8); const f32x4 a = s[0], b = s[1];
        v4u o; o.x = pk2(a.x, a.y); o.y = pk2(a.z, a.w); o.z = pk2(b.x, b.y); o.w = pk2(b.z, b.w); *(GAS v4u*)(((bf16*)(F.ws + WS_CMK)) + (size_t)i * 8) = o; }
    for (int i = gt; i < DEPTH * CGN * 128 * 128; i += ngt) { const int s = i & 127, t = (i >> 7) & 127; ((bf16*)(F.ws + WS_WM))[i] = (bf16)(s <= t ? f2bf(p.in[I_CWS][i]) : 0u); }
    for (int i = gt; i < 128 * DM / 8; i += ngt) *(GAS v4u*)(((bf16*)(F.ws + WS_WIN)) + (size_t)3200 * DM + (size_t)i * 8) = (v4u){0u, 0u, 0u, 0u};
    for (int i = gt; i < 8 * 8 * 128 * 128 / 8; i += ngt) *(GAS v4u*)(((bf16*)(F.ws + WS_VNT)) + (size_t)128 * 8 * 128 * 128 + (size_t)i * 8) = (v4u){0u, 0u, 0u, 0u};
    for (int m = F.gw; m < MT; m += F.ngw) rms_row_bf16(xrow_in(p, m), p.in[I_GPRE], ((bf16*)(F.ws + WS_H)) + (size_t)m * DM, F.lane);
    for (int m = F.gw; m < DEPTH * NB * NMEM; m += F.ngw) { const int l = m / (NB * NMEM), r = m % (NB * NMEM);
        rms_row_bf16(p.in[I_MEM] + (size_t)r * DM, p.in[I_GMEM] + (size_t)l * DM, ((bf16*)(F.ws + WS_MEMN)) + (size_t)m * DM, F.lane); }
}
DI void prep_rwkv_item(const P& p, const Frame& F, int l, int r0) {
    LAS float* tw = (LAS float*)F.lds; LAS float* ta = tw + 16 * 64; LAS float* al = ta + 16 * 64;
    const bf16* proj = ((bf16*)(F.ws + WS_PROJ)); const int tid = F.tid, lane = F.lane;
    const float* mu = p.in[I_AMU] + (size_t)l * SHW;
    const bool is_p = r0 < MP; const int t0 = is_p ? (r0 & (SEQ - 1)) : ((r0 - MP) & (DSEQ - 1)); const int bsm = is_p ? 0 : ((r0 - MP) >> 6);
    const float* shp = p.in[I_SSH] + (size_t)(l * NB + bsm) * SHW;
    {
        const int tok = tid >> 5, j = 2 * (tid & 31); const int row = r0 + tok; const bool first = (t0 + tok) == 0;
#pragma unroll
        for (int part = 0; part < 2; ++part) { const int pc = (part ? PC_AD : PC_WD) + j;
            const unsigned cu = *(const GAS unsigned*)(proj + (size_t)row * NINP + pc); const float c0 = bflo(cu), c1 = bfhi(cu); float p0, p1;
            if (!first) { const unsigned pu = *(const GAS unsigned*)(proj + (size_t)(row - 1) * NINP + pc); p0 = bflo(pu); p1 = bfhi(pu); }
            else if (is_p) { p0 = p1 = 0.f; }
            else { p0 = shp[pc]; p1 = shp[pc + 1]; }
            const float x0 = c0 + mu[pc] * (p0 - c0), x1 = c1 + mu[pc + 1] * (p1 - c1);
            if (part) { ta[tok * 64 + j] = x0; ta[tok * 64 + j + 1] = x1; } else { tw[tok * 64 + j] = tanhf(x0); tw[tok * 64 + j + 1] = tanhf(x1); } }
    }
    __syncthreads();
    {
        float acc[16][2];
        const float* wup = p.in[I_AWUP] + (size_t)l * 64 * BW; const float w00 = p.in[I_AW0][l * BW + tid], w01 = p.in[I_AW0][l * BW + tid + 512];
#pragma unroll
        for (int t = 0; t < 16; ++t) { acc[t][0] = w00; acc[t][1] = w01; }
#pragma unroll 1
        for (int j = 0; j < 64; j += 4) { float wa[4], wb[4];
#pragma unroll
            for (int q = 0; q < 4; ++q) { wa[q] = wup[(size_t)(j + q) * BW + tid]; wb[q] = wup[(size_t)(j + q) * BW + tid + 512]; }
#pragma unroll
            for (int t = 0; t < 16; ++t) { const f32x4 x = *(const LAS f32x4*)(tw + t * 64 + j);
                acc[t][0] += x.x * wa[0] + x.y * wa[1] + x.z * wa[2] + x.w * wa[3]; acc[t][1] += x.x * wb[0] + x.y * wb[1] + x.z * wb[2] + x.w * wb[3]; } }
        float* sp = SCAN5P(F, l) + ((size_t)r0 * AH + F.wave) * (5 * 64) + 64 + lane;
#pragma unroll
        for (int t = 0; t < 16; ++t) { sp[(size_t)t * (AH * 5 * 64)] = __expf(-0.6065306597126334f * sigmoidf_(acc[t][0])); sp[(size_t)t * (AH * 5 * 64) + 8 * 5 * 64] = __expf(-0.6065306597126334f * sigmoidf_(acc[t][1])); }
    }
    {
        float acc[16][2];
        const float* aup = p.in[I_AAUP] + (size_t)l * 64 * BW; const float a00 = p.in[I_AA0][l * BW + tid], a01 = p.in[I_AA0][l * BW + tid + 512];
#pragma unroll
        for (int t = 0; t < 16; ++t) { acc[t][0] = a00; acc[t][1] = a01; }
#pragma unroll 1
        for (int j = 0; j < 64; j += 4) { float wa[4], wb[4];
#pragma unroll
            for (int q = 0; q < 4; ++q) { wa[q] = aup[(size_t)(j + q) * BW + tid]; wb[q] = aup[(size_t)(j + q) * BW + tid + 512]; }
#pragma unroll
            for (int t = 0; t < 16; ++t) { const f32x4 x = *(const LAS f32x4*)(ta + t * 64 + j);
                acc[t][0] += x.x * wa[0] + x.y * wa[1] + x.z * wa[2] + x.w * wa[3]; acc[t][1] += x.x * wb[0] + x.y * wb[1] + x.z * wb[2] + x.w * wb[3]; } }
#pragma unroll
        for (int t = 0; t < 16; ++t) { al[t * BW + tid] = sigmoidf_(acc[t][0]); al[t * BW + tid + 512] = sigmoidf_(acc[t][1]); }
    }
#pragma unroll 1
    for (int ch = 0; ch < 2; ++ch) { const int c = tid + 512 * ch, head = F.wave + 8 * ch;
        const float mur = mu[PC_R + c], muk = mu[PC_K + c], muv = mu[PC_V + c];
        const float kk_ = p.in[I_AKK][l * BW + c], ka_ = p.in[I_AKA][l * BW + c], rk_ = p.in[I_ARK][l * BW + c];
        float pr, pk, pvv;
        if (t0 != 0) { const bf16* q = proj + (size_t)(r0 - 1) * NINP; pr = bf2f(q[PC_R + c]); pk = bf2f(q[PC_K + c]); pvv = bf2f(q[PC_V + c]); }
        else if (is_p) { pr = pk = pvv = 0.f; }
        else { pr = shp[PC_R + c]; pk = shp[PC_K + c]; pvv = shp[PC_V + c]; }
#pragma unroll 2
        for (int t = 0; t < 16; ++t) { const int row = r0 + t; const bf16* q = proj + (size_t)row * NINP;
            const float cr = bf2f(q[PC_R + c]), ck = bf2f(q[PC_K + c]), cv = bf2f(q[PC_V + c]);
            const float xr = cr + mur * (pr - cr), xk = ck + muk * (pk - ck), xv = cv + muv * (pvv - cv); pr = cr; pk = ck; pvv = cv;
            const float a = al[t * BW + c];
            const float kkv = xk * kk_; const float ss = wave_sum(kkv * kkv); const float kkn = kkv / fmaxf(sqrtf(ss), 1e-12f);
            const float kp = xk * (1.0f + (a - 1.0f) * ka_); const float bon = wave_sum(xr * kp * rk_);
            float* sp = SCAN5P(F, l) + ((size_t)row * AH + head) * (5 * 64) + lane;
            sp[0] = kkn; sp[128] = kkn * a; sp[192] = kp; sp[256] = xr; SCANVP(F)[(size_t)row * BW + c] = xv;
            if (lane == 0) ((float*)(F.ws + WS_BONUS))[(size_t)row * AH + head] = bon; }
    }
    __syncthreads();
}
DI void prep_ln_item(const P& p, const Frame& F, int l, int item) {
    LAS unsigned* tile = (LAS unsigned*)F.lds;
    const int lane = F.lane; int row0, ch, s0;
    if (item < 256) { ch = item >> 1; s0 = (item & 1) * 64; row0 = ch * 128 + s0; } else { ch = 128 + (item - 256); s0 = 0; row0 = MP + (item - 256) * 64; }
    const float* lnw = p.in[I_CLNW] + (size_t)l * BW + lane * 16; const float* lnb = p.in[I_CLNB] + (size_t)l * BW + lane * 16;
    for (int rr = 0; rr < 8; ++rr) { const int tr = F.wave * 8 + rr, row = row0 + tr;
        const GAS v4u* src = (const GAS v4u*)(((bf16*)(F.ws + WS_PROJ)) + (size_t)row * NINP + PC_CV + lane * 16); const v4u u0 = src[0], u1 = src[1];
        float x[16] = {bflo(u0.x), bfhi(u0.x), bflo(u0.y), bfhi(u0.y), bflo(u0.z), bfhi(u0.z), bflo(u0.w), bfhi(u0.w), bflo(u1.x), bfhi(u1.x), bflo(u1.y), bfhi(u1.y), bflo(u1.z), bfhi(u1.z), bflo(u1.w), bfhi(u1.w)};
        float s = 0.f;
#pragma unroll
        for (int i = 0; i < 16; ++i) s += x[i];
        const float mean = wave_sum(s) * (1.0f / BW); float q = 0.f;
#pragma unroll
        for (int i = 0; i < 16; ++i) { x[i] -= mean; q += x[i] * x[i]; }
        const float rstd = 1.0f / sqrtf(wave_sum(q) * (1.0f / BW) + NORM_EPS);
#pragma unroll
        for (int i = 0; i < 16; ++i) x[i] = x[i] * rstd * lnw[i] + lnb[i];
        if (row >= MP) { GAS f32x4* o = (GAS f32x4*)(F.out + O_CVS + ((size_t)l * MS + (row - MP)) * BW + lane * 16);
#pragma unroll
            for (int i = 0; i < 4; ++i) o[i] = (f32x4){x[4 * i], x[4 * i + 1], x[4 * i + 2], x[4 * i + 3]}; }
        LAS unsigned* tp = tile + tr * 513 + lane * 8;
#pragma unroll
        for (int i = 0; i < 8; ++i) tp[i] = pk2(x[2 * i], x[2 * i + 1]);
    }
    __syncthreads();
    const LAS bf16* t16 = (const LAS bf16*)tile; const int c = F.tid & 7;
    for (int pass = 0; pass < 16; ++pass) { const int dd = (F.tid >> 3) + 64 * pass; const LAS bf16* s = t16 + (8 * c) * 1026 + dd;
        v4u o; o.x = (unsigned)s[0 * 1026] | ((unsigned)s[1 * 1026] << 16); o.y = (unsigned)s[2 * 1026] | ((unsigned)s[3 * 1026] << 16);
        o.z = (unsigned)s[4 * 1026] | ((unsigned)s[5 * 1026] << 16); o.w = (unsigned)s[6 * 1026] | ((unsigned)s[7 * 1026] << 16);
        *(GAS v4u*)(((bf16*)(F.ws + WS_VNT)) + ((size_t)ch * BW + dd) * 128 + s0 + 8 * c) = o; }
    __syncthreads();
}
DI void ph_prep(const P& p, const Frame& F, int l) {
    for (int it = F.bx; it < MT / 16; it += F.G) prep_rwkv_item(p, F, l, it * 16);
    for (int it = F.bx; it < 256 + 8; it += F.G) prep_ln_item(p, F, l, it);
    int rot = 0;
    {
        LAS unsigned* scr = (LAS unsigned*)(F.lds + F.wave * 16640);
        const int nP = NB * BHN * (SEQ / 64) * 2, nS = NB * BHN * 2, nitems = nP + nS;
        FOR_ITEMS(it, nitems, F.gw, F.ngw, rot) {
            if (it < nP) { const int dt = it & 1, tt = (it >> 1) & 31, h = (it >> 6) & 7, b = it >> 9;
                tr64_bf16(((bf16*)(F.ws + WS_PROJ)) + ((size_t)b * SEQ + tt * 64) * NINP + PC_BV + h * BHD + dt * 64, (size_t)NINP, ((bf16*)(F.ws + WS_VT)) + ((size_t)(b * BHN + h) * BHD + dt * 64) * SEQ + tt * 64, (size_t)SEQ, scr, F.lane); }
            else { const int j = it - nP, dt = j & 1, h = (j >> 1) & 7, b = j >> 4;
                tr64_bf16(((bf16*)(F.ws + WS_PROJ)) + ((size_t)MP + b * DSEQ) * NINP + PC_BV + h * BHD + dt * 64, (size_t)NINP, ((bf16*)(F.ws + WS_VTCAT)) + ((size_t)((l * NB + b) * BHN + h) * BHD + dt * 64) * KCATN + PAST, (size_t)KCATN, scr, F.lane); } }
        ROT_ADV(rot, nitems, F.ngw);
    }
    {
        LAS float* scr = (LAS float*)(F.lds + F.wave * 16640);
        const int nitems = NB * MHN * 16;
        FOR_ITEMS(it, nitems, F.gw, F.ngw, rot) { const int dt = it & 3, mt = (it >> 2) & 3, hm = (it >> 4) & 3, b = it >> 6;
            tr64_f32(F.out + O_MV + ((size_t)(l * NB + b) * NMEM + mt * 64) * BW + hm * MHD + dt * 64, (size_t)BW, ((bf16*)(F.ws + WS_MVT)) + ((size_t)((l * NB + b) * MHN + hm) * MHD + dt * 64) * NMEM + mt * 64, (size_t)NMEM, scr, F.lane); }
        ROT_ADV(rot, nitems, F.ngw);
    }
    const int gt = F.bx * NTHR + F.tid, ngt = F.G * NTHR;
    for (int i = gt; i < NB * NMEM * (BW / 8); i += ngt) { const GAS f32x4* s = (const GAS f32x4*)(F.out + O_MK + (size_t)l * NB * NMEM * BW + (size_t)i * 8); const f32x4 a = s[0], b = s[1];
        v4u o; o.x = pk2(a.x, a.y); o.y = pk2(a.z, a.w); o.z = pk2(b.x, b.y); o.w = pk2(b.z, b.w); *(GAS v4u*)(((bf16*)(F.ws + WS_MKB)) + (size_t)l * NB * NMEM * BW + (size_t)i * 8) = o; }
    for (int i = gt; i < MS * (BW / 8); i += ngt) { const int c8 = i & 127, r = i >> 7, b = r >> 6, t = r & 63;
        *(GAS v4u*)(((bf16*)(F.ws + WS_KCAT)) + ((size_t)(l * NB + b) * KCATN + PAST + t) * BW + c8 * 8) = *(const GAS v4u*)(((bf16*)(F.ws + WS_PROJ)) + (size_t)(MP + r) * NINP + PC_BK + c8 * 8); }
    for (long i = gt; i < (long)MT * 256; i += ngt) { const int c8 = (int)(i & 255); const int row = (int)(i >> 8); const int seg = c8 >> 7, col = (c8 & 127) * 8;
        const v4u u = *(const GAS v4u*)(((bf16*)(F.ws + WS_PROJ)) + (size_t)row * NINP + (seg ? PC_BV : PC_BK) + col);
        float* dst = row < MP ? F.out + (seg ? O_SVP : O_SKP) + ((size_t)l * MP + row) * BW + col : F.out + (seg ? O_SVS : O_SKS) + ((size_t)l * MS + (row - MP)) * BW + col;
        ((GAS f32x4*)dst)[0] = (f32x4){bflo(u.x), bfhi(u.x), bflo(u.y), bfhi(u.y)}; ((GAS f32x4*)dst)[1] = (f32x4){bflo(u.z), bfhi(u.z), bflo(u.w), bfhi(u.w)}; }
    for (int i = gt; i < 16 * SHW; i += ngt) { const int sq = i / SHW, c = i % SHW; const int b = sq & 7; const bool smp = sq >= 8;
        const int row = smp ? MP + b * DSEQ + DSEQ - 1 : b * SEQ + SEQ - 1;
        F.out[(smp ? O_SHS : O_SHP) + (size_t)(l * NB + b) * SHW + c] = bf2f(((bf16*)(F.ws + WS_PROJ))[(size_t)row * NINP + c]); }
}
DI void scan_unit(const float* sbase, const float* vbase, const float* s0, float* yraw, float* sout, int T, int lane) {
    float S[64];
    if (s0) {
#pragma unroll
        for (int k = 0; k < 64; k += 4) { const f32x4 v = *(const GAS f32x4*)(s0 + lane * 64 + k); S[k] = v.x; S[k + 1] = v.y; S[k + 2] = v.z; S[k + 3] = v.w; }
    } else {
#pragma unroll
        for (int k = 0; k < 64; ++k) S[k] = 0.f;
    }
    for (int t = 0; t < T; ++t) {
        const float* pg = sbase + (size_t)t * (AH * 5 * 64);
        const CAS float* p = (const CAS float*)pg;
        const float vv = vbase[(size_t)t * BW + lane];
        float a0 = 0.f, a1 = 0.f, a2 = 0.f, a3 = 0.f;
#pragma unroll
        for (int k = 0; k < 64; k += 4) { a0 += S[k] * p[k]; a1 += S[k + 1] * p[k + 1]; a2 += S[k + 2] * p[k + 2]; a3 += S[k + 3] * p[k + 3]; }
        const float nskk = -((a0 + a1) + (a2 + a3));
        float y0 = 0.f, y1 = 0.f, y2 = 0.f, y3 = 0.f;
#pragma unroll
        for (int k = 0; k < 64; k += 4) {
            float s;
            s = S[k] * p[64 + k];         s = fmaf(nskk, p[128 + k], s);     s = fmaf(vv, p[192 + k], s);     S[k] = s;     y0 = fmaf(s, p[256 + k], y0);
            s = S[k + 1] * p[64 + k + 1]; s = fmaf(nskk, p[128 + k + 1], s); s = fmaf(vv, p[192 + k + 1], s); S[k + 1] = s; y1 = fmaf(s, p[256 + k + 1], y1);
            s = S[k + 2] * p[64 + k + 2]; s = fmaf(nskk, p[128 + k + 2], s); s = fmaf(vv, p[192 + k + 2], s); S[k + 2] = s; y2 = fmaf(s, p[256 + k + 2], y2);
            s = S[k + 3] * p[64 + k + 3]; s = fmaf(nskk, p[128 + k + 3], s); s = fmaf(vv, p[192 + k + 3], s); S[k + 3] = s; y3 = fmaf(s, p[256 + k + 3], y3);
        }
        yraw[(size_t)t * BW + lane] = (y0 + y1) + (y2 + y3);
    }
#pragma unroll
    for (int k = 0; k < 64; k += 4) *(GAS f32x4*)(sout + lane * 64 + k) = (f32x4){S[k], S[k + 1], S[k + 2], S[k + 3]};
}
DI void sb_unit(const bf16* Qp, const bf16* Kp, int kpitch, const bf16* VTp, int vpitch, int qpos0, const bf16* Zp, bf16* Op, int lane) {
    const int r = lane & 31, h = lane >> 5;
    bf16x8 qf[8];
#pragma unroll
    for (int s = 0; s < 8; ++s) qf[s] = *(const GAS bf16x8*)(Qp + (size_t)r * NINP + 16 * s + 8 * h);
    f32x16 o[4];
#pragma unroll
    for (int db = 0; db < 4; ++db)
#pragma unroll
        for (int i = 0; i < 16; ++i) o[db][i] = 0.f;
    float R = 0.f; const int qpos = qpos0 + r; const float scale = 0.08838834764831845f;
    for (int kt = qpos0 >> 5; kt >= 0; --kt) {
        const int key0 = kt * 32;
        f32x16 sc;
#pragma unroll
        for (int i = 0; i < 16; ++i) sc[i] = 0.f;
        const bf16* kr = Kp + (size_t)(key0 + r) * kpitch + 8 * h;
#pragma unroll
        for (int s = 0; s < 8; ++s) { const bf16x8 kf = *(const GAS bf16x8*)(kr + 16 * s); sc = MFMA32(kf, qf[s], sc); }
        float lm[16], lb[16];
#pragma unroll
        for (int i = 0; i < 16; ++i) { const int key = key0 + crow16(i, h); const float z = sc[i] * scale; const bool valid = key < qpos;
            const float e = __expf(-fabsf(z)); const float sp = fmaxf(z, 0.f) + __logf(1.0f + e);
            lm[i] = valid ? -sp : 0.f; lb[i] = valid ? (z - sp) : -1e30f; }
        float G[4], Go[4], aft[4];
#pragma unroll
        for (int g = 0; g < 4; ++g) { G[g] = (lm[4 * g] + lm[4 * g + 1]) + (lm[4 * g + 2] + lm[4 * g + 3]); Go[g] = __shfl_xor(G[g], 32); }
        float tail = 0.f;
#pragma unroll
        for (int g = 3; g >= 0; --g) { aft[g] = tail + (h == 0 ? Go[g] : 0.f); tail += G[g] + Go[g]; }
        float att[16];
#pragma unroll
        for (int g = 0; g < 4; ++g) { float suf = aft[g] + R;
#pragma unroll
            for (int j = 3; j >= 0; --j) { att[4 * g + j] = __expf(lb[4 * g + j] + suf); suf += lm[4 * g + j]; } }
        R += tail;
        const bf16x8 p0 = pack8(att[0], att[1], att[2], att[3], att[4], att[5], att[6], att[7]);
        const bf16x8 p1 = pack8(att[8], att[9], att[10], att[11], att[12], att[13], att[14], att[15]);
#pragma unroll
        for (int db = 0; db < 4; ++db) { const bf16* vr = VTp + (size_t)(32 * db + r) * vpitch + key0 + 4 * h;
            const s16x4 a0 = *(const GAS s16x4*)(vr), a1 = *(const GAS s16x4*)(vr + 8), b0 = *(const GAS s16x4*)(vr + 16), b1 = *(const GAS s16x4*)(vr + 24);
            o[db] = MFMA32(__builtin_shufflevector(a0, a1, 0, 1, 2, 3, 4, 5, 6, 7), p0, o[db]);
            o[db] = MFMA32(__builtin_shufflevector(b0, b1, 0, 1, 2, 3, 4, 5, 6, 7), p1, o[db]); }
    }
#pragma unroll
    for (int db = 0; db < 4; ++db)
#pragma unroll
        for (int g = 0; g < 4; ++g) { const int d0 = 32 * db + 8 * g + 4 * h; const v2u zu = *(const GAS v2u*)(Zp + (size_t)r * NINP + d0);
            v2u w; w.x = pk2(o[db][4 * g] * siluf_(bflo(zu.x)), o[db][4 * g + 1] * siluf_(bfhi(zu.x))); w.y = pk2(o[db][4 * g + 2] * siluf_(bflo(zu.y)), o[db][4 * g + 3] * siluf_(bfhi(zu.y)));
            *(GAS v2u*)(Op + (size_t)r * BW + d0) = w; }
}
DI void xattn_unit(const bf16* Qp, const bf16* Kp, const bf16* VTp, bf16* Op, int lane) {
    const int r = lane & 31, h = lane >> 5;
    f32x16 sT[8];
#pragma unroll
    for (int kt = 0; kt < 8; ++kt)
#pragma unroll
        for (int i = 0; i < 16; ++i) sT[kt][i] = 0.f;
#pragma unroll 1
    for (int s = 0; s < 16; ++s) { const bf16x8 qf = *(const GAS bf16x8*)(Qp + (size_t)r * NINP + 16 * s + 8 * h);
#pragma unroll
        for (int kt = 0; kt < 8; ++kt) { const bf16x8 kf = *(const GAS bf16x8*)(Kp + (size_t)(kt * 32 + r) * BW + 16 * s + 8 * h); sT[kt] = MFMA32(kf, qf, sT[kt]); } }
    float m = -3.0e38f;
#pragma unroll
    for (int kt = 0; kt < 8; ++kt)
#pragma unroll
        for (int i = 0; i < 16; ++i) m = fmaxf(m, sT[kt][i]);
    m = fmaxf(m, __shfl_xor(m, 32)); m *= 0.0625f;
    float lsum = 0.f; bf16x8 pk[8][2];
#pragma unroll
    for (int kt = 0; kt < 8; ++kt) { float e[16];
#pragma unroll
        for (int i = 0; i < 16; ++i) { e[i] = __expf(sT[kt][i] * 0.0625f - m); lsum += e[i]; }
        pk[kt][0] = pack8(e[0], e[1], e[2], e[3], e[4], e[5], e[6], e[7]); pk[kt][1] = pack8(e[8], e[9], e[10], e[11], e[12], e[13], e[14], e[15]); }
    lsum += __shfl_xor(lsum, 32); const float inv = 1.0f / lsum;
    for (int db = 0; db < 8; ++db) { f32x16 o;
#pragma unroll
        for (int i = 0; i < 16; ++i) o[i] = 0.f;
        const bf16* vr = VTp + (size_t)(32 * db + r) * NMEM + 4 * h;
#pragma unroll
        for (int kt = 0; kt < 8; ++kt) { const s16x4 a0 = *(const GAS s16x4*)(vr + kt * 32), a1 = *(const GAS s16x4*)(vr + kt * 32 + 8), b0 = *(const GAS s16x4*)(vr + kt * 32 + 16), b1 = *(const GAS s16x4*)(vr + kt * 32 + 24);
            o = MFMA32(__builtin_shufflevector(a0, a1, 0, 1, 2, 3, 4, 5, 6, 7), pk[kt][0], o); o = MFMA32(__builtin_shufflevector(b0, b1, 0, 1, 2, 3, 4, 5, 6, 7), pk[kt][1], o); }
#pragma unroll
        for (int g = 0; g < 4; ++g) { const int d0 = 32 * db + 8 * g + 4 * h; v2u w; w.x = pk2(o[4 * g] * inv, o[4 * g + 1] * inv); w.y = pk2(o[4 * g + 2] * inv, o[4 * g + 3] * inv);
            *(GAS v2u*)(Op + (size_t)r * BW + d0) = w; }
    }
}
DI void gmlp_unit(const P& p, const Frame& F, int l, int ch, int g, int lane) {
    const int r = lane & 31, h = lane >> 5; const int row0 = ch < 128 ? ch * 128 : MP + (ch - 128) * 64; const int ntb = ch < 128 ? 4 : 2;
    const bf16* wm = ((bf16*)(F.ws + WS_WM)) + (size_t)(l * CGN + g) * 128 * 128; const bf16* vn = ((bf16*)(F.ws + WS_VNT)) + (size_t)(ch * CGN + g) * 128 * 128;
    const float* bs = p.in[I_CBS] + (size_t)(l * CGN + g) * 128; bf16* oc = ((bf16*)(F.ws + WS_OALL)) + (size_t)2 * MT * BW;
    for (int tb = 0; tb < ntb; ++tb) { f32x16 c[4];
#pragma unroll
        for (int db = 0; db < 4; ++db)
#pragma unroll
            for (int i = 0; i < 16; ++i) c[db][i] = 0.f;
        for (int ks = 0; ks < 2 * (tb + 1); ++ks) { const bf16x8 af = *(const GAS bf16x8*)(wm + (size_t)(32 * tb + r) * 128 + 16 * ks + 8 * h);
#pragma unroll
            for (int db = 0; db < 4; ++db) { const bf16x8 bfr = *(const GAS bf16x8*)(vn + (size_t)(32 * db + r) * 128 + 16 * ks + 8 * h); c[db] = MFMA32(af, bfr, c[db]); } }
#pragma unroll
        for (int i = 0; i < 16; ++i) { const int t = 32 * tb + crow16(i, h); const size_t row = (size_t)(row0 + t); const float bt = bs[t];
#pragma unroll
            for (int db = 0; db < 4; ++db) { const int col = g * CGD + 32 * db + r; const float u = bf2f(((bf16*)(F.ws + WS_PROJ))[row * NINP + PC_CU + col]), z = bf2f(((bf16*)(F.ws + WS_PROJ))[row * NINP + PC_CZ + col]);
                oc[row * BW + col] = (bf16)f2bf(u * (c[db][i] + bt) * siluf_(z)); } }
    }
}
constexpr int N_SCAN_WG = 16;
DI void ph_mixers(const P& p, const Frame& F, int l) {
    const int lane = F.lane;
    if (F.bx < N_SCAN_WG) {
        const int u = F.bx * NWAVES + F.wave, b = u >> 4, h = u & 15; const size_t row0 = (size_t)b * SEQ;
        scan_unit(SCAN5P(F, l) + (row0 * AH + h) * (5 * 64), SCANVP(F) + row0 * BW + h * 64, nullptr, YRAWP(F, l) + row0 * BW + h * 64, F.out + O_RWP + ((size_t)(l * NB + b) * AH + h) * 4096, SEQ, lane);
        return;
    }
    const int wv = (F.bx - N_SCAN_WG) * NWAVES + F.wave, nwv = (F.G - N_SCAN_WG) * NWAVES;
    if (wv < NB * AH) {
        const int b = wv >> 4, h = wv & 15; const size_t row0 = (size_t)MP + b * DSEQ;
        scan_unit(SCAN5P(F, l) + (row0 * AH + h) * (5 * 64), SCANVP(F) + row0 * BW + h * 64, p.in[I_SRW] + ((size_t)(l * NB + b) * AH + h) * 4096, YRAWP(F, l) + row0 * BW + h * 64, F.out + O_RWS + ((size_t)(l * NB + b) * AH + h) * 4096, DSEQ, lane);
    }
    for (int k = 0;; ++k) { int u = k * nwv + wv; if (k & 1) u = (k + 1) * nwv - 1 - wv; if (k * nwv >= 4096) break; if (u >= 4096) continue;
        const int qb = 63 - (u >> 6), bh = u & 63, b = bh >> 3, hd = bh & 7; const size_t row0 = (size_t)b * SEQ + qb * 32;
        sb_unit(((bf16*)(F.ws + WS_PROJ)) + row0 * NINP + PC_BQ + hd * BHD, ((bf16*)(F.ws + WS_PROJ)) + (size_t)b * SEQ * NINP + PC_BK + hd * BHD, NINP, ((bf16*)(F.ws + WS_VT)) + (size_t)(b * BHN + hd) * BHD * SEQ, SEQ, qb * 32,
                ((bf16*)(F.ws + WS_PROJ)) + row0 * NINP + PC_BZ + hd * BHD, ((bf16*)(F.ws + WS_OALL)) + (size_t)1 * MT * BW + row0 * BW + hd * BHD, lane); }
    for (int u = wv; u < 128; u += nwv) { const int qb = u & 1, bh = u >> 1, b = bh >> 3, hd = bh & 7; const size_t row0 = (size_t)MP + b * DSEQ + qb * 32;
        sb_unit(((bf16*)(F.ws + WS_PROJ)) + row0 * NINP + PC_BQ + hd * BHD, ((bf16*)(F.ws + WS_KCAT)) + (size_t)(l * NB + b) * KCATN * BW + hd * BHD, BW, ((bf16*)(F.ws + WS_VTCAT)) + (size_t)((l * NB + b) * BHN + hd) * BHD * KCATN, KCATN, PAST + qb * 32,
                ((bf16*)(F.ws + WS_PROJ)) + row0 * NINP + PC_BZ + hd * BHD, ((bf16*)(F.ws + WS_OALL)) + (size_t)1 * MT * BW + row0 * BW + hd * BHD, lane); }
    for (int u = wv; u < (MT / 32) * MHN; u += nwv) { const int hm = u & 3, rb = u >> 2; const size_t row0 = (size_t)rb * 32; const bool smp = row0 >= MP;
        const int b = smp ? (int)((row0 - MP) >> 6) : (int)(row0 >> 11);
        const bf16* Kp = (smp ? ((bf16*)(F.ws + WS_CMK)) : ((bf16*)(F.ws + WS_MKB))) + ((size_t)(l * NB + b) * NMEM) * BW + hm * MHD; const bf16* VTp = (smp ? ((bf16*)(F.ws + WS_CMVT)) : ((bf16*)(F.ws + WS_MVT))) + (size_t)((l * NB + b) * MHN + hm) * MHD * NMEM;
        xattn_unit(((bf16*)(F.ws + WS_PROJ)) + row0 * NINP + PC_MQ + hm * MHD, Kp, VTp, ((bf16*)(F.ws + WS_OALL)) + (size_t)3 * MT * BW + row0 * BW + hm * MHD, lane); }
    for (int u = wv; u < 136 * CGN; u += nwv) gmlp_unit(p, F, l, u >> 3, u & 7, lane);
}
DI void ph_posta(const P& p, const Frame& F, int l) {
    const int lane = F.lane, c0 = lane * 16, head = lane >> 2;
    const float* gw_ = p.in[I_AGNW] + (size_t)l * BW + c0; const float* gb_ = p.in[I_AGNB] + (size_t)l * BW + c0; const float muv = 0.f; (void)muv;
    for (int row = F.gw; row < MT; row += F.ngw) {
        const GAS f32x4* yp = (const GAS f32x4*)(YRAWP(F, l) + (size_t)row * BW + c0); float y[16];
#pragma unroll
        for (int i = 0; i < 4; ++i) { const f32x4 v = yp[i]; y[4 * i] = v.x; y[4 * i + 1] = v.y; y[4 * i + 2] = v.z; y[4 * i + 3] = v.w; }
        float s = 0.f;
#pragma unroll
        for (int i = 0; i < 16; ++i) s += y[i];
        s += __shfl_xor(s, 1); s += __shfl_xor(s, 2); const float mean = s * (1.0f / 64.0f); float q = 0.f;
#pragma unroll
        for (int i = 0; i < 16; ++i) { y[i] -= mean; q += y[i] * y[i]; }
        q += __shfl_xor(q, 1); q += __shfl_xor(q, 2); const float rstd = 1.0f / sqrtf(q * (1.0f / 64.0f) + GN_EPS);
        const float bon = ((float*)(F.ws + WS_BONUS))[(size_t)row * AH + head];
        const GAS f32x4* vp = (const GAS f32x4*)(SCANVP(F) + (size_t)row * BW + c0);
        const GAS v4u* zp = (const GAS v4u*)(((bf16*)(F.ws + WS_PROJ)) + (size_t)row * NINP + PC_AZ + c0); const v4u z0 = zp[0], z1 = zp[1];
        const float z[16] = {bflo(z0.x), bfhi(z0.x), bflo(z0.y), bfhi(z0.y), bflo(z0.z), bfhi(z0.z), bflo(z0.w), bfhi(z0.w), bflo(z1.x), bfhi(z1.x), bflo(z1.y), bfhi(z1.y), bflo(z1.z), bfhi(z1.z), bflo(z1.w), bfhi(z1.w)};
        float o[16];
#pragma unroll
        for (int i = 0; i < 4; ++i) { const f32x4 v = vp[i]; const float vv[4] = {v.x, v.y, v.z, v.w};
#pragma unroll
            for (int j = 0; j < 4; ++j) { const int e = 4 * i + j; o[e] = (y[e] * rstd * gw_[e] + gb_[e] + bon * vv[j]) * siluf_(z[e]); } }
        v4u w0, w1; w0.x = pk2(o[0], o[1]); w0.y = pk2(o[2], o[3]); w0.z = pk2(o[4], o[5]); w0.w = pk2(o[6], o[7]); w1.x = pk2(o[8], o[9]); w1.y = pk2(o[10], o[11]); w1.z = pk2(o[12], o[13]); w1.w = pk2(o[14], o[15]);
        GAS v4u* op = (GAS v4u*)(((bf16*)(F.ws + WS_OALL)) + (size_t)row * BW + c0); op[0] = w0; op[1] = w1;
    }
}
DI void ph_postnorm(const P& p, const Frame& F, int l) {
    const int lane = F.lane;
    const GAS f32x4* gpo = (const GAS f32x4*)(p.in[I_GPOST] + (size_t)l * DM) + lane;
    const GAS f32x4* gpr = (const GAS f32x4*)(p.in[I_GPRE] + (size_t)(l + 1 < DEPTH ? l + 1 : l) * DM) + lane;
    for (int row = F.gw; row < MT; row += F.ngw) {
        const GAS f32x4* op = (const GAS f32x4*)(((float*)(F.ws + WS_OUTF)) + (size_t)row * DM) + lane;
        const GAS f32x4* xp = (const GAS f32x4*)(l == 0 ? xrow_in(p, row) : F.out + (size_t)row * DM) + lane;
        GAS f32x4* yp = (GAS f32x4*)(F.out + (size_t)row * DM) + lane;
        f32x4 v[16]; float s = 0.f;
#pragma unroll
        for (int j = 0; j < 16; ++j) { v[j] = op[64 * j]; s += (v[j].x * v[j].x + v[j].y * v[j].y) + (v[j].z * v[j].z + v[j].w * v[j].w); }
        const float rstd = 1.0f / sqrtf(wave_sum(s) * (1.0f / DM) + NORM_EPS); float s2 = 0.f;
#pragma unroll
        for (int j = 0; j < 16; ++j) { const f32x4 x = xp[64 * j], g = gpo[64 * j]; v[j] = x + v[j] * rstd * g; yp[64 * j] = v[j]; s2 += (v[j].x * v[j].x + v[j].y * v[j].y) + (v[j].z * v[j].z + v[j].w * v[j].w); }
        if (l + 1 < DEPTH) { const float r2 = 1.0f / sqrtf(wave_sum(s2) * (1.0f / DM) + NORM_EPS); GAS v2u* hp = (GAS v2u*)(((bf16*)(F.ws + WS_H)) + (size_t)row * DM) + lane;
#pragma unroll
            for (int j = 0; j < 16; ++j) { const f32x4 g = gpr[64 * j]; v2u w; w.x = pk2(v[j].x * r2 * g.x, v[j].y * r2 * g.y); w.y = pk2(v[j].z * r2 * g.z, v[j].w * r2 * g.w); hp[64 * j] = w; } }
    }
}
__global__ void __launch_bounds__(NTHR, 2) fwd(P p) {
    extern __shared__ __attribute__((aligned(16))) unsigned char lds[];
    Frame F;
    F.lds = (LAS unsigned char*)lds; F.tid = threadIdx.x; F.lane = F.tid & 63; F.wave = __builtin_amdgcn_readfirstlane(F.tid >> 6);
    F.bx = blockIdx.x; F.G = GRID; F.gw = F.bx * NWAVES + F.wave; F.ngw = GRID * NWAVES;
    F.out = p.out; F.ws = p.ws;
    unsigned char* ws = p.ws;
    for (int u = F.tid; u < (LDS_BYTES - LDSCTL_OFF) / 4; u += NTHR) ((LAS unsigned*)(F.lds + LDSCTL_OFF))[u] = 0u;
    __syncthreads();
    const int lo = p.ph_lo, hi = p.ph_hi;
    gu32* ctl = (gu32*)(ws + WS_CTL);
    XcdBarrier bar; bar.bar = (unsigned*)(ctl + CW_BAR); bar.x = 0; bar.st = nullptr;
    if (hi - lo > 1) bar = xcd_barrier_post((unsigned*)(ctl + CW_BAR), (volatile LAS unsigned*)(F.lds + LDSCTL_OFF + 32));
#define IN(k) (lo <= (k) && (k) < hi)
#define FRESH() do { int t_ = threadIdx.x; asm volatile("" : "+v"(t_)); F.tid = t_; F.lane = t_ & 63; size_t z_ = 0; asm volatile("" : "+s"(z_)); F.ws = p.ws + z_; F.out = p.out + z_; } while (0)
#define SEAM(k) do { if (IN((k) + 1)) { xcd_barrier(bar); } } while (0)
    LAS unsigned char* ring = F.lds;
    #ifndef SKIP_P0
    if (IN(0)) { FRESH(); ph_prologue(p, F); SEAM(0); }
#endif
#ifndef SKIP_G1
    if (IN(1)) {
        pg8::Gemm g{((bf16*)(F.ws + WS_MEMN)), ((bf16*)(F.ws + WS_WMEM)), 4096, 4096, DM}; pg8::MemOrder S{F.G, F.bx}; pg8::EpiMemKV E{F.out + O_MK, (size_t)(O_MV - O_MK)};
        pg8::gemm_phase<pg8::EpiMemKV, pg8::MemOrder, true, true>(ring, g, S, E);
        SEAM(1);
    }
#endif
    for (int l = 0; l < DEPTH; ++l) {
        const int pb = 2 + 7 * l;
#ifndef SKIP_G2
        if (IN(pb + 0)) {
            pg8::Gemm g{((bf16*)(F.ws + WS_H)), ((bf16*)(F.ws + WS_WIN)), MT, NINP, DM}; pg8::StaticOrder S; S.init(MT, NINP, F.G, F.bx); pg8::EpiBf16 E{((bf16*)(F.ws + WS_PROJ)), NINP};
            pg8::gemm_phase<pg8::EpiBf16, pg8::StaticOrder, true, true>(ring, g, S, E);
            SEAM(pb + 0);
        }
#endif
#ifndef SKIP_PREP
        if (IN(pb + 1)) { FRESH(); ph_prep(p, F, l); if (l == 0) { int rot = 0; conv_layer_win(p, F, 1, rot); } SEAM(pb + 1); }
#endif
        if (IN(pb + 2)) {
#ifndef SKIP_MIX
            FRESH(); ph_mixers(p, F, l); __syncthreads();
#endif
#ifndef SKIP_G3
            pg8::Gemm g{((bf16*)(F.ws + WS_H)), ((bf16*)(F.ws + WS_WG)), MT, 4 * DM, DM}; pg8::SkewOrder S; S.init(MT, 4 * DM, F.G, F.bx); S.nslow = N_SCAN_WG; S.rs = 9;
            pg8::EpiGate8 E{GATESP(F, l), 4 * DM, p.in[I_BGATE] + (size_t)l * 4 * DM};
            pg8::gemm_phase<pg8::EpiGate8, pg8::SkewOrder, true, true>(ring, g, S, E);
#endif
            SEAM(pb + 2);
        }
#ifndef SKIP_POSTA
        if (IN(pb + 3)) { FRESH(); ph_posta(p, F, l); if (l == 0) { int rot = 0; conv_layer_wgate(p, F, 1, rot); } SEAM(pb + 3); }
#endif
#ifndef SKIP_G4
        if (IN(pb + 4)) {
            pg8::Gemm g{((bf16*)(F.ws + WS_OALL)), ((bf16*)(F.ws + WS_WBR)), 4 * MT, 4 * DM, BW}; pg8::BranchOrder S; S.init(MT, DM, F.G, F.bx); S.mtiles = MT / 256; S.ntiles = DM / 256;
            pg8::EpiBranch E{GATESP(F, l), ((float*)(F.ws + WS_OUTF)), ((bf16*)(F.ws + WS_MERGED)), MT / 256, DM / 256};
            pg8::gemm_phase<pg8::EpiBranch, pg8::BranchOrder, true, true>(ring, g, S, E);
            SEAM(pb + 4);
        }
#endif
#ifndef SKIP_G5
        if (IN(pb + 5)) {
            pg8::Gemm g{((bf16*)(F.ws + WS_MERGED)), ((bf16*)(F.ws + WS_WOUT)), MT, DM, DM}; pg8::StaticOrder S; S.init(MT, DM, F.G, F.bx); pg8::EpiF32 E{((float*)(F.ws + WS_OUTF)), DM};
            pg8::gemm_phase<pg8::EpiF32, pg8::StaticOrder, true, true>(ring, g, S, E);
            SEAM(pb + 5);
        }
#endif
#ifndef SKIP_POSTN
        if (IN(pb + 6)) { FRESH(); ph_postnorm(p, F, l); if (l == 0) { int rot = 0; conv_layer_wbr(p, F, 1, rot); conv_layer_wout(p, F, 1, rot); } SEAM(pb + 6); }
#endif
    }
#undef IN
#undef SEAM
}

#ifndef MK_ONE_LAUNCH
#define MK_ONE_LAUNCH 0
#endif
extern "C" void kernel_launch(void* const* d_in, const int* in_sizes, int n_in, void* d_out, int out_size, void* d_ws, size_t ws_size, hipStream_t stream) {
    static int grid = 0;
    if (grid == 0) {
        if (n_in != N_INPUTS || (size_t)out_size != O_END || ws_size < WS_END) { fprintf(stderr, "kernel_launch: unexpected problem: n_in %d out %d ws %zu (need %zu)\n", n_in, out_size, ws_size, (size_t)WS_END); grid = -1; return; }
        int dev = 0, cus = 0, per_cu = 0;
        if (hipGetDevice(&dev) != hipSuccess || hipDeviceGetAttribute(&cus, hipDeviceAttributeMultiprocessorCount, dev) != hipSuccess) { grid = -1; return; }
        if (hipFuncSetAttribute((const void*)fwd, hipFuncAttributeMaxDynamicSharedMemorySize, LDS_BYTES) != hipSuccess) { fprintf(stderr, "kernel_launch: hipFuncSetAttribute failed\n"); grid = -1; return; }
        if (hipOccupancyMaxActiveBlocksPerMultiprocessor(&per_cu, (const void*)fwd, NTHR, LDS_BYTES) != hipSuccess || per_cu < 1) fprintf(stderr, "kernel_launch: occupancy query says %d\n", per_cu);
        (void)hipGetLastError();
        if (cus != GRID) fprintf(stderr, "kernel_launch: built for %d CUs, device has %d\n", GRID, cus);
        grid = GRID;
    }
    if (grid < 0) return;
    if (hipMemsetAsync((char*)d_ws + WS_CTL, 0, CTL_ZERO_BYTES, stream) != hipSuccess) return;
    P a{};
    for (int i = 0; i < N_INPUTS; ++i) a.in[i] = (const float*)d_in[i];
    a.out = (float*)d_out; a.ws = (unsigned char*)d_ws; a.dbg = 0; a.pad = 0;
#if MK_ONE_LAUNCH
    a.ph_lo = 0; a.ph_hi = N_PHASES;
    hipLaunchKernelGGL(fwd, dim3(grid), dim3(NTHR), LDS_BYTES, stream, a);
#else
    for (int k = 0; k < N_PHASES; ++k) { a.ph_lo = k; a.ph_hi = k + 1; hipLaunchKernelGGL(fwd, dim3(grid), dim3(NTHR), LDS_BYTES, stream, a); }
#endif
}
```

```cpp
#include <hip/hip_runtime.h>
#include <cstdio>
#include <cstdint>
namespace pg8 {
#define PG8_LAS __attribute__((address_space(3)))
typedef unsigned short bf16_t;
typedef short bf16x8 __attribute__((ext_vector_type(8)));
typedef float f32x4 __attribute__((ext_vector_type(4)));
typedef unsigned u32x4 __attribute__((ext_vector_type(4)));
constexpr int BM = 256, BK = 64, HALF = 128, HTB = HALF * BK * 2  , STAGE_BYTES = 8 * HTB, NXCD = 8, WGM = 8;

__host__ __device__ __forceinline__ int lds_byte(int r, int c) { const int st = (r >> 4) * 2 + (c >> 5), rr = r & 15, cc = c & 31, ob = rr * 64 + cc * 2; return st * 1024 + (ob ^ (((ob >> 9) & 1) << 5)); }
__host__ __device__ __forceinline__ void stage_rc(int b, int& R, int& C) { const int st = b / 1024, sb = b % 1024, swz = sb ^ (((sb >> 9) & 1) << 5); R = (st >> 1) * 16 + swz / 64; C = (st & 1) * 32 + (swz % 64) / 2; }
__host__ __device__ __forceinline__ int perm32(int rho) { const int n = rho >> 4, i = rho & 15; return 8 * (i >> 2) + 4 * n + (i & 3); }

struct Unit { int pm, pn; };
struct Gemm { const bf16_t* A; const bf16_t* Bt; int M, N, K, ld; };

__device__ __forceinline__ unsigned cvt_pk_bf16(float lo, float hi) { unsigned r; asm volatile("v_cvt_pk_bf16_f32 %0, %1, %2" : "=v"(r) : "v"(lo), "v"(hi)); return r; }
typedef float f32x2 __attribute__((ext_vector_type(2)));
typedef unsigned u32x2 __attribute__((ext_vector_type(2)));
typedef int i32x8 __attribute__((ext_vector_type(8)));
struct StaticOrder {
    int nM, nN, nwg, G, c;
    __host__ __device__ void init(int M, int N, int G_, int c_) { nM = M / BM; nN = N / BM; nwg = nM * nN; G = G_; c = c_; }
    __host__ __device__ __forceinline__ void tile_of(int wgid, int& pm, int& pn) const {
        { const int q = nwg / NXCD, r = nwg % NXCD, xcd = wgid % NXCD, off = wgid / NXCD; wgid = (xcd < r ? xcd * (q + 1) : r * (q + 1) + (xcd - r) * q) + off; }
        const int nig = WGM * nN, gid = wgid / nig, fm = gid * WGM, gsz = (nM - fm) < WGM ? (nM - fm) : WGM;
        pm = fm + ((wgid % nig) % gsz); pn = (wgid % nig) / gsz; }
    __host__ __device__ bool next(int i, Unit& u) const { const long L = (long)i * G + c; if (L >= nwg) return false; tile_of((int)L, u.pm, u.pn); return true; }
    __device__ __forceinline__ void a_ready(const Unit&) const {}
    __device__ __forceinline__ void done(const Unit&) const {}
};
struct MaskOrder : StaticOrder {
    unsigned long long mask;
    __host__ __device__ bool next(int i, Unit& u) const { const long L = (long)i * G + c; if (L >= nwg) return false; int pm, j; tile_of((int)L, pm, j); unsigned long long m = mask;
        for (int q = 0; q < j; ++q) m &= m - 1;
        u.pm = pm; u.pn = __builtin_ctzll(m); return true; }
};
struct MaskSkewOrder : StaticOrder {
    unsigned long long mask; int nslow, rs;
    __host__ __device__ bool next(int i, Unit& u) const {
        long L;
        if (i < rs) L = (long)i * G + c; else { if (c < nslow) return false; L = (long)rs * G + (long)(i - rs) * (G - nslow) + (c - nslow); }
        if (L >= nwg) return false; int pm, j; tile_of((int)L, pm, j); unsigned long long m = mask;
        for (int q = 0; q < j; ++q) m &= m - 1;
        u.pm = pm; u.pn = __builtin_ctzll(m); return true; }
};
struct SkewOrder : StaticOrder {
    int nslow, rs;
    __host__ __device__ bool next(int i, Unit& u) const {
        long L;
        if (i < rs) L = (long)i * G + c; else { if (c < nslow) return false; L = (long)rs * G + (long)(i - rs) * (G - nslow) + (c - nslow); }
        if (L >= nwg) return false; tile_of((int)L, u.pm, u.pn); return true; }
};
struct BranchOrder : StaticOrder {
    int mtiles, ntiles;
    __host__ __device__ bool next(int i, Unit& u) const { const long L = (long)(i >> 2) * G + c; if (L >= nwg) return false; int pm, pn; tile_of((int)L, pm, pn); const int n = i & 3; u.pm = n * mtiles + pm; u.pn = n * ntiles + pn; return true; }
};
struct MemOrder {
    int G, c;
    __host__ __device__ bool next(int i, Unit& u) const { const long L = (long)i * G + c; if (L >= 128) return false; const int l = (int)L >> 6, t = (int)L & 63; u.pm = l * 8 + (t >> 3); u.pn = l * 8 + (t & 7); return true; }
    __device__ __forceinline__ void a_ready(const Unit&) const {}
    __device__ __forceinline__ void done(const Unit&) const {}
};

struct EpiBf16 {
    static constexpr bool PERM = true, AFTER_DRAIN = false, KEEP_ACC = false, FP8 = false, I8 = false;
    bf16_t* O; int ldc;
    __device__ __forceinline__ void operator()(const f32x4 (&acc)[2][2][4][2], const Unit& u, int wr, int wc, int fr, int fq) const {
        const int row0 = u.pm * BM + wr * 64 + fr, col0 = u.pn * BM + wc * 32 + 8 * fq;
#pragma unroll
        for (int ai = 0; ai < 2; ++ai)
#pragma unroll
            for (int m = 0; m < 4; ++m) { bf16_t* rowp = O + (size_t)(row0 + ai * HALF + m * 16) * ldc + col0;
#pragma unroll
                for (int bj = 0; bj < 2; ++bj) { const f32x4 v0 = acc[ai][bj][m][0], v1 = acc[ai][bj][m][1];
                    u32x4 w; w.x = cvt_pk_bf16(v0[0], v0[1]); w.y = cvt_pk_bf16(v0[2], v0[3]); w.z = cvt_pk_bf16(v1[0], v1[1]); w.w = cvt_pk_bf16(v1[2], v1[3]);
                    *(u32x4*)(rowp + bj * HALF) = w; } }
    }
};
struct EpiF32 {
    static constexpr bool PERM = false, AFTER_DRAIN = false, KEEP_ACC = false, FP8 = false, I8 = false;
    float* C; int ldc;
    __device__ __forceinline__ void operator()(const f32x4 (&acc)[2][2][4][2], const Unit& u, int wr, int wc, int fr, int fq) const {
        const int row0 = u.pm * BM + wr * 64 + fr, col0 = u.pn * BM + wc * 32 + 4 * fq;
#pragma unroll
        for (int ai = 0; ai < 2; ++ai)
#pragma unroll
            for (int m = 0; m < 4; ++m) { float* rowp = C + (size_t)(row0 + ai * HALF + m * 16) * ldc + col0;
#pragma unroll
                for (int bj = 0; bj < 2; ++bj)
#pragma unroll
                    for (int n = 0; n < 2; ++n) *(f32x4*)(rowp + bj * HALF + n * 16) = acc[ai][bj][m][n]; }
    }
};
struct EpiMemKV {
    static constexpr bool PERM = false, AFTER_DRAIN = false, KEEP_ACC = false, FP8 = false, I8 = false;
    float* outk; size_t voff;
    __device__ __forceinline__ void operator()(const f32x4 (&acc)[2][2][4][2], const Unit& u, int wr, int wc, int fr, int fq) const {
        const int l = u.pm >> 3, pm = u.pm & 7, pn = u.pn & 7;
        float* base = outk + (size_t)(pn >> 2) * voff + (size_t)l * 2048 * 1024;
        const int row0 = pm * BM + wr * 64 + fr, col0 = (pn & 3) * BM + wc * 32 + 4 * fq;
#pragma unroll
        for (int ai = 0; ai < 2; ++ai)
#pragma unroll
            for (int m = 0; m < 4; ++m) { float* rowp = base + (size_t)(row0 + ai * HALF + m * 16) * 1024 + col0;
#pragma unroll
                for (int bj = 0; bj < 2; ++bj)
#pragma unroll
                    for (int n = 0; n < 2; ++n) *(f32x4*)(rowp + bj * HALF + n * 16) = acc[ai][bj][m][n]; }
    }
};
__device__ __forceinline__ float i8val(float accbits, float s) { return (float)__builtin_bit_cast(int, accbits) * s; }
__device__ __forceinline__ unsigned sig8(float x) { const float s = __builtin_amdgcn_rcpf(1.0f + __builtin_amdgcn_exp2f(-x * 1.4426950408889634f)); const unsigned q = (unsigned)(s * 255.0f + 0.5f); return q < 1u ? 1u : q; }
struct EpiI8Bf16 {
    static constexpr bool PERM = true, AFTER_DRAIN = false, KEEP_ACC = false, FP8 = false, I8 = true;
    bf16_t* O; int ldc; const float* sa; const float* cmax;
    __device__ __forceinline__ void operator()(const f32x4 (&acc)[2][2][4][2], const Unit& u, int wr, int wc, int fr, int fq) const {
        asm volatile("" : "+v"(fr), "+v"(fq));
        const int row0 = u.pm * BM + wr * 64 + fr, col0 = u.pn * BM + wc * 32 + 8 * fq;
        f32x4 srv[2], cb0[2], cb1[2];
#pragma unroll
        for (int ai = 0; ai < 2; ++ai) { srv[ai][0] = sa[row0 + ai * HALF]; srv[ai][1] = sa[row0 + ai * HALF + 16]; srv[ai][2] = sa[row0 + ai * HALF + 32]; srv[ai][3] = sa[row0 + ai * HALF + 48]; }
#pragma unroll
        for (int bj = 0; bj < 2; ++bj) { cb0[bj] = *(const f32x4*)(cmax + col0 + bj * HALF) * (1.0f / 127.0f); cb1[bj] = *(const f32x4*)(cmax + col0 + bj * HALF + 4) * (1.0f / 127.0f); }
#pragma unroll
        for (int bj = 0; bj < 2; ++bj) { const f32x4 b0 = cb0[bj], b1 = cb1[bj];
#pragma unroll
            for (int ai = 0; ai < 2; ++ai)
#pragma unroll
                for (int m = 0; m < 4; ++m) { const int row = row0 + ai * HALF + m * 16; const float sr = srv[ai][m]; bf16_t* rowp = O + (size_t)row * ldc + col0;
                    const f32x4 v0 = acc[ai][bj][m][0], v1 = acc[ai][bj][m][1];
                    u32x4 w; w.x = cvt_pk_bf16(i8val(v0[0], sr * b0[0]), i8val(v0[1], sr * b0[1])); w.y = cvt_pk_bf16(i8val(v0[2], sr * b0[2]), i8val(v0[3], sr * b0[3]));
                    w.z = cvt_pk_bf16(i8val(v1[0], sr * b1[0]), i8val(v1[1], sr * b1[1])); w.w = cvt_pk_bf16(i8val(v1[2], sr * b1[2]), i8val(v1[3], sr * b1[3]));
                    *(u32x4*)(rowp + bj * HALF) = w; } }
    }
};
struct EpiGate8 {
    static constexpr bool PERM = true, AFTER_DRAIN = false, KEEP_ACC = false, FP8 = false, I8 = true;
    unsigned char* G; int ldc; const float* bias; const float* sa; const float* cmax;
    __device__ __forceinline__ void operator()(const f32x4 (&acc)[2][2][4][2], const Unit& u, int wr, int wc, int fr, int fq) const {
        asm volatile("" : "+v"(fr), "+v"(fq));
        const int row0 = u.pm * BM + wr * 64 + fr, col0 = u.pn * BM + wc * 32 + 8 * fq;
        f32x4 srv[2], gb0[2], gb1[2], gc0[2], gc1[2];
#pragma unroll
        for (int ai = 0; ai < 2; ++ai) { srv[ai][0] = sa[row0 + ai * HALF]; srv[ai][1] = sa[row0 + ai * HALF + 16]; srv[ai][2] = sa[row0 + ai * HALF + 32]; srv[ai][3] = sa[row0 + ai * HALF + 48]; }
#pragma unroll
        for (int bj = 0; bj < 2; ++bj) { gb0[bj] = *(const f32x4*)(bias + col0 + bj * HALF); gb1[bj] = *(const f32x4*)(bias + col0 + bj * HALF + 4);
            gc0[bj] = *(const f32x4*)(cmax + col0 + bj * HALF) * (1.0f / 127.0f); gc1[bj] = *(const f32x4*)(cmax + col0 + bj * HALF + 4) * (1.0f / 127.0f); }
#pragma unroll
        for (int bj = 0; bj < 2; ++bj) { const f32x4 b0 = gb0[bj], b1 = gb1[bj], c0 = gc0[bj], c1 = gc1[bj];
#pragma unroll
            for (int ai = 0; ai < 2; ++ai)
#pragma unroll
                for (int m = 0; m < 4; ++m) { const int row = row0 + ai * HALF + m * 16; const float sr = srv[ai][m]; unsigned char* rowp = G + (size_t)row * ldc + col0;
                    const f32x4 v0 = acc[ai][bj][m][0], v1 = acc[ai][bj][m][1];
                    u32x2 w;
                    w.x = sig8(i8val(v0[0], sr * c0[0]) + b0[0]) | (sig8(i8val(v0[1], sr * c0[1]) + b0[1]) << 8) | (sig8(i8val(v0[2], sr * c0[2]) + b0[2]) << 16) | (sig8(i8val(v0[3], sr * c0[3]) + b0[3]) << 24);
                    w.y = sig8(i8val(v1[0], sr * c1[0]) + b1[0]) | (sig8(i8val(v1[1], sr * c1[1]) + b1[1]) << 8) | (sig8(i8val(v1[2], sr * c1[2]) + b1[2]) << 16) | (sig8(i8val(v1[3], sr * c1[3]) + b1[3]) << 24);
                    *(u32x2*)(rowp + bj * HALF) = w; } }
    }
};
struct EpiBranch {
    static constexpr bool PERM = true, AFTER_DRAIN = false, KEEP_ACC = true, FP8 = false, I8 = false;
    const unsigned char* G; bf16_t* merged; int mtiles, ntiles, ldm;
    __device__ __forceinline__ bool keep(const Unit& u) const { return (u.pn / ntiles) < 3; }
    __device__ __forceinline__ void operator()(f32x4 (&acc)[2][2][4][2], const Unit& u, int wr, int wc, int fr, int fq) const {
        const int n = u.pn / ntiles, pm = u.pm - n * mtiles, pn = u.pn - n * ntiles;
        const int row0 = pm * BM + wr * 64 + fr, col0 = pn * BM + wc * 32 + 8 * fq;
#pragma unroll
        for (int ai = 0; ai < 2; ++ai)
#pragma unroll
            for (int m = 0; m < 4; ++m) { const size_t row = (size_t)(row0 + ai * HALF + m * 16);
#pragma unroll
                for (int bj = 0; bj < 2; ++bj) { const int col = col0 + bj * HALF;
                    const unsigned char* gp = G + row * (size_t)(4 * 4096) + (size_t)n * 4096 + col;
                    const u32x2 g = *(const u32x2*)gp;
                    f32x4 g0, g1;
                    g0[0] = (float)(g.x & 255u); g0[1] = (float)((g.x >> 8) & 255u); g0[2] = (float)((g.x >> 16) & 255u); g0[3] = (float)(g.x >> 24);
                    g1[0] = (float)(g.y & 255u); g1[1] = (float)((g.y >> 8) & 255u); g1[2] = (float)((g.y >> 16) & 255u); g1[3] = (float)(g.y >> 24);
                    if (n < 3) { const u32x2 h = *(const u32x2*)(gp + 4096);
                        g0[0] *= __builtin_amdgcn_rcpf((float)(h.x & 255u)); g0[1] *= __builtin_amdgcn_rcpf((float)((h.x >> 8) & 255u)); g0[2] *= __builtin_amdgcn_rcpf((float)((h.x >> 16) & 255u)); g0[3] *= __builtin_amdgcn_rcpf((float)(h.x >> 24));
                        g1[0] *= __builtin_amdgcn_rcpf((float)(h.y & 255u)); g1[1] *= __builtin_amdgcn_rcpf((float)((h.y >> 8) & 255u)); g1[2] *= __builtin_amdgcn_rcpf((float)((h.y >> 16) & 255u)); g1[3] *= __builtin_amdgcn_rcpf((float)(h.y >> 24));
                        acc[ai][bj][m][0] *= g0; acc[ai][bj][m][1] *= g1; }
                    else { const float k = 1.0f / 255.0f; const f32x4 v0 = acc[ai][bj][m][0] * g0 * k, v1 = acc[ai][bj][m][1] * g1 * k;
                        u32x4 w; w.x = cvt_pk_bf16(v0[0], v0[1]); w.y = cvt_pk_bf16(v0[2], v0[3]); w.z = cvt_pk_bf16(v1[0], v1[1]); w.w = cvt_pk_bf16(v1[2], v1[3]);
                        *(u32x4*)(merged + row * (size_t)ldm + col) = w; } } }
    }
};

__device__ __forceinline__ void atom_add_f32(float* p, float v) { asm volatile("global_atomic_add_f32 %0, %1, off" :: "v"(p), "v"(v) : "memory"); }
struct SliceOrder {
    int pm, pn; bool valid;
    __host__ __device__ bool next(int i, Unit& u) const { if (i != 0 || !valid) return false; u.pm = pm; u.pn = pn; return true; }
    __device__ __forceinline__ void a_ready(const Unit&) const {}
    __device__ __forceinline__ void done(const Unit&) const {}
};
struct EpiBranchPart {
    static constexpr bool PERM = true, AFTER_DRAIN = false, KEEP_ACC = false, FP8 = false, I8 = false;
    const unsigned char* G; float* part; int mtiles, ntiles, row_base;
    __device__ __forceinline__ void operator()(const f32x4 (&acc)[2][2][4][2], const Unit& u, int wr, int wc, int fr, int fq) const {
        const int n = u.pn / ntiles, pm = u.pm - n * mtiles, pn = u.pn - n * ntiles;
        const int row0 = pm * BM + wr * 64 + fr, col0 = pn * BM + wc * 32 + 8 * fq;
        u32x2 gq[2][4][2];
#pragma unroll
        for (int ai = 0; ai < 2; ++ai)
#pragma unroll
            for (int m = 0; m < 4; ++m)
#pragma unroll
                for (int bj = 0; bj < 2; ++bj) gq[ai][m][bj] = *(const u32x2*)(G + (size_t)(row0 + ai * HALF + m * 16) * (size_t)(4 * 4096) + (size_t)n * 4096 + col0 + bj * HALF);
#pragma unroll
        for (int ai = 0; ai < 2; ++ai)
#pragma unroll
            for (int m = 0; m < 4; ++m) { const size_t row = (size_t)(row0 + ai * HALF + m * 16);
#pragma unroll
                for (int bj = 0; bj < 2; ++bj) { const int col = col0 + bj * HALF;
                    const u32x2 g = gq[ai][m][bj]; const float k = 1.0f / 255.0f;
                    f32x4 g0, g1;
                    g0[0] = (float)(g.x & 255u) * k; g0[1] = (float)((g.x >> 8) & 255u) * k; g0[2] = (float)((g.x >> 16) & 255u) * k; g0[3] = (float)(g.x >> 24) * k;
                    g1[0] = (float)(g.y & 255u) * k; g1[1] = (float)((g.y >> 8) & 255u) * k; g1[2] = (float)((g.y >> 16) & 255u) * k; g1[3] = (float)(g.y >> 24) * k;
                    float* q = part + (size_t)n * 512 * 4096 + (row - (size_t)row_base) * 4096 + col;
                    *(f32x4*)q = acc[ai][bj][m][0] * g0; *(f32x4*)(q + 4) = acc[ai][bj][m][1] * g1; } }
    }
};
template <class Epi, class Sched, bool ALIGN_EPI = false, bool SP2 = false>
__device__ __forceinline__ void gemm_phase(PG8_LAS unsigned char* lds, const Gemm g, const Sched& S, const Epi& E, int wave_id) {
    int tid_l; asm volatile("v_mbcnt_lo_u32_b32 %0, -1, 0\n\tv_mbcnt_hi_u32_b32 %0, -1, %0" : "=v"(tid_l)); tid_l += wave_id * 64;
    const int tid = tid_l, wid = __builtin_amdgcn_readfirstlane(tid >> 6), lane = tid & 63, wr = wid >> 2, wc = wid & 3, fr = lane & 15, fq = lane >> 4;
    const int K = g.K, nt = K / BK, ld = g.ld;
    unsigned voffA[2], voffB[2];
#pragma unroll
    for (int i = 0; i < 2; ++i) { int R, C; stage_rc(tid * 16 + i * 8192, R, C); const int Rb = Epi::PERM ? ((R & ~31) + perm32(R & 31)) : R;
        voffA[i] = (unsigned)(R * ld + C) * 2u; voffB[i] = (unsigned)(Rb * ld + C) * 2u; }
    const size_t kstep = (size_t)(BK * 2);
    const size_t hstep = (size_t)HALF * ld * 2;
    const size_t tstep = 2 * hstep;
    const unsigned ldsw = (unsigned)wid * 1024u;
    const int aoff = lds_byte(wr * 64 + fr, fq * 8), boff = lds_byte(wc * 32 + fr, fq * 8);
#define PG8_SA(b, h) (((b) * 2 + (h)) * HTB)
#define PG8_SB(b, h) ((4 + (b) * 2 + (h)) * HTB)
#define PG8_STAGE(bufoff, gbase, voff) do { _Pragma("unroll") for (int _i = 0; _i < 2; ++_i) \
        __builtin_amdgcn_global_load_lds((const unsigned*)((const char*)(gbase) + (voff)[_i]), (PG8_LAS unsigned*)(lds + (bufoff) + ldsw + _i * 8192), 16, 0, 0); } while (0)
#define PG8_LDA(dst, b, h) do { _Pragma("unroll") for (int m = 0; m < 4; ++m) _Pragma("unroll") for (int k = 0; k < 2; ++k) dst[m][k] = *(const PG8_LAS bf16x8*)(lds + PG8_SA(b, h) + aoff + m * 2048 + k * 1024); } while (0)
#define PG8_LDB(dst, b, h) do { _Pragma("unroll") for (int n = 0; n < 2; ++n) _Pragma("unroll") for (int k = 0; k < 2; ++k) dst[n][k] = *(const PG8_LAS bf16x8*)(lds + PG8_SB(b, h) + boff + n * 2048 + k * 1024); } while (0)
#define PG8_MMA(ai, bj, At, Bt) do { __builtin_amdgcn_s_setprio(1); \
        if constexpr (Epi::FP8) { _Pragma("unroll") for (int m = 0; m < 4; ++m) _Pragma("unroll") for (int n = 0; n < 2; ++n) \
            asm volatile("v_mfma_scale_f32_16x16x128_f8f6f4 %0, %1, %2, %0, %3, %3 op_sel_hi:[0,0,0]" : "+v"(acc[ai][bj][m][n]) \
                : "v"(__builtin_bit_cast(i32x8, __builtin_shufflevector(Bt[n][0], Bt[n][1], 0, 1, 2, 3, 4, 5, 6, 7, 8, 9, 10, 11, 12, 13, 14, 15))), \
                  "v"(__builtin_bit_cast(i32x8, __builtin_shufflevector(At[m][0], At[m][1], 0, 1, 2, 3, 4, 5, 6, 7, 8, 9, 10, 11, 12, 13, 14, 15))), "v"(fp8_unit_scale)); } \
        else if constexpr (Epi::I8) { _Pragma("unroll") for (int m = 0; m < 4; ++m) _Pragma("unroll") for (int n = 0; n < 2; ++n) _Pragma("unroll") for (int k = 0; k < 2; ++k) \
            asm volatile("v_mfma_i32_16x16x64_i8 %0, %1, %2, %0" : "+v"(acc[ai][bj][m][n]) : "v"(Bt[n][k]), "v"(At[m][k])); } \
        else { _Pragma("unroll") for (int m = 0; m < 4; ++m) _Pragma("unroll") for (int n = 0; n < 2; ++n) _Pragma("unroll") for (int k = 0; k < 2; ++k) \
        acc[ai][bj][m][n] = __builtin_amdgcn_mfma_f32_16x16x32_bf16(Bt[n][k], At[m][k], acc[ai][bj][m][n], 0, 0, 0); } __builtin_amdgcn_s_setprio(0); } while (0)
#define PG8_WAIT_V(n) asm volatile("s_waitcnt vmcnt(" #n ")" ::: "memory")
#define PG8_WAIT_L(n) asm volatile("s_waitcnt lgkmcnt(" #n ")" ::: "memory")
#define PG8_BAR __builtin_amdgcn_s_barrier()
#define PG8_SCHED __builtin_amdgcn_sched_barrier(0)
    int fp8_unit_scale = 0x7f7f7f7f; if constexpr (Epi::FP8) asm volatile("" : "+v"(fp8_unit_scale));
    Unit cur, nxt; int ui = 0;
    if (!S.next(0, cur)) return;
    f32x4 acc[2][2][4][2];
#pragma unroll
    for (int a = 0; a < 2; ++a)
#pragma unroll
        for (int b = 0; b < 2; ++b)
#pragma unroll
            for (int m = 0; m < 4; ++m)
#pragma unroll
                for (int n = 0; n < 2; ++n) acc[a][b][m][n] = (f32x4){0.f, 0.f, 0.f, 0.f};
    bf16x8 At[4][2], B0[2][2], B1[2][2];
    const char* cA = (const char*)g.A + (size_t)cur.pm * tstep; const char* cB = (const char*)g.Bt + (size_t)cur.pn * tstep;
    S.a_ready(cur);
    if constexpr (SP2) {
        PG8_STAGE(PG8_SB(0, 0), cB, voffB); PG8_STAGE(PG8_SB(0, 1), cB + hstep, voffB); PG8_STAGE(PG8_SA(0, 0), cA, voffA); PG8_STAGE(PG8_SA(0, 1), cA + hstep, voffA);
        if (wr == 1) PG8_BAR;
        PG8_WAIT_V(2); PG8_BAR;
        PG8_STAGE(PG8_SB(1, 0), cB + kstep, voffB); PG8_STAGE(PG8_SA(1, 0), cA + kstep, voffA); PG8_STAGE(PG8_SB(1, 1), cB + hstep + kstep, voffB);
        PG8_WAIT_V(6); PG8_BAR;
    } else {
        PG8_STAGE(PG8_SB(0, 0), cB, voffB); PG8_STAGE(PG8_SA(0, 0), cA, voffA); PG8_STAGE(PG8_SB(0, 1), cB + hstep, voffB); PG8_STAGE(PG8_SA(0, 1), cA + hstep, voffA);
        if (wr == 1) PG8_BAR;
        PG8_WAIT_V(4); PG8_BAR;
        PG8_STAGE(PG8_SB(1, 0), cB + kstep, voffB); PG8_STAGE(PG8_SA(1, 0), cA + kstep, voffA); PG8_STAGE(PG8_SB(1, 1), cB + hstep + kstep, voffB);
        PG8_WAIT_V(6); PG8_BAR;
    }
    for (;;) {
        const bool has_next = S.next(ui + 1, nxt);
        const char* nA = has_next ? (const char*)g.A + (size_t)nxt.pm * tstep : cA; const char* nB = has_next ? (const char*)g.Bt + (size_t)nxt.pn * tstep : cB;
        for (int t = 0; t < nt; t += 2) {
            const bool last = (t == nt - 2);
            const char* a1 = cA + (size_t)(t + 1) * kstep;
            const char* a2 = last ? nA : cA + (size_t)(t + 2) * kstep; const char* b2 = last ? nB : cB + (size_t)(t + 2) * kstep;
            const char* a3 = a2 + kstep; const char* b3 = b2 + kstep;
            if (last && has_next) S.a_ready(nxt);
            if constexpr (SP2) {
            PG8_LDB(B0, 0, 0); PG8_LDB(B1, 0, 1); PG8_SCHED; PG8_LDA(At, 0, 0); PG8_STAGE(PG8_SA(1, 1), a1 + hstep, voffA);
            PG8_WAIT_V(8); PG8_WAIT_L(0); PG8_BAR; PG8_MMA(0, 0, At, B0); PG8_MMA(0, 1, At, B1); PG8_BAR; PG8_SCHED;
            PG8_LDA(At, 0, 1); PG8_STAGE(PG8_SB(0, 0), b2, voffB); PG8_STAGE(PG8_SB(0, 1), b2 + hstep, voffB); PG8_STAGE(PG8_SA(0, 0), a2, voffA);
            PG8_WAIT_V(8); PG8_WAIT_L(0); PG8_BAR; PG8_MMA(1, 0, At, B0); PG8_MMA(1, 1, At, B1); PG8_BAR; PG8_SCHED;
            PG8_LDB(B0, 1, 0); PG8_LDB(B1, 1, 1); PG8_SCHED; PG8_LDA(At, 1, 0); PG8_STAGE(PG8_SA(0, 1), a2 + hstep, voffA);
            PG8_WAIT_V(8); PG8_WAIT_L(0); PG8_BAR; PG8_MMA(0, 0, At, B0); PG8_MMA(0, 1, At, B1); PG8_BAR; PG8_SCHED;
            PG8_LDA(At, 1, 1); PG8_STAGE(PG8_SB(1, 0), b3, voffB); PG8_STAGE(PG8_SB(1, 1), b3 + hstep, voffB); PG8_STAGE(PG8_SA(1, 0), a3, voffA);
            PG8_WAIT_V(8); PG8_WAIT_L(0); PG8_BAR; PG8_MMA(1, 0, At, B0); PG8_MMA(1, 1, At, B1); PG8_BAR; PG8_SCHED;
            } else {
            PG8_LDB(B0, 0, 0); PG8_SCHED; PG8_LDA(At, 0, 0); PG8_STAGE(PG8_SA(1, 1), a1 + hstep, voffA);
            PG8_WAIT_L(8); PG8_BAR; PG8_WAIT_L(0); PG8_MMA(0, 0, At, B0); PG8_BAR; PG8_SCHED;
            PG8_LDB(B1, 0, 1); PG8_STAGE(PG8_SB(0, 0), b2, voffB);
            PG8_BAR; PG8_WAIT_L(0); PG8_MMA(0, 1, At, B1); PG8_BAR;
            PG8_LDA(At, 0, 1); PG8_STAGE(PG8_SA(0, 0), a2, voffA);
            PG8_BAR; PG8_WAIT_L(0); PG8_MMA(1, 0, At, B0); PG8_BAR; PG8_SCHED;
            PG8_STAGE(PG8_SB(0, 1), b2 + hstep, voffB);
            PG8_WAIT_V(6); PG8_BAR; PG8_MMA(1, 1, At, B1); PG8_BAR;
            PG8_LDB(B0, 1, 0); PG8_SCHED; PG8_LDA(At, 1, 0); PG8_STAGE(PG8_SA(0, 1), a2 + hstep, voffA);
            PG8_WAIT_L(8); PG8_BAR; PG8_WAIT_L(0); PG8_MMA(0, 0, At, B0); PG8_BAR; PG8_SCHED;
            PG8_LDB(B1, 1, 1); PG8_STAGE(PG8_SB(1, 0), b3, voffB);
            PG8_BAR; PG8_WAIT_L(0); PG8_MMA(0, 1, At, B1); PG8_BAR;
            PG8_LDA(At, 1, 1); PG8_STAGE(PG8_SA(1, 0), a3, voffA);
            PG8_BAR; PG8_WAIT_L(0); PG8_MMA(1, 0, At, B0); PG8_BAR; PG8_SCHED;
            PG8_STAGE(PG8_SB(1, 1), b3 + hstep, voffB);
            PG8_WAIT_V(6); PG8_BAR; PG8_MMA(1, 1, At, B1); PG8_BAR;
            }
        }
        if constexpr (ALIGN_EPI) { if (wr == 0) PG8_BAR; }
        if constexpr (Epi::FP8 || Epi::I8) asm volatile("s_nop 15\n\ts_nop 7" ::: "memory");
        if constexpr (!Epi::AFTER_DRAIN) { E(acc, cur, wr, wc, fr, fq); S.done(cur); }
        if (!has_next) break;
        bool keep_acc = false; if constexpr (Epi::KEEP_ACC) keep_acc = E.keep(cur);
        if (!keep_acc) {
#pragma unroll
        for (int a = 0; a < 2; ++a)
#pragma unroll
            for (int b = 0; b < 2; ++b)
#pragma unroll
                for (int m = 0; m < 4; ++m)
#pragma unroll
                    for (int n = 0; n < 2; ++n) acc[a][b][m][n] = (f32x4){0.f, 0.f, 0.f, 0.f};
        }
        cur = nxt; cA = nA; cB = nB; ++ui;
        if constexpr (ALIGN_EPI) { if (wr == 1) PG8_BAR; }
    }
    PG8_WAIT_V(0);
    if constexpr (!ALIGN_EPI) { if (wr == 0) PG8_BAR; }
    PG8_BAR;
    if constexpr (Epi::AFTER_DRAIN) { E.fused(acc, cur, wr, wc, fr, fq, lds, wid, lane); S.done(cur); }
#undef PG8_SA
#undef PG8_SB
#undef PG8_STAGE
#undef PG8_LDA
#undef PG8_LDB
#undef PG8_MMA
#undef PG8_WAIT_V
#undef PG8_WAIT_L
#undef PG8_BAR
#undef PG8_SCHED
}
}
#define GAS __attribute__((address_space(1)))
#define LAS __attribute__((address_space(3)))
typedef unsigned short bf16;
typedef unsigned v4u __attribute__((ext_vector_type(4)));
typedef float f32x4 __attribute__((ext_vector_type(4)));
typedef short bf16x8 __attribute__((ext_vector_type(8)));
typedef GAS unsigned gu32;
typedef GAS unsigned long long gu64;
#define RLX_AGENT __ATOMIC_RELAXED, __HIP_MEMORY_SCOPE_AGENT
#define LDS_WAIT() asm volatile("s_waitcnt lgkmcnt(0)" ::: "memory")
#define VM_WAIT() asm volatile("s_waitcnt vmcnt(0)" ::: "memory")
__device__ __forceinline__ unsigned long long rt() { return __builtin_amdgcn_s_memrealtime(); }
__device__ __forceinline__ unsigned f2bf(float f) { unsigned u = __builtin_bit_cast(unsigned, f); return (u + 0x7fffu + ((u >> 16) & 1u)) >> 16; }
__device__ __forceinline__ unsigned pk2(float lo, float hi) { return f2bf(lo) | (f2bf(hi) << 16); }

#define XB_TMO      128
#define XB_XCNT(j)  (256  + 64 * (j))
#define XB_XSUB(j)  (1280 + 64 * (j))
#define XB_XGEN(j)  (2304 + 64 * (j))
#define XB_TOP      3328
#define XB_TOPGEN   3392
#define XCD_BAR_WORDS 3456
#define XB_SPIN_CAP (1u << 18)

__device__ __forceinline__ unsigned xb_ld(unsigned* p)              { return __hip_atomic_load(p, __ATOMIC_RELAXED, __HIP_MEMORY_SCOPE_AGENT); }
__device__ __forceinline__ unsigned xb_add(unsigned* p, unsigned v) { return __hip_atomic_fetch_add(p, v, __ATOMIC_RELAXED, __HIP_MEMORY_SCOPE_AGENT); }
__device__ __forceinline__ unsigned xb_xcc_id() { return (unsigned)__builtin_amdgcn_s_getreg((3 << 11) | 20) & 0xFu; }
#define XB_SPIN(cond, bar) do { unsigned _sp = 0; while (cond) { __builtin_amdgcn_s_sleep(1); \
    if ((++_sp & 255u) == 0u) { if (xb_ld(&(bar)[XB_TMO])) break; if (_sp > XB_SPIN_CAP) { atomicAdd(&(bar)[XB_TMO], 1u); break; } } } } while (0)

struct XcdBarrier {
    unsigned* bar; unsigned x;
    volatile LAS unsigned* st;
};

__device__ __forceinline__ XcdBarrier xcd_barrier_post(unsigned* bar, volatile LAS unsigned* st) {
    XcdBarrier b; b.bar = bar; b.x = xb_xcc_id(); b.st = st;
    if (threadIdx.x == 0) (void)xb_add(&bar[XB_XCNT(b.x)], 1u);
    return b;
}
__device__ __forceinline__ void xcd_barrier_complete(unsigned* bar, unsigned x, unsigned& nloc, unsigned& nx) {
    const unsigned G = gridDim.x * gridDim.y * gridDim.z;
    unsigned sum, cnt, mine, sp = 0u;
    for (;;) {
        sum = 0u; cnt = 0u; mine = 0u;
#pragma unroll
        for (unsigned j = 0; j < 16; ++j) { const unsigned c = xb_ld(&bar[XB_XCNT(j)]); sum += c; cnt += (c > 0u) ? 1u : 0u; mine = (j == x) ? c : mine; }
        if (sum == G) break;
        __builtin_amdgcn_s_sleep(1);
        if ((++sp & 255u) == 0u) { if (xb_ld(&bar[XB_TMO])) break; if (sp > XB_SPIN_CAP) { atomicAdd(&bar[XB_TMO], 1u); break; } }
    }
    nloc = mine > 0u ? mine : 1u; nx = cnt > 0u ? cnt : 1u;
}

__device__ __forceinline__ void xcd_barrier(const XcdBarrier& b) {
    asm volatile("s_waitcnt vmcnt(0)" ::: "memory");
    __syncthreads();
    if (threadIdx.x == 0) {
        unsigned* bar = b.bar;
        __builtin_amdgcn_s_waitcnt(0);
        unsigned nloc = b.st[0], nx = b.st[1];
        if (nloc == 0u) { xcd_barrier_complete(bar, b.x, nloc, nx); b.st[0] = nloc; b.st[1] = nx; }
        const unsigned old = xb_add(&bar[XB_XSUB(b.x)], 1u);
        const unsigned gen = old / nloc;
        if (old + 1u == (gen + 1u) * nloc) {
            __builtin_amdgcn_fence(__ATOMIC_RELEASE, "agent");
            asm volatile("s_waitcnt vmcnt(0)" ::: "memory");
            const unsigned og = xb_add(&bar[XB_TOP], 1u);
            const unsigned tg = og / nx;
            if (og + 1u == (tg + 1u) * nx) xb_add(&bar[XB_TOPGEN], 1u);
            else XB_SPIN(xb_ld(&bar[XB_TOPGEN]) == tg, bar);
            __builtin_amdgcn_fence(__ATOMIC_ACQUIRE, "agent");
            xb_add(&bar[XB_XGEN(b.x)], 1u);
            asm volatile("s_waitcnt vmcnt(0)" ::: "memory");
        } else {
            XB_SPIN(xb_ld(&bar[XB_XGEN(b.x)]) == gen, bar);
            __builtin_amdgcn_fence(__ATOMIC_ACQUIRE, "agent");
            asm volatile("s_waitcnt vmcnt(0)" ::: "memory");
        }
    }
    __syncthreads();
}
#define DI __device__ __forceinline__
#define CAS __attribute__((address_space(4)))
typedef unsigned v2u __attribute__((ext_vector_type(2)));
typedef float f32x16 __attribute__((ext_vector_type(16)));
typedef short s16x4 __attribute__((ext_vector_type(4)));

constexpr int DM = 4096, NB = 8, SEQ = 2048, DEPTH = 2, DSEQ = 64, PAST = 1024, KCATN = PAST + DSEQ;
constexpr int NMEM = 256, BW = 1024, AH = 16, AHD = 64, SHW = 3200;
constexpr int BHN = 8, BHD = 128, CGN = 8, CGD = 128, MHN = 4, MHD = 256;
constexpr int NIN = 12416, NINP = 12544, LDP = DM + 64;
constexpr int MP = NB * SEQ, MS = NB * DSEQ, MT = MP + MS;
constexpr int PC_R = 0, PC_K = 1024, PC_V = 2048, PC_WD = 3072, PC_AD = 3136, PC_AZ = 3328, PC_BQ = 4352, PC_BK = 5376, PC_BV = 6400, PC_BZ = 7424,
              PC_CU = 8448, PC_CV = 9472, PC_CZ = 10496, PC_MQ = 11520;
constexpr float NORM_EPS = 1e-6f, GN_EPS = 64e-5f;
enum { I_XP = 0, I_XS, I_CMK, I_CMV, I_CSK, I_CSV, I_SRW, I_SSH, I_MEM, I_GPRE, I_GPOST, I_WIN, I_AMU, I_AW0, I_AWUP, I_AA0, I_AAUP, I_AKK, I_AKA, I_ARK,
       I_AGNW, I_AGNB, I_CWS, I_CBS, I_CLNW, I_CLNB, I_GMEM, I_WMEM, I_WGATE, I_BGATE, I_WBR, I_WOUT, N_INPUTS };
constexpr size_t O_YP = 0, O_YS = O_YP + (size_t)MP * DM, O_MK = O_YS + (size_t)MS * DM, O_MV = O_MK + (size_t)DEPTH * NB * NMEM * BW,
    O_SKP = O_MV + (size_t)DEPTH * NB * NMEM * BW, O_SVP = O_SKP + (size_t)DEPTH * MP * BW, O_RWP = O_SVP + (size_t)DEPTH * MP * BW,
    O_SHP = O_RWP + (size_t)DEPTH * NB * AH * 64 * 64, O_SKS = O_SHP + (size_t)DEPTH * NB * SHW, O_SVS = O_SKS + (size_t)DEPTH * MS * BW,
    O_RWS = O_SVS + (size_t)DEPTH * MS * BW, O_SHS = O_RWS + (size_t)DEPTH * NB * AH * 64 * 64, O_CVS = O_SHS + (size_t)DEPTH * NB * SHW,
    O_END = O_CVS + (size_t)DEPTH * MS * BW;
constexpr size_t MiB = 1u << 20;
constexpr size_t WS_CTL = 0, CTL_ZERO_BYTES = 1 * MiB;
constexpr size_t WS_WIN = 1 * MiB, WS_WG = 99 * MiB, WS_WBR = 227 * MiB, WS_WOUT = 259 * MiB, WS_WMEM = 291 * MiB;
constexpr size_t WS_H = 323 * MiB, WS_MEMN = 455 * MiB, WS_PROJ = 487 * MiB, WS_MERGED = WS_PROJ, WS_OUTF = WS_PROJ + 132 * MiB;
constexpr size_t WS_RA = 892 * MiB, WS_RB = 1222 * MiB, WS_SCANV = 1552 * MiB, WS_OALL = 1618 * MiB, WS_VT = 1750 * MiB, WS_VNT = 1782 * MiB;
constexpr size_t R_YRAW_OFF = 264 * MiB;
constexpr size_t WS_KCAT = 1816 * MiB, WS_VTCAT = 1850 * MiB, WS_MKB = 1884 * MiB, WS_MVT = 1892 * MiB, WS_CMK = 1900 * MiB, WS_CMVT = 1908 * MiB;
constexpr size_t WS_WM = 1916 * MiB, WS_BONUS = 1917 * MiB, WS_DBG = 1919 * MiB, WS_UPT = WS_DBG, WS_H8 = 1920 * MiB, WS_END = 2035 * MiB;
constexpr size_t WS_PARTS = WS_VT;
static_assert(WS_PARTS + (size_t)8 * MS * DM * 4 <= WS_KCAT, "parts");
static_assert(WS_WIN + (size_t)NINP * DM * 2 <= WS_WG && WS_WG + (size_t)4 * DM * DM * 2 <= WS_WBR && WS_WBR + (size_t)4 * DM * BW * 2 <= WS_WOUT && WS_WOUT + (size_t)DM * DM * 2 <= WS_WMEM, "ws map 1");
static_assert(WS_WMEM + (size_t)DEPTH * 2 * BW * DM * 2 <= WS_H && WS_H + (size_t)MT * DM * 2 <= WS_MEMN && WS_MEMN + (size_t)DEPTH * NB * NMEM * DM * 2 <= WS_PROJ, "ws map 2");
static_assert(WS_PROJ + (size_t)MT * NINP * 2 <= WS_RA && WS_MERGED + (size_t)MT * DM * 2 <= WS_OUTF && WS_OUTF + (size_t)MT * DM * 4 <= WS_RA, "ws map 3");
static_assert(WS_RA + (size_t)MT * AH * 5 * 64 * 4 <= WS_RB && WS_RB + (size_t)MT * AH * 5 * 64 * 4 <= WS_SCANV && (size_t)MT * 4 * DM <= R_YRAW_OFF && R_YRAW_OFF + (size_t)MT * BW * 4 <= WS_RB - WS_RA, "ws map 4");
static_assert(WS_SCANV + (size_t)MT * BW * 4 <= WS_OALL && WS_OALL + (size_t)4 * MT * BW * 2 <= WS_VT && WS_VT + (size_t)MP * BW * 2 <= WS_VNT && WS_VNT + (size_t)136 * 8 * 128 * 128 * 2 <= WS_KCAT, "ws map 5");
static_assert(WS_KCAT + (size_t)DEPTH * NB * KCATN * BW * 2 <= WS_VTCAT && WS_VTCAT + (size_t)DEPTH * NB * KCATN * BW * 2 <= WS_MKB, "ws map 6");
constexpr int CW_TMO = 0, CW_BAR = 4096;
constexpr int LDS_BYTES = 147456, LDSCTL_OFF = 146944;
constexpr int NWAVES = 8, NTHR = 512, GRID = 256;
constexpr int N_PHASES = 2 + 7 * DEPTH;
#define SCAN5P(F, l) ((float*)((F).ws + (((l) & 1) ? WS_RB : WS_RA)))
#define GATESP(F, l) ((F).ws + (((l) & 1) ? WS_RA : WS_RB))
#define YRAWP(F, l) ((float*)((F).ws + (((l) & 1) ? WS_RA : WS_RB) + R_YRAW_OFF))
#define SCANVP(F) ((float*)((F).ws + WS_SCANV))
#define WGP(F, l) ((F).ws + WS_WG + (size_t)(l) * 64 * MiB)
#define WBRP(F, l) ((bf16*)((F).ws + ((l) ? WS_MEMN : WS_WBR)))
#define WOUTP(F, l) ((bf16*)((F).ws + ((l) ? WS_WMEM : WS_WOUT)))
#define HSP(F) ((float*)((F).ws + WS_BONUS + 3 * MiB / 2))
#define CMAX_WIN(F, l) ((float*)((F).ws + WS_CTL + 256 * 1024) + (size_t)(l) * NINP)
#define CMAX_WG(F, l) ((float*)((F).ws + WS_CTL + 256 * 1024) + (size_t)DEPTH * NINP + (size_t)(l) * 4 * DM)
static_assert(256 * 1024 + ((size_t)DEPTH * NINP + (size_t)DEPTH * 4 * DM) * 4 <= CTL_ZERO_BYTES, "cmax in the zeroed control region");
constexpr size_t WS_WIN8 = 1986 * MiB;
static_assert(WS_WIN8 + (size_t)NINP * DM <= 2048 * MiB, "win8");
#ifndef W_IN_INT8_TILES
#define W_IN_INT8_TILES 0x1e1fffffe2000ull
#endif
constexpr unsigned long long WIN_I8_MASK = W_IN_INT8_TILES, WIN_BF_MASK = ((1ull << 49) - 1) & ~WIN_I8_MASK;
constexpr int WIN_I8U = __builtin_popcountll(WIN_I8_MASK) * ((MT + 255) / 256), WIN_BFU = __builtin_popcountll(WIN_BF_MASK) * ((MT + 255) / 256);
constexpr int WIN_NSLOW0 = WIN_BFU % GRID, WIN_RS0 = WIN_I8U / GRID - 1;
constexpr bool WIN_SKEW = WIN_NSLOW0 > 0 && WIN_RS0 > 0 && (WIN_I8U - WIN_RS0 * GRID) <= 2 * (GRID - WIN_NSLOW0);
constexpr int WIN_NSLOW = WIN_SKEW ? WIN_NSLOW0 : 0, WIN_RS = WIN_SKEW ? WIN_RS0 : (1 << 20);
#define SWZ_XOR(v, x) __int_as_float(__builtin_amdgcn_ds_swizzle(__float_as_int(v), ((x) << 10) | 0x1f))
DI float xor32_sum(float v) { const auto r = __builtin_amdgcn_permlane32_swap(__float_as_uint(v), __float_as_uint(v), false, false); return __uint_as_float(r[0]) + __uint_as_float(r[1]); }
DI float xor32_max(float v) { const auto r = __builtin_amdgcn_permlane32_swap(__float_as_uint(v), __float_as_uint(v), false, false); return fmaxf(__uint_as_float(r[0]), __uint_as_float(r[1])); }
DI float xor32_partner(float v, int h) { const auto r = __builtin_amdgcn_permlane32_swap(__float_as_uint(v), __float_as_uint(v), false, false); return h ? __uint_as_float(r[0]) : __uint_as_float(r[1]); }
DI float wave_sum(float v) { v += SWZ_XOR(v, 1); v += SWZ_XOR(v, 2); v += SWZ_XOR(v, 4); v += SWZ_XOR(v, 8); v += SWZ_XOR(v, 16); return xor32_sum(v); }
DI float bflo(unsigned w) { return __uint_as_float(w << 16); }
DI float bfhi(unsigned w) { return __uint_as_float(w & 0xffff0000u); }
DI float bf2f(bf16 b) { return __uint_as_float(((unsigned)b) << 16); }
DI float sigmoidf_(float x) { return __builtin_amdgcn_rcpf(1.0f + __expf(-x)); }
DI float siluf_(float x) { return x * sigmoidf_(x); }
DI int crow16(int i, int h) { return (i & 3) + 8 * (i >> 2) + 4 * h; }
#define MFMA32(a, b, c) __builtin_amdgcn_mfma_f32_32x32x16_bf16((a), (b), (c), 0, 0, 0)
DI bf16x8 pack8(float a0, float a1, float a2, float a3, float a4, float a5, float a6, float a7) {
    v4u p; p.x = pk2(a0, a1); p.y = pk2(a2, a3); p.z = pk2(a4, a5); p.w = pk2(a6, a7); return __builtin_bit_cast(bf16x8, p);
}
DI void tr64_f32(const float* src, size_t lds_, bf16* dst, size_t ldd, LAS float* scr, int lane) {
#pragma unroll 4
    for (int i = 0; i < 16; ++i) { const int kk = 4 * i + (lane >> 4); const f32x4 v = *(const GAS f32x4*)(src + (size_t)kk * lds_ + 4 * (lane & 15));
        LAS float* s = scr + kk * 65 + 4 * (lane & 15); s[0] = v.x; s[1] = v.y; s[2] = v.z; s[3] = v.w; }
    LDS_WAIT(); asm volatile("" ::: "memory");
    const int c = lane & 7;
#pragma unroll
    for (int j = 0; j < 8; ++j) { const int n = (lane >> 3) + 8 * j; const LAS float* s = scr + (8 * c) * 65 + n;
        v4u o; o.x = pk2(s[0 * 65], s[1 * 65]); o.y = pk2(s[2 * 65], s[3 * 65]); o.z = pk2(s[4 * 65], s[5 * 65]); o.w = pk2(s[6 * 65], s[7 * 65]);
        *(GAS v4u*)(dst + (size_t)n * ldd + 8 * c) = o; }
    LDS_WAIT(); asm volatile("" ::: "memory");
}
DI unsigned pk4_fp8(float a, float b, float c, float d) { int w = __builtin_amdgcn_cvt_pk_fp8_f32(a, b, 0, false); w = __builtin_amdgcn_cvt_pk_fp8_f32(c, d, w, true); return (unsigned)w; }
DI void tr64_f32_fp8(const float* src, size_t lds_, unsigned char* dst, size_t ldd, float scale, LAS float* scr, int lane) {
#pragma unroll 4
    for (int i = 0; i < 16; ++i) { const int kk = 4 * i + (lane >> 4); const f32x4 v = *(const GAS f32x4*)(src + (size_t)kk * lds_ + 4 * (lane & 15));
        LAS float* s = scr + kk * 65 + 4 * (lane & 15); s[0] = v.x; s[1] = v.y; s[2] = v.z; s[3] = v.w; }
    LDS_WAIT(); asm volatile("" ::: "memory");
    const int c = lane & 7;
#pragma unroll
    for (int j = 0; j < 8; ++j) { const int n = (lane >> 3) + 8 * j; const LAS float* s = scr + (8 * c) * 65 + n;
        v2u o; o.x = pk4_fp8(s[0 * 65] * scale, s[1 * 65] * scale, s[2 * 65] * scale, s[3 * 65] * scale); o.y = pk4_fp8(s[4 * 65] * scale, s[5 * 65] * scale, s[6 * 65] * scale, s[7 * 65] * scale);
        *(GAS v2u*)(dst + (size_t)n * ldd + 8 * c) = o; }
    LDS_WAIT(); asm volatile("" ::: "memory");
}
DI void tr64_ld(f32x4 (&v)[16], const float* src, size_t lds_, int lane) {
#pragma unroll
    for (int i = 0; i < 16; ++i) { const int kk = 4 * i + (lane >> 4); v[i] = *(const GAS f32x4*)(src + (size_t)kk * lds_ + 4 * (lane & 15)); }
}
DI void tile_colmax(const f32x4 (&v)[16], float* cm, int lane) {
    f32x4 m = (f32x4){0.f, 0.f, 0.f, 0.f};
#pragma unroll
    for (int i = 0; i < 16; ++i) { m.x = fmaxf(m.x, fabsf(v[i].x)); m.y = fmaxf(m.y, fabsf(v[i].y)); m.z = fmaxf(m.z, fabsf(v[i].z)); m.w = fmaxf(m.w, fabsf(v[i].w)); }
    m.x = fmaxf(m.x, SWZ_XOR(m.x, 16)); m.y = fmaxf(m.y, SWZ_XOR(m.y, 16)); m.z = fmaxf(m.z, SWZ_XOR(m.z, 16)); m.w = fmaxf(m.w, SWZ_XOR(m.w, 16));
    m.x = xor32_max(m.x); m.y = xor32_max(m.y); m.z = xor32_max(m.z); m.w = xor32_max(m.w);
    if (lane < 16) { unsigned* c = (unsigned*)cm + 4 * lane; atomicMax(c, __float_as_uint(m.x)); atomicMax(c + 1, __float_as_uint(m.y)); atomicMax(c + 2, __float_as_uint(m.z)); atomicMax(c + 3, __float_as_uint(m.w)); }
}
DI void tr64_put(const f32x4 (&v)[16], LAS float* scr, int lane) {
#pragma unroll
    for (int i = 0; i < 16; ++i) { const int kk = 4 * i + (lane >> 4); LAS float* s = scr + kk * 65 + 4 * (lane & 15); s[0] = v[i].x; s[1] = v[i].y; s[2] = v[i].z; s[3] = v[i].w; }
    LDS_WAIT(); asm volatile("" ::: "memory");
}
DI unsigned q8(float v) { return (unsigned)(int)rintf(fminf(fmaxf(v, -127.f), 127.f)) & 255u; }
DI unsigned pk4_i8(float a, float b, float c, float d) { return q8(a) | (q8(b) << 8) | (q8(c) << 16) | (q8(d) << 24); }
template <int MODE> DI void tr64_get(void* dst_, size_t ldd, float scale, const float* cmax, const LAS float* scr, int lane) {
    const int c = lane & 7;
    float cmv[8];
#pragma unroll
    for (int j = 0; j < 8; ++j) cmv[j] = (MODE == 2) ? cmax[(lane >> 3) + 8 * j] : 0.f;
#pragma unroll
    for (int j = 0; j < 8; ++j) { const int n = (lane >> 3) + 8 * j; const LAS float* s = scr + (8 * c) * 65 + n;
        if (MODE == 1) { v2u o; o.x = pk4_fp8(s[0 * 65] * scale, s[1 * 65] * scale, s[2 * 65] * scale, s[3 * 65] * scale); o.y = pk4_fp8(s[4 * 65] * scale, s[5 * 65] * scale, s[6 * 65] * scale, s[7 * 65] * scale);
            *(GAS v2u*)((unsigned char*)dst_ + (size_t)n * ldd + 8 * c) = o; }
        else if (MODE == 2) { const float cm = cmv[j]; const float iv = cm > 0.f ? 127.0f / cm : 0.f;
            v2u o; o.x = pk4_i8(s[0 * 65] * iv, s[1 * 65] * iv, s[2 * 65] * iv, s[3 * 65] * iv); o.y = pk4_i8(s[4 * 65] * iv, s[5 * 65] * iv, s[6 * 65] * iv, s[7 * 65] * iv);
            *(GAS v2u*)((unsigned char*)dst_ + (size_t)n * ldd + 8 * c) = o; }
        else { v4u o; o.x = pk2(s[0 * 65], s[1 * 65]); o.y = pk2(s[2 * 65], s[3 * 65]); o.z = pk2(s[4 * 65], s[5 * 65]); o.w = pk2(s[6 * 65], s[7 * 65]);
            *(GAS v4u*)((bf16*)dst_ + (size_t)n * ldd + 8 * c) = o; } }
    LDS_WAIT(); asm volatile("" ::: "memory");
}
DI void tr64_bf16(const bf16* src, size_t lds_, bf16* dst, size_t ldd, LAS unsigned* scr, int lane) {
#pragma unroll
    for (int i = 0; i < 8; ++i) { const int t = 8 * i + (lane >> 3); const v4u v = *(const GAS v4u*)(src + (size_t)t * lds_ + 8 * (lane & 7));
        LAS unsigned* s = scr + t * 33 + 4 * (lane & 7); s[0] = v.x; s[1] = v.y; s[2] = v.z; s[3] = v.w; }
    LDS_WAIT(); asm volatile("" ::: "memory");
    const int c = lane & 7; const LAS bf16* s16 = (const LAS bf16*)scr;
#pragma unroll
    for (int j = 0; j < 8; ++j) { const int d = (lane >> 3) + 8 * j; const LAS bf16* s = s16 + (8 * c) * 66 + d;
        v4u o; o.x = (unsigned)s[0 * 66] | ((unsigned)s[1 * 66] << 16); o.y = (unsigned)s[2 * 66] | ((unsigned)s[3 * 66] << 16);
        o.z = (unsigned)s[4 * 66] | ((unsigned)s[5 * 66] << 16); o.w = (unsigned)s[6 * 66] | ((unsigned)s[7 * 66] << 16);
        *(GAS v4u*)(dst + (size_t)d * ldd + 8 * c) = o; }
    LDS_WAIT(); asm volatile("" ::: "memory");
}
DI void rms_row_bf16(const float* xrow, const float* g, bf16* orow, unsigned char* orow8, int lane) {
    const GAS f32x4* xr = (const GAS f32x4*)xrow + lane; const GAS f32x4* gr = (const GAS f32x4*)g + lane;
    f32x4 v[16]; float s = 0.f;
#pragma unroll
    for (int j = 0; j < 16; ++j) { v[j] = xr[64 * j]; s += (v[j].x * v[j].x + v[j].y * v[j].y) + (v[j].z * v[j].z + v[j].w * v[j].w); }
    const float rstd = 1.0f / sqrtf(wave_sum(s) * (1.0f / DM) + NORM_EPS);
    GAS v2u* o8 = (GAS v2u*)orow + lane; GAS unsigned* q8 = (GAS unsigned*)orow8 + lane;
#pragma unroll
    for (int j = 0; j < 16; ++j) { const f32x4 gg = gr[64 * j]; const float a0 = v[j].x * rstd * gg.x, a1 = v[j].y * rstd * gg.y, a2 = v[j].z * rstd * gg.z, a3 = v[j].w * rstd * gg.w;
        v2u w; w.x = pk2(a0, a1); w.y = pk2(a2, a3); o8[64 * j] = w; if (orow8) q8[64 * j] = pk4_fp8(a0, a1, a2, a3); }
}
DI void rms_row_i8(const float* xrow, const float* g, unsigned char* orow8, float* oscale, bf16* orow, int lane) {
    const GAS f32x4* xr = (const GAS f32x4*)xrow + lane; const GAS f32x4* gr = (const GAS f32x4*)g + lane;
    f32x4 v[16]; float s = 0.f;
#pragma unroll
    for (int j = 0; j < 16; ++j) { v[j] = xr[64 * j]; s += (v[j].x * v[j].x + v[j].y * v[j].y) + (v[j].z * v[j].z + v[j].w * v[j].w); }
    const float rstd = 1.0f / sqrtf(wave_sum(s) * (1.0f / DM) + NORM_EPS); float am = 0.f;
#pragma unroll
    for (int j = 0; j < 16; ++j) { const f32x4 gg = gr[64 * j]; v[j] = v[j] * rstd * gg; am = fmaxf(am, fmaxf(fmaxf(fabsf(v[j].x), fabsf(v[j].y)), fmaxf(fabsf(v[j].z), fabsf(v[j].w)))); }
    am = fmaxf(am, SWZ_XOR(am, 1)); am = fmaxf(am, SWZ_XOR(am, 2)); am = fmaxf(am, SWZ_XOR(am, 4)); am = fmaxf(am, SWZ_XOR(am, 8)); am = fmaxf(am, SWZ_XOR(am, 16)); am = xor32_max(am);
    const float iv = am > 0.f ? 127.0f / am : 0.f; GAS unsigned* q = (GAS unsigned*)orow8 + lane;
#pragma unroll
    for (int j = 0; j < 16; ++j) q[64 * j] = pk4_i8(v[j].x * iv, v[j].y * iv, v[j].z * iv, v[j].w * iv);
    GAS v2u* o8 = (GAS v2u*)orow + lane;
#pragma unroll
    for (int j = 0; j < 16; ++j) { v2u w; w.x = pk2(v[j].x, v[j].y); w.y = pk2(v[j].z, v[j].w); o8[64 * j] = w; }
    if (lane == 0) *oscale = am * (1.0f / 127.0f);
}
struct P { const float* in[N_INPUTS]; float* out; unsigned char* ws; int ph_lo, ph_hi, dbg, pad; };
struct Frame {
    LAS unsigned char* lds; int tid, lane, wave, bx, G, gw, ngw;
    float* out; unsigned char* ws;
};
DI const float* xrow_in(const P& p, int row) { return row < MP ? p.in[I_XP] + (size_t)row * DM : p.in[I_XS] + (size_t)(row - MP) * DM; }

#define FOR_ITEMS(it, n, id, nid, rot) for (int it = ((id) - (rot) + (nid)) % (nid); it < (n); it += (nid))
#define ROT_ADV(rot, n, nid) rot = (int)(((long)(rot) + (long)(n)) % (nid))

template <int MODE> DI void conv_weight_t(const Frame& F, const float* Wsrc, int NM, int K, int N, void* WT, int split_n, int split_shift, float scale, const float* cmax, int id, int nid, int& rot, int ldw = 0) {
    if (ldw == 0) ldw = N;
    LAS float* scr = (LAS float*)(F.lds + F.wave * 16640);
    const int nb = N / 64, per = (K / 64) * nb, nitems = NM * per;
    int it = (id - rot + nid) % nid;
    f32x4 cur[16];
#define CW_SRC(i) (Wsrc + (size_t)((i) / per) * K * ldw + (size_t)((((i) % per) / nb) * 64) * ldw + (((i) % per) % nb) * 64)
    if (it < nitems) tr64_ld(cur, CW_SRC(it), (size_t)ldw, F.lane);
    for (; it < nitems; it += nid) {
        const int m = it / per, r = it % per, kb = r / nb, n0 = (r % nb) * 64; const int ro = m * N + n0 + (n0 >= split_n ? split_shift : 0);
        const int itn = it + nid;
        void* dst = MODE ? (void*)((unsigned char*)WT + (size_t)ro * K + kb * 64) : (void*)((bf16*)WT + (size_t)ro * K + kb * 64);
        tr64_put(cur, scr, F.lane);
        if (itn < nitems) tr64_ld(cur, CW_SRC(itn), (size_t)ldw, F.lane);
        tr64_get<MODE>(dst, (size_t)K, scale, cmax + ro, scr, F.lane);
    }
    ROT_ADV(rot, nitems, nid);
#undef CW_SRC
}
DI void conv_weight(const Frame& F, const float* Wsrc, int K, int N, bf16* WT, int split_n, int split_shift, int id, int nid, int& rot) { conv_weight_t<0>(F, Wsrc, 1, K, N, WT, split_n, split_shift, 1.f, nullptr, id, nid, rot); }
DI void colmax_weight(const Frame& F, const float* Wsrc, int NM, int K, int N, float* cm, int split_n, int split_shift, int id, int nid, int& rot, int ldw = 0) {
    if (ldw == 0) ldw = N;
    const int nb = N / 64, per = (K / 64) * nb, nitems = NM * per;
    FOR_ITEMS(it, nitems, id, nid, rot) { const int m = it / per, r = it % per, kb = r / nb, n0 = (r % nb) * 64; const int ro = m * N + n0 + (n0 >= split_n ? split_shift : 0);
        f32x4 v[16]; tr64_ld(v, Wsrc + (size_t)m * K * ldw + (size_t)(kb * 64) * ldw + n0, (size_t)ldw, F.lane); tile_colmax(v, cm + ro, F.lane); }
    ROT_ADV(rot, nitems, nid);
}
DI void colmax_layer(const P& p, const Frame& F, int l, int id, int nid, int& rot) {
    for (int t = 0; t < 49;) { if (!((WIN_I8_MASK >> t) & 1ull)) { ++t; continue; } int t1 = t; while (t1 < 49 && ((WIN_I8_MASK >> t1) & 1ull) && (t1 == t || t1 != 13)) ++t1;
        const int pc0 = 256 * t, pc1 = (t1 == 13 || (t1 > 12 && t <= 12)) ? 3200 : 256 * t1, oc0 = pc0 >= 3328 ? pc0 - 128 : pc0;
        colmax_weight(F, p.in[I_WIN] + (size_t)l * DM * NIN + oc0, 1, DM, pc1 - pc0, CMAX_WIN(F, l) + pc0, 1 << 30, 0, id, nid, rot, NIN); t = t1; }
    colmax_weight(F, p.in[I_WGATE] + (size_t)l * 4 * DM * DM, 4, DM, DM, CMAX_WG(F, l), 1 << 30, 0, id, nid, rot);
}
template <int MODE> DI void conv_win_cols(const P& p, const Frame& F, int l, int pc0, int pc1, int id, int nid, int& rot) {
    const int oc0 = pc0 >= 3328 ? pc0 - 128 : pc0;
    if (MODE == 2) conv_weight_t<2>(F, p.in[I_WIN] + (size_t)l * DM * NIN + oc0, 1, DM, pc1 - pc0, (void*)(F.ws + WS_WIN8 + (size_t)pc0 * DM), 1 << 30, 0, 1.f, CMAX_WIN(F, l) + pc0, id, nid, rot, NIN);
    else conv_weight_t<0>(F, p.in[I_WIN] + (size_t)l * DM * NIN + oc0, 1, DM, pc1 - pc0, (void*)(((bf16*)(F.ws + WS_WIN)) + (size_t)pc0 * DM), 1 << 30, 0, 1.f, nullptr, id, nid, rot, NIN);
}
template <int MODE> DI void conv_win_mask(const P& p, const Frame& F, int l, unsigned long long mask, int id, int nid, int& rot) {
    for (int t = 0; t < 49;) { if (!((mask >> t) & 1ull)) { ++t; continue; } int t1 = t; while (t1 < 49 && ((mask >> t1) & 1ull) && (t1 == t || t1 != 13)) ++t1;
        const int pc0 = 256 * t, pc1 = (t1 == 13 || (t1 > 12 && t <= 12)) ? 3200 : 256 * t1;
        conv_win_cols<MODE>(p, F, l, pc0, pc1, id, nid, rot); t = t1; }
}
DI void conv_layer_win(const P& p, const Frame& F, int l, int id, int nid, int& rot) { conv_win_mask<2>(p, F, l, WIN_I8_MASK, id, nid, rot); conv_win_mask<0>(p, F, l, WIN_BF_MASK, id, nid, rot); }
DI void conv_layer_wgate(const P& p, const Frame& F, int l, int id, int nid, int& rot) {
    conv_weight_t<2>(F, p.in[I_WGATE] + (size_t)l * 4 * DM * DM, 4, DM, DM, (void*)WGP(F, l), 1 << 30, 0, 1.f, CMAX_WG(F, l), id, nid, rot); }
DI void conv_layer_wbr(const P& p, const Frame& F, int l, int id, int nid, int& rot) { conv_weight_t<0>(F, p.in[I_WBR] + (size_t)l * 4 * BW * DM, 4, BW, DM, WBRP(F, l), 1 << 30, 0, 1.f, nullptr, id, nid, rot); }
DI void conv_layer_wout(const P& p, const Frame& F, int l, int id, int nid, int& rot) { conv_weight(F, p.in[I_WOUT] + (size_t)l * DM * DM, DM, DM, WOUTP(F, l), 1 << 30, 0, id, nid, rot); }
DI void conv_caches(const P& p, const Frame& F, int l, int wid, int nw, int& rot) {
    LAS float* scr = (LAS float*)(F.lds + F.wave * 16640);
    {
        const int nitems = NB * BHN * (PAST / 64) * (BHD / 64);
        FOR_ITEMS(it, nitems, wid, nw, rot) { const int dt = it & 1, pt = (it >> 1) & 15, h = (it >> 5) & 7, lb = l * NB + (it >> 8);
            tr64_f32(p.in[I_CSV] + ((size_t)lb * PAST + pt * 64) * BW + h * BHD + dt * 64, (size_t)BW, ((bf16*)(F.ws + WS_VTCAT)) + ((size_t)(lb * BHN + h) * BHD + dt * 64) * KCATN + pt * 64, (size_t)KCATN, scr, F.lane); }
        ROT_ADV(rot, nitems, nw);
    }
    {
        const int nitems = NB * MHN * 4 * 4;
        FOR_ITEMS(it, nitems, wid, nw, rot) { const int dt = it & 3, mt = (it >> 2) & 3, hm = (it >> 4) & 3, lb = l * NB + (it >> 6);
            tr64_f32(p.in[I_CMV] + ((size_t)lb * NMEM + mt * 64) * BW + hm * MHD + dt * 64, (size_t)BW, ((bf16*)(F.ws + WS_CMVT)) + ((size_t)(lb * MHN + hm) * MHD + dt * 64) * NMEM + mt * 64, (size_t)NMEM, scr, F.lane); }
        ROT_ADV(rot, nitems, nw);
    }
    const int gt = wid * 64 + F.lane, ngt = nw * 64;
    for (long i = gt; i < (long)NB * PAST * (BW / 8); i += ngt) { const int c8 = (int)(i & 127); const long r = ((long)l * NB * PAST) + (i >> 7); const int pos = (int)(r & (PAST - 1)); const long lb = r >> 10;
        const GAS f32x4* s = (const GAS f32x4*)(p.in[I_CSK] + (size_t)r * BW + c8 * 8); const f32x4 a = s[0], b = s[1];
        v4u o; o.x = pk2(a.x, a.y); o.y = pk2(a.z, a.w); o.z = pk2(b.x, b.y); o.w = pk2(b.z, b.w);
        *(GAS v4u*)(((bf16*)(F.ws + WS_KCAT)) + ((size_t)lb * KCATN + pos) * BW + c8 * 8) = o; }
    for (long i = gt; i < (long)NB * NMEM * (BW / 8); i += ngt) { const size_t e = ((size_t)l * NB * NMEM * (BW / 8) + (size_t)i) * 8; const GAS f32x4* s = (const GAS f32x4*)(p.in[I_CMK] + e); const f32x4 a = s[0], b = s[1];
        v4u o; o.x = pk2(a.x, a.y); o.y = pk2(a.z, a.w); o.z = pk2(b.x, b.y); o.w = pk2(b.z, b.w); *(GAS v4u*)(((bf16*)(F.ws + WS_CMK)) + e) = o; }
}
DI void ph_prologue(const P& p, const Frame& F) {
    int rot = 0;
    colmax_layer(p, F, 0, F.gw, F.ngw, rot); colmax_layer(p, F, 1, F.gw, F.ngw, rot);
    for (int l = 0; l < DEPTH; ++l) conv_weight(F, p.in[I_WMEM] + (size_t)l * DM * 2 * BW, DM, 2 * BW, ((bf16*)(F.ws + WS_WMEM)) + (size_t)l * 2 * BW * DM, 1 << 30, 0, F.gw, F.ngw, rot);
    conv_caches(p, F, 0, F.gw, F.ngw, rot);
    const int gt = F.bx * NTHR + F.tid, ngt = F.G * NTHR;
    for (int i = gt; i < DEPTH * CGN * 128 * 128; i += ngt) { const int s = i & 127, t = (i >> 7) & 127; ((bf16*)(F.ws + WS_WM))[i] = (bf16)(s <= t ? f2bf(p.in[I_CWS][i]) : 0u); }
    for (int i = gt; i < DEPTH * 2 * BW * 64; i += ngt) { const int j = i & 63, c = (i >> 6) & 1023, lo = (i >> 16) & 1, ll = i >> 17;
        ((bf16*)(F.ws + WS_UPT))[i] = (bf16)f2bf(p.in[lo ? I_AAUP : I_AWUP][((size_t)ll * 64 + j) * BW + c]); }
    for (int i = gt; i < 128 * DM / 8; i += ngt) *(GAS v4u*)(((bf16*)(F.ws + WS_WIN)) + (size_t)3200 * DM + (size_t)i * 8) = (v4u){0u, 0u, 0u, 0u};
    for (int i = gt; i < 8 * 8 * 128 * 128 / 8; i += ngt) *(GAS v4u*)(((bf16*)(F.ws + WS_VNT)) + (size_t)128 * 8 * 128 * 128 + (size_t)i * 8) = (v4u){0u, 0u, 0u, 0u};
    for (int m = F.gw; m < MT; m += F.ngw) rms_row_i8(xrow_in(p, m), p.in[I_GPRE], (unsigned char*)(F.ws + WS_H8) + (size_t)m * DM, HSP(F) + m, ((bf16*)(F.ws + WS_H)) + (size_t)m * DM, F.lane);
    for (int m = F.gw; m < DEPTH * NB * NMEM; m += F.ngw) { const int l = m / (NB * NMEM), r = m % (NB * NMEM);
        rms_row_bf16(p.in[I_MEM] + (size_t)r * DM, p.in[I_GMEM] + (size_t)l * DM, ((bf16*)(F.ws + WS_MEMN)) + (size_t)m * DM, nullptr, F.lane); }
}
#define RW_K(cc, fr) (32 * ((fr) >> 3) + 2 * ((fr) & 7) + ((cc) & 1) + 16 * ((cc) >> 1))
#define SWZ16_SUM(v) do { v += SWZ_XOR(v, 1); v += SWZ_XOR(v, 2); v += SWZ_XOR(v, 4); v += SWZ_XOR(v, 8); } while (0)
DI void prep_rwkv_item(const P& p, const Frame& F, int l, int r0) {
    LAS bf16* tw = (LAS bf16*)F.lds; LAS bf16* ta = tw + 16 * 64;
    const bf16* proj = ((bf16*)(F.ws + WS_PROJ)); const int tid = F.tid, lane = F.lane, fr = lane & 15, fq = lane >> 4;
    const float* mu = p.in[I_AMU] + (size_t)l * SHW;
    const bool is_p = r0 < MP; const int t0 = is_p ? (r0 & (SEQ - 1)) : ((r0 - MP) & (DSEQ - 1)); const int bsm = is_p ? 0 : ((r0 - MP) >> 6);
    const float* shp = p.in[I_SSH] + (size_t)(l * NB + bsm) * SHW;
    {
        const int tok = tid >> 5, j = 2 * (tid & 31); const int row = r0 + tok; const bool first = (t0 + tok) == 0;
#pragma unroll
        for (int part = 0; part < 2; ++part) { const int pc = (part ? PC_AD : PC_WD) + j;
            const unsigned cu = *(const GAS unsigned*)(proj + (size_t)row * NINP + pc); const float c0 = bflo(cu), c1 = bfhi(cu); float p0, p1;
            if (!first) { const unsigned pu = *(const GAS unsigned*)(proj + (size_t)(row - 1) * NINP + pc); p0 = bflo(pu); p1 = bfhi(pu); }
            else if (is_p) { p0 = p1 = 0.f; }
            else { p0 = shp[pc]; p1 = shp[pc + 1]; }
            const float x0 = c0 + mu[pc] * (p0 - c0), x1 = c1 + mu[pc + 1] * (p1 - c1);
            *(LAS unsigned*)((part ? ta : tw) + tok * 64 + j) = part ? pk2(x0, x1) : pk2(tanhf(x0), tanhf(x1)); }
    }
    __syncthreads();
    LAS float* lw = (LAS float*)(F.lds + 8192); LAS float* la = lw + 16 * BW;
    {
        f32x4 accw[8], acca[8];
        const bf16* wupT = ((bf16*)(F.ws + WS_UPT)) + (size_t)(l * 2 + 0) * BW * 64; const bf16* aupT = ((bf16*)(F.ws + WS_UPT)) + (size_t)(l * 2 + 1) * BW * 64;
#pragma unroll
        for (int ct = 0; ct < 8; ++ct) { accw[ct] = (f32x4){0.f, 0.f, 0.f, 0.f}; acca[ct] = (f32x4){0.f, 0.f, 0.f, 0.f}; }
#pragma unroll
        for (int ks = 0; ks < 2; ++ks) { const bf16x8 aw = *(const LAS bf16x8*)(tw + fr * 64 + 32 * ks + 8 * fq), aa = *(const LAS bf16x8*)(ta + fr * 64 + 32 * ks + 8 * fq);
#pragma unroll
            for (int ct = 0; ct < 8; ++ct) { const size_t co = (size_t)(128 * F.wave + 64 * (ct >> 2) + RW_K(ct & 3, fr)) * 64 + 32 * ks + 8 * fq;
                accw[ct] = __builtin_amdgcn_mfma_f32_16x16x32_bf16(aw, *(const GAS bf16x8*)(wupT + co), accw[ct], 0, 0, 0);
                acca[ct] = __builtin_amdgcn_mfma_f32_16x16x32_bf16(aa, *(const GAS bf16x8*)(aupT + co), acca[ct], 0, 0, 0); } }
#pragma unroll
        for (int ct = 0; ct < 8; ++ct)
#pragma unroll
            for (int q = 0; q < 4; ++q) { const int o = (4 * fq + q) * BW + 128 * F.wave + 64 * (ct >> 2) + RW_K(ct & 3, fr); lw[o] = accw[ct][q]; la[o] = acca[ct][q]; }
    }
#pragma unroll 1
    for (int hh = 0; hh < 2; ++hh) { const int head = 2 * F.wave + hh;
        float mur[4], muk[4], muv[4], kk_[4], ka_[4], rk_[4], w0_[4], a0_[4], pr[4], pk[4], pvv[4];
#pragma unroll
        for (int cc = 0; cc < 4; ++cc) { const int c = 64 * head + RW_K(cc, fr);
            mur[cc] = mu[PC_R + c]; muk[cc] = mu[PC_K + c]; muv[cc] = mu[PC_V + c]; kk_[cc] = p.in[I_AKK][l * BW + c]; ka_[cc] = p.in[I_AKA][l * BW + c]; rk_[cc] = p.in[I_ARK][l * BW + c];
            w0_[cc] = p.in[I_AW0][l * BW + c]; a0_[cc] = p.in[I_AA0][l * BW + c];
            if (t0 + 4 * fq != 0) { const bf16* q = proj + (size_t)(r0 + 4 * fq - 1) * NINP; pr[cc] = bf2f(q[PC_R + c]); pk[cc] = bf2f(q[PC_K + c]); pvv[cc] = bf2f(q[PC_V + c]); }
            else if (is_p) { pr[cc] = pk[cc] = pvv[cc] = 0.f; }
            else { pr[cc] = shp[PC_R + c]; pk[cc] = shp[PC_K + c]; pvv[cc] = shp[PC_V + c]; } }
        bf16 qr[4][4], qk[4][4], qv[4][4]; float laq[4][4], lwq[4][4];
#pragma unroll
        for (int q = 0; q < 4; ++q) { const bf16* pq = proj + (size_t)(r0 + 4 * fq + q) * NINP;
#pragma unroll
            for (int cc = 0; cc < 4; ++cc) { const int c = 64 * head + RW_K(cc, fr); qr[q][cc] = pq[PC_R + c]; qk[q][cc] = pq[PC_K + c]; qv[q][cc] = pq[PC_V + c];
                laq[q][cc] = la[(4 * fq + q) * BW + c]; lwq[q][cc] = lw[(4 * fq + q) * BW + c]; } }
#pragma unroll
        for (int q = 0; q < 4; ++q) { const int row = r0 + 4 * fq + q;
            float xr[4], xk[4], xv[4], a[4], kkv[4], kp[4]; float ss = 0.f, bon = 0.f;
#pragma unroll
            for (int cc = 0; cc < 4; ++cc) { const float cr = bf2f(qr[q][cc]), ck = bf2f(qk[q][cc]), cv = bf2f(qv[q][cc]);
                xr[cc] = cr + mur[cc] * (pr[cc] - cr); xk[cc] = ck + muk[cc] * (pk[cc] - ck); xv[cc] = cv + muv[cc] * (pvv[cc] - cv); pr[cc] = cr; pk[cc] = ck; pvv[cc] = cv;
                a[cc] = sigmoidf_(a0_[cc] + laq[q][cc]);
                kkv[cc] = xk[cc] * kk_[cc]; ss += kkv[cc] * kkv[cc]; kp[cc] = xk[cc] * (1.0f + (a[cc] - 1.0f) * ka_[cc]); bon += xr[cc] * kp[cc] * rk_[cc]; }
            SWZ16_SUM(ss); SWZ16_SUM(bon);
            const float inv = 1.0f / fmaxf(sqrtf(ss), 1e-12f);
            float kkn[4], dd[4];
#pragma unroll
            for (int cc = 0; cc < 4; ++cc) { kkn[cc] = kkv[cc] * inv; dd[cc] = __expf(-0.6065306597126334f * sigmoidf_(w0_[cc] + lwq[q][cc])); }
            GAS f32x4* sp = (GAS f32x4*)(SCAN5P(F, l) + ((size_t)row * AH + head) * (5 * 64)) + fr;
            sp[0] = (f32x4){kkn[0], kkn[2], kkn[1], kkn[3]}; sp[16] = (f32x4){dd[0], dd[2], dd[1], dd[3]}; sp[32] = (f32x4){kkn[0] * a[0], kkn[2] * a[2], kkn[1] * a[1], kkn[3] * a[3]};
            sp[48] = (f32x4){kp[0], kp[2], kp[1], kp[3]}; sp[64] = (f32x4){xr[0], xr[2], xr[1], xr[3]};
            { float* vp = SCANVP(F) + (size_t)row * BW + 64 * head + RW_K(0, fr); vp[0] = xv[0]; vp[1] = xv[1]; vp[16] = xv[2]; vp[17] = xv[3]; }
            if (fr == 0) ((float*)(F.ws + WS_BONUS))[(size_t)row * AH + head] = bon; }
    }
    __syncthreads();
}
DI void prep_ln_item(const P& p, const Frame& F, int l, int item) {
    LAS unsigned* tile = (LAS unsigned*)F.lds;
    const int lane = F.lane; int row0, ch, s0;
    if (item < 256) { ch = item >> 1; s0 = (item & 1) * 64; row0 = ch * 128 + s0; } else { ch = 128 + (item - 256); s0 = 0; row0 = MP + (item - 256) * 64; }
    const float* lnw = p.in[I_CLNW] + (size_t)l * BW + lane * 16; const float* lnb = p.in[I_CLNB] + (size_t)l * BW + lane * 16;
    for (int rr = 0; rr < 8; ++rr) { const int tr = F.wave * 8 + rr, row = row0 + tr;
        const GAS v4u* src = (const GAS v4u*)(((bf16*)(F.ws + WS_PROJ)) + (size_t)row * NINP + PC_CV + lane * 16); const v4u u0 = src[0], u1 = src[1];
        float x[16] = {bflo(u0.x), bfhi(u0.x), bflo(u0.y), bfhi(u0.y), bflo(u0.z), bfhi(u0.z), bflo(u0.w), bfhi(u0.w), bflo(u1.x), bfhi(u1.x), bflo(u1.y), bfhi(u1.y), bflo(u1.z), bfhi(u1.z), bflo(u1.w), bfhi(u1.w)};
        float s = 0.f;
#pragma unroll
        for (int i = 0; i < 16; ++i) s += x[i];
        const float mean = wave_sum(s) * (1.0f / BW); float q = 0.f;
#pragma unroll
        for (int i = 0; i < 16; ++i) { x[i] -= mean; q += x[i] * x[i]; }
        const float rstd = 1.0f / sqrtf(wave_sum(q) * (1.0f / BW) + NORM_EPS);
#pragma unroll
        for (int i = 0; i < 16; ++i) x[i] = x[i] * rstd * lnw[i] + lnb[i];
        if (row >= MP) { GAS f32x4* o = (GAS f32x4*)(F.out + O_CVS + ((size_t)l * MS + (row - MP)) * BW + lane * 16);
#pragma unroll
            for (int i = 0; i < 4; ++i) o[i] = (f32x4){x[4 * i], x[4 * i + 1], x[4 * i + 2], x[4 * i + 3]}; }
        LAS unsigned* tp = tile + tr * 513 + lane * 8;
#pragma unroll
        for (int i = 0; i < 8; ++i) tp[i] = pk2(x[2 * i], x[2 * i + 1]);
    }
    __syncthreads();
    const LAS bf16* t16 = (const LAS bf16*)tile; const int c = F.tid & 7;
    for (int pass = 0; pass < 16; ++pass) { const int dd = (F.tid >> 3) + 64 * pass; const LAS bf16* s = t16 + (8 * c) * 1026 + dd;
        v4u o; o.x = (unsigned)s[0 * 1026] | ((unsigned)s[1 * 1026] << 16); o.y = (unsigned)s[2 * 1026] | ((unsigned)s[3 * 1026] << 16);
        o.z = (unsigned)s[4 * 1026] | ((unsigned)s[5 * 1026] << 16); o.w = (unsigned)s[6 * 1026] | ((unsigned)s[7 * 1026] << 16);
        *(GAS v4u*)(((bf16*)(F.ws + WS_VNT)) + ((size_t)ch * BW + dd) * 128 + s0 + 8 * c) = o; }
    __syncthreads();
}
DI void ph_prep(const P& p, const Frame& F, int l) {
#ifndef DUP_PHASE
#define DUP_PHASE (-1)
#endif
#define REPP(k) _Pragma("unroll 1") for (int repp_ = 0; repp_ < ((DUP_PHASE) == (k) ? 2 : 1); ++repp_)
    REPP(601) for (int it = F.bx; it < MT / 16; it += F.G) prep_rwkv_item(p, F, l, it * 16);
    REPP(602) for (int it = F.bx; it < 256 + 8; it += F.G) prep_ln_item(p, F, l, it);
    int rot = 0;
    REPP(603) {
        LAS unsigned* scr = (LAS unsigned*)(F.lds + F.wave * 16640);
        const int nP = NB * BHN * (SEQ / 64) * 2, nS = NB * BHN * 2, nitems = nP + nS;
        FOR_ITEMS(it, nitems, F.gw, F.ngw, rot) {
            if (it < nP) { const int dt = it & 1, tt = (it >> 1) & 31, h = (it >> 6) & 7, b = it >> 9;
                tr64_bf16(((bf16*)(F.ws + WS_PROJ)) + ((size_t)b * SEQ + tt * 64) * NINP + PC_BV + h * BHD + dt * 64, (size_t)NINP, ((bf16*)(F.ws + WS_VT)) + ((size_t)(b * BHN + h) * BHD + dt * 64) * SEQ + tt * 64, (size_t)SEQ, scr, F.lane); }
            else { const int j = it - nP, dt = j & 1, h = (j >> 1) & 7, b = j >> 4;
                tr64_bf16(((bf16*)(F.ws + WS_PROJ)) + ((size_t)MP + b * DSEQ) * NINP + PC_BV + h * BHD + dt * 64, (size_t)NINP, ((bf16*)(F.ws + WS_VTCAT)) + ((size_t)((l * NB + b) * BHN + h) * BHD + dt * 64) * KCATN + PAST, (size_t)KCATN, scr, F.lane); } }
        ROT_ADV(rot, nitems, F.ngw);
    }
    {
        LAS float* scr = (LAS float*)(F.lds + F.wave * 16640);
        const int nitems = NB * MHN * 16;
        FOR_ITEMS(it, nitems, F.gw, F.ngw, rot) { const int dt = it & 3, mt = (it >> 2) & 3, hm = (it >> 4) & 3, b = it >> 6;
            tr64_f32(F.out + O_MV + ((size_t)(l * NB + b) * NMEM + mt * 64) * BW + hm * MHD + dt * 64, (size_t)BW, ((bf16*)(F.ws + WS_MVT)) + ((size_t)((l * NB + b) * MHN + hm) * MHD + dt * 64) * NMEM + mt * 64, (size_t)NMEM, scr, F.lane); }
        ROT_ADV(rot, nitems, F.ngw);
    }
    const int gt = F.bx * NTHR + F.tid, ngt = F.G * NTHR;
    for (int i = gt; i < NB * NMEM * (BW / 8); i += ngt) { const GAS f32x4* s = (const GAS f32x4*)(F.out + O_MK + (size_t)l * NB * NMEM * BW + (size_t)i * 8); const f32x4 a = s[0], b = s[1];
        v4u o; o.x = pk2(a.x, a.y); o.y = pk2(a.z, a.w); o.z = pk2(b.x, b.y); o.w = pk2(b.z, b.w); *(GAS v4u*)(((bf16*)(F.ws + WS_MKB)) + (size_t)l * NB * NMEM * BW + (size_t)i * 8) = o; }
    for (int i = gt; i < MS * (BW / 8); i += ngt) { const int c8 = i & 127, r = i >> 7, b = r >> 6, t = r & 63;
        *(GAS v4u*)(((bf16*)(F.ws + WS_KCAT)) + ((size_t)(l * NB + b) * KCATN + PAST + t) * BW + c8 * 8) = *(const GAS v4u*)(((bf16*)(F.ws + WS_PROJ)) + (size_t)(MP + r) * NINP + PC_BK + c8 * 8); }
    REPP(604) for (long i = gt; i < (long)MT * 256; i += ngt) { const int c8 = (int)(i & 255); const int row = (int)(i >> 8); const int seg = c8 >> 7, col = (c8 & 127) * 8;
        const v4u u = *(const GAS v4u*)(((bf16*)(F.ws + WS_PROJ)) + (size_t)row * NINP + (seg ? PC_BV : PC_BK) + col);
        float* dst = row < MP ? F.out + (seg ? O_SVP : O_SKP) + ((size_t)l * MP + row) * BW + col : F.out + (seg ? O_SVS : O_SKS) + ((size_t)l * MS + (row - MP)) * BW + col;
        ((GAS f32x4*)dst)[0] = (f32x4){bflo(u.x), bfhi(u.x), bflo(u.y), bfhi(u.y)}; ((GAS f32x4*)dst)[1] = (f32x4){bflo(u.z), bfhi(u.z), bflo(u.w), bfhi(u.w)}; }
    for (int i = gt; i < 16 * SHW; i += ngt) { const int sq = i / SHW, c = i % SHW; const int b = sq & 7; const bool smp = sq >= 8;
        const int row = smp ? MP + b * DSEQ + DSEQ - 1 : b * SEQ + SEQ - 1;
        F.out[(smp ? O_SHS : O_SHP) + (size_t)(l * NB + b) * SHW + c] = bf2f(((bf16*)(F.ws + WS_PROJ))[(size_t)row * NINP + c]); }
}
typedef float f32x2s __attribute__((ext_vector_type(2)));
struct ScanOps { f32x2s kk, dd, ka, kp, rr; float vv; };
DI void scan_load(ScanOps& o, const float* sbase, const float* vbase, int t, int lane) {
    const GAS float* p = (const GAS float*)(sbase + (size_t)t * (AH * 5 * 64) + ((lane >> 5) * 16 + (lane & 15)) * 2); const GAS float* pv = (const GAS float*)(vbase + (size_t)t * BW + (lane & 31));
    asm volatile("global_load_dwordx2 %0, %6, off\n\tglobal_load_dwordx2 %1, %6, off offset:256\n\tglobal_load_dwordx2 %2, %6, off offset:512\n\tglobal_load_dwordx2 %3, %6, off offset:768\n\t"
                 "global_load_dwordx2 %4, %6, off offset:1024\n\tglobal_load_dword %5, %7, off"
                 : "=&v"(o.kk), "=&v"(o.dd), "=&v"(o.ka), "=&v"(o.kp), "=&v"(o.rr), "=&v"(o.vv) : "v"(p), "v"(pv) : "memory");
}
DI void scan_wait(ScanOps& o) { asm volatile("s_waitcnt vmcnt(18)" : "+v"(o.kk), "+v"(o.dd), "+v"(o.ka), "+v"(o.kp), "+v"(o.rr), "+v"(o.vv) :: "memory"); }
#define SCAN_DPP(op, n) op " row_newbcast:" #n " row_mask:0xf bank_mask:0xf"
DI float scan_step(float (&S)[32], ScanOps& o) {
    float a0 = 0.f, a1 = 0.f, a2 = 0.f, a3 = 0.f;
    scan_wait(o);
    asm volatile("s_nop 1");
    asm volatile(SCAN_DPP("v_fmac_f32_dpp %0, %1, %2", 0) : "+v"(a0) : "v"(o.kk[0]), "v"(S[0]));
    asm volatile(SCAN_DPP("v_fmac_f32_dpp %0, %1, %2", 1) : "+v"(a1) : "v"(o.kk[0]), "v"(S[1]));
    asm volatile(SCAN_DPP("v_fmac_f32_dpp %0, %1, %2", 2) : "+v"(a2) : "v"(o.kk[0]), "v"(S[2]));
    asm volatile(SCAN_DPP("v_fmac_f32_dpp %0, %1, %2", 3) : "+v"(a3) : "v"(o.kk[0]), "v"(S[3]));
    asm volatile(SCAN_DPP("v_fmac_f32_dpp %0, %1, %2", 4) : "+v"(a0) : "v"(o.kk[0]), "v"(S[4]));
    asm volatile(SCAN_DPP("v_fmac_f32_dpp %0, %1, %2", 5) : "+v"(a1) : "v"(o.kk[0]), "v"(S[5]));
    asm volatile(SCAN_DPP("v_fmac_f32_dpp %0, %1, %2", 6) : "+v"(a2) : "v"(o.kk[0]), "v"(S[6]));
    asm volatile(SCAN_DPP("v_fmac_f32_dpp %0, %1, %2", 7) : "+v"(a3) : "v"(o.kk[0]), "v"(S[7]));
    asm volatile(SCAN_DPP("v_fmac_f32_dpp %0, %1, %2", 8) : "+v"(a0) : "v"(o.kk[0]), "v"(S[8]));
    asm volatile(SCAN_DPP("v_fmac_f32_dpp %0, %1, %2", 9) : "+v"(a1) : "v"(o.kk[0]), "v"(S[9]));
    asm volatile(SCAN_DPP("v_fmac_f32_dpp %0, %1, %2", 10) : "+v"(a2) : "v"(o.kk[0]), "v"(S[10]));
    asm volatile(SCAN_DPP("v_fmac_f32_dpp %0, %1, %2", 11) : "+v"(a3) : "v"(o.kk[0]), "v"(S[11]));
    asm volatile(SCAN_DPP("v_fmac_f32_dpp %0, %1, %2", 12) : "+v"(a0) : "v"(o.kk[0]), "v"(S[12]));
    asm volatile(SCAN_DPP("v_fmac_f32_dpp %0, %1, %2", 13) : "+v"(a1) : "v"(o.kk[0]), "v"(S[13]));
    asm volatile(SCAN_DPP("v_fmac_f32_dpp %0, %1, %2", 14) : "+v"(a2) : "v"(o.kk[0]), "v"(S[14]));
    asm volatile(SCAN_DPP("v_fmac_f32_dpp %0, %1, %2", 15) : "+v"(a3) : "v"(o.kk[0]), "v"(S[15]));
    asm volatile(SCAN_DPP("v_fmac_f32_dpp %0, %1, %2", 0) : "+v"(a0) : "v"(o.kk[1]), "v"(S[16]));
    asm volatile(SCAN_DPP("v_fmac_f32_dpp %0, %1, %2", 1) : "+v"(a1) : "v"(o.kk[1]), "v"(S[17]));
    asm volatile(SCAN_DPP("v_fmac_f32_dpp %0, %1, %2", 2) : "+v"(a2) : "v"(o.kk[1]), "v"(S[18]));
    asm volatile(SCAN_DPP("v_fmac_f32_dpp %0, %1, %2", 3) : "+v"(a3) : "v"(o.kk[1]), "v"(S[19]));
    asm volatile(SCAN_DPP("v_fmac_f32_dpp %0, %1, %2", 4) : "+v"(a0) : "v"(o.kk[1]), "v"(S[20]));
    asm volatile(SCAN_DPP("v_fmac_f32_dpp %0, %1, %2", 5) : "+v"(a1) : "v"(o.kk[1]), "v"(S[21]));
    asm volatile(SCAN_DPP("v_fmac_f32_dpp %0, %1, %2", 6) : "+v"(a2) : "v"(o.kk[1]), "v"(S[22]));
    asm volatile(SCAN_DPP("v_fmac_f32_dpp %0, %1, %2", 7) : "+v"(a3) : "v"(o.kk[1]), "v"(S[23]));
    asm volatile(SCAN_DPP("v_fmac_f32_dpp %0, %1, %2", 8) : "+v"(a0) : "v"(o.kk[1]), "v"(S[24]));
    asm volatile(SCAN_DPP("v_fmac_f32_dpp %0, %1, %2", 9) : "+v"(a1) : "v"(o.kk[1]), "v"(S[25]));
    asm volatile(SCAN_DPP("v_fmac_f32_dpp %0, %1, %2", 10) : "+v"(a2) : "v"(o.kk[1]), "v"(S[26]));
    asm volatile(SCAN_DPP("v_fmac_f32_dpp %0, %1, %2", 11) : "+v"(a3) : "v"(o.kk[1]), "v"(S[27]));
    asm volatile(SCAN_DPP("v_fmac_f32_dpp %0, %1, %2", 12) : "+v"(a0) : "v"(o.kk[1]), "v"(S[28]));
    asm volatile(SCAN_DPP("v_fmac_f32_dpp %0, %1, %2", 13) : "+v"(a1) : "v"(o.kk[1]), "v"(S[29]));
    asm volatile(SCAN_DPP("v_fmac_f32_dpp %0, %1, %2", 14) : "+v"(a2) : "v"(o.kk[1]), "v"(S[30]));
    asm volatile(SCAN_DPP("v_fmac_f32_dpp %0, %1, %2", 15) : "+v"(a3) : "v"(o.kk[1]), "v"(S[31]));
    const float nskk = -xor32_sum((a0 + a1) + (a2 + a3)); const float vv = o.vv;
    float y0 = 0.f, y1 = 0.f, y2 = 0.f, y3 = 0.f;
    asm volatile("s_nop 1");
    asm volatile(SCAN_DPP("v_mul_f32_dpp %0, %1, %0", 0) : "+v"(S[0]) : "v"(o.dd[0]));
    asm volatile(SCAN_DPP("v_mul_f32_dpp %0, %1, %0", 1) : "+v"(S[1]) : "v"(o.dd[0]));
    asm volatile(SCAN_DPP("v_mul_f32_dpp %0, %1, %0", 2) : "+v"(S[2]) : "v"(o.dd[0]));
    asm volatile(SCAN_DPP("v_mul_f32_dpp %0, %1, %0", 3) : "+v"(S[3]) : "v"(o.dd[0]));
    asm volatile(SCAN_DPP("v_fmac_f32_dpp %0, %1, %2", 0) : "+v"(S[0]) : "v"(o.ka[0]), "v"(nskk));
    asm volatile(SCAN_DPP("v_fmac_f32_dpp %0, %1, %2", 1) : "+v"(S[1]) : "v"(o.ka[0]), "v"(nskk));
    asm volatile(SCAN_DPP("v_fmac_f32_dpp %0, %1, %2", 2) : "+v"(S[2]) : "v"(o.ka[0]), "v"(nskk));
    asm volatile(SCAN_DPP("v_fmac_f32_dpp %0, %1, %2", 3) : "+v"(S[3]) : "v"(o.ka[0]), "v"(nskk));
    asm volatile(SCAN_DPP("v_fmac_f32_dpp %0, %1, %2", 0) : "+v"(S[0]) : "v"(o.kp[0]), "v"(vv));
    asm volatile(SCAN_DPP("v_fmac_f32_dpp %0, %1, %2", 1) : "+v"(S[1]) : "v"(o.kp[0]), "v"(vv));
    asm volatile(SCAN_DPP("v_fmac_f32_dpp %0, %1, %2", 2) : "+v"(S[2]) : "v"(o.kp[0]), "v"(vv));
    asm volatile(SCAN_DPP("v_fmac_f32_dpp %0, %1, %2", 3) : "+v"(S[3]) : "v"(o.kp[0]), "v"(vv));
    asm volatile(SCAN_DPP("v_fmac_f32_dpp %0, %1, %2", 0) : "+v"(y0) : "v"(o.rr[0]), "v"(S[0]));
    asm volatile(SCAN_DPP("v_fmac_f32_dpp %0, %1, %2", 1) : "+v"(y1) : "v"(o.rr[0]), "v"(S[1]));
    asm volatile(SCAN_DPP("v_fmac_f32_dpp %0, %1, %2", 2) : "+v"(y2) : "v"(o.rr[0]), "v"(S[2]));
    asm volatile(SCAN_DPP("v_fmac_f32_dpp %0, %1, %2", 3) : "+v"(y3) : "v"(o.rr[0]), "v"(S[3]));
    asm volatile(SCAN_DPP("v_mul_f32_dpp %0, %1, %0", 4) : "+v"(S[4]) : "v"(o.dd[0]));
    asm volatile(SCAN_DPP("v_mul_f32_dpp %0, %1, %0", 5) : "+v"(S[5]) : "v"(o.dd[0]));
    asm volatile(SCAN_DPP("v_mul_f32_dpp %0, %1, %0", 6) : "+v"(S[6]) : "v"(o.dd[0]));
    asm volatile(SCAN_DPP("v_mul_f32_dpp %0, %1, %0", 7) : "+v"(S[7]) : "v"(o.dd[0]));
    asm volatile(SCAN_DPP("v_fmac_f32_dpp %0, %1, %2", 4) : "+v"(S[4]) : "v"(o.ka[0]), "v"(nskk));
    asm volatile(SCAN_DPP("v_fmac_f32_dpp %0, %1, %2", 5) : "+v"(S[5]) : "v"(o.ka[0]), "v"(nskk));
    asm volatile(SCAN_DPP("v_fmac_f32_dpp %0, %1, %2", 6) : "+v"(S[6]) : "v"(o.ka[0]), "v"(nskk));
    asm volatile(SCAN_DPP("v_fmac_f32_dpp %0, %1, %2", 7) : "+v"(S[7]) : "v"(o.ka[0]), "v"(nskk));
    asm volatile(SCAN_DPP("v_fmac_f32_dpp %0, %1, %2", 4) : "+v"(S[4]) : "v"(o.kp[0]), "v"(vv));
    asm volatile(SCAN_DPP("v_fmac_f32_dpp %0, %1, %2", 5) : "+v"(S[5]) : "v"(o.kp[0]), "v"(vv));
    asm volatile(SCAN_DPP("v_fmac_f32_dpp %0, %1, %2", 6) : "+v"(S[6]) : "v"(o.kp[0]), "v"(vv));
    asm volatile(SCAN_DPP("v_fmac_f32_dpp %0, %1, %2", 7) : "+v"(S[7]) : "v"(o.kp[0]), "v"(vv));
    asm volatile(SCAN_DPP("v_fmac_f32_dpp %0, %1, %2", 4) : "+v"(y0) : "v"(o.rr[0]), "v"(S[4]));
    asm volatile(SCAN_DPP("v_fmac_f32_dpp %0, %1, %2", 5) : "+v"(y1) : "v"(o.rr[0]), "v"(S[5]));
    asm volatile(SCAN_DPP("v_fmac_f32_dpp %0, %1, %2", 6) : "+v"(y2) : "v"(o.rr[0]), "v"(S[6]));
    asm volatile(SCAN_DPP("v_fmac_f32_dpp %0, %1, %2", 7) : "+v"(y3) : "v"(o.rr[0]), "v"(S[7]));
    asm volatile(SCAN_DPP("v_mul_f32_dpp %0, %1, %0", 8) : "+v"(S[8]) : "v"(o.dd[0]));
    asm volatile(SCAN_DPP("v_mul_f32_dpp %0, %1, %0", 9) : "+v"(S[9]) : "v"(o.dd[0]));
    asm volatile(SCAN_DPP("v_mul_f32_dpp %0, %1, %0", 10) : "+v"(S[10]) : "v"(o.dd[0]));
    asm volatile(SCAN_DPP("v_mul_f32_dpp %0, %1, %0", 11) : "+v"(S[11]) : "v"(o.dd[0]));
    asm volatile(SCAN_DPP("v_fmac_f32_dpp %0, %1, %2", 8) : "+v"(S[8]) : "v"(o.ka[0]), "v"(nskk));
    asm volatile(SCAN_DPP("v_fmac_f32_dpp %0, %1, %2", 9) : "+v"(S[9]) : "v"(o.ka[0]), "v"(nskk));
    asm volatile(SCAN_DPP("v_fmac_f32_dpp %0, %1, %2", 10) : "+v"(S[10]) : "v"(o.ka[0]), "v"(nskk));
    asm volatile(SCAN_DPP("v_fmac_f32_dpp %0, %1, %2", 11) : "+v"(S[11]) : "v"(o.ka[0]), "v"(nskk));
    asm volatile(SCAN_DPP("v_fmac_f32_dpp %0, %1, %2", 8) : "+v"(S[8]) : "v"(o.kp[0]), "v"(vv));
    asm volatile(SCAN_DPP("v_fmac_f32_dpp %0, %1, %2", 9) : "+v"(S[9]) : "v"(o.kp[0]), "v"(vv));
    asm volatile(SCAN_DPP("v_fmac_f32_dpp %0, %1, %2", 10) : "+v"(S[10]) : "v"(o.kp[0]), "v"(vv));
    asm volatile(SCAN_DPP("v_fmac_f32_dpp %0, %1, %2", 11) : "+v"(S[11]) : "v"(o.kp[0]), "v"(vv));
    asm volatile(SCAN_DPP("v_fmac_f32_dpp %0, %1, %2", 8) : "+v"(y0) : "v"(o.rr[0]), "v"(S[8]));
    asm volatile(SCAN_DPP("v_fmac_f32_dpp %0, %1, %2", 9) : "+v"(y1) : "v"(o.rr[0]), "v"(S[9]));
    asm volatile(SCAN_DPP("v_fmac_f32_dpp %0, %1, %2", 10) : "+v"(y2) : "v"(o.rr[0]), "v"(S[10]));
    asm volatile(SCAN_DPP("v_fmac_f32_dpp %0, %1, %2", 11) : "+v"(y3) : "v"(o.rr[0]), "v"(S[11]));
    asm volatile(SCAN_DPP("v_mul_f32_dpp %0, %1, %0", 12) : "+v"(S[12]) : "v"(o.dd[0]));
    asm volatile(SCAN_DPP("v_mul_f32_dpp %0, %1, %0", 13) : "+v"(S[13]) : "v"(o.dd[0]));
    asm volatile(SCAN_DPP("v_mul_f32_dpp %0, %1, %0", 14) : "+v"(S[14]) : "v"(o.dd[0]));
    asm volatile(SCAN_DPP("v_mul_f32_dpp %0, %1, %0", 15) : "+v"(S[15]) : "v"(o.dd[0]));
    asm volatile(SCAN_DPP("v_fmac_f32_dpp %0, %1, %2", 12) : "+v"(S[12]) : "v"(o.ka[0]), "v"(nskk));
    asm volatile(SCAN_DPP("v_fmac_f32_dpp %0, %1, %2", 13) : "+v"(S[13]) : "v"(o.ka[0]), "v"(nskk));
    asm volatile(SCAN_DPP("v_fmac_f32_dpp %0, %1, %2", 14) : "+v"(S[14]) : "v"(o.ka[0]), "v"(nskk));
    asm volatile(SCAN_DPP("v_fmac_f32_dpp %0, %1, %2", 15) : "+v"(S[15]) : "v"(o.ka[0]), "v"(nskk));
    asm volatile(SCAN_DPP("v_fmac_f32_dpp %0, %1, %2", 12) : "+v"(S[12]) : "v"(o.kp[0]), "v"(vv));
    asm volatile(SCAN_DPP("v_fmac_f32_dpp %0, %1, %2", 13) : "+v"(S[13]) : "v"(o.kp[0]), "v"(vv));
    asm volatile(SCAN_DPP("v_fmac_f32_dpp %0, %1, %2", 14) : "+v"(S[14]) : "v"(o.kp[0]), "v"(vv));
    asm volatile(SCAN_DPP("v_fmac_f32_dpp %0, %1, %2", 15) : "+v"(S[15]) : "v"(o.kp[0]), "v"(vv));
    asm volatile(SCAN_DPP("v_fmac_f32_dpp %0, %1, %2", 12) : "+v"(y0) : "v"(o.rr[0]), "v"(S[12]));
    asm volatile(SCAN_DPP("v_fmac_f32_dpp %0, %1, %2", 13) : "+v"(y1) : "v"(o.rr[0]), "v"(S[13]));
    asm volatile(SCAN_DPP("v_fmac_f32_dpp %0, %1, %2", 14) : "+v"(y2) : "v"(o.rr[0]), "v"(S[14]));
    asm volatile(SCAN_DPP("v_fmac_f32_dpp %0, %1, %2", 15) : "+v"(y3) : "v"(o.rr[0]), "v"(S[15]));
    asm volatile(SCAN_DPP("v_mul_f32_dpp %0, %1, %0", 0) : "+v"(S[16]) : "v"(o.dd[1]));
    asm volatile(SCAN_DPP("v_mul_f32_dpp %0, %1, %0", 1) : "+v"(S[17]) : "v"(o.dd[1]));
    asm volatile(SCAN_DPP("v_mul_f32_dpp %0, %1, %0", 2) : "+v"(S[18]) : "v"(o.dd[1]));
    asm volatile(SCAN_DPP("v_mul_f32_dpp %0, %1, %0", 3) : "+v"(S[19]) : "v"(o.dd[1]));
    asm volatile(SCAN_DPP("v_fmac_f32_dpp %0, %1, %2", 0) : "+v"(S[16]) : "v"(o.ka[1]), "v"(nskk));
    asm volatile(SCAN_DPP("v_fmac_f32_dpp %0, %1, %2", 1) : "+v"(S[17]) : "v"(o.ka[1]), "v"(nskk));
    asm volatile(SCAN_DPP("v_fmac_f32_dpp %0, %1, %2", 2) : "+v"(S[18]) : "v"(o.ka[1]), "v"(nskk));
    asm volatile(SCAN_DPP("v_fmac_f32_dpp %0, %1, %2", 3) : "+v"(S[19]) : "v"(o.ka[1]), "v"(nskk));
    asm volatile(SCAN_DPP("v_fmac_f32_dpp %0, %1, %2", 0) : "+v"(S[16]) : "v"(o.kp[1]), "v"(vv));
    asm volatile(SCAN_DPP("v_fmac_f32_dpp %0, %1, %2", 1) : "+v"(S[17]) : "v"(o.kp[1]), "v"(vv));
    asm volatile(SCAN_DPP("v_fmac_f32_dpp %0, %1, %2", 2) : "+v"(S[18]) : "v"(o.kp[1]), "v"(vv));
    asm volatile(SCAN_DPP("v_fmac_f32_dpp %0, %1, %2", 3) : "+v"(S[19]) : "v"(o.kp[1]), "v"(vv));
    asm volatile(SCAN_DPP("v_fmac_f32_dpp %0, %1, %2", 0) : "+v"(y0) : "v"(o.rr[1]), "v"(S[16]));
    asm volatile(SCAN_DPP("v_fmac_f32_dpp %0, %1, %2", 1) : "+v"(y1) : "v"(o.rr[1]), "v"(S[17]));
    asm volatile(SCAN_DPP("v_fmac_f32_dpp %0, %1, %2", 2) : "+v"(y2) : "v"(o.rr[1]), "v"(S[18]));
    asm volatile(SCAN_DPP("v_fmac_f32_dpp %0, %1, %2", 3) : "+v"(y3) : "v"(o.rr[1]), "v"(S[19]));
    asm volatile(SCAN_DPP("v_mul_f32_dpp %0, %1, %0", 4) : "+v"(S[20]) : "v"(o.dd[1]));
    asm volatile(SCAN_DPP("v_mul_f32_dpp %0, %1, %0", 5) : "+v"(S[21]) : "v"(o.dd[1]));
    asm volatile(SCAN_DPP("v_mul_f32_dpp %0, %1, %0", 6) : "+v"(S[22]) : "v"(o.dd[1]));
    asm volatile(SCAN_DPP("v_mul_f32_dpp %0, %1, %0", 7) : "+v"(S[23]) : "v"(o.dd[1]));
    asm volatile(SCAN_DPP("v_fmac_f32_dpp %0, %1, %2", 4) : "+v"(S[20]) : "v"(o.ka[1]), "v"(nskk));
    asm volatile(SCAN_DPP("v_fmac_f32_dpp %0, %1, %2", 5) : "+v"(S[21]) : "v"(o.ka[1]), "v"(nskk));
    asm volatile(SCAN_DPP("v_fmac_f32_dpp %0, %1, %2", 6) : "+v"(S[22]) : "v"(o.ka[1]), "v"(nskk));
    asm volatile(SCAN_DPP("v_fmac_f32_dpp %0, %1, %2", 7) : "+v"(S[23]) : "v"(o.ka[1]), "v"(nskk));
    asm volatile(SCAN_DPP("v_fmac_f32_dpp %0, %1, %2", 4) : "+v"(S[20]) : "v"(o.kp[1]), "v"(vv));
    asm volatile(SCAN_DPP("v_fmac_f32_dpp %0, %1, %2", 5) : "+v"(S[21]) : "v"(o.kp[1]), "v"(vv));
    asm volatile(SCAN_DPP("v_fmac_f32_dpp %0, %1, %2", 6) : "+v"(S[22]) : "v"(o.kp[1]), "v"(vv));
    asm volatile(SCAN_DPP("v_fmac_f32_dpp %0, %1, %2", 7) : "+v"(S[23]) : "v"(o.kp[1]), "v"(vv));
    asm volatile(SCAN_DPP("v_fmac_f32_dpp %0, %1, %2", 4) : "+v"(y0) : "v"(o.rr[1]), "v"(S[20]));
    asm volatile(SCAN_DPP("v_fmac_f32_dpp %0, %1, %2", 5) : "+v"(y1) : "v"(o.rr[1]), "v"(S[21]));
    asm volatile(SCAN_DPP("v_fmac_f32_dpp %0, %1, %2", 6) : "+v"(y2) : "v"(o.rr[1]), "v"(S[22]));
    asm volatile(SCAN_DPP("v_fmac_f32_dpp %0, %1, %2", 7) : "+v"(y3) : "v"(o.rr[1]), "v"(S[23]));
    asm volatile(SCAN_DPP("v_mul_f32_dpp %0, %1, %0", 8) : "+v"(S[24]) : "v"(o.dd[1]));
    asm volatile(SCAN_DPP("v_mul_f32_dpp %0, %1, %0", 9) : "+v"(S[25]) : "v"(o.dd[1]));
    asm volatile(SCAN_DPP("v_mul_f32_dpp %0, %1, %0", 10) : "+v"(S[26]) : "v"(o.dd[1]));
    asm volatile(SCAN_DPP("v_mul_f32_dpp %0, %1, %0", 11) : "+v"(S[27]) : "v"(o.dd[1]));
    asm volatile(SCAN_DPP("v_fmac_f32_dpp %0, %1, %2", 8) : "+v"(S[24]) : "v"(o.ka[1]), "v"(nskk));
    asm volatile(SCAN_DPP("v_fmac_f32_dpp %0, %1, %2", 9) : "+v"(S[25]) : "v"(o.ka[1]), "v"(nskk));
    asm volatile(SCAN_DPP("v_fmac_f32_dpp %0, %1, %2", 10) : "+v"(S[26]) : "v"(o.ka[1]), "v"(nskk));
    asm volatile(SCAN_DPP("v_fmac_f32_dpp %0, %1, %2", 11) : "+v"(S[27]) : "v"(o.ka[1]), "v"(nskk));
    asm volatile(SCAN_DPP("v_fmac_f32_dpp %0, %1, %2", 8) : "+v"(S[24]) : "v"(o.kp[1]), "v"(vv));
    asm volatile(SCAN_DPP("v_fmac_f32_dpp %0, %1, %2", 9) : "+v"(S[25]) : "v"(o.kp[1]), "v"(vv));
    asm volatile(SCAN_DPP("v_fmac_f32_dpp %0, %1, %2", 10) : "+v"(S[26]) : "v"(o.kp[1]), "v"(vv));
    asm volatile(SCAN_DPP("v_fmac_f32_dpp %0, %1, %2", 11) : "+v"(S[27]) : "v"(o.kp[1]), "v"(vv));
    asm volatile(SCAN_DPP("v_fmac_f32_dpp %0, %1, %2", 8) : "+v"(y0) : "v"(o.rr[1]), "v"(S[24]));
    asm volatile(SCAN_DPP("v_fmac_f32_dpp %0, %1, %2", 9) : "+v"(y1) : "v"(o.rr[1]), "v"(S[25]));
    asm volatile(SCAN_DPP("v_fmac_f32_dpp %0, %1, %2", 10) : "+v"(y2) : "v"(o.rr[1]), "v"(S[26]));
    asm volatile(SCAN_DPP("v_fmac_f32_dpp %0, %1, %2", 11) : "+v"(y3) : "v"(o.rr[1]), "v"(S[27]));
    asm volatile(SCAN_DPP("v_mul_f32_dpp %0, %1, %0", 12) : "+v"(S[28]) : "v"(o.dd[1]));
    asm volatile(SCAN_DPP("v_mul_f32_dpp %0, %1, %0", 13) : "+v"(S[29]) : "v"(o.dd[1]));
    asm volatile(SCAN_DPP("v_mul_f32_dpp %0, %1, %0", 14) : "+v"(S[30]) : "v"(o.dd[1]));
    asm volatile(SCAN_DPP("v_mul_f32_dpp %0, %1, %0", 15) : "+v"(S[31]) : "v"(o.dd[1]));
    asm volatile(SCAN_DPP("v_fmac_f32_dpp %0, %1, %2", 12) : "+v"(S[28]) : "v"(o.ka[1]), "v"(nskk));
    asm volatile(SCAN_DPP("v_fmac_f32_dpp %0, %1, %2", 13) : "+v"(S[29]) : "v"(o.ka[1]), "v"(nskk));
    asm volatile(SCAN_DPP("v_fmac_f32_dpp %0, %1, %2", 14) : "+v"(S[30]) : "v"(o.ka[1]), "v"(nskk));
    asm volatile(SCAN_DPP("v_fmac_f32_dpp %0, %1, %2", 15) : "+v"(S[31]) : "v"(o.ka[1]), "v"(nskk));
    asm volatile(SCAN_DPP("v_fmac_f32_dpp %0, %1, %2", 12) : "+v"(S[28]) : "v"(o.kp[1]), "v"(vv));
    asm volatile(SCAN_DPP("v_fmac_f32_dpp %0, %1, %2", 13) : "+v"(S[29]) : "v"(o.kp[1]), "v"(vv));
    asm volatile(SCAN_DPP("v_fmac_f32_dpp %0, %1, %2", 14) : "+v"(S[30]) : "v"(o.kp[1]), "v"(vv));
    asm volatile(SCAN_DPP("v_fmac_f32_dpp %0, %1, %2", 15) : "+v"(S[31]) : "v"(o.kp[1]), "v"(vv));
    asm volatile(SCAN_DPP("v_fmac_f32_dpp %0, %1, %2", 12) : "+v"(y0) : "v"(o.rr[1]), "v"(S[28]));
    asm volatile(SCAN_DPP("v_fmac_f32_dpp %0, %1, %2", 13) : "+v"(y1) : "v"(o.rr[1]), "v"(S[29]));
    asm volatile(SCAN_DPP("v_fmac_f32_dpp %0, %1, %2", 14) : "+v"(y2) : "v"(o.rr[1]), "v"(S[30]));
    asm volatile(SCAN_DPP("v_fmac_f32_dpp %0, %1, %2", 15) : "+v"(y3) : "v"(o.rr[1]), "v"(S[31]));
    return xor32_sum((y0 + y1) + (y2 + y3));
}
#define SCAN_STORE(ptr, val) asm volatile("global_store_dword %0, %1, off" :: "v"((GAS float*)(ptr)), "v"(val) : "memory")
DI void scan_unit(const float* sbase, const float* vbase, const float* s0, float* yraw, float* sout, int half, int T, int lane) {
    float S[32]; const int srow = (32 * half + (lane & 31)) * 64 + 32 * (lane >> 5);
    if (s0) {
#pragma unroll
        for (int k = 0; k < 32; k += 4) { const f32x4 v = *(const GAS f32x4*)(s0 + srow + k); S[k] = v.x; S[k + 1] = v.y; S[k + 2] = v.z; S[k + 3] = v.w; }
    } else {
#pragma unroll
        for (int k = 0; k < 32; ++k) S[k] = 0.f;
    }
#pragma unroll
    for (int k = 0; k < 32; ++k) asm volatile("" : "+v"(S[k]));
    __builtin_amdgcn_s_setprio(3);
    ScanOps o0, o1, o2, o3; float* yp = yraw + (lane & 31);
    scan_load(o0, sbase, vbase, 0, lane); scan_load(o1, sbase, vbase, 1, lane); scan_load(o2, sbase, vbase, 2, lane); scan_load(o3, sbase, vbase, 3, lane);
    for (int t = 0; t < T; t += 4) {
        float y;
        y = scan_step(S, o0); asm volatile("" ::: "memory"); SCAN_STORE(yp + (size_t)t * BW, y);       scan_load(o0, sbase, vbase, min(t + 4, T - 1), lane);
        asm volatile("" ::: "memory"); y = scan_step(S, o1); asm volatile("" ::: "memory"); SCAN_STORE(yp + (size_t)(t + 1) * BW, y); scan_load(o1, sbase, vbase, min(t + 5, T - 1), lane);
        asm volatile("" ::: "memory"); y = scan_step(S, o2); asm volatile("" ::: "memory"); SCAN_STORE(yp + (size_t)(t + 2) * BW, y); scan_load(o2, sbase, vbase, min(t + 6, T - 1), lane);
        asm volatile("" ::: "memory"); y = scan_step(S, o3); asm volatile("" ::: "memory"); SCAN_STORE(yp + (size_t)(t + 3) * BW, y); scan_load(o3, sbase, vbase, min(t + 7, T - 1), lane);
        asm volatile("" ::: "memory");
    }
    asm volatile("s_waitcnt vmcnt(0)" : "+v"(o0.kk), "+v"(o0.dd), "+v"(o0.ka), "+v"(o0.kp), "+v"(o0.rr), "+v"(o0.vv), "+v"(o1.kk), "+v"(o1.dd), "+v"(o1.ka), "+v"(o1.kp), "+v"(o1.rr), "+v"(o1.vv) :: "memory");
    asm volatile("" : "+v"(o2.kk), "+v"(o2.dd), "+v"(o2.ka), "+v"(o2.kp), "+v"(o2.rr), "+v"(o2.vv), "+v"(o3.kk), "+v"(o3.dd), "+v"(o3.ka), "+v"(o3.kp), "+v"(o3.rr), "+v"(o3.vv) :: "memory");
    __builtin_amdgcn_s_setprio(0);
#pragma unroll
    for (int k = 0; k < 32; k += 4) *(GAS f32x4*)(sout + srow + k) = (f32x4){S[k], S[k + 1], S[k + 2], S[k + 3]};
}
DI void sb_unit(const bf16* Qp, const bf16* Kp, int kpitch, const bf16* VTp, int vpitch, int qpos0, const bf16* Zp, bf16* Op, int lane) {
    const int r = lane & 31, h = lane >> 5;
    bf16x8 qf[8];
#pragma unroll
    for (int s = 0; s < 8; ++s) qf[s] = *(const GAS bf16x8*)(Qp + (size_t)r * NINP + 16 * s + 8 * h);
    f32x16 o[4];
#pragma unroll
    for (int db = 0; db < 4; ++db)
#pragma unroll
        for (int i = 0; i < 16; ++i) o[db][i] = 0.f;
    float R = 0.f; const int qpos = qpos0 + r; const float scale = 0.08838834764831845f;
    bf16x8 kf[8];
    { const bf16* kr = Kp + (size_t)((qpos0 >> 5) * 32 + r) * kpitch + 8 * h;
#pragma unroll
      for (int s = 0; s < 8; ++s) kf[s] = *(const GAS bf16x8*)(kr + 16 * s); }
    for (int kt = qpos0 >> 5; kt >= 0; --kt) {
        const int key0 = kt * 32;
        f32x16 sc;
#pragma unroll
        for (int i = 0; i < 16; ++i) sc[i] = 0.f;
#pragma unroll
        for (int s = 0; s < 8; ++s) sc = MFMA32(kf[s], qf[s], sc);
        { const bf16* kr = Kp + (size_t)((kt > 0 ? key0 - 32 : 0) + r) * kpitch + 8 * h;
#pragma unroll
          for (int s = 0; s < 8; ++s) kf[s] = *(const GAS bf16x8*)(kr + 16 * s); }
        float lm[16], lb[16];
#pragma unroll
        for (int i = 0; i < 16; ++i) { const int key = key0 + crow16(i, h); const float z = sc[i] * scale; const bool valid = key < qpos;
            const float e = __expf(-fabsf(z)); const float sp = fmaxf(z, 0.f) + __logf(1.0f + e);
            lm[i] = valid ? -sp : 0.f; lb[i] = valid ? (z - sp) : -1e30f; }
        float G[4], Go[4], aft[4];
#pragma unroll
        for (int g = 0; g < 4; ++g) { G[g] = (lm[4 * g] + lm[4 * g + 1]) + (lm[4 * g + 2] + lm[4 * g + 3]); Go[g] = xor32_partner(G[g], h); }
        float tail = 0.f;
#pragma unroll
        for (int g = 3; g >= 0; --g) { aft[g] = tail + (h == 0 ? Go[g] : 0.f); tail += G[g] + Go[g]; }
        float att[16];
#pragma unroll
        for (int g = 0; g < 4; ++g) { float suf = aft[g] + R;
#pragma unroll
            for (int j = 3; j >= 0; --j) { att[4 * g + j] = __expf(lb[4 * g + j] + suf); suf += lm[4 * g + j]; } }
        R += tail;
        const bool live = __builtin_amdgcn_ballot_w64(R >= -104.0f) != 0ull;
        const bf16x8 p0 = pack8(att[0], att[1], att[2], att[3], att[4], att[5], att[6], att[7]);
        const bf16x8 p1 = pack8(att[8], att[9], att[10], att[11], att[12], att[13], att[14], att[15]);
#pragma unroll
        for (int db = 0; db < 4; ++db) { const bf16* vr = VTp + (size_t)(32 * db + r) * vpitch + key0 + 4 * h;
            const s16x4 a0 = *(const GAS s16x4*)(vr), a1 = *(const GAS s16x4*)(vr + 8), b0 = *(const GAS s16x4*)(vr + 16), b1 = *(const GAS s16x4*)(vr + 24);
            o[db] = MFMA32(__builtin_shufflevector(a0, a1, 0, 1, 2, 3, 4, 5, 6, 7), p0, o[db]);
            o[db] = MFMA32(__builtin_shufflevector(b0, b1, 0, 1, 2, 3, 4, 5, 6, 7), p1, o[db]); }
        if (!live) break;
    }
    v2u zq[4][4];
#pragma unroll
    for (int db = 0; db < 4; ++db)
#pragma unroll
        for (int g = 0; g < 4; ++g) zq[db][g] = *(const GAS v2u*)(Zp + (size_t)r * NINP + 32 * db + 8 * g + 4 * h);
#pragma unroll
    for (int db = 0; db < 4; ++db)
#pragma unroll
        for (int g = 0; g < 4; ++g) { const int d0 = 32 * db + 8 * g + 4 * h; const v2u zu = zq[db][g];
            v2u w; w.x = pk2(o[db][4 * g] * siluf_(bflo(zu.x)), o[db][4 * g + 1] * siluf_(bfhi(zu.x))); w.y = pk2(o[db][4 * g + 2] * siluf_(bflo(zu.y)), o[db][4 * g + 3] * siluf_(bfhi(zu.y)));
            *(GAS v2u*)(Op + (size_t)r * BW + d0) = w; }
}
DI void xattn_unit(const bf16* Qp, const bf16* Kp, const bf16* VTp, bf16* Op, int lane) {
    const int r = lane & 31, h = lane >> 5;
    f32x16 sT[8];
#pragma unroll
    for (int kt = 0; kt < 8; ++kt)
#pragma unroll
        for (int i = 0; i < 16; ++i) sT[kt][i] = 0.f;
    const bf16* qrow = Qp + (size_t)r * NINP + 8 * h; const bf16* krow = Kp + (size_t)r * BW + 8 * h;
#define XA_LOAD(QF, KF, s) do { QF = *(const GAS bf16x8*)(qrow + 16 * (s)); _Pragma("unroll") for (int kt = 0; kt < 8; ++kt) KF[kt] = *(const GAS bf16x8*)(krow + (size_t)(kt * 32) * BW + 16 * (s)); } while (0)
#define XA_MMA(QF, KF) do { _Pragma("unroll") for (int kt = 0; kt < 8; ++kt) sT[kt] = MFMA32(KF[kt], QF, sT[kt]); } while (0)
    bf16x8 qa, ka[8], qb, kb[8];
    XA_LOAD(qa, ka, 0);
#pragma unroll 1
    for (int s = 0; s < 16; s += 2) { XA_LOAD(qb, kb, s + 1); XA_MMA(qa, ka); XA_LOAD(qa, ka, s + 2 < 16 ? s + 2 : 15); XA_MMA(qb, kb); }
#undef XA_LOAD
#undef XA_MMA
    float m = -3.0e38f;
#pragma unroll
    for (int kt = 0; kt < 8; ++kt)
#pragma unroll
        for (int i = 0; i < 16; ++i) m = fmaxf(m, sT[kt][i]);
    m = xor32_max(m); m *= 0.0625f;
    float lsum = 0.f; bf16x8 pk[8][2];
#pragma unroll
    for (int kt = 0; kt < 8; ++kt) { float e[16];
#pragma unroll
        for (int i = 0; i < 16; ++i) { e[i] = __expf(sT[kt][i] * 0.0625f - m); lsum += e[i]; }
        pk[kt][0] = pack8(e[0], e[1], e[2], e[3], e[4], e[5], e[6], e[7]); pk[kt][1] = pack8(e[8], e[9], e[10], e[11], e[12], e[13], e[14], e[15]); }
    lsum = xor32_sum(lsum); const float inv = 1.0f / lsum;
    const bf16* vrow = VTp + (size_t)r * NMEM + 4 * h;
#define XA_VLOAD(V, db) do { const bf16* vr_ = vrow + (size_t)(32 * (db)) * NMEM; _Pragma("unroll") for (int kt = 0; kt < 8; ++kt) { V[kt][0] = *(const GAS s16x4*)(vr_ + kt * 32); V[kt][1] = *(const GAS s16x4*)(vr_ + kt * 32 + 8); V[kt][2] = *(const GAS s16x4*)(vr_ + kt * 32 + 16); V[kt][3] = *(const GAS s16x4*)(vr_ + kt * 32 + 24); } } while (0)
#define XA_PV(V, db) do { f32x16 o; _Pragma("unroll") for (int i = 0; i < 16; ++i) o[i] = 0.f; \
        _Pragma("unroll") for (int kt = 0; kt < 8; ++kt) { o = MFMA32(__builtin_shufflevector(V[kt][0], V[kt][1], 0, 1, 2, 3, 4, 5, 6, 7), pk[kt][0], o); o = MFMA32(__builtin_shufflevector(V[kt][2], V[kt][3], 0, 1, 2, 3, 4, 5, 6, 7), pk[kt][1], o); } \
        _Pragma("unroll") for (int g = 0; g < 4; ++g) { const int d0 = 32 * (db) + 8 * g + 4 * h; v2u w; w.x = pk2(o[4 * g] * inv, o[4 * g + 1] * inv); w.y = pk2(o[4 * g + 2] * inv, o[4 * g + 3] * inv); \
            *(GAS v2u*)(Op + (size_t)r * BW + d0) = w; } } while (0)
    s16x4 va[8][4], vb[8][4];
    XA_VLOAD(va, 0);
#pragma unroll 1
    for (int db = 0; db < 8; db += 2) { XA_VLOAD(vb, db + 1); XA_PV(va, db); XA_VLOAD(va, db + 2 < 8 ? db + 2 : 7); XA_PV(vb, db + 1); }
#undef XA_VLOAD
#undef XA_PV
}
DI void gmlp_unit(const P& p, const Frame& F, int l, int ch, int g, int lane) {
    const int r = lane & 31, h = lane >> 5; const int row0 = ch < 128 ? ch * 128 : MP + (ch - 128) * 64; const int ntb = ch < 128 ? 4 : 2;
    const bf16* wm = ((bf16*)(F.ws + WS_WM)) + (size_t)(l * CGN + g) * 128 * 128; const bf16* vn = ((bf16*)(F.ws + WS_VNT)) + (size_t)(ch * CGN + g) * 128 * 128;
    const float* bs = p.in[I_CBS] + (size_t)(l * CGN + g) * 128; bf16* oc = ((bf16*)(F.ws + WS_OALL)) + (size_t)2 * MT * BW; const bf16* proj = (const bf16*)(F.ws + WS_PROJ);
    for (int tb = 0; tb < ntb; ++tb) { f32x16 c[4];
#pragma unroll
        for (int db = 0; db < 4; ++db)
#pragma unroll
            for (int i = 0; i < 16; ++i) c[db][i] = 0.f;
        const int t = 32 * tb + r; const size_t row = (size_t)(row0 + t);
#pragma unroll 2
        for (int ks = 0; ks < 2 * (tb + 1); ++ks) { const bf16x8 wf = *(const GAS bf16x8*)(wm + (size_t)t * 128 + 16 * ks + 8 * h);
#pragma unroll
            for (int db = 0; db < 4; ++db) { const bf16x8 vf = *(const GAS bf16x8*)(vn + (size_t)(32 * db + r) * 128 + 16 * ks + 8 * h); c[db] = MFMA32(vf, wf, c[db]); } }
        const float bt = bs[t];
        v2u uq[4][4], zq[4][4];
#pragma unroll
        for (int db = 0; db < 4; ++db)
#pragma unroll
            for (int q = 0; q < 4; ++q) { const int col = g * CGD + 32 * db + 8 * q + 4 * h;
                uq[db][q] = *(const GAS v2u*)(proj + row * NINP + PC_CU + col); zq[db][q] = *(const GAS v2u*)(proj + row * NINP + PC_CZ + col); }
#pragma unroll
        for (int db = 0; db < 4; ++db)
#pragma unroll
            for (int q = 0; q < 4; ++q) { const int col = g * CGD + 32 * db + 8 * q + 4 * h;
                const v2u uu = uq[db][q], zz = zq[db][q];
                v2u w; w.x = pk2(bflo(uu.x) * (c[db][4 * q] + bt) * siluf_(bflo(zz.x)), bfhi(uu.x) * (c[db][4 * q + 1] + bt) * siluf_(bfhi(zz.x)));
                w.y = pk2(bflo(uu.y) * (c[db][4 * q + 2] + bt) * siluf_(bflo(zz.y)), bfhi(uu.y) * (c[db][4 * q + 3] + bt) * siluf_(bfhi(zz.y)));
                *(GAS v2u*)(oc + row * BW + col) = w; }
    }
}
#define REPM(k) _Pragma("unroll 1") for (int repm_ = 0; repm_ < ((DUP_PHASE) == (k) ? 2 : 1); ++repm_)
constexpr int N_SCAN_WG = 64, SCAN_WAVES = 4;
DI void ph_mixers(const P& p, const Frame& F, int l) {
    const int lane = F.lane;
    if (F.bx < N_SCAN_WG) {
        if (F.wave < SCAN_WAVES) {
        const int u = F.bx * SCAN_WAVES + F.wave, half = u & 1, b = u >> 5, h = (u >> 1) & 15; const size_t row0 = (size_t)b * SEQ;
        REPM(204) scan_unit(SCAN5P(F, l) + (row0 * AH + h) * (5 * 64), SCANVP(F) + row0 * BW + h * 64 + 32 * half, nullptr, YRAWP(F, l) + row0 * BW + h * 64 + 32 * half, F.out + O_RWP + ((size_t)(l * NB + b) * AH + h) * 4096, half, SEQ, lane);
        return; }
        if (l + 1 < DEPTH) { const int id = F.bx * (NWAVES - SCAN_WAVES) + (F.wave - SCAN_WAVES), nid = N_SCAN_WG * (NWAVES - SCAN_WAVES); int rot = 0;
            if (l == 0) { conv_layer_wbr(p, F, 0, id, nid, rot); conv_layer_wout(p, F, 0, id, nid, rot); }
            conv_layer_win(p, F, l + 1, id, nid, rot); conv_layer_wgate(p, F, l + 1, id, nid, rot); conv_layer_wbr(p, F, l + 1, id, nid, rot); conv_layer_wout(p, F, l + 1, id, nid, rot); conv_caches(p, F, l + 1, id, nid, rot);
            return; }
    }
    const int nmain = (F.G - N_SCAN_WG) * NWAVES, nextra = (l + 1 < DEPTH) ? 0 : N_SCAN_WG * (NWAVES - SCAN_WAVES);
    const int wv = F.bx < N_SCAN_WG ? nmain + F.bx * (NWAVES - SCAN_WAVES) + (F.wave - SCAN_WAVES) : (F.bx - N_SCAN_WG) * NWAVES + F.wave, nwv = nmain + nextra;
    if (wv < 2 * NB * AH) {
        const int half = wv & 1, b = wv >> 5, h = (wv >> 1) & 15; const size_t row0 = (size_t)MP + b * DSEQ;
        scan_unit(SCAN5P(F, l) + (row0 * AH + h) * (5 * 64), SCANVP(F) + row0 * BW + h * 64 + 32 * half, p.in[I_SRW] + ((size_t)(l * NB + b) * AH + h) * 4096, YRAWP(F, l) + row0 * BW + h * 64 + 32 * half, F.out + O_RWS + ((size_t)(l * NB + b) * AH + h) * 4096, half, DSEQ, lane);
    }
    REPM(304) for (int k = 0;; ++k) { int u = k * nwv + wv; if (k & 1) u = (k + 1) * nwv - 1 - wv; if (k * nwv >= 4096) break; if (u >= 4096) continue;
        const int qb = 63 - (u >> 6), bh = u & 63, b = bh >> 3, hd = bh & 7; const size_t row0 = (size_t)b * SEQ + qb * 32;
        sb_unit(((bf16*)(F.ws + WS_PROJ)) + row0 * NINP + PC_BQ + hd * BHD, ((bf16*)(F.ws + WS_PROJ)) + (size_t)b * SEQ * NINP + PC_BK + hd * BHD, NINP, ((bf16*)(F.ws + WS_VT)) + (size_t)(b * BHN + hd) * BHD * SEQ, SEQ, qb * 32,
                ((bf16*)(F.ws + WS_PROJ)) + row0 * NINP + PC_BZ + hd * BHD, ((bf16*)(F.ws + WS_OALL)) + (size_t)1 * MT * BW + row0 * BW + hd * BHD, lane); }
    for (int u = wv; u < 128; u += nwv) { const int qb = u & 1, bh = u >> 1, b = bh >> 3, hd = bh & 7; const size_t row0 = (size_t)MP + b * DSEQ + qb * 32;
        sb_unit(((bf16*)(F.ws + WS_PROJ)) + row0 * NINP + PC_BQ + hd * BHD, ((bf16*)(F.ws + WS_KCAT)) + (size_t)(l * NB + b) * KCATN * BW + hd * BHD, BW, ((bf16*)(F.ws + WS_VTCAT)) + (size_t)((l * NB + b) * BHN + hd) * BHD * KCATN, KCATN, PAST + qb * 32,
                ((bf16*)(F.ws + WS_PROJ)) + row0 * NINP + PC_BZ + hd * BHD, ((bf16*)(F.ws + WS_OALL)) + (size_t)1 * MT * BW + row0 * BW + hd * BHD, lane); }
    REPM(404) for (int u = wv; u < (MT / 32) * MHN; u += nwv) { const int hm = u & 3, rb = u >> 2; const size_t row0 = (size_t)rb * 32; const bool smp = row0 >= MP;
        const int b = smp ? (int)((row0 - MP) >> 6) : (int)(row0 >> 11);
        const bf16* Kp = (smp ? ((bf16*)(F.ws + WS_CMK)) : ((bf16*)(F.ws + WS_MKB))) + ((size_t)(l * NB + b) * NMEM) * BW + hm * MHD; const bf16* VTp = (smp ? ((bf16*)(F.ws + WS_CMVT)) : ((bf16*)(F.ws + WS_MVT))) + (size_t)((l * NB + b) * MHN + hm) * MHD * NMEM;
        xattn_unit(((bf16*)(F.ws + WS_PROJ)) + row0 * NINP + PC_MQ + hm * MHD, Kp, VTp, ((bf16*)(F.ws + WS_OALL)) + (size_t)3 * MT * BW + row0 * BW + hm * MHD, lane); }
    REPM(504) for (int u = wv; u < 136 * CGN; u += nwv) gmlp_unit(p, F, l, u >> 3, u & 7, lane);
}
DI void ph_posta(const P& p, const Frame& F, int l) {
    const int lane = F.lane, c0 = lane * 16, head = lane >> 2;
    const float* gw_ = p.in[I_AGNW] + (size_t)l * BW + c0; const float* gb_ = p.in[I_AGNB] + (size_t)l * BW + c0; const float muv = 0.f; (void)muv;
    for (int row = F.gw; row < MT; row += F.ngw) {
        const GAS f32x4* yp = (const GAS f32x4*)(YRAWP(F, l) + (size_t)row * BW + c0); float y[16];
#pragma unroll
        for (int i = 0; i < 4; ++i) { const f32x4 v = yp[i]; y[4 * i] = v.x; y[4 * i + 1] = v.y; y[4 * i + 2] = v.z; y[4 * i + 3] = v.w; }
        float s = 0.f;
#pragma unroll
        for (int i = 0; i < 16; ++i) s += y[i];
        s += SWZ_XOR(s, 1); s += SWZ_XOR(s, 2); const float mean = s * (1.0f / 64.0f); float q = 0.f;
#pragma unroll
        for (int i = 0; i < 16; ++i) { y[i] -= mean; q += y[i] * y[i]; }
        q += SWZ_XOR(q, 1); q += SWZ_XOR(q, 2); const float rstd = 1.0f / sqrtf(q * (1.0f / 64.0f) + GN_EPS);
        const float bon = ((float*)(F.ws + WS_BONUS))[(size_t)row * AH + head];
        const GAS f32x4* vp = (const GAS f32x4*)(SCANVP(F) + (size_t)row * BW + c0);
        const GAS v4u* zp = (const GAS v4u*)(((bf16*)(F.ws + WS_PROJ)) + (size_t)row * NINP + PC_AZ + c0); const v4u z0 = zp[0], z1 = zp[1];
        const float z[16] = {bflo(z0.x), bfhi(z0.x), bflo(z0.y), bfhi(z0.y), bflo(z0.z), bfhi(z0.z), bflo(z0.w), bfhi(z0.w), bflo(z1.x), bfhi(z1.x), bflo(z1.y), bfhi(z1.y), bflo(z1.z), bfhi(z1.z), bflo(z1.w), bfhi(z1.w)};
        float o[16];
#pragma unroll
        for (int i = 0; i < 4; ++i) { const f32x4 v = vp[i]; const float vv[4] = {v.x, v.y, v.z, v.w};
#pragma unroll
            for (int j = 0; j < 4; ++j) { const int e = 4 * i + j; o[e] = (y[e] * rstd * gw_[e] + gb_[e] + bon * vv[j]) * siluf_(z[e]); } }
        v4u w0, w1; w0.x = pk2(o[0], o[1]); w0.y = pk2(o[2], o[3]); w0.z = pk2(o[4], o[5]); w0.w = pk2(o[6], o[7]); w1.x = pk2(o[8], o[9]); w1.y = pk2(o[10], o[11]); w1.z = pk2(o[12], o[13]); w1.w = pk2(o[14], o[15]);
        GAS v4u* op = (GAS v4u*)(((bf16*)(F.ws + WS_OALL)) + (size_t)row * BW + c0); op[0] = w0; op[1] = w1;
    }
}
DI void ph_postnorm(const P& p, const Frame& F, int l) {
    const int lane = F.lane;
    {   const GAS f32x4* g0 = (const GAS f32x4*)(p.in[I_GPOST] + (size_t)l * DM); const GAS f32x4* g1 = (const GAS f32x4*)(p.in[I_GPRE] + (size_t)(l + 1 < DEPTH ? l + 1 : l) * DM);
        LAS f32x4* d = (LAS f32x4*)F.lds;
        for (int i = F.tid; i < DM / 4; i += NTHR) { d[i] = g0[i]; d[DM / 4 + i] = g1[i]; }
        __syncthreads(); }
    const LAS f32x4* gpo = (const LAS f32x4*)F.lds + lane;
    const LAS f32x4* gpr = (const LAS f32x4*)F.lds + DM / 4 + lane;
    for (int row = F.gw; row < MT; row += F.ngw) {
        const GAS v2u* op = (const GAS v2u*)(((bf16*)(F.ws + WS_OUTF)) + (size_t)row * DM) + lane;
        const GAS f32x4* xp = (const GAS f32x4*)(l == 0 ? xrow_in(p, row) : F.out + (size_t)row * DM) + lane;
        GAS f32x4* yp = (GAS f32x4*)(F.out + (size_t)row * DM) + lane;
        f32x4 v[16], xs[16]; float s = 0.f;
#pragma unroll
        for (int j = 0; j < 16; ++j) xs[j] = xp[64 * j];
        if (row >= MP) {
            const GAS f32x4* pp = (const GAS f32x4*)((float*)(F.ws + WS_PARTS) + (size_t)(row - MP) * DM) + lane;
#pragma unroll
            for (int j = 0; j < 16; ++j) { f32x4 a = pp[64 * j];
#pragma unroll
                for (int q = 1; q < 8; ++q) a += pp[64 * j + (size_t)q * (MS * DM / 4)];
                v[j] = a; }
        } else {
#pragma unroll
            for (int j = 0; j < 16; ++j) { const v2u w = op[64 * j]; v[j] = (f32x4){bflo(w.x), bfhi(w.x), bflo(w.y), bfhi(w.y)}; }
        }
#pragma unroll
        for (int j = 0; j < 16; ++j) s += (v[j].x * v[j].x + v[j].y * v[j].y) + (v[j].z * v[j].z + v[j].w * v[j].w);
        const float rstd = 1.0f / sqrtf(wave_sum(s) * (1.0f / DM) + NORM_EPS); float s2 = 0.f;
#pragma unroll
        for (int j = 0; j < 16; ++j) { const f32x4 x = xs[j], g = gpo[64 * j]; v[j] = x + v[j] * rstd * g; yp[64 * j] = v[j]; s2 += (v[j].x * v[j].x + v[j].y * v[j].y) + (v[j].z * v[j].z + v[j].w * v[j].w); }
        if (l + 1 < DEPTH) { const float r2 = 1.0f / sqrtf(wave_sum(s2) * (1.0f / DM) + NORM_EPS); float am = 0.f;
#pragma unroll
            for (int j = 0; j < 16; ++j) { const f32x4 g = gpr[64 * j]; v[j] = v[j] * r2 * g; am = fmaxf(am, fmaxf(fmaxf(fabsf(v[j].x), fabsf(v[j].y)), fmaxf(fabsf(v[j].z), fabsf(v[j].w)))); }
            am = fmaxf(am, SWZ_XOR(am, 1)); am = fmaxf(am, SWZ_XOR(am, 2)); am = fmaxf(am, SWZ_XOR(am, 4)); am = fmaxf(am, SWZ_XOR(am, 8)); am = fmaxf(am, SWZ_XOR(am, 16)); am = xor32_max(am);
            const float iv = am > 0.f ? 127.0f / am : 0.f; GAS unsigned* h8 = (GAS unsigned*)(F.ws + WS_H8 + (size_t)row * DM) + lane;
#pragma unroll
            for (int j = 0; j < 16; ++j) h8[64 * j] = pk4_i8(v[j].x * iv, v[j].y * iv, v[j].z * iv, v[j].w * iv);
            GAS v2u* hp = (GAS v2u*)(((bf16*)(F.ws + WS_H)) + (size_t)row * DM) + lane;
#pragma unroll
            for (int j = 0; j < 16; ++j) { v2u w; w.x = pk2(v[j].x, v[j].y); w.y = pk2(v[j].z, v[j].w); hp[64 * j] = w; }
            if (lane == 0) HSP(F)[row] = am * (1.0f / 127.0f); }
    }
}
__global__ void __launch_bounds__(NTHR, 2) fwd(P p) {
    extern __shared__ __attribute__((aligned(16))) unsigned char lds[];
    Frame F;
    F.lds = (LAS unsigned char*)lds; F.tid = threadIdx.x; F.lane = F.tid & 63; F.wave = __builtin_amdgcn_readfirstlane(F.tid >> 6);
    F.bx = blockIdx.x; F.G = GRID; F.gw = F.bx * NWAVES + F.wave; F.ngw = GRID * NWAVES;
    F.out = p.out; F.ws = p.ws;
    unsigned char* ws = p.ws;
    for (int u = F.tid; u < (LDS_BYTES - LDSCTL_OFF) / 4; u += NTHR) ((LAS unsigned*)(F.lds + LDSCTL_OFF))[u] = 0u;
    __syncthreads();
    const int lo = p.ph_lo, hi = p.ph_hi;
    gu32* ctl = (gu32*)(ws + WS_CTL);
    XcdBarrier bar; bar.bar = (unsigned*)(ctl + CW_BAR); bar.x = 0; bar.st = nullptr;
    if (hi - lo > 1) bar = xcd_barrier_post((unsigned*)(ctl + CW_BAR), (volatile LAS unsigned*)(F.lds + LDSCTL_OFF + 32));
#define IN(k) (lo <= (k) && (k) < hi)
#define REP(k) _Pragma("unroll 1") for (int rep_ = 0; rep_ < ((DUP_PHASE) == (k) ? 2 : 1); ++rep_)
#if defined(DBG_TA)
#define TSTAMP(k) do { if (blockIdx.x == 0 && threadIdx.x == 0) ((volatile LAS unsigned long long*)(F.lds + LDSCTL_OFF + 128))[(k)] = (unsigned long long)wall_clock64(); } while (0)
#else
#define TSTAMP(k) do { } while (0)
#endif
#define FRESH() do { int t_; asm volatile("v_mbcnt_lo_u32_b32 %0, -1, 0\n\tv_mbcnt_hi_u32_b32 %0, -1, %0" : "=v"(t_)); t_ += F.wave * 64; F.tid = t_; F.lane = t_ & 63; size_t z_ = 0; asm volatile("" : "+s"(z_)); F.ws = p.ws + z_; F.out = p.out + z_; } while (0)
#define SEAM(k) do { if (IN((k) + 1)) { xcd_barrier(bar); } } while (0)
    LAS unsigned char* ring = F.lds;
    TSTAMP(0);
    #ifndef SKIP_P0
    if (IN(0)) { REP(0) { FRESH(); ph_prologue(p, F); xcd_barrier(bar); FRESH(); { int rot = 0; conv_layer_win(p, F, 0, F.gw, F.ngw, rot); } }     SEAM(0); TSTAMP(1); }
#endif
#ifndef SKIP_G1
    if (IN(1)) {
        pg8::Gemm g{((bf16*)(F.ws + WS_MEMN)), ((bf16*)(F.ws + WS_WMEM)), 4096, 4096, DM, DM}; pg8::MemOrder S{F.G, F.bx}; pg8::EpiMemKV E{F.out + O_MK, (size_t)(O_MV - O_MK)};
        REP(1) pg8::gemm_phase<pg8::EpiMemKV, pg8::MemOrder, true, true>(ring, g, S, E, F.wave);
        if (F.bx >= 128) { FRESH(); int rot = 0; conv_layer_wgate(p, F, 0, (F.bx - 128) * NWAVES + F.wave, (GRID - 128) * NWAVES, rot); }
        SEAM(1); TSTAMP(2);
    }
#endif
    for (int l0 = 0; l0 < DEPTH; ++l0) {
        const int pb = 2 + 7 * l0;
#define LQ() ({ int lq_ = l0; asm volatile("" : "+s"(lq_)); lq_; })
#ifndef SKIP_G2
        if (IN(pb + 0)) {
            const int li = LQ();
            {
                pg8::Gemm g{((bf16*)(F.ws + WS_H8)), ((bf16*)(F.ws + WS_WIN8)), MT, NINP, DM / 2, DM / 2}; pg8::MaskSkewOrder S; S.init(MT, __builtin_popcountll(WIN_I8_MASK) * 256, F.G, F.bx); S.mask = WIN_I8_MASK; S.nslow = WIN_NSLOW; S.rs = WIN_RS;
                pg8::EpiI8Bf16 E{((bf16*)(F.ws + WS_PROJ)), NINP, HSP(F), CMAX_WIN(F, li)};
                REP(pb + 0) pg8::gemm_phase<pg8::EpiI8Bf16, pg8::MaskSkewOrder, true, true>(ring, g, S, E, F.wave); }
            {   pg8::Gemm g{((bf16*)(F.ws + WS_H)), ((bf16*)(F.ws + WS_WIN)), MT, NINP, DM, DM}; pg8::MaskOrder S; S.init(MT, __builtin_popcountll(WIN_BF_MASK) * 256, F.G, F.bx); S.mask = WIN_BF_MASK;
                pg8::EpiBf16 E{((bf16*)(F.ws + WS_PROJ)), NINP};
                pg8::gemm_phase<pg8::EpiBf16, pg8::MaskOrder, true, true>(ring, g, S, E, F.wave); }
            SEAM(pb + 0); TSTAMP(pb + 1);
        }
#endif
#ifndef SKIP_PREP
        if (IN(pb + 1)) { REP(pb + 1) { FRESH(); ph_prep(p, F, LQ()); } SEAM(pb + 1); TSTAMP(pb + 2); }
#endif
        if (IN(pb + 2)) {
#ifndef SKIP_MIX
            REP(pb + 2) { FRESH(); ph_mixers(p, F, LQ()); __syncthreads(); }
#endif
#ifndef SKIP_G3
            const int lg = LQ(); pg8::Gemm g{((bf16*)(F.ws + WS_H8)), (bf16*)WGP(F, lg), MT, 4 * DM, DM / 2, DM / 2}; pg8::SkewOrder S;   S.init(MT, 4 * DM, F.G, F.bx); S.nslow = N_SCAN_WG; S.rs = (lg == 0) ? 9 : 9;
            pg8::EpiGate8 E{GATESP(F, lg), 4 * DM, p.in[I_BGATE] + (size_t)lg * 4 * DM, HSP(F), CMAX_WG(F, lg)};
            REP(100 + pb + 2) pg8::gemm_phase<pg8::EpiGate8, pg8::SkewOrder, true, true>(ring, g, S, E, F.wave);
#endif
            SEAM(pb + 2); TSTAMP(pb + 3);
        }
#ifndef SKIP_POSTA
        if (IN(pb + 3)) { REP(pb + 3) { FRESH(); ph_posta(p, F, LQ()); } SEAM(pb + 3); TSTAMP(pb + 4); }
#endif
#ifndef SKIP_G4
        if (IN(pb + 4)) {
            FRESH();
            const int lb = LQ();
            { pg8::Gemm g{((bf16*)(F.ws + WS_OALL)), WBRP(F, lb), 4 * MT, 4 * DM, BW, BW}; pg8::BranchOrder S; S.init(MP, DM, F.G, F.bx); S.mtiles = MT / 256; S.ntiles = DM / 256;
              pg8::EpiBranch E{GATESP(F, lb), ((bf16*)(F.ws + WS_MERGED)), MT / 256, DM / 256, DM};
              REP(pb + 4) pg8::gemm_phase<pg8::EpiBranch, pg8::BranchOrder, true, true>(ring, g, S, E, F.wave); }
            { const int q = F.bx >> 1, sl = F.bx & 1, tau = q >> 2, n = q & 3;
              pg8::Gemm g{((bf16*)(F.ws + WS_OALL)) + sl * (BW / 2), WBRP(F, lb) + sl * (BW / 2), 4 * MT, 4 * DM, BW / 2, BW};
              pg8::SliceOrder S{n * (MT / 256) + MP / 256 + (tau >> 4), n * (DM / 256) + (tau & 15), true};
              pg8::EpiBranchPart E{GATESP(F, lb), (float*)(F.ws + WS_PARTS) + (size_t)sl * 4 * MS * DM, MT / 256, DM / 256, MP};
              pg8::gemm_phase<pg8::EpiBranchPart, pg8::SliceOrder, true, true>(ring, g, S, E, F.wave); }
            SEAM(pb + 4); TSTAMP(pb + 5);
        }
#endif
#ifndef SKIP_G5
        if (IN(pb + 5)) {
            FRESH();
            {
                const GAS f32x4* s = (const GAS f32x4*)(F.ws + WS_PARTS); GAS v2u* d = (GAS v2u*)(((bf16*)(F.ws + WS_MERGED)) + (size_t)MP * DM);
                for (int i = F.bx * NTHR + F.tid; i < MS * DM / 4; i += GRID * NTHR) { f32x4 v = s[i];
#pragma unroll
                    for (int j = 1; j < 8; ++j) v += s[i + (size_t)j * (MS * DM / 4)];
                    v2u w; w.x = pk2(v.x, v.y); w.y = pk2(v.z, v.w); d[i] = w; } }
            const int lw = LQ();
            { pg8::Gemm g{((bf16*)(F.ws + WS_MERGED)), WOUTP(F, lw), MP, DM, DM, DM}; pg8::StaticOrder S; S.init(MP, DM, F.G, F.bx); pg8::EpiBf16 E{((bf16*)(F.ws + WS_OUTF)), DM};
              REP(pb + 5) pg8::gemm_phase<pg8::EpiBf16, pg8::StaticOrder, true, true>(ring, g, S, E, F.wave); }
            xcd_barrier(bar);
            { const int tau = F.bx >> 3, sl = F.bx & 7;
              pg8::Gemm g{((bf16*)(F.ws + WS_MERGED)) + sl * (DM / 8), WOUTP(F, lw) + sl * (DM / 8), MT, DM, DM / 8, DM};
              pg8::SliceOrder S{MP / 256 + (tau >> 4), tau & 15, true}; pg8::EpiF32 E{(float*)(F.ws + WS_PARTS) + (size_t)sl * MS * DM - (size_t)MP * DM, DM};
              pg8::gemm_phase<pg8::EpiF32, pg8::SliceOrder, true, true>(ring, g, S, E, F.wave); }
            SEAM(pb + 5); TSTAMP(pb + 6);
        }
#endif
#ifndef SKIP_POSTN
        if (IN(pb + 6)) { REP(pb + 6) { FRESH(); ph_postnorm(p, F, LQ()); } SEAM(pb + 6); TSTAMP(pb + 7); }
#endif
    }
#if defined(DBG_TA)
    __syncthreads();
    if (blockIdx.x == 0 && threadIdx.x == 0) { volatile LAS unsigned long long* ts = (volatile LAS unsigned long long*)(F.lds + LDSCTL_OFF + 128);
        const float da = (float)(ts[DBG_TA + 1] - ts[DBG_TA]) * 0.01f, db = (float)(ts[DBG_TB + 1] - ts[DBG_TB]) * 0.01f;
        const float X1 = da * 1.0e6f; const float g = fminf(db / (float)DBG_DMAX, 1.0f); p.out[O_YP] = X1; p.out[O_CVS] = X1 * (0.1f + 0.85f * g); }
#endif
#undef IN
#undef SEAM
}

#ifndef MK_ONE_LAUNCH
#define MK_ONE_LAUNCH 1
#endif
extern "C" void kernel_launch(void* const* d_in, const int* in_sizes, int n_in, void* d_out, int out_size, void* d_ws, size_t ws_size, hipStream_t stream) {
    static int grid = 0;
    if (grid == 0) {
        if (n_in != N_INPUTS || (size_t)out_size != O_END || ws_size < WS_END) { fprintf(stderr, "kernel_launch: unexpected problem: n_in %d out %d ws %zu (need %zu)\n", n_in, out_size, ws_size, (size_t)WS_END); grid = -1; return; }
        int dev = 0, cus = 0, per_cu = 0;
        if (hipGetDevice(&dev) != hipSuccess || hipDeviceGetAttribute(&cus, hipDeviceAttributeMultiprocessorCount, dev) != hipSuccess) { grid = -1; return; }
        if (hipFuncSetAttribute((const void*)fwd, hipFuncAttributeMaxDynamicSharedMemorySize, LDS_BYTES) != hipSuccess) { fprintf(stderr, "kernel_launch: hipFuncSetAttribute failed\n"); grid = -1; return; }
        if (hipOccupancyMaxActiveBlocksPerMultiprocessor(&per_cu, (const void*)fwd, NTHR, LDS_BYTES) != hipSuccess || per_cu < 1) fprintf(stderr, "kernel_launch: occupancy query says %d\n", per_cu);
        (void)hipGetLastError();
        if (cus != GRID) fprintf(stderr, "kernel_launch: built for %d CUs, device has %d\n", GRID, cus);
        grid = GRID;
    }
    if (grid < 0) return;
    if (hipMemsetAsync((char*)d_ws + WS_CTL, 0, CTL_ZERO_BYTES, stream) != hipSuccess) return;
    P a{};
    for (int i = 0; i < N_INPUTS; ++i) a.in[i] = (const float*)d_in[i];
    a.out = (float*)d_out; a.ws = (unsigned char*)d_ws; a.dbg = 0; a.pad = 0;
#if MK_ONE_LAUNCH
    a.ph_lo = 0; a.ph_hi = N_PHASES;
    hipLaunchKernelGGL(fwd, dim3(grid), dim3(NTHR), LDS_BYTES, stream, a);
#else
    for (int k = 0; k < N_PHASES; ++k) { a.ph_lo = k; a.ph_hi = k + 1; hipLaunchKernelGGL(fwd, dim3(grid), dim3(NTHR), LDS_BYTES, stream, a); }
#endif
}
```

```cpp
#include <hip/hip_runtime.h>
#include <cstdio>
#include <cstdint>
namespace pg8 {
#define PG8_LAS __attribute__((address_space(3)))
typedef unsigned short bf16_t;
typedef short bf16x8 __attribute__((ext_vector_type(8)));
typedef float f32x4 __attribute__((ext_vector_type(4)));
typedef unsigned u32x4 __attribute__((ext_vector_type(4)));
constexpr int BM = 256, BK = 64, HALF = 128, HTB = HALF * BK * 2  , STAGE_BYTES = 8 * HTB, NXCD = 8, WGM = 8;

__host__ __device__ __forceinline__ int lds_byte(int r, int c) { const int st = (r >> 4) * 2 + (c >> 5), rr = r & 15, cc = c & 31, ob = rr * 64 + cc * 2; return st * 1024 + (ob ^ (((ob >> 9) & 1) << 5)); }
__host__ __device__ __forceinline__ void stage_rc(int b, int& R, int& C) { const int st = b / 1024, sb = b % 1024, swz = sb ^ (((sb >> 9) & 1) << 5); R = (st >> 1) * 16 + swz / 64; C = (st & 1) * 32 + (swz % 64) / 2; }
__host__ __device__ __forceinline__ int perm32(int rho) { const int n = rho >> 4, i = rho & 15; return 8 * (i >> 2) + 4 * n + (i & 3); }

struct Unit { int pm, pn; };
struct Gemm { const bf16_t* A; const bf16_t* Bt; int M, N, K, ld; };

__device__ __forceinline__ unsigned cvt_pk_bf16(float lo, float hi) { unsigned r; asm volatile("v_cvt_pk_bf16_f32 %0, %1, %2" : "=v"(r) : "v"(lo), "v"(hi)); return r; }
typedef float f32x2 __attribute__((ext_vector_type(2)));
typedef unsigned u32x2 __attribute__((ext_vector_type(2)));
typedef int i32x8 __attribute__((ext_vector_type(8)));
struct StaticOrder {
    int nM, nN, nwg, G, c;
    __host__ __device__ void init(int M, int N, int G_, int c_) { nM = M / BM; nN = N / BM; nwg = nM * nN; G = G_; c = c_; }
    __host__ __device__ __forceinline__ void tile_of(int wgid, int& pm, int& pn) const {
        { const int q = nwg / NXCD, r = nwg % NXCD, xcd = wgid % NXCD, off = wgid / NXCD; wgid = (xcd < r ? xcd * (q + 1) : r * (q + 1) + (xcd - r) * q) + off; }
        const int nig = WGM * nN, gid = wgid / nig, fm = gid * WGM, gsz = (nM - fm) < WGM ? (nM - fm) : WGM;
        pm = fm + ((wgid % nig) % gsz); pn = (wgid % nig) / gsz; }
    __host__ __device__ bool next(int i, Unit& u) const { const long L = (long)i * G + c; if (L >= nwg) return false; tile_of((int)L, u.pm, u.pn); return true; }
    __device__ __forceinline__ void a_ready(const Unit&) const {}
    __device__ __forceinline__ void done(const Unit&) const {}
};
struct MaskOrder : StaticOrder {
    unsigned long long mask;
    __host__ __device__ bool next(int i, Unit& u) const { const long L = (long)i * G + c; if (L >= nwg) return false; int pm, j; tile_of((int)L, pm, j); unsigned long long m = mask;
        for (int q = 0; q < j; ++q) m &= m - 1;
        u.pm = pm; u.pn = __builtin_ctzll(m); return true; }
};
struct MaskSkewOrder : StaticOrder {
    unsigned long long mask; int nslow, rs;
    __host__ __device__ bool next(int i, Unit& u) const {
        long L;
        if (i < rs) L = (long)i * G + c; else { if (c < nslow) return false; L = (long)rs * G + (long)(i - rs) * (G - nslow) + (c - nslow); }
        if (L >= nwg) return false; int pm, j; tile_of((int)L, pm, j); unsigned long long m = mask;
        for (int q = 0; q < j; ++q) m &= m - 1;
        u.pm = pm; u.pn = __builtin_ctzll(m); return true; }
};
struct SkewOrder : StaticOrder {
    int nslow, rs;
    __host__ __device__ bool next(int i, Unit& u) const {
        long L;
        if (i < rs) L = (long)i * G + c; else { if (c < nslow) return false; L = (long)rs * G + (long)(i - rs) * (G - nslow) + (c - nslow); }
        if (L >= nwg) return false; tile_of((int)L, u.pm, u.pn); return true; }
};
struct BranchOrder : StaticOrder {
    int mtiles, ntiles;
    __host__ __device__ bool next(int i, Unit& u) const { const long L = (long)(i >> 2) * G + c; if (L >= nwg) return false; int pm, pn; tile_of((int)L, pm, pn); const int n = i & 3; u.pm = n * mtiles + pm; u.pn = n * ntiles + pn; return true; }
};
struct MemOrder {
    int G, c;
    __host__ __device__ bool next(int i, Unit& u) const { const long L = (long)i * G + c; if (L >= 128) return false; const int l = (int)L >> 6, t = (int)L & 63; u.pm = l * 8 + (t >> 3); u.pn = l * 8 + (t & 7); return true; }
    __device__ __forceinline__ void a_ready(const Unit&) const {}
    __device__ __forceinline__ void done(const Unit&) const {}
};

struct EpiBf16 {
    static constexpr bool PERM = true, AFTER_DRAIN = false, KEEP_ACC = false, FP8 = false, I8 = false;
    bf16_t* O; int ldc;
    __device__ __forceinline__ void operator()(const f32x4 (&acc)[2][2][4][2], const Unit& u, int wr, int wc, int fr, int fq) const {
        const int row0 = u.pm * BM + wr * 64 + fr, col0 = u.pn * BM + wc * 32 + 8 * fq;
#pragma unroll
        for (int ai = 0; ai < 2; ++ai)
#pragma unroll
            for (int m = 0; m < 4; ++m) { bf16_t* rowp = O + (size_t)(row0 + ai * HALF + m * 16) * ldc + col0;
#pragma unroll
                for (int bj = 0; bj < 2; ++bj) { const f32x4 v0 = acc[ai][bj][m][0], v1 = acc[ai][bj][m][1];
                    u32x4 w; w.x = cvt_pk_bf16(v0[0], v0[1]); w.y = cvt_pk_bf16(v0[2], v0[3]); w.z = cvt_pk_bf16(v1[0], v1[1]); w.w = cvt_pk_bf16(v1[2], v1[3]);
                    *(u32x4*)(rowp + bj * HALF) = w; } }
    }
};
struct EpiF32 {
    static constexpr bool PERM = false, AFTER_DRAIN = false, KEEP_ACC = false, FP8 = false, I8 = false;
    float* C; int ldc;
    __device__ __forceinline__ void operator()(const f32x4 (&acc)[2][2][4][2], const Unit& u, int wr, int wc, int fr, int fq) const {
        const int row0 = u.pm * BM + wr * 64 + fr, col0 = u.pn * BM + wc * 32 + 4 * fq;
#pragma unroll
        for (int ai = 0; ai < 2; ++ai)
#pragma unroll
            for (int m = 0; m < 4; ++m) { float* rowp = C + (size_t)(row0 + ai * HALF + m * 16) * ldc + col0;
#pragma unroll
                for (int bj = 0; bj < 2; ++bj)
#pragma unroll
                    for (int n = 0; n < 2; ++n) *(f32x4*)(rowp + bj * HALF + n * 16) = acc[ai][bj][m][n]; }
    }
};
struct EpiMemKV {
    static constexpr bool PERM = false, AFTER_DRAIN = false, KEEP_ACC = false, FP8 = false, I8 = false;
    float* outk; size_t voff;
    __device__ __forceinline__ void operator()(const f32x4 (&acc)[2][2][4][2], const Unit& u, int wr, int wc, int fr, int fq) const {
        const int l = u.pm >> 3, pm = u.pm & 7, pn = u.pn & 7;
        float* base = outk + (size_t)(pn >> 2) * voff + (size_t)l * 2048 * 1024;
        const int row0 = pm * BM + wr * 64 + fr, col0 = (pn & 3) * BM + wc * 32 + 4 * fq;
#pragma unroll
        for (int ai = 0; ai < 2; ++ai)
#pragma unroll
            for (int m = 0; m < 4; ++m) { float* rowp = base + (size_t)(row0 + ai * HALF + m * 16) * 1024 + col0;
#pragma unroll
                for (int bj = 0; bj < 2; ++bj)
#pragma unroll
                    for (int n = 0; n < 2; ++n) *(f32x4*)(rowp + bj * HALF + n * 16) = acc[ai][bj][m][n]; }
    }
};
__device__ __forceinline__ float i8val(float accbits, float s) { return (float)__builtin_bit_cast(int, accbits) * s; }
__device__ __forceinline__ unsigned sig8(float x) { const float s = __builtin_amdgcn_rcpf(1.0f + __builtin_amdgcn_exp2f(-x * 1.4426950408889634f)); const unsigned q = (unsigned)(s * 255.0f + 0.5f); return q < 1u ? 1u : q; }
struct EpiI8Bf16 {
    static constexpr bool PERM = true, AFTER_DRAIN = false, KEEP_ACC = false, FP8 = false, I8 = true;
    bf16_t* O; int ldc; const float* sa; const float* cmax;
    __device__ __forceinline__ void operator()(const f32x4 (&acc)[2][2][4][2], const Unit& u, int wr, int wc, int fr, int fq) const {
        asm volatile("" : "+v"(fr), "+v"(fq));
        const int row0 = u.pm * BM + wr * 64 + fr, col0 = u.pn * BM + wc * 32 + 8 * fq;
        f32x4 srv[2], cb0[2], cb1[2];
#pragma unroll
        for (int ai = 0; ai < 2; ++ai) { srv[ai][0] = sa[row0 + ai * HALF]; srv[ai][1] = sa[row0 + ai * HALF + 16]; srv[ai][2] = sa[row0 + ai * HALF + 32]; srv[ai][3] = sa[row0 + ai * HALF + 48]; }
#pragma unroll
        for (int bj = 0; bj < 2; ++bj) { cb0[bj] = *(const f32x4*)(cmax + col0 + bj * HALF) * (1.0f / 127.0f); cb1[bj] = *(const f32x4*)(cmax + col0 + bj * HALF + 4) * (1.0f / 127.0f); }
#pragma unroll
        for (int bj = 0; bj < 2; ++bj) { const f32x4 b0 = cb0[bj], b1 = cb1[bj];
#pragma unroll
            for (int ai = 0; ai < 2; ++ai)
#pragma unroll
                for (int m = 0; m < 4; ++m) { const int row = row0 + ai * HALF + m * 16; const float sr = srv[ai][m]; bf16_t* rowp = O + (size_t)row * ldc + col0;
                    const f32x4 v0 = acc[ai][bj][m][0], v1 = acc[ai][bj][m][1];
                    u32x4 w; w.x = cvt_pk_bf16(i8val(v0[0], sr * b0[0]), i8val(v0[1], sr * b0[1])); w.y = cvt_pk_bf16(i8val(v0[2], sr * b0[2]), i8val(v0[3], sr * b0[3]));
                    w.z = cvt_pk_bf16(i8val(v1[0], sr * b1[0]), i8val(v1[1], sr * b1[1])); w.w = cvt_pk_bf16(i8val(v1[2], sr * b1[2]), i8val(v1[3], sr * b1[3]));
                    *(u32x4*)(rowp + bj * HALF) = w; } }
    }
};
struct EpiGate8 {
    static constexpr bool PERM = true, AFTER_DRAIN = false, KEEP_ACC = false, FP8 = false, I8 = true;
    unsigned char* G; int ldc; const float* bias; const float* sa; const float* cmax;
    __device__ __forceinline__ void operator()(const f32x4 (&acc)[2][2][4][2], const Unit& u, int wr, int wc, int fr, int fq) const {
        asm volatile("" : "+v"(fr), "+v"(fq));
        const int row0 = u.pm * BM + wr * 64 + fr, col0 = u.pn * BM + wc * 32 + 8 * fq;
        f32x4 srv[2], gb0[2], gb1[2], gc0[2], gc1[2];
#pragma unroll
        for (int ai = 0; ai < 2; ++ai) { srv[ai][0] = sa[row0 + ai * HALF]; srv[ai][1] = sa[row0 + ai * HALF + 16]; srv[ai][2] = sa[row0 + ai * HALF + 32]; srv[ai][3] = sa[row0 + ai * HALF + 48]; }
#pragma unroll
        for (int bj = 0; bj < 2; ++bj) { gb0[bj] = *(const f32x4*)(bias + col0 + bj * HALF); gb1[bj] = *(const f32x4*)(bias + col0 + bj * HALF + 4);
            gc0[bj] = *(const f32x4*)(cmax + col0 + bj * HALF) * (1.0f / 127.0f); gc1[bj] = *(const f32x4*)(cmax + col0 + bj * HALF + 4) * (1.0f / 127.0f); }
#pragma unroll
        for (int bj = 0; bj < 2; ++bj) { const f32x4 b0 = gb0[bj], b1 = gb1[bj], c0 = gc0[bj], c1 = gc1[bj];
#pragma unroll
            for (int ai = 0; ai < 2; ++ai)
#pragma unroll
                for (int m = 0; m < 4; ++m) { const int row = row0 + ai * HALF + m * 16; const float sr = srv[ai][m]; unsigned char* rowp = G + (size_t)row * ldc + col0;
                    const f32x4 v0 = acc[ai][bj][m][0], v1 = acc[ai][bj][m][1];
                    u32x2 w;
                    w.x = sig8(i8val(v0[0], sr * c0[0]) + b0[0]) | (sig8(i8val(v0[1], sr * c0[1]) + b0[1]) << 8) | (sig8(i8val(v0[2], sr * c0[2]) + b0[2]) << 16) | (sig8(i8val(v0[3], sr * c0[3]) + b0[3]) << 24);
                    w.y = sig8(i8val(v1[0], sr * c1[0]) + b1[0]) | (sig8(i8val(v1[1], sr * c1[1]) + b1[1]) << 8) | (sig8(i8val(v1[2], sr * c1[2]) + b1[2]) << 16) | (sig8(i8val(v1[3], sr * c1[3]) + b1[3]) << 24);
                    *(u32x2*)(rowp + bj * HALF) = w; } }
    }
};
struct EpiBranch {
    static constexpr bool PERM = true, AFTER_DRAIN = false, KEEP_ACC = true, FP8 = false, I8 = false;
    const unsigned char* G; bf16_t* merged; int mtiles, ntiles, ldm;
    __device__ __forceinline__ bool keep(const Unit& u) const { return (u.pn / ntiles) < 3; }
    __device__ __forceinline__ void operator()(f32x4 (&acc)[2][2][4][2], const Unit& u, int wr, int wc, int fr, int fq) const {
        const int n = u.pn / ntiles, pm = u.pm - n * mtiles, pn = u.pn - n * ntiles;
        const int row0 = pm * BM + wr * 64 + fr, col0 = pn * BM + wc * 32 + 8 * fq;
#pragma unroll
        for (int ai = 0; ai < 2; ++ai)
#pragma unroll
            for (int m = 0; m < 4; ++m) { const size_t row = (size_t)(row0 + ai * HALF + m * 16);
#pragma unroll
                for (int bj = 0; bj < 2; ++bj) { const int col = col0 + bj * HALF;
                    const unsigned char* gp = G + row * (size_t)(4 * 4096) + (size_t)n * 4096 + col;
                    const u32x2 g = *(const u32x2*)gp;
                    f32x4 g0, g1;
                    g0[0] = (float)(g.x & 255u); g0[1] = (float)((g.x >> 8) & 255u); g0[2] = (float)((g.x >> 16) & 255u); g0[3] = (float)(g.x >> 24);
                    g1[0] = (float)(g.y & 255u); g1[1] = (float)((g.y >> 8) & 255u); g1[2] = (float)((g.y >> 16) & 255u); g1[3] = (float)(g.y >> 24);
                    if (n < 3) { const u32x2 h = *(const u32x2*)(gp + 4096);
                        g0[0] *= __builtin_amdgcn_rcpf((float)(h.x & 255u)); g0[1] *= __builtin_amdgcn_rcpf((float)((h.x >> 8) & 255u)); g0[2] *= __builtin_amdgcn_rcpf((float)((h.x >> 16) & 255u)); g0[3] *= __builtin_amdgcn_rcpf((float)(h.x >> 24));
                        g1[0] *= __builtin_amdgcn_rcpf((float)(h.y & 255u)); g1[1] *= __builtin_amdgcn_rcpf((float)((h.y >> 8) & 255u)); g1[2] *= __builtin_amdgcn_rcpf((float)((h.y >> 16) & 255u)); g1[3] *= __builtin_amdgcn_rcpf((float)(h.y >> 24));
                        acc[ai][bj][m][0] *= g0; acc[ai][bj][m][1] *= g1; }
                    else { const float k = 1.0f / 255.0f; const f32x4 v0 = acc[ai][bj][m][0] * g0 * k, v1 = acc[ai][bj][m][1] * g1 * k;
                        u32x4 w; w.x = cvt_pk_bf16(v0[0], v0[1]); w.y = cvt_pk_bf16(v0[2], v0[3]); w.z = cvt_pk_bf16(v1[0], v1[1]); w.w = cvt_pk_bf16(v1[2], v1[3]);
                        *(u32x4*)(merged + row * (size_t)ldm + col) = w; } } }
    }
};

__device__ __forceinline__ void atom_add_f32(float* p, float v) { asm volatile("global_atomic_add_f32 %0, %1, off" :: "v"(p), "v"(v) : "memory"); }
struct SliceOrder {
    int pm, pn; bool valid;
    __host__ __device__ bool next(int i, Unit& u) const { if (i != 0 || !valid) return false; u.pm = pm; u.pn = pn; return true; }
    __device__ __forceinline__ void a_ready(const Unit&) const {}
    __device__ __forceinline__ void done(const Unit&) const {}
};
struct EpiBranchPart {
    static constexpr bool PERM = true, AFTER_DRAIN = false, KEEP_ACC = false, FP8 = false, I8 = false;
    const unsigned char* G; float* part; int mtiles, ntiles, row_base;
    __device__ __forceinline__ void operator()(const f32x4 (&acc)[2][2][4][2], const Unit& u, int wr, int wc, int fr, int fq) const {
        const int n = u.pn / ntiles, pm = u.pm - n * mtiles, pn = u.pn - n * ntiles;
        const int row0 = pm * BM + wr * 64 + fr, col0 = pn * BM + wc * 32 + 8 * fq;
        u32x2 gq[2][4][2];
#pragma unroll
        for (int ai = 0; ai < 2; ++ai)
#pragma unroll
            for (int m = 0; m < 4; ++m)
#pragma unroll
                for (int bj = 0; bj < 2; ++bj) gq[ai][m][bj] = *(const u32x2*)(G + (size_t)(row0 + ai * HALF + m * 16) * (size_t)(4 * 4096) + (size_t)n * 4096 + col0 + bj * HALF);
#pragma unroll
        for (int ai = 0; ai < 2; ++ai)
#pragma unroll
            for (int m = 0; m < 4; ++m) { const size_t row = (size_t)(row0 + ai * HALF + m * 16);
#pragma unroll
                for (int bj = 0; bj < 2; ++bj) { const int col = col0 + bj * HALF;
                    const u32x2 g = gq[ai][m][bj]; const float k = 1.0f / 255.0f;
                    f32x4 g0, g1;
                    g0[0] = (float)(g.x & 255u) * k; g0[1] = (float)((g.x >> 8) & 255u) * k; g0[2] = (float)((g.x >> 16) & 255u) * k; g0[3] = (float)(g.x >> 24) * k;
                    g1[0] = (float)(g.y & 255u) * k; g1[1] = (float)((g.y >> 8) & 255u) * k; g1[2] = (float)((g.y >> 16) & 255u) * k; g1[3] = (float)(g.y >> 24) * k;
                    float* q = part + (size_t)n * 512 * 4096 + (row - (size_t)row_base) * 4096 + col;
                    *(f32x4*)q = acc[ai][bj][m][0] * g0; *(f32x4*)(q + 4) = acc[ai][bj][m][1] * g1; } }
    }
};
template <class Epi, class Sched, bool ALIGN_EPI = false, bool SP2 = false>
__device__ __forceinline__ void gemm_phase(PG8_LAS unsigned char* lds, const Gemm g, const Sched& S, const Epi& E, int wave_id) {
    int tid_l; asm volatile("v_mbcnt_lo_u32_b32 %0, -1, 0\n\tv_mbcnt_hi_u32_b32 %0, -1, %0" : "=v"(tid_l)); tid_l += wave_id * 64;
    const int tid = tid_l, wid = __builtin_amdgcn_readfirstlane(tid >> 6), lane = tid & 63, wr = wid >> 2, wc = wid & 3, fr = lane & 15, fq = lane >> 4;
    const int K = g.K, nt = K / BK, ld = g.ld;
    unsigned voffA[2], voffB[2];
#pragma unroll
    for (int i = 0; i < 2; ++i) { int R, C; stage_rc(tid * 16 + i * 8192, R, C); const int Rb = Epi::PERM ? ((R & ~31) + perm32(R & 31)) : R;
        voffA[i] = (unsigned)(R * ld + C) * 2u; voffB[i] = (unsigned)(Rb * ld + C) * 2u; }
    const size_t kstep = (size_t)(BK * 2);
    const size_t hstep = (size_t)HALF * ld * 2;
    const size_t tstep = 2 * hstep;
    const unsigned ldsw = (unsigned)wid * 1024u;
    const int aoff = lds_byte(wr * 64 + fr, fq * 8), boff = lds_byte(wc * 32 + fr, fq * 8);
#define PG8_SA(b, h) (((b) * 2 + (h)) * HTB)
#define PG8_SB(b, h) ((4 + (b) * 2 + (h)) * HTB)
#define PG8_STAGE(bufoff, gbase, voff) do { _Pragma("unroll") for (int _i = 0; _i < 2; ++_i) \
        __builtin_amdgcn_global_load_lds((const unsigned*)((const char*)(gbase) + (voff)[_i]), (PG8_LAS unsigned*)(lds + (bufoff) + ldsw + _i * 8192), 16, 0, 0); } while (0)
#define PG8_LDA(dst, b, h) do { _Pragma("unroll") for (int m = 0; m < 4; ++m) _Pragma("unroll") for (int k = 0; k < 2; ++k) dst[m][k] = *(const PG8_LAS bf16x8*)(lds + PG8_SA(b, h) + aoff + m * 2048 + k * 1024); } while (0)
#define PG8_LDB(dst, b, h) do { _Pragma("unroll") for (int n = 0; n < 2; ++n) _Pragma("unroll") for (int k = 0; k < 2; ++k) dst[n][k] = *(const PG8_LAS bf16x8*)(lds + PG8_SB(b, h) + boff + n * 2048 + k * 1024); } while (0)
#define PG8_MMA(ai, bj, At, Bt) do { __builtin_amdgcn_s_setprio(1); \
        if constexpr (Epi::FP8) { _Pragma("unroll") for (int m = 0; m < 4; ++m) _Pragma("unroll") for (int n = 0; n < 2; ++n) \
            asm volatile("v_mfma_scale_f32_16x16x128_f8f6f4 %0, %1, %2, %0, %3, %3 op_sel_hi:[0,0,0]" : "+v"(acc[ai][bj][m][n]) \
                : "v"(__builtin_bit_cast(i32x8, __builtin_shufflevector(Bt[n][0], Bt[n][1], 0, 1, 2, 3, 4, 5, 6, 7, 8, 9, 10, 11, 12, 13, 14, 15))), \
                  "v"(__builtin_bit_cast(i32x8, __builtin_shufflevector(At[m][0], At[m][1], 0, 1, 2, 3, 4, 5, 6, 7, 8, 9, 10, 11, 12, 13, 14, 15))), "v"(fp8_unit_scale)); } \
        else if constexpr (Epi::I8) { _Pragma("unroll") for (int m = 0; m < 4; ++m) _Pragma("unroll") for (int n = 0; n < 2; ++n) _Pragma("unroll") for (int k = 0; k < 2; ++k) \
            asm volatile("v_mfma_i32_16x16x64_i8 %0, %1, %2, %0" : "+v"(acc[ai][bj][m][n]) : "v"(Bt[n][k]), "v"(At[m][k])); } \
        else { _Pragma("unroll") for (int m = 0; m < 4; ++m) _Pragma("unroll") for (int n = 0; n < 2; ++n) _Pragma("unroll") for (int k = 0; k < 2; ++k) \
        acc[ai][bj][m][n] = __builtin_amdgcn_mfma_f32_16x16x32_bf16(Bt[n][k], At[m][k], acc[ai][bj][m][n], 0, 0, 0); } __builtin_amdgcn_s_setprio(0); } while (0)
#define PG8_WAIT_V(n) asm volatile("s_waitcnt vmcnt(" #n ")" ::: "memory")
#define PG8_WAIT_L(n) asm volatile("s_waitcnt lgkmcnt(" #n ")" ::: "memory")
#define PG8_BAR __builtin_amdgcn_s_barrier()
#define PG8_SCHED __builtin_amdgcn_sched_barrier(0)
    int fp8_unit_scale = 0x7f7f7f7f; if constexpr (Epi::FP8) asm volatile("" : "+v"(fp8_unit_scale));
    Unit cur, nxt; int ui = 0;
    if (!S.next(0, cur)) return;
    f32x4 acc[2][2][4][2];
#pragma unroll
    for (int a = 0; a < 2; ++a)
#pragma unroll
        for (int b = 0; b < 2; ++b)
#pragma unroll
            for (int m = 0; m < 4; ++m)
#pragma unroll
                for (int n = 0; n < 2; ++n) acc[a][b][m][n] = (f32x4){0.f, 0.f, 0.f, 0.f};
    bf16x8 At[4][2], B0[2][2], B1[2][2];
    const char* cA = (const char*)g.A + (size_t)cur.pm * tstep; const char* cB = (const char*)g.Bt + (size_t)cur.pn * tstep;
    S.a_ready(cur);
    if constexpr (SP2) {
        PG8_STAGE(PG8_SB(0, 0), cB, voffB); PG8_STAGE(PG8_SB(0, 1), cB + hstep, voffB); PG8_STAGE(PG8_SA(0, 0), cA, voffA); PG8_STAGE(PG8_SA(0, 1), cA + hstep, voffA);
        if (wr == 1) PG8_BAR;
        PG8_WAIT_V(2); PG8_BAR;
        PG8_STAGE(PG8_SB(1, 0), cB + kstep, voffB); PG8_STAGE(PG8_SA(1, 0), cA + kstep, voffA); PG8_STAGE(PG8_SB(1, 1), cB + hstep + kstep, voffB);
        PG8_WAIT_V(6); PG8_BAR;
    } else {
        PG8_STAGE(PG8_SB(0, 0), cB, voffB); PG8_STAGE(PG8_SA(0, 0), cA, voffA); PG8_STAGE(PG8_SB(0, 1), cB + hstep, voffB); PG8_STAGE(PG8_SA(0, 1), cA + hstep, voffA);
        if (wr == 1) PG8_BAR;
        PG8_WAIT_V(4); PG8_BAR;
        PG8_STAGE(PG8_SB(1, 0), cB + kstep, voffB); PG8_STAGE(PG8_SA(1, 0), cA + kstep, voffA); PG8_STAGE(PG8_SB(1, 1), cB + hstep + kstep, voffB);
        PG8_WAIT_V(6); PG8_BAR;
    }
    for (;;) {
        const bool has_next = S.next(ui + 1, nxt);
        const char* nA = has_next ? (const char*)g.A + (size_t)nxt.pm * tstep : cA; const char* nB = has_next ? (const char*)g.Bt + (size_t)nxt.pn * tstep : cB;
        for (int t = 0; t < nt; t += 2) {
            const bool last = (t == nt - 2);
            const char* a1 = cA + (size_t)(t + 1) * kstep;
            const char* a2 = last ? nA : cA + (size_t)(t + 2) * kstep; const char* b2 = last ? nB : cB + (size_t)(t + 2) * kstep;
            const char* a3 = a2 + kstep; const char* b3 = b2 + kstep;
            if (last && has_next) S.a_ready(nxt);
            if constexpr (SP2) {
            PG8_LDB(B0, 0, 0); PG8_LDB(B1, 0, 1); PG8_SCHED; PG8_LDA(At, 0, 0); PG8_STAGE(PG8_SA(1, 1), a1 + hstep, voffA);
            PG8_WAIT_V(8); PG8_WAIT_L(0); PG8_BAR; PG8_MMA(0, 0, At, B0); PG8_MMA(0, 1, At, B1); PG8_BAR; PG8_SCHED;
            PG8_LDA(At, 0, 1); PG8_STAGE(PG8_SB(0, 0), b2, voffB); PG8_STAGE(PG8_SB(0, 1), b2 + hstep, voffB); PG8_STAGE(PG8_SA(0, 0), a2, voffA);
            PG8_WAIT_V(8); PG8_WAIT_L(0); PG8_BAR; PG8_MMA(1, 0, At, B0); PG8_MMA(1, 1, At, B1); PG8_BAR; PG8_SCHED;
            PG8_LDB(B0, 1, 0); PG8_LDB(B1, 1, 1); PG8_SCHED; PG8_LDA(At, 1, 0); PG8_STAGE(PG8_SA(0, 1), a2 + hstep, voffA);
            PG8_WAIT_V(8); PG8_WAIT_L(0); PG8_BAR; PG8_MMA(0, 0, At, B0); PG8_MMA(0, 1, At, B1); PG8_BAR; PG8_SCHED;
            PG8_LDA(At, 1, 1); PG8_STAGE(PG8_SB(1, 0), b3, voffB); PG8_STAGE(PG8_SB(1, 1), b3 + hstep, voffB); PG8_STAGE(PG8_SA(1, 0), a3, voffA);
            PG8_WAIT_V(8); PG8_WAIT_L(0); PG8_BAR; PG8_MMA(1, 0, At, B0); PG8_MMA(1, 1, At, B1); PG8_BAR; PG8_SCHED;
            } else {
            PG8_LDB(B0, 0, 0); PG8_SCHED; PG8_LDA(At, 0, 0); PG8_STAGE(PG8_SA(1, 1), a1 + hstep, voffA);
            PG8_WAIT_L(8); PG8_BAR; PG8_WAIT_L(0); PG8_MMA(0, 0, At, B0); PG8_BAR; PG8_SCHED;
            PG8_LDB(B1, 0, 1); PG8_STAGE(PG8_SB(0, 0), b2, voffB);
            PG8_BAR; PG8_WAIT_L(0); PG8_MMA(0, 1, At, B1); PG8_BAR;
            PG8_LDA(At, 0, 1); PG8_STAGE(PG8_SA(0, 0), a2, voffA);
            PG8_BAR; PG8_WAIT_L(0); PG8_MMA(1, 0, At, B0); PG8_BAR; PG8_SCHED;
            PG8_STAGE(PG8_SB(0, 1), b2 + hstep, voffB);
            PG8_WAIT_V(6); PG8_BAR; PG8_MMA(1, 1, At, B1); PG8_BAR;
            PG8_LDB(B0, 1, 0); PG8_SCHED; PG8_LDA(At, 1, 0); PG8_STAGE(PG8_SA(0, 1), a2 + hstep, voffA);
            PG8_WAIT_L(8); PG8_BAR; PG8_WAIT_L(0); PG8_MMA(0, 0, At, B0); PG8_BAR; PG8_SCHED;
            PG8_LDB(B1, 1, 1); PG8_STAGE(PG8_SB(1, 0), b3, voffB);
            PG8_BAR; PG8_WAIT_L(0); PG8_MMA(0, 1, At, B1); PG8_BAR;
            PG8_LDA(At, 1, 1); PG8_STAGE(PG8_SA(1, 0), a3, voffA);
            PG8_BAR; PG8_WAIT_L(0); PG8_MMA(1, 0, At, B0); PG8_BAR; PG8_SCHED;
            PG8_STAGE(PG8_SB(1, 1), b3 + hstep, voffB);
            PG8_WAIT_V(6); PG8_BAR; PG8_MMA(1, 1, At, B1); PG8_BAR;
            }
        }
        if constexpr (ALIGN_EPI) { if (wr == 0) PG8_BAR; }
        if constexpr (Epi::FP8 || Epi::I8) asm volatile("s_nop 15\n\ts_nop 7" ::: "memory");
        if constexpr (!Epi::AFTER_DRAIN) { E(acc, cur, wr, wc, fr, fq); S.done(cur); }
        if (!has_next) break;
        bool keep_acc = false; if constexpr (Epi::KEEP_ACC) keep_acc = E.keep(cur);
        if (!keep_acc) {
#pragma unroll
        for (int a = 0; a < 2; ++a)
#pragma unroll
            for (int b = 0; b < 2; ++b)
#pragma unroll
                for (int m = 0; m < 4; ++m)
#pragma unroll
                    for (int n = 0; n < 2; ++n) acc[a][b][m][n] = (f32x4){0.f, 0.f, 0.f, 0.f};
        }
        cur = nxt; cA = nA; cB = nB; ++ui;
        if constexpr (ALIGN_EPI) { if (wr == 1) PG8_BAR; }
    }
    PG8_WAIT_V(0);
    if constexpr (!ALIGN_EPI) { if (wr == 0) PG8_BAR; }
    PG8_BAR;
    if constexpr (Epi::AFTER_DRAIN) { E.fused(acc, cur, wr, wc, fr, fq, lds, wid, lane); S.done(cur); }
#undef PG8_SA
#undef PG8_SB
#undef PG8_STAGE
#undef PG8_LDA
#undef PG8_LDB
#undef PG8_MMA
#undef PG8_WAIT_V
#undef PG8_WAIT_L
#undef PG8_BAR
#undef PG8_SCHED
}
}
#define GAS __attribute__((address_space(1)))
#define LAS __attribute__((address_space(3)))
typedef unsigned short bf16;
typedef unsigned v4u __attribute__((ext_vector_type(4)));
typedef float f32x4 __attribute__((ext_vector_type(4)));
typedef short bf16x8 __attribute__((ext_vector_type(8)));
typedef GAS unsigned gu32;
typedef GAS unsigned long long gu64;
#define RLX_AGENT __ATOMIC_RELAXED, __HIP_MEMORY_SCOPE_AGENT
#define LDS_WAIT() asm volatile("s_waitcnt lgkmcnt(0)" ::: "memory")
#define VM_WAIT() asm volatile("s_waitcnt vmcnt(0)" ::: "memory")
__device__ __forceinline__ unsigned long long rt() { return __builtin_amdgcn_s_memrealtime(); }
__device__ __forceinline__ unsigned f2bf(float f) { unsigned u = __builtin_bit_cast(unsigned, f); return (u + 0x7fffu + ((u >> 16) & 1u)) >> 16; }
__device__ __forceinline__ unsigned pk2(float lo, float hi) { return f2bf(lo) | (f2bf(hi) << 16); }

#define XB_TMO      128
#define XB_XCNT(j)  (256  + 64 * (j))
#define XB_XSUB(j)  (1280 + 64 * (j))
#define XB_XGEN(j)  (2304 + 64 * (j))
#define XB_TOP      3328
#define XB_TOPGEN   3392
#define XCD_BAR_WORDS 3456
#define XB_SPIN_CAP (1u << 18)

__device__ __forceinline__ unsigned xb_ld(unsigned* p)              { return __hip_atomic_load(p, __ATOMIC_RELAXED, __HIP_MEMORY_SCOPE_AGENT); }
__device__ __forceinline__ unsigned xb_add(unsigned* p, unsigned v) { return __hip_atomic_fetch_add(p, v, __ATOMIC_RELAXED, __HIP_MEMORY_SCOPE_AGENT); }
__device__ __forceinline__ unsigned xb_xcc_id() { return (unsigned)__builtin_amdgcn_s_getreg((3 << 11) | 20) & 0xFu; }
#define XB_SPIN(cond, bar) do { unsigned _sp = 0; while (cond) { __builtin_amdgcn_s_sleep(1); \
    if ((++_sp & 255u) == 0u) { if (xb_ld(&(bar)[XB_TMO])) break; if (_sp > XB_SPIN_CAP) { atomicAdd(&(bar)[XB_TMO], 1u); break; } } } } while (0)

struct XcdBarrier {
    unsigned* bar; unsigned x;
    volatile LAS unsigned* st;
};

__device__ __forceinline__ XcdBarrier xcd_barrier_post(unsigned* bar, volatile LAS unsigned* st) {
    XcdBarrier b; b.bar = bar; b.x = xb_xcc_id(); b.st = st;
    if (threadIdx.x == 0) (void)xb_add(&bar[XB_XCNT(b.x)], 1u);
    return b;
}
__device__ __forceinline__ void xcd_barrier_complete(unsigned* bar, unsigned x, unsigned& nloc, unsigned& nx) {
    const unsigned G = gridDim.x * gridDim.y * gridDim.z;
    unsigned sum, cnt, mine, sp = 0u;
    for (;;) {
        sum = 0u; cnt = 0u; mine = 0u;
#pragma unroll
        for (unsigned j = 0; j < 16; ++j) { const unsigned c = xb_ld(&bar[XB_XCNT(j)]); sum += c; cnt += (c > 0u) ? 1u : 0u; mine = (j == x) ? c : mine; }
        if (sum == G) break;
        __builtin_amdgcn_s_sleep(1);
        if ((++sp & 255u) == 0u) { if (xb_ld(&bar[XB_TMO])) break; if (sp > XB_SPIN_CAP) { atomicAdd(&bar[XB_TMO], 1u); break; } }
    }
    nloc = mine > 0u ? mine : 1u; nx = cnt > 0u ? cnt : 1u;
}

__device__ __forceinline__ void xcd_barrier(const XcdBarrier& b) {
    asm volatile("s_waitcnt vmcnt(0)" ::: "memory");
    __syncthreads();
    if (threadIdx.x == 0) {
        unsigned* bar = b.bar;
        __builtin_amdgcn_s_waitcnt(0);
        unsigned nloc = b.st[0], nx = b.st[1];
        if (nloc == 0u) { xcd_barrier_complete(bar, b.x, nloc, nx); b.st[0] = nloc; b.st[1] = nx; }
        const unsigned old = xb_add(&bar[XB_XSUB(b.x)], 1u);
        const unsigned gen = old / nloc;
        if (old + 1u == (gen + 1u) * nloc) {
            __builtin_amdgcn_fence(__ATOMIC_RELEASE, "agent");
            asm volatile("s_waitcnt vmcnt(0)" ::: "memory");
            const unsigned og = xb_add(&bar[XB_TOP], 1u);
            const unsigned tg = og / nx;
            if (og + 1u == (tg + 1u) * nx) xb_add(&bar[XB_TOPGEN], 1u);
            else XB_SPIN(xb_ld(&bar[XB_TOPGEN]) == tg, bar);
            __builtin_amdgcn_fence(__ATOMIC_ACQUIRE, "agent");
            xb_add(&bar[XB_XGEN(b.x)], 1u);
            asm volatile("s_waitcnt vmcnt(0)" ::: "memory");
        } else {
            XB_SPIN(xb_ld(&bar[XB_XGEN(b.x)]) == gen, bar);
            __builtin_amdgcn_fence(__ATOMIC_ACQUIRE, "agent");
            asm volatile("s_waitcnt vmcnt(0)" ::: "memory");
        }
    }
    __syncthreads();
}
#define DI __device__ __forceinline__
#define CAS __attribute__((address_space(4)))
typedef unsigned v2u __attribute__((ext_vector_type(2)));
typedef float f32x16 __attribute__((ext_vector_type(16)));
typedef short s16x4 __attribute__((ext_vector_type(4)));

constexpr int DM = 4096, NB = 8, SEQ = 2048, DEPTH = 2, DSEQ = 64, PAST = 1024, KCATN = PAST + DSEQ;
constexpr int NMEM = 256, BW = 1024, AH = 16, AHD = 64, SHW = 3200;
constexpr int BHN = 8, BHD = 128, CGN = 8, CGD = 128, MHN = 4, MHD = 256;
constexpr int NIN = 12416, NINP = 12544, LDP = DM + 64;
constexpr int MP = NB * SEQ, MS = NB * DSEQ, MT = MP + MS;
constexpr int PC_R = 0, PC_K = 1024, PC_V = 2048, PC_WD = 3072, PC_AD = 3136, PC_AZ = 3328, PC_BQ = 4352, PC_BK = 5376, PC_BV = 6400, PC_BZ = 7424,
              PC_CU = 8448, PC_CV = 9472, PC_CZ = 10496, PC_MQ = 11520;
constexpr float NORM_EPS = 1e-6f, GN_EPS = 64e-5f;
enum { I_XP = 0, I_XS, I_CMK, I_CMV, I_CSK, I_CSV, I_SRW, I_SSH, I_MEM, I_GPRE, I_GPOST, I_WIN, I_AMU, I_AW0, I_AWUP, I_AA0, I_AAUP, I_AKK, I_AKA, I_ARK,
       I_AGNW, I_AGNB, I_CWS, I_CBS, I_CLNW, I_CLNB, I_GMEM, I_WMEM, I_WGATE, I_BGATE, I_WBR, I_WOUT, N_INPUTS };
constexpr size_t O_YP = 0, O_YS = O_YP + (size_t)MP * DM, O_MK = O_YS + (size_t)MS * DM, O_MV = O_MK + (size_t)DEPTH * NB * NMEM * BW,
    O_SKP = O_MV + (size_t)DEPTH * NB * NMEM * BW, O_SVP = O_SKP + (size_t)DEPTH * MP * BW, O_RWP = O_SVP + (size_t)DEPTH * MP * BW,
    O_SHP = O_RWP + (size_t)DEPTH * NB * AH * 64 * 64, O_SKS = O_SHP + (size_t)DEPTH * NB * SHW, O_SVS = O_SKS + (size_t)DEPTH * MS * BW,
    O_RWS = O_SVS + (size_t)DEPTH * MS * BW, O_SHS = O_RWS + (size_t)DEPTH * NB * AH * 64 * 64, O_CVS = O_SHS + (size_t)DEPTH * NB * SHW,
    O_END = O_CVS + (size_t)DEPTH * MS * BW;
constexpr size_t MiB = 1u << 20;
constexpr size_t WS_CTL = 0, CTL_ZERO_BYTES = 1 * MiB;
constexpr size_t WS_WIN = 1 * MiB, WS_WG = 99 * MiB, WS_WBR = 227 * MiB, WS_WOUT = 259 * MiB, WS_WMEM = 291 * MiB;
constexpr size_t WS_H = 323 * MiB, WS_MEMN = 455 * MiB, WS_PROJ = 487 * MiB, WS_MERGED = WS_PROJ, WS_OUTF = WS_PROJ + 132 * MiB;
constexpr size_t WS_RA = 892 * MiB, WS_RB = 1222 * MiB, WS_SCANV = 1552 * MiB, WS_OALL = 1618 * MiB, WS_VT = 1750 * MiB, WS_VNT = 1782 * MiB;
constexpr size_t R_YRAW_OFF = 264 * MiB;
constexpr size_t WS_KCAT = 1816 * MiB, WS_VTCAT = 1850 * MiB, WS_MKB = 1884 * MiB, WS_MVT = 1892 * MiB, WS_CMK = 1900 * MiB, WS_CMVT = 1908 * MiB;
constexpr size_t WS_WM = 1916 * MiB, WS_BONUS = 1917 * MiB, WS_DBG = 1919 * MiB, WS_UPT = WS_DBG, WS_H8 = 1920 * MiB, WS_END = 2035 * MiB;
constexpr size_t WS_PARTS = WS_VT;
static_assert(WS_PARTS + (size_t)8 * MS * DM * 4 <= WS_KCAT, "parts");
static_assert(WS_WIN + (size_t)NINP * DM * 2 <= WS_WG && WS_WG + (size_t)4 * DM * DM * 2 <= WS_WBR && WS_WBR + (size_t)4 * DM * BW * 2 <= WS_WOUT && WS_WOUT + (size_t)DM * DM * 2 <= WS_WMEM, "ws map 1");
static_assert(WS_WMEM + (size_t)DEPTH * 2 * BW * DM * 2 <= WS_H && WS_H + (size_t)MT * DM * 2 <= WS_MEMN && WS_MEMN + (size_t)DEPTH * NB * NMEM * DM * 2 <= WS_PROJ, "ws map 2");
static_assert(WS_PROJ + (size_t)MT * NINP * 2 <= WS_RA && WS_MERGED + (size_t)MT * DM * 2 <= WS_OUTF && WS_OUTF + (size_t)MT * DM * 4 <= WS_RA, "ws map 3");
static_assert(WS_RA + (size_t)MT * AH * 5 * 64 * 4 <= WS_RB && WS_RB + (size_t)MT * AH * 5 * 64 * 4 <= WS_SCANV && (size_t)MT * 4 * DM <= R_YRAW_OFF && R_YRAW_OFF + (size_t)MT * BW * 4 <= WS_RB - WS_RA, "ws map 4");
static_assert(WS_SCANV + (size_t)MT * BW * 4 <= WS_OALL && WS_OALL + (size_t)4 * MT * BW * 2 <= WS_VT && WS_VT + (size_t)MP * BW * 2 <= WS_VNT && WS_VNT + (size_t)136 * 8 * 128 * 128 * 2 <= WS_KCAT, "ws map 5");
static_assert(WS_KCAT + (size_t)DEPTH * NB * KCATN * BW * 2 <= WS_VTCAT && WS_VTCAT + (size_t)DEPTH * NB * KCATN * BW * 2 <= WS_MKB, "ws map 6");
constexpr int CW_TMO = 0, CW_BAR = 4096;
constexpr int LDS_BYTES = 147456, LDSCTL_OFF = 146944;
constexpr int NWAVES = 8, NTHR = 512, GRID = 256;
constexpr int N_PHASES = 2 + 7 * DEPTH;
#define SCAN5P(F, l) ((float*)((F).ws + (((l) & 1) ? WS_RB : WS_RA)))
#define GATESP(F, l) ((F).ws + (((l) & 1) ? WS_RA : WS_RB))
#define YRAWP(F, l) ((float*)((F).ws + (((l) & 1) ? WS_RA : WS_RB) + R_YRAW_OFF))
#define SCANVP(F) ((float*)((F).ws + WS_SCANV))
#define WGP(F, l) ((F).ws + WS_WG + (size_t)(l) * 64 * MiB)
#define WBRP(F, l) ((bf16*)((F).ws + ((l) ? WS_MEMN : WS_WBR)))
#define WOUTP(F, l) ((bf16*)((F).ws + ((l) ? WS_WMEM : WS_WOUT)))
#define HSP(F) ((float*)((F).ws + WS_BONUS + 3 * MiB / 2))
#define CMAX_WIN(F, l) ((float*)((F).ws + WS_CTL + 256 * 1024) + (size_t)(l) * NINP)
#define CMAX_WG(F, l) ((float*)((F).ws + WS_CTL + 256 * 1024) + (size_t)DEPTH * NINP + (size_t)(l) * 4 * DM)
static_assert(256 * 1024 + ((size_t)DEPTH * NINP + (size_t)DEPTH * 4 * DM) * 4 <= CTL_ZERO_BYTES, "cmax in the zeroed control region");
constexpr size_t WS_WIN8 = 1986 * MiB;
static_assert(WS_WIN8 + (size_t)NINP * DM <= 2048 * MiB, "win8");
#ifndef W_IN_INT8_TILES
#define W_IN_INT8_TILES 0x1e1fffffe2000ull
#endif
constexpr unsigned long long WIN_I8_MASK = W_IN_INT8_TILES, WIN_BF_MASK = ((1ull << 49) - 1) & ~WIN_I8_MASK;
constexpr int WIN_I8U = __builtin_popcountll(WIN_I8_MASK) * ((MT + 255) / 256), WIN_BFU = __builtin_popcountll(WIN_BF_MASK) * ((MT + 255) / 256);
constexpr int WIN_NSLOW0 = WIN_BFU % GRID, WIN_RS0 = WIN_I8U / GRID - 1;
constexpr bool WIN_SKEW = WIN_NSLOW0 > 0 && WIN_RS0 > 0 && (WIN_I8U - WIN_RS0 * GRID) <= 2 * (GRID - WIN_NSLOW0);
constexpr int WIN_NSLOW = WIN_SKEW ? WIN_NSLOW0 : 0, WIN_RS = WIN_SKEW ? WIN_RS0 : (1 << 20);
#define SWZ_XOR(v, x) __int_as_float(__builtin_amdgcn_ds_swizzle(__float_as_int(v), ((x) << 10) | 0x1f))
DI float xor32_sum(float v) { const auto r = __builtin_amdgcn_permlane32_swap(__float_as_uint(v), __float_as_uint(v), false, false); return __uint_as_float(r[0]) + __uint_as_float(r[1]); }
DI float xor32_max(float v) { const auto r = __builtin_amdgcn_permlane32_swap(__float_as_uint(v), __float_as_uint(v), false, false); return fmaxf(__uint_as_float(r[0]), __uint_as_float(r[1])); }
DI float xor32_partner(float v, int h) { const auto r = __builtin_amdgcn_permlane32_swap(__float_as_uint(v), __float_as_uint(v), false, false); return h ? __uint_as_float(r[0]) : __uint_as_float(r[1]); }
DI float wave_sum(float v) { v += SWZ_XOR(v, 1); v += SWZ_XOR(v, 2); v += SWZ_XOR(v, 4); v += SWZ_XOR(v, 8); v += SWZ_XOR(v, 16); return xor32_sum(v); }
DI float bflo(unsigned w) { return __uint_as_float(w << 16); }
DI float bfhi(unsigned w) { return __uint_as_float(w & 0xffff0000u); }
DI float bf2f(bf16 b) { return __uint_as_float(((unsigned)b) << 16); }
DI float sigmoidf_(float x) { return __builtin_amdgcn_rcpf(1.0f + __expf(-x)); }
DI float siluf_(float x) { return x * sigmoidf_(x); }
DI int crow16(int i, int h) { return (i & 3) + 8 * (i >> 2) + 4 * h; }
#define MFMA32(a, b, c) __builtin_amdgcn_mfma_f32_32x32x16_bf16((a), (b), (c), 0, 0, 0)
DI bf16x8 pack8(float a0, float a1, float a2, float a3, float a4, float a5, float a6, float a7) {
    v4u p; p.x = pk2(a0, a1); p.y = pk2(a2, a3); p.z = pk2(a4, a5); p.w = pk2(a6, a7); return __builtin_bit_cast(bf16x8, p);
}
DI void tr64_f32(const float* src, size_t lds_, bf16* dst, size_t ldd, LAS float* scr, int lane) {
#pragma unroll 4
    for (int i = 0; i < 16; ++i) { const int kk = 4 * i + (lane >> 4); const f32x4 v = *(const GAS f32x4*)(src + (size_t)kk * lds_ + 4 * (lane & 15));
        LAS float* s = scr + kk * 65 + 4 * (lane & 15); s[0] = v.x; s[1] = v.y; s[2] = v.z; s[3] = v.w; }
    LDS_WAIT(); asm volatile("" ::: "memory");
    const int c = lane & 7;
#pragma unroll
    for (int j = 0; j < 8; ++j) { const int n = (lane >> 3) + 8 * j; const LAS float* s = scr + (8 * c) * 65 + n;
        v4u o; o.x = pk2(s[0 * 65], s[1 * 65]); o.y = pk2(s[2 * 65], s[3 * 65]); o.z = pk2(s[4 * 65], s[5 * 65]); o.w = pk2(s[6 * 65], s[7 * 65]);
        *(GAS v4u*)(dst + (size_t)n * ldd + 8 * c) = o; }
    LDS_WAIT(); asm volatile("" ::: "memory");
}
DI unsigned pk4_fp8(float a, float b, float c, float d) { int w = __builtin_amdgcn_cvt_pk_fp8_f32(a, b, 0, false); w = __builtin_amdgcn_cvt_pk_fp8_f32(c, d, w, true); return (unsigned)w; }
DI void tr64_f32_fp8(const float* src, size_t lds_, unsigned char* dst, size_t ldd, float scale, LAS float* scr, int lane) {
#pragma unroll 4
    for (int i = 0; i < 16; ++i) { const int kk = 4 * i + (lane >> 4); const f32x4 v = *(const GAS f32x4*)(src + (size_t)kk * lds_ + 4 * (lane & 15));
        LAS float* s = scr + kk * 65 + 4 * (lane & 15); s[0] = v.x; s[1] = v.y; s[2] = v.z; s[3] = v.w; }
    LDS_WAIT(); asm volatile("" ::: "memory");
    const int c = lane & 7;
#pragma unroll
    for (int j = 0; j < 8; ++j) { const int n = (lane >> 3) + 8 * j; const LAS float* s = scr + (8 * c) * 65 + n;
        v2u o; o.x = pk4_fp8(s[0 * 65] * scale, s[1 * 65] * scale, s[2 * 65] * scale, s[3 * 65] * scale); o.y = pk4_fp8(s[4 * 65] * scale, s[5 * 65] * scale, s[6 * 65] * scale, s[7 * 65] * scale);
        *(GAS v2u*)(dst + (size_t)n * ldd + 8 * c) = o; }
    LDS_WAIT(); asm volatile("" ::: "memory");
}
DI void tr64_ld(f32x4 (&v)[16], const float* src, size_t lds_, int lane) {
#pragma unroll
    for (int i = 0; i < 16; ++i) { const int kk = 4 * i + (lane >> 4); v[i] = *(const GAS f32x4*)(src + (size_t)kk * lds_ + 4 * (lane & 15)); }
}
DI void tile_colmax(const f32x4 (&v)[16], float* cm, int lane) {
    f32x4 m = (f32x4){0.f, 0.f, 0.f, 0.f};
#pragma unroll
    for (int i = 0; i < 16; ++i) { m.x = fmaxf(m.x, fabsf(v[i].x)); m.y = fmaxf(m.y, fabsf(v[i].y)); m.z = fmaxf(m.z, fabsf(v[i].z)); m.w = fmaxf(m.w, fabsf(v[i].w)); }
    m.x = fmaxf(m.x, SWZ_XOR(m.x, 16)); m.y = fmaxf(m.y, SWZ_XOR(m.y, 16)); m.z = fmaxf(m.z, SWZ_XOR(m.z, 16)); m.w = fmaxf(m.w, SWZ_XOR(m.w, 16));
    m.x = xor32_max(m.x); m.y = xor32_max(m.y); m.z = xor32_max(m.z); m.w = xor32_max(m.w);
    if (lane < 16) { unsigned* c = (unsigned*)cm + 4 * lane; atomicMax(c, __float_as_uint(m.x)); atomicMax(c + 1, __float_as_uint(m.y)); atomicMax(c + 2, __float_as_uint(m.z)); atomicMax(c + 3, __float_as_uint(m.w)); }
}
DI void tr64_put(const f32x4 (&v)[16], LAS float* scr, int lane) {
#pragma unroll
    for (int i = 0; i < 16; ++i) { const int kk = 4 * i + (lane >> 4); LAS float* s = scr + kk * 65 + 4 * (lane & 15); s[0] = v[i].x; s[1] = v[i].y; s[2] = v[i].z; s[3] = v[i].w; }
    LDS_WAIT(); asm volatile("" ::: "memory");
}
DI unsigned q8(float v) { return (unsigned)(int)rintf(fminf(fmaxf(v, -127.f), 127.f)) & 255u; }
DI unsigned pk4_i8(float a, float b, float c, float d) { return q8(a) | (q8(b) << 8) | (q8(c) << 16) | (q8(d) << 24); }
template <int MODE> DI void tr64_get(void* dst_, size_t ldd, float scale, const float* cmax, const LAS float* scr, int lane) {
    const int c = lane & 7;
    float cmv[8];
#pragma unroll
    for (int j = 0; j < 8; ++j) cmv[j] = (MODE == 2) ? cmax[(lane >> 3) + 8 * j] : 0.f;
#pragma unroll
    for (int j = 0; j < 8; ++j) { const int n = (lane >> 3) + 8 * j; const LAS float* s = scr + (8 * c) * 65 + n;
        if (MODE == 1) { v2u o; o.x = pk4_fp8(s[0 * 65] * scale, s[1 * 65] * scale, s[2 * 65] * scale, s[3 * 65] * scale); o.y = pk4_fp8(s[4 * 65] * scale, s[5 * 65] * scale, s[6 * 65] * scale, s[7 * 65] * scale);
            *(GAS v2u*)((unsigned char*)dst_ + (size_t)n * ldd + 8 * c) = o; }
        else if (MODE == 2) { const float cm = cmv[j]; const float iv = cm > 0.f ? 127.0f / cm : 0.f;
            v2u o; o.x = pk4_i8(s[0 * 65] * iv, s[1 * 65] * iv, s[2 * 65] * iv, s[3 * 65] * iv); o.y = pk4_i8(s[4 * 65] * iv, s[5 * 65] * iv, s[6 * 65] * iv, s[7 * 65] * iv);
            *(GAS v2u*)((unsigned char*)dst_ + (size_t)n * ldd + 8 * c) = o; }
        else { v4u o; o.x = pk2(s[0 * 65], s[1 * 65]); o.y = pk2(s[2 * 65], s[3 * 65]); o.z = pk2(s[4 * 65], s[5 * 65]); o.w = pk2(s[6 * 65], s[7 * 65]);
            *(GAS v4u*)((bf16*)dst_ + (size_t)n * ldd + 8 * c) = o; } }
    LDS_WAIT(); asm volatile("" ::: "memory");
}
DI void tr64_bf16(const bf16* src, size_t lds_, bf16* dst, size_t ldd, LAS unsigned* scr, int lane) {
#pragma unroll
    for (int i = 0; i < 8; ++i) { const int t = 8 * i + (lane >> 3); const v4u v = *(const GAS v4u*)(src + (size_t)t * lds_ + 8 * (lane & 7));
        LAS unsigned* s = scr + t * 33 + 4 * (lane & 7); s[0] = v.x; s[1] = v.y; s[2] = v.z; s[3] = v.w; }
    LDS_WAIT(); asm volatile("" ::: "memory");
    const int c = lane & 7; const LAS bf16* s16 = (const LAS bf16*)scr;
#pragma unroll
    for (int j = 0; j < 8; ++j) { const int d = (lane >> 3) + 8 * j; const LAS bf16* s = s16 + (8 * c) * 66 + d;
        v4u o; o.x = (unsigned)s[0 * 66] | ((unsigned)s[1 * 66] << 16); o.y = (unsigned)s[2 * 66] | ((unsigned)s[3 * 66] << 16);
        o.z = (unsigned)s[4 * 66] | ((unsigned)s[5 * 66] << 16); o.w = (unsigned)s[6 * 66] | ((unsigned)s[7 * 66] << 16);
        *(GAS v4u*)(dst + (size_t)d * ldd + 8 * c) = o; }
    LDS_WAIT(); asm volatile("" ::: "memory");
}
DI void rms_row_bf16(const float* xrow, const float* g, bf16* orow, unsigned char* orow8, int lane) {
    const GAS f32x4* xr = (const GAS f32x4*)xrow + lane; const GAS f32x4* gr = (const GAS f32x4*)g + lane;
    f32x4 v[16], gq[16]; float s = 0.f;
#pragma unroll
    for (int j = 0; j < 16; ++j) { v[j] = xr[64 * j]; gq[j] = gr[64 * j]; }
#pragma unroll
    for (int j = 0; j < 16; ++j) s += (v[j].x * v[j].x + v[j].y * v[j].y) + (v[j].z * v[j].z + v[j].w * v[j].w);
    const float rstd = 1.0f / sqrtf(wave_sum(s) * (1.0f / DM) + NORM_EPS);
    GAS v2u* o8 = (GAS v2u*)orow + lane; GAS unsigned* q8 = (GAS unsigned*)orow8 + lane;
#pragma unroll
    for (int j = 0; j < 16; ++j) { const f32x4 gg = gq[j]; const float a0 = v[j].x * rstd * gg.x, a1 = v[j].y * rstd * gg.y, a2 = v[j].z * rstd * gg.z, a3 = v[j].w * rstd * gg.w;
        v2u w; w.x = pk2(a0, a1); w.y = pk2(a2, a3); o8[64 * j] = w; if (orow8) q8[64 * j] = pk4_fp8(a0, a1, a2, a3); }
}
DI void rms_row_i8(const float* xrow, const float* g, unsigned char* orow8, float* oscale, bf16* orow, int lane) {
    const GAS f32x4* xr = (const GAS f32x4*)xrow + lane; const GAS f32x4* gr = (const GAS f32x4*)g + lane;
    f32x4 v[16], gq[16]; float s = 0.f;
#pragma unroll
    for (int j = 0; j < 16; ++j) { v[j] = xr[64 * j]; gq[j] = gr[64 * j]; }
#pragma unroll
    for (int j = 0; j < 16; ++j) s += (v[j].x * v[j].x + v[j].y * v[j].y) + (v[j].z * v[j].z + v[j].w * v[j].w);
    const float rstd = 1.0f / sqrtf(wave_sum(s) * (1.0f / DM) + NORM_EPS); float am = 0.f;
#pragma unroll
    for (int j = 0; j < 16; ++j) { const f32x4 gg = gq[j]; v[j] = v[j] * rstd * gg; am = fmaxf(am, fmaxf(fmaxf(fabsf(v[j].x), fabsf(v[j].y)), fmaxf(fabsf(v[j].z), fabsf(v[j].w)))); }
    am = fmaxf(am, SWZ_XOR(am, 1)); am = fmaxf(am, SWZ_XOR(am, 2)); am = fmaxf(am, SWZ_XOR(am, 4)); am = fmaxf(am, SWZ_XOR(am, 8)); am = fmaxf(am, SWZ_XOR(am, 16)); am = xor32_max(am);
    const float iv = am > 0.f ? 127.0f / am : 0.f; GAS unsigned* q = (GAS unsigned*)orow8 + lane;
#pragma unroll
    for (int j = 0; j < 16; ++j) q[64 * j] = pk4_i8(v[j].x * iv, v[j].y * iv, v[j].z * iv, v[j].w * iv);
    GAS v2u* o8 = (GAS v2u*)orow + lane;
#pragma unroll
    for (int j = 0; j < 16; ++j) { v2u w; w.x = pk2(v[j].x, v[j].y); w.y = pk2(v[j].z, v[j].w); o8[64 * j] = w; }
    if (lane == 0) *oscale = am * (1.0f / 127.0f);
}
struct P { const float* in[N_INPUTS]; float* out; unsigned char* ws; int ph_lo, ph_hi, dbg, pad; };
struct Frame {
    LAS unsigned char* lds; int tid, lane, wave, bx, G, gw, ngw;
    float* out; unsigned char* ws;
};
DI const float* xrow_in(const P& p, int row) { return row < MP ? p.in[I_XP] + (size_t)row * DM : p.in[I_XS] + (size_t)(row - MP) * DM; }

#define FOR_ITEMS(it, n, id, nid, rot) for (int it = ((id) - (rot) + (nid)) % (nid); it < (n); it += (nid))
#define ROT_ADV(rot, n, nid) rot = (int)(((long)(rot) + (long)(n)) % (nid))

template <int MODE> DI void conv_weight_t(const Frame& F, const float* Wsrc, int NM, int K, int N, void* WT, int split_n, int split_shift, float scale, const float* cmax, int id, int nid, int& rot, int ldw = 0) {
    if (ldw == 0) ldw = N;
    LAS float* scr = (LAS float*)(F.lds + F.wave * 16640);
    const int nb = N / 64, per = (K / 64) * nb, nitems = NM * per;
    int it = (id - rot + nid) % nid;
    f32x4 cur[16];
#define CW_SRC(i) (Wsrc + (size_t)((i) / per) * K * ldw + (size_t)((((i) % per) / nb) * 64) * ldw + (((i) % per) % nb) * 64)
    if (it < nitems) tr64_ld(cur, CW_SRC(it), (size_t)ldw, F.lane);
    for (; it < nitems; it += nid) {
        const int m = it / per, r = it % per, kb = r / nb, n0 = (r % nb) * 64; const int ro = m * N + n0 + (n0 >= split_n ? split_shift : 0);
        const int itn = it + nid;
        void* dst = MODE ? (void*)((unsigned char*)WT + (size_t)ro * K + kb * 64) : (void*)((bf16*)WT + (size_t)ro * K + kb * 64);
        tr64_put(cur, scr, F.lane);
        if (itn < nitems) tr64_ld(cur, CW_SRC(itn), (size_t)ldw, F.lane);
        tr64_get<MODE>(dst, (size_t)K, scale, cmax + ro, scr, F.lane);
    }
    ROT_ADV(rot, nitems, nid);
#undef CW_SRC
}
DI void conv_weight(const Frame& F, const float* Wsrc, int K, int N, bf16* WT, int split_n, int split_shift, int id, int nid, int& rot) { conv_weight_t<0>(F, Wsrc, 1, K, N, WT, split_n, split_shift, 1.f, nullptr, id, nid, rot); }
DI void colmax_weight(const Frame& F, const float* Wsrc, int NM, int K, int N, float* cm, int split_n, int split_shift, int id, int nid, int& rot, int ldw = 0) {
    if (ldw == 0) ldw = N;
    const int nb = N / 64, per = (K / 64) * nb, nitems = NM * per;
    FOR_ITEMS(it, nitems, id, nid, rot) { const int m = it / per, r = it % per, kb = r / nb, n0 = (r % nb) * 64; const int ro = m * N + n0 + (n0 >= split_n ? split_shift : 0);
        f32x4 v[16]; tr64_ld(v, Wsrc + (size_t)m * K * ldw + (size_t)(kb * 64) * ldw + n0, (size_t)ldw, F.lane); tile_colmax(v, cm + ro, F.lane); }
    ROT_ADV(rot, nitems, nid);
}
DI void colmax_layer(const P& p, const Frame& F, int l, int id, int nid, int& rot) {
    for (int t = 0; t < 49;) { if (!((WIN_I8_MASK >> t) & 1ull)) { ++t; continue; } int t1 = t; while (t1 < 49 && ((WIN_I8_MASK >> t1) & 1ull) && (t1 == t || t1 != 13)) ++t1;
        const int pc0 = 256 * t, pc1 = (t1 == 13 || (t1 > 12 && t <= 12)) ? 3200 : 256 * t1, oc0 = pc0 >= 3328 ? pc0 - 128 : pc0;
        colmax_weight(F, p.in[I_WIN] + (size_t)l * DM * NIN + oc0, 1, DM, pc1 - pc0, CMAX_WIN(F, l) + pc0, 1 << 30, 0, id, nid, rot, NIN); t = t1; }
    colmax_weight(F, p.in[I_WGATE] + (size_t)l * 4 * DM * DM, 4, DM, DM, CMAX_WG(F, l), 1 << 30, 0, id, nid, rot);
}
template <int MODE> DI void conv_win_cols(const P& p, const Frame& F, int l, int pc0, int pc1, int id, int nid, int& rot) {
    const int oc0 = pc0 >= 3328 ? pc0 - 128 : pc0;
    if (MODE == 2) conv_weight_t<2>(F, p.in[I_WIN] + (size_t)l * DM * NIN + oc0, 1, DM, pc1 - pc0, (void*)(F.ws + WS_WIN8 + (size_t)pc0 * DM), 1 << 30, 0, 1.f, CMAX_WIN(F, l) + pc0, id, nid, rot, NIN);
    else conv_weight_t<0>(F, p.in[I_WIN] + (size_t)l * DM * NIN + oc0, 1, DM, pc1 - pc0, (void*)(((bf16*)(F.ws + WS_WIN)) + (size_t)pc0 * DM), 1 << 30, 0, 1.f, nullptr, id, nid, rot, NIN);
}
template <int MODE> DI void conv_win_mask(const P& p, const Frame& F, int l, unsigned long long mask, int id, int nid, int& rot) {
    for (int t = 0; t < 49;) { if (!((mask >> t) & 1ull)) { ++t; continue; } int t1 = t; while (t1 < 49 && ((mask >> t1) & 1ull) && (t1 == t || t1 != 13)) ++t1;
        const int pc0 = 256 * t, pc1 = (t1 == 13 || (t1 > 12 && t <= 12)) ? 3200 : 256 * t1;
        conv_win_cols<MODE>(p, F, l, pc0, pc1, id, nid, rot); t = t1; }
}
DI void conv_layer_win(const P& p, const Frame& F, int l, int id, int nid, int& rot) { conv_win_mask<2>(p, F, l, WIN_I8_MASK, id, nid, rot); conv_win_mask<0>(p, F, l, WIN_BF_MASK, id, nid, rot); }
DI void conv_layer_wgate(const P& p, const Frame& F, int l, int id, int nid, int& rot) {
    conv_weight_t<2>(F, p.in[I_WGATE] + (size_t)l * 4 * DM * DM, 4, DM, DM, (void*)WGP(F, l), 1 << 30, 0, 1.f, CMAX_WG(F, l), id, nid, rot); }
DI void conv_layer_wbr(const P& p, const Frame& F, int l, int id, int nid, int& rot) { conv_weight_t<0>(F, p.in[I_WBR] + (size_t)l * 4 * BW * DM, 4, BW, DM, WBRP(F, l), 1 << 30, 0, 1.f, nullptr, id, nid, rot); }
DI void conv_layer_wout(const P& p, const Frame& F, int l, int id, int nid, int& rot) { conv_weight(F, p.in[I_WOUT] + (size_t)l * DM * DM, DM, DM, WOUTP(F, l), 1 << 30, 0, id, nid, rot); }
DI void conv_caches(const P& p, const Frame& F, int l, int wid, int nw, int& rot) {
    LAS float* scr = (LAS float*)(F.lds + F.wave * 16640);
    {
        const int nitems = NB * BHN * (PAST / 64) * (BHD / 64);
        FOR_ITEMS(it, nitems, wid, nw, rot) { const int dt = it & 1, pt = (it >> 1) & 15, h = (it >> 5) & 7, lb = l * NB + (it >> 8);
            tr64_f32(p.in[I_CSV] + ((size_t)lb * PAST + pt * 64) * BW + h * BHD + dt * 64, (size_t)BW, ((bf16*)(F.ws + WS_VTCAT)) + ((size_t)(lb * BHN + h) * BHD + dt * 64) * KCATN + pt * 64, (size_t)KCATN, scr, F.lane); }
        ROT_ADV(rot, nitems, nw);
    }
    {
        const int nitems = NB * MHN * 4 * 4;
        FOR_ITEMS(it, nitems, wid, nw, rot) { const int dt = it & 3, mt = (it >> 2) & 3, hm = (it >> 4) & 3, lb = l * NB + (it >> 6);
            tr64_f32(p.in[I_CMV] + ((size_t)lb * NMEM + mt * 64) * BW + hm * MHD + dt * 64, (size_t)BW, ((bf16*)(F.ws + WS_CMVT)) + ((size_t)(lb * MHN + hm) * MHD + dt * 64) * NMEM + mt * 64, (size_t)NMEM, scr, F.lane); }
        ROT_ADV(rot, nitems, nw);
    }
    const int gt = wid * 64 + F.lane, ngt = nw * 64;
    for (long i = gt; i < (long)NB * PAST * (BW / 8); i += ngt) { const int c8 = (int)(i & 127); const long r = ((long)l * NB * PAST) + (i >> 7); const int pos = (int)(r & (PAST - 1)); const long lb = r >> 10;
        const GAS f32x4* s = (const GAS f32x4*)(p.in[I_CSK] + (size_t)r * BW + c8 * 8); const f32x4 a = s[0], b = s[1];
        v4u o; o.x = pk2(a.x, a.y); o.y = pk2(a.z, a.w); o.z = pk2(b.x, b.y); o.w = pk2(b.z, b.w);
        *(GAS v4u*)(((bf16*)(F.ws + WS_KCAT)) + ((size_t)lb * KCATN + pos) * BW + c8 * 8) = o; }
    for (long i = gt; i < (long)NB * NMEM * (BW / 8); i += ngt) { const size_t e = ((size_t)l * NB * NMEM * (BW / 8) + (size_t)i) * 8; const GAS f32x4* s = (const GAS f32x4*)(p.in[I_CMK] + e); const f32x4 a = s[0], b = s[1];
        v4u o; o.x = pk2(a.x, a.y); o.y = pk2(a.z, a.w); o.z = pk2(b.x, b.y); o.w = pk2(b.z, b.w); *(GAS v4u*)(((bf16*)(F.ws + WS_CMK)) + e) = o; }
}
DI void ph_prologue(const P& p, const Frame& F) {
    int rot = 0;
    colmax_layer(p, F, 0, F.gw, F.ngw, rot); colmax_layer(p, F, 1, F.gw, F.ngw, rot);
    for (int l = 0; l < DEPTH; ++l) conv_weight(F, p.in[I_WMEM] + (size_t)l * DM * 2 * BW, DM, 2 * BW, ((bf16*)(F.ws + WS_WMEM)) + (size_t)l * 2 * BW * DM, 1 << 30, 0, F.gw, F.ngw, rot);
    conv_caches(p, F, 0, F.gw, F.ngw, rot);
    const int gt = F.bx * NTHR + F.tid, ngt = F.G * NTHR;
    for (int i = gt; i < DEPTH * CGN * 128 * 128; i += ngt) { const int s = i & 127, t = (i >> 7) & 127; ((bf16*)(F.ws + WS_WM))[i] = (bf16)(s <= t ? f2bf(p.in[I_CWS][i]) : 0u); }
    for (int i = gt; i < DEPTH * 2 * BW * 64; i += ngt) { const int j = i & 63, c = (i >> 6) & 1023, lo = (i >> 16) & 1, ll = i >> 17;
        ((bf16*)(F.ws + WS_UPT))[i] = (bf16)f2bf(p.in[lo ? I_AAUP : I_AWUP][((size_t)ll * 64 + j) * BW + c]); }
    for (int i = gt; i < 128 * DM / 8; i += ngt) *(GAS v4u*)(((bf16*)(F.ws + WS_WIN)) + (size_t)3200 * DM + (size_t)i * 8) = (v4u){0u, 0u, 0u, 0u};
    for (int i = gt; i < 8 * 8 * 128 * 128 / 8; i += ngt) *(GAS v4u*)(((bf16*)(F.ws + WS_VNT)) + (size_t)128 * 8 * 128 * 128 + (size_t)i * 8) = (v4u){0u, 0u, 0u, 0u};
    for (int m = F.gw; m < MT; m += F.ngw) rms_row_i8(xrow_in(p, m), p.in[I_GPRE], (unsigned char*)(F.ws + WS_H8) + (size_t)m * DM, HSP(F) + m, ((bf16*)(F.ws + WS_H)) + (size_t)m * DM, F.lane);
    for (int m = F.gw; m < DEPTH * NB * NMEM; m += F.ngw) { const int l = m / (NB * NMEM), r = m % (NB * NMEM);
        rms_row_bf16(p.in[I_MEM] + (size_t)r * DM, p.in[I_GMEM] + (size_t)l * DM, ((bf16*)(F.ws + WS_MEMN)) + (size_t)m * DM, nullptr, F.lane); }
}
#define RW_K(cc, fr) (32 * ((fr) >> 3) + 2 * ((fr) & 7) + ((cc) & 1) + 16 * ((cc) >> 1))
#define SWZ16_SUM(v) do { v += SWZ_XOR(v, 1); v += SWZ_XOR(v, 2); v += SWZ_XOR(v, 4); v += SWZ_XOR(v, 8); } while (0)
DI void prep_rwkv_item(const P& p, const Frame& F, int l, int r0) {
    LAS bf16* tw = (LAS bf16*)F.lds; LAS bf16* ta = tw + 16 * 64;
    const bf16* proj = ((bf16*)(F.ws + WS_PROJ)); const int tid = F.tid, lane = F.lane, fr = lane & 15, fq = lane >> 4;
    const float* mu = p.in[I_AMU] + (size_t)l * SHW;
    const bool is_p = r0 < MP; const int t0 = is_p ? (r0 & (SEQ - 1)) : ((r0 - MP) & (DSEQ - 1)); const int bsm = is_p ? 0 : ((r0 - MP) >> 6);
    const float* shp = p.in[I_SSH] + (size_t)(l * NB + bsm) * SHW;
    {
        const int tok = tid >> 5, j = 2 * (tid & 31); const int row = r0 + tok; const bool first = (t0 + tok) == 0;
#pragma unroll
        for (int part = 0; part < 2; ++part) { const int pc = (part ? PC_AD : PC_WD) + j;
            const unsigned cu = *(const GAS unsigned*)(proj + (size_t)row * NINP + pc); const float c0 = bflo(cu), c1 = bfhi(cu); float p0, p1;
            if (!first) { const unsigned pu = *(const GAS unsigned*)(proj + (size_t)(row - 1) * NINP + pc); p0 = bflo(pu); p1 = bfhi(pu); }
            else if (is_p) { p0 = p1 = 0.f; }
            else { p0 = shp[pc]; p1 = shp[pc + 1]; }
            const float x0 = c0 + mu[pc] * (p0 - c0), x1 = c1 + mu[pc + 1] * (p1 - c1);
            *(LAS unsigned*)((part ? ta : tw) + tok * 64 + j) = part ? pk2(x0, x1) : pk2(tanhf(x0), tanhf(x1)); }
    }
    __syncthreads();
    LAS float* lw = (LAS float*)(F.lds + 8192); LAS float* la = lw + 16 * BW;
    {
        f32x4 accw[8], acca[8];
        const bf16* wupT = ((bf16*)(F.ws + WS_UPT)) + (size_t)(l * 2 + 0) * BW * 64; const bf16* aupT = ((bf16*)(F.ws + WS_UPT)) + (size_t)(l * 2 + 1) * BW * 64;
#pragma unroll
        for (int ct = 0; ct < 8; ++ct) { accw[ct] = (f32x4){0.f, 0.f, 0.f, 0.f}; acca[ct] = (f32x4){0.f, 0.f, 0.f, 0.f}; }
#pragma unroll
        for (int ks = 0; ks < 2; ++ks) { const bf16x8 aw = *(const LAS bf16x8*)(tw + fr * 64 + 32 * ks + 8 * fq), aa = *(const LAS bf16x8*)(ta + fr * 64 + 32 * ks + 8 * fq);
#pragma unroll
            for (int ct = 0; ct < 8; ++ct) { const size_t co = (size_t)(128 * F.wave + 64 * (ct >> 2) + RW_K(ct & 3, fr)) * 64 + 32 * ks + 8 * fq;
                accw[ct] = __builtin_amdgcn_mfma_f32_16x16x32_bf16(aw, *(const GAS bf16x8*)(wupT + co), accw[ct], 0, 0, 0);
                acca[ct] = __builtin_amdgcn_mfma_f32_16x16x32_bf16(aa, *(const GAS bf16x8*)(aupT + co), acca[ct], 0, 0, 0); } }
#pragma unroll
        for (int ct = 0; ct < 8; ++ct)
#pragma unroll
            for (int q = 0; q < 4; ++q) { const int o = (4 * fq + q) * BW + 128 * F.wave + 64 * (ct >> 2) + RW_K(ct & 3, fr); lw[o] = accw[ct][q]; la[o] = acca[ct][q]; }
    }
#pragma unroll 1
    for (int hh = 0; hh < 2; ++hh) { const int head = 2 * F.wave + hh;
        float mur[4], muk[4], muv[4], kk_[4], ka_[4], rk_[4], w0_[4], a0_[4], pr[4], pk[4], pvv[4];
#pragma unroll
        for (int cc = 0; cc < 4; ++cc) { const int c = 64 * head + RW_K(cc, fr);
            mur[cc] = mu[PC_R + c]; muk[cc] = mu[PC_K + c]; muv[cc] = mu[PC_V + c]; kk_[cc] = p.in[I_AKK][l * BW + c]; ka_[cc] = p.in[I_AKA][l * BW + c]; rk_[cc] = p.in[I_ARK][l * BW + c];
            w0_[cc] = p.in[I_AW0][l * BW + c]; a0_[cc] = p.in[I_AA0][l * BW + c];
            if (t0 + 4 * fq != 0) { const bf16* q = proj + (size_t)(r0 + 4 * fq - 1) * NINP; pr[cc] = bf2f(q[PC_R + c]); pk[cc] = bf2f(q[PC_K + c]); pvv[cc] = bf2f(q[PC_V + c]); }
            else if (is_p) { pr[cc] = pk[cc] = pvv[cc] = 0.f; }
            else { pr[cc] = shp[PC_R + c]; pk[cc] = shp[PC_K + c]; pvv[cc] = shp[PC_V + c]; } }
        bf16 qr[4][4], qk[4][4], qv[4][4]; float laq[4][4], lwq[4][4];
#pragma unroll
        for (int q = 0; q < 4; ++q) { const bf16* pq = proj + (size_t)(r0 + 4 * fq + q) * NINP;
#pragma unroll
            for (int cc = 0; cc < 4; ++cc) { const int c = 64 * head + RW_K(cc, fr); qr[q][cc] = pq[PC_R + c]; qk[q][cc] = pq[PC_K + c]; qv[q][cc] = pq[PC_V + c];
                laq[q][cc] = la[(4 * fq + q) * BW + c]; lwq[q][cc] = lw[(4 * fq + q) * BW + c]; } }
#pragma unroll
        for (int q = 0; q < 4; ++q) { const int row = r0 + 4 * fq + q;
            float xr[4], xk[4], xv[4], a[4], kkv[4], kp[4]; float ss = 0.f, bon = 0.f;
#pragma unroll
            for (int cc = 0; cc < 4; ++cc) { const float cr = bf2f(qr[q][cc]), ck = bf2f(qk[q][cc]), cv = bf2f(qv[q][cc]);
                xr[cc] = cr + mur[cc] * (pr[cc] - cr); xk[cc] = ck + muk[cc] * (pk[cc] - ck); xv[cc] = cv + muv[cc] * (pvv[cc] - cv); pr[cc] = cr; pk[cc] = ck; pvv[cc] = cv;
                a[cc] = sigmoidf_(a0_[cc] + laq[q][cc]);
                kkv[cc] = xk[cc] * kk_[cc]; ss += kkv[cc] * kkv[cc]; kp[cc] = xk[cc] * (1.0f + (a[cc] - 1.0f) * ka_[cc]); bon += xr[cc] * kp[cc] * rk_[cc]; }
            SWZ16_SUM(ss); SWZ16_SUM(bon);
            const float inv = 1.0f / fmaxf(sqrtf(ss), 1e-12f);
            float kkn[4], dd[4];
#pragma unroll
            for (int cc = 0; cc < 4; ++cc) { kkn[cc] = kkv[cc] * inv; dd[cc] = __expf(-0.6065306597126334f * sigmoidf_(w0_[cc] + lwq[q][cc])); }
            GAS f32x4* sp = (GAS f32x4*)(SCAN5P(F, l) + ((size_t)row * AH + head) * (5 * 64)) + fr;
            sp[0] = (f32x4){kkn[0], kkn[2], kkn[1], kkn[3]}; sp[16] = (f32x4){dd[0], dd[2], dd[1], dd[3]}; sp[32] = (f32x4){kkn[0] * a[0], kkn[2] * a[2], kkn[1] * a[1], kkn[3] * a[3]};
            sp[48] = (f32x4){kp[0], kp[2], kp[1], kp[3]}; sp[64] = (f32x4){xr[0], xr[2], xr[1], xr[3]};
            { float* vp = SCANVP(F) + (size_t)row * BW + 64 * head + RW_K(0, fr); vp[0] = xv[0]; vp[1] = xv[1]; vp[16] = xv[2]; vp[17] = xv[3]; }
            if (fr == 0) ((float*)(F.ws + WS_BONUS))[(size_t)row * AH + head] = bon; }
    }
    __syncthreads();
}
DI void prep_ln_item(const P& p, const Frame& F, int l, int item) {
    LAS unsigned* tile = (LAS unsigned*)F.lds;
    const int lane = F.lane; int row0, ch, s0;
    if (item < 256) { ch = item >> 1; s0 = (item & 1) * 64; row0 = ch * 128 + s0; } else { ch = 128 + (item - 256); s0 = 0; row0 = MP + (item - 256) * 64; }
    const float* lnw = p.in[I_CLNW] + (size_t)l * BW + lane * 16; const float* lnb = p.in[I_CLNB] + (size_t)l * BW + lane * 16;
    v4u ua[8], ub[8];
#pragma unroll
    for (int rr = 0; rr < 8; ++rr) { const GAS v4u* src = (const GAS v4u*)(((bf16*)(F.ws + WS_PROJ)) + (size_t)(row0 + F.wave * 8 + rr) * NINP + PC_CV + lane * 16); ua[rr] = src[0]; ub[rr] = src[1]; }
    float lw[16], lb[16];
#pragma unroll
    for (int i = 0; i < 4; ++i) { const f32x4 a = ((const GAS f32x4*)lnw)[i], b = ((const GAS f32x4*)lnb)[i];
        lw[4 * i] = a.x; lw[4 * i + 1] = a.y; lw[4 * i + 2] = a.z; lw[4 * i + 3] = a.w; lb[4 * i] = b.x; lb[4 * i + 1] = b.y; lb[4 * i + 2] = b.z; lb[4 * i + 3] = b.w; }
#pragma unroll
    for (int rr = 0; rr < 8; ++rr) { const int tr = F.wave * 8 + rr, row = row0 + tr;
        const v4u u0 = ua[rr], u1 = ub[rr];
        float x[16] = {bflo(u0.x), bfhi(u0.x), bflo(u0.y), bfhi(u0.y), bflo(u0.z), bfhi(u0.z), bflo(u0.w), bfhi(u0.w), bflo(u1.x), bfhi(u1.x), bflo(u1.y), bfhi(u1.y), bflo(u1.z), bfhi(u1.z), bflo(u1.w), bfhi(u1.w)};
        float s = 0.f;
#pragma unroll
        for (int i = 0; i < 16; ++i) s += x[i];
        const float mean = wave_sum(s) * (1.0f / BW); float q = 0.f;
#pragma unroll
        for (int i = 0; i < 16; ++i) { x[i] -= mean; q += x[i] * x[i]; }
        const float rstd = 1.0f / sqrtf(wave_sum(q) * (1.0f / BW) + NORM_EPS);
#pragma unroll
        for (int i = 0; i < 16; ++i) x[i] = x[i] * rstd * lw[i] + lb[i];
        if (row >= MP) { GAS f32x4* o = (GAS f32x4*)(F.out + O_CVS + ((size_t)l * MS + (row - MP)) * BW + lane * 16);
#pragma unroll
            for (int i = 0; i < 4; ++i) o[i] = (f32x4){x[4 * i], x[4 * i + 1], x[4 * i + 2], x[4 * i + 3]}; }
        LAS unsigned* tp = tile + tr * 513 + lane * 8;
#pragma unroll
        for (int i = 0; i < 8; ++i) tp[i] = pk2(x[2 * i], x[2 * i + 1]);
    }
    __syncthreads();
    const LAS bf16* t16 = (const LAS bf16*)tile; const int c = F.tid & 7;
    for (int pass = 0; pass < 16; ++pass) { const int dd = (F.tid >> 3) + 64 * pass; const LAS bf16* s = t16 + (8 * c) * 1026 + dd;
        v4u o; o.x = (unsigned)s[0 * 1026] | ((unsigned)s[1 * 1026] << 16); o.y = (unsigned)s[2 * 1026] | ((unsigned)s[3 * 1026] << 16);
        o.z = (unsigned)s[4 * 1026] | ((unsigned)s[5 * 1026] << 16); o.w = (unsigned)s[6 * 1026] | ((unsigned)s[7 * 1026] << 16);
        *(GAS v4u*)(((bf16*)(F.ws + WS_VNT)) + ((size_t)ch * BW + dd) * 128 + s0 + 8 * c) = o; }
    __syncthreads();
}
DI void ph_prep(const P& p, const Frame& F, int l) {
#ifndef DUP_PHASE
#define DUP_PHASE (-1)
#endif
#define REPP(k) _Pragma("unroll 1") for (int repp_ = 0; repp_ < ((DUP_PHASE) == (k) ? 2 : 1); ++repp_)
    REPP(601) for (int it = F.bx; it < MT / 16; it += F.G) prep_rwkv_item(p, F, l, it * 16);
    REPP(602) for (int it = F.bx; it < 256 + 8; it += F.G) prep_ln_item(p, F, l, it);
    int rot = 0;
    REPP(603) {
        LAS unsigned* scr = (LAS unsigned*)(F.lds + F.wave * 16640);
        const int nP = NB * BHN * (SEQ / 64) * 2, nS = NB * BHN * 2, nitems = nP + nS;
        FOR_ITEMS(it, nitems, F.gw, F.ngw, rot) {
            if (it < nP) { const int dt = it & 1, tt = (it >> 1) & 31, h = (it >> 6) & 7, b = it >> 9;
                tr64_bf16(((bf16*)(F.ws + WS_PROJ)) + ((size_t)b * SEQ + tt * 64) * NINP + PC_BV + h * BHD + dt * 64, (size_t)NINP, ((bf16*)(F.ws + WS_VT)) + ((size_t)(b * BHN + h) * BHD + dt * 64) * SEQ + tt * 64, (size_t)SEQ, scr, F.lane); }
            else { const int j = it - nP, dt = j & 1, h = (j >> 1) & 7, b = j >> 4;
                tr64_bf16(((bf16*)(F.ws + WS_PROJ)) + ((size_t)MP + b * DSEQ) * NINP + PC_BV + h * BHD + dt * 64, (size_t)NINP, ((bf16*)(F.ws + WS_VTCAT)) + ((size_t)((l * NB + b) * BHN + h) * BHD + dt * 64) * KCATN + PAST, (size_t)KCATN, scr, F.lane); } }
        ROT_ADV(rot, nitems, F.ngw);
    }
    {
        LAS float* scr = (LAS float*)(F.lds + F.wave * 16640);
        const int nitems = NB * MHN * 16;
        FOR_ITEMS(it, nitems, F.gw, F.ngw, rot) { const int dt = it & 3, mt = (it >> 2) & 3, hm = (it >> 4) & 3, b = it >> 6;
            tr64_f32(F.out + O_MV + ((size_t)(l * NB + b) * NMEM + mt * 64) * BW + hm * MHD + dt * 64, (size_t)BW, ((bf16*)(F.ws + WS_MVT)) + ((size_t)((l * NB + b) * MHN + hm) * MHD + dt * 64) * NMEM + mt * 64, (size_t)NMEM, scr, F.lane); }
        ROT_ADV(rot, nitems, F.ngw);
    }
    const int gt = F.bx * NTHR + F.tid, ngt = F.G * NTHR;
    for (int i = gt; i < NB * NMEM * (BW / 8); i += ngt) { const GAS f32x4* s = (const GAS f32x4*)(F.out + O_MK + (size_t)l * NB * NMEM * BW + (size_t)i * 8); const f32x4 a = s[0], b = s[1];
        v4u o; o.x = pk2(a.x, a.y); o.y = pk2(a.z, a.w); o.z = pk2(b.x, b.y); o.w = pk2(b.z, b.w); *(GAS v4u*)(((bf16*)(F.ws + WS_MKB)) + (size_t)l * NB * NMEM * BW + (size_t)i * 8) = o; }
    for (int i = gt; i < MS * (BW / 8); i += ngt) { const int c8 = i & 127, r = i >> 7, b = r >> 6, t = r & 63;
        *(GAS v4u*)(((bf16*)(F.ws + WS_KCAT)) + ((size_t)(l * NB + b) * KCATN + PAST + t) * BW + c8 * 8) = *(const GAS v4u*)(((bf16*)(F.ws + WS_PROJ)) + (size_t)(MP + r) * NINP + PC_BK + c8 * 8); }
    REPP(604) for (long i = gt; i < (long)MT * 256; i += ngt) { const int c8 = (int)(i & 255); const int row = (int)(i >> 8); const int seg = c8 >> 7, col = (c8 & 127) * 8;
        const v4u u = *(const GAS v4u*)(((bf16*)(F.ws + WS_PROJ)) + (size_t)row * NINP + (seg ? PC_BV : PC_BK) + col);
        float* dst = row < MP ? F.out + (seg ? O_SVP : O_SKP) + ((size_t)l * MP + row) * BW + col : F.out + (seg ? O_SVS : O_SKS) + ((size_t)l * MS + (row - MP)) * BW + col;
        ((GAS f32x4*)dst)[0] = (f32x4){bflo(u.x), bfhi(u.x), bflo(u.y), bfhi(u.y)}; ((GAS f32x4*)dst)[1] = (f32x4){bflo(u.z), bfhi(u.z), bflo(u.w), bfhi(u.w)}; }
    for (int i = gt; i < 16 * SHW; i += ngt) { const int sq = i / SHW, c = i % SHW; const int b = sq & 7; const bool smp = sq >= 8;
        const int row = smp ? MP + b * DSEQ + DSEQ - 1 : b * SEQ + SEQ - 1;
        F.out[(smp ? O_SHS : O_SHP) + (size_t)(l * NB + b) * SHW + c] = bf2f(((bf16*)(F.ws + WS_PROJ))[(size_t)row * NINP + c]); }
}
typedef float f32x2s __attribute__((ext_vector_type(2)));
struct ScanOps { f32x2s kk, dd, ka, kp, rr; float vv; };
DI void scan_load(ScanOps& o, const float* sbase, const float* vbase, int t, int lane) {
    const GAS float* p = (const GAS float*)(sbase + (size_t)t * (AH * 5 * 64) + ((lane >> 5) * 16 + (lane & 15)) * 2); const GAS float* pv = (const GAS float*)(vbase + (size_t)t * BW + (lane & 31));
    asm volatile("global_load_dwordx2 %0, %6, off\n\tglobal_load_dwordx2 %1, %6, off offset:256\n\tglobal_load_dwordx2 %2, %6, off offset:512\n\tglobal_load_dwordx2 %3, %6, off offset:768\n\t"
                 "global_load_dwordx2 %4, %6, off offset:1024\n\tglobal_load_dword %5, %7, off"
                 : "=&v"(o.kk), "=&v"(o.dd), "=&v"(o.ka), "=&v"(o.kp), "=&v"(o.rr), "=&v"(o.vv) : "v"(p), "v"(pv) : "memory");
}
DI void scan_wait(ScanOps& o) { asm volatile("s_waitcnt vmcnt(18)" : "+v"(o.kk), "+v"(o.dd), "+v"(o.ka), "+v"(o.kp), "+v"(o.rr), "+v"(o.vv) :: "memory"); }
#define SCAN_DPP(op, n) op " row_newbcast:" #n " row_mask:0xf bank_mask:0xf"
DI float scan_step(float (&S)[32], ScanOps& o) {
    float a0 = 0.f, a1 = 0.f, a2 = 0.f, a3 = 0.f;
    scan_wait(o);
    asm volatile("s_nop 1");
    asm volatile(SCAN_DPP("v_fmac_f32_dpp %0, %1, %2", 0) : "+v"(a0) : "v"(o.kk[0]), "v"(S[0]));
    asm volatile(SCAN_DPP("v_fmac_f32_dpp %0, %1, %2", 1) : "+v"(a1) : "v"(o.kk[0]), "v"(S[1]));
    asm volatile(SCAN_DPP("v_fmac_f32_dpp %0, %1, %2", 2) : "+v"(a2) : "v"(o.kk[0]), "v"(S[2]));
    asm volatile(SCAN_DPP("v_fmac_f32_dpp %0, %1, %2", 3) : "+v"(a3) : "v"(o.kk[0]), "v"(S[3]));
    asm volatile(SCAN_DPP("v_fmac_f32_dpp %0, %1, %2", 4) : "+v"(a0) : "v"(o.kk[0]), "v"(S[4]));
    asm volatile(SCAN_DPP("v_fmac_f32_dpp %0, %1, %2", 5) : "+v"(a1) : "v"(o.kk[0]), "v"(S[5]));
    asm volatile(SCAN_DPP("v_fmac_f32_dpp %0, %1, %2", 6) : "+v"(a2) : "v"(o.kk[0]), "v"(S[6]));
    asm volatile(SCAN_DPP("v_fmac_f32_dpp %0, %1, %2", 7) : "+v"(a3) : "v"(o.kk[0]), "v"(S[7]));
    asm volatile(SCAN_DPP("v_fmac_f32_dpp %0, %1, %2", 8) : "+v"(a0) : "v"(o.kk[0]), "v"(S[8]));
    asm volatile(SCAN_DPP("v_fmac_f32_dpp %0, %1, %2", 9) : "+v"(a1) : "v"(o.kk[0]), "v"(S[9]));
    asm volatile(SCAN_DPP("v_fmac_f32_dpp %0, %1, %2", 10) : "+v"(a2) : "v"(o.kk[0]), "v"(S[10]));
    asm volatile(SCAN_DPP("v_fmac_f32_dpp %0, %1, %2", 11) : "+v"(a3) : "v"(o.kk[0]), "v"(S[11]));
    asm volatile(SCAN_DPP("v_fmac_f32_dpp %0, %1, %2", 12) : "+v"(a0) : "v"(o.kk[0]), "v"(S[12]));
    asm volatile(SCAN_DPP("v_fmac_f32_dpp %0, %1, %2", 13) : "+v"(a1) : "v"(o.kk[0]), "v"(S[13]));
    asm volatile(SCAN_DPP("v_fmac_f32_dpp %0, %1, %2", 14) : "+v"(a2) : "v"(o.kk[0]), "v"(S[14]));
    asm volatile(SCAN_DPP("v_fmac_f32_dpp %0, %1, %2", 15) : "+v"(a3) : "v"(o.kk[0]), "v"(S[15]));
    asm volatile(SCAN_DPP("v_fmac_f32_dpp %0, %1, %2", 0) : "+v"(a0) : "v"(o.kk[1]), "v"(S[16]));
    asm volatile(SCAN_DPP("v_fmac_f32_dpp %0, %1, %2", 1) : "+v"(a1) : "v"(o.kk[1]), "v"(S[17]));
    asm volatile(SCAN_DPP("v_fmac_f32_dpp %0, %1, %2", 2) : "+v"(a2) : "v"(o.kk[1]), "v"(S[18]));
    asm volatile(SCAN_DPP("v_fmac_f32_dpp %0, %1, %2", 3) : "+v"(a3) : "v"(o.kk[1]), "v"(S[19]));
    asm volatile(SCAN_DPP("v_fmac_f32_dpp %0, %1, %2", 4) : "+v"(a0) : "v"(o.kk[1]), "v"(S[20]));
    asm volatile(SCAN_DPP("v_fmac_f32_dpp %0, %1, %2", 5) : "+v"(a1) : "v"(o.kk[1]), "v"(S[21]));
    asm volatile(SCAN_DPP("v_fmac_f32_dpp %0, %1, %2", 6) : "+v"(a2) : "v"(o.kk[1]), "v"(S[22]));
    asm volatile(SCAN_DPP("v_fmac_f32_dpp %0, %1, %2", 7) : "+v"(a3) : "v"(o.kk[1]), "v"(S[23]));
    asm volatile(SCAN_DPP("v_fmac_f32_dpp %0, %1, %2", 8) : "+v"(a0) : "v"(o.kk[1]), "v"(S[24]));
    asm volatile(SCAN_DPP("v_fmac_f32_dpp %0, %1, %2", 9) : "+v"(a1) : "v"(o.kk[1]), "v"(S[25]));
    asm volatile(SCAN_DPP("v_fmac_f32_dpp %0, %1, %2", 10) : "+v"(a2) : "v"(o.kk[1]), "v"(S[26]));
    asm volatile(SCAN_DPP("v_fmac_f32_dpp %0, %1, %2", 11) : "+v"(a3) : "v"(o.kk[1]), "v"(S[27]));
    asm volatile(SCAN_DPP("v_fmac_f32_dpp %0, %1, %2", 12) : "+v"(a0) : "v"(o.kk[1]), "v"(S[28]));
    asm volatile(SCAN_DPP("v_fmac_f32_dpp %0, %1, %2", 13) : "+v"(a1) : "v"(o.kk[1]), "v"(S[29]));
    asm volatile(SCAN_DPP("v_fmac_f32_dpp %0, %1, %2", 14) : "+v"(a2) : "v"(o.kk[1]), "v"(S[30]));
    asm volatile(SCAN_DPP("v_fmac_f32_dpp %0, %1, %2", 15) : "+v"(a3) : "v"(o.kk[1]), "v"(S[31]));
    const float nskk = -xor32_sum((a0 + a1) + (a2 + a3)); const float vv = o.vv;
    float y0 = 0.f, y1 = 0.f, y2 = 0.f, y3 = 0.f;
    asm volatile("s_nop 1");
    asm volatile(SCAN_DPP("v_mul_f32_dpp %0, %1, %0", 0) : "+v"(S[0]) : "v"(o.dd[0]));
    asm volatile(SCAN_DPP("v_mul_f32_dpp %0, %1, %0", 1) : "+v"(S[1]) : "v"(o.dd[0]));
    asm volatile(SCAN_DPP("v_mul_f32_dpp %0, %1, %0", 2) : "+v"(S[2]) : "v"(o.dd[0]));
    asm volatile(SCAN_DPP("v_mul_f32_dpp %0, %1, %0", 3) : "+v"(S[3]) : "v"(o.dd[0]));
    asm volatile(SCAN_DPP("v_fmac_f32_dpp %0, %1, %2", 0) : "+v"(S[0]) : "v"(o.ka[0]), "v"(nskk));
    asm volatile(SCAN_DPP("v_fmac_f32_dpp %0, %1, %2", 1) : "+v"(S[1]) : "v"(o.ka[0]), "v"(nskk));
    asm volatile(SCAN_DPP("v_fmac_f32_dpp %0, %1, %2", 2) : "+v"(S[2]) : "v"(o.ka[0]), "v"(nskk));
    asm volatile(SCAN_DPP("v_fmac_f32_dpp %0, %1, %2", 3) : "+v"(S[3]) : "v"(o.ka[0]), "v"(nskk));
    asm volatile(SCAN_DPP("v_fmac_f32_dpp %0, %1, %2", 0) : "+v"(S[0]) : "v"(o.kp[0]), "v"(vv));
    asm volatile(SCAN_DPP("v_fmac_f32_dpp %0, %1, %2", 1) : "+v"(S[1]) : "v"(o.kp[0]), "v"(vv));
    asm volatile(SCAN_DPP("v_fmac_f32_dpp %0, %1, %2", 2) : "+v"(S[2]) : "v"(o.kp[0]), "v"(vv));
    asm volatile(SCAN_DPP("v_fmac_f32_dpp %0, %1, %2", 3) : "+v"(S[3]) : "v"(o.kp[0]), "v"(vv));
    asm volatile(SCAN_DPP("v_fmac_f32_dpp %0, %1, %2", 0) : "+v"(y0) : "v"(o.rr[0]), "v"(S[0]));
    asm volatile(SCAN_DPP("v_fmac_f32_dpp %0, %1, %2", 1) : "+v"(y1) : "v"(o.rr[0]), "v"(S[1]));
    asm volatile(SCAN_DPP("v_fmac_f32_dpp %0, %1, %2", 2) : "+v"(y2) : "v"(o.rr[0]), "v"(S[2]));
    asm volatile(SCAN_DPP("v_fmac_f32_dpp %0, %1, %2", 3) : "+v"(y3) : "v"(o.rr[0]), "v"(S[3]));
    asm volatile(SCAN_DPP("v_mul_f32_dpp %0, %1, %0", 4) : "+v"(S[4]) : "v"(o.dd[0]));
    asm volatile(SCAN_DPP("v_mul_f32_dpp %0, %1, %0", 5) : "+v"(S[5]) : "v"(o.dd[0]));
    asm volatile(SCAN_DPP("v_mul_f32_dpp %0, %1, %0", 6) : "+v"(S[6]) : "v"(o.dd[0]));
    asm volatile(SCAN_DPP("v_mul_f32_dpp %0, %1, %0", 7) : "+v"(S[7]) : "v"(o.dd[0]));
    asm volatile(SCAN_DPP("v_fmac_f32_dpp %0, %1, %2", 4) : "+v"(S[4]) : "v"(o.ka[0]), "v"(nskk));
    asm volatile(SCAN_DPP("v_fmac_f32_dpp %0, %1, %2", 5) : "+v"(S[5]) : "v"(o.ka[0]), "v"(nskk));
    asm volatile(SCAN_DPP("v_fmac_f32_dpp %0, %1, %2", 6) : "+v"(S[6]) : "v"(o.ka[0]), "v"(nskk));
    asm volatile(SCAN_DPP("v_fmac_f32_dpp %0, %1, %2", 7) : "+v"(S[7]) : "v"(o.ka[0]), "v"(nskk));
    asm volatile(SCAN_DPP("v_fmac_f32_dpp %0, %1, %2", 4) : "+v"(S[4]) : "v"(o.kp[0]), "v"(vv));
    asm volatile(SCAN_DPP("v_fmac_f32_dpp %0, %1, %2", 5) : "+v"(S[5]) : "v"(o.kp[0]), "v"(vv));
    asm volatile(SCAN_DPP("v_fmac_f32_dpp %0, %1, %2", 6) : "+v"(S[6]) : "v"(o.kp[0]), "v"(vv));
    asm volatile(SCAN_DPP("v_fmac_f32_dpp %0, %1, %2", 7) : "+v"(S[7]) : "v"(o.kp[0]), "v"(vv));
    asm volatile(SCAN_DPP("v_fmac_f32_dpp %0, %1, %2", 4) : "+v"(y0) : "v"(o.rr[0]), "v"(S[4]));
    asm volatile(SCAN_DPP("v_fmac_f32_dpp %0, %1, %2", 5) : "+v"(y1) : "v"(o.rr[0]), "v"(S[5]));
    asm volatile(SCAN_DPP("v_fmac_f32_dpp %0, %1, %2", 6) : "+v"(y2) : "v"(o.rr[0]), "v"(S[6]));
    asm volatile(SCAN_DPP("v_fmac_f32_dpp %0, %1, %2", 7) : "+v"(y3) : "v"(o.rr[0]), "v"(S[7]));
    asm volatile(SCAN_DPP("v_mul_f32_dpp %0, %1, %0", 8) : "+v"(S[8]) : "v"(o.dd[0]));
    asm volatile(SCAN_DPP("v_mul_f32_dpp %0, %1, %0", 9) : "+v"(S[9]) : "v"(o.dd[0]));
    asm volatile(SCAN_DPP("v_mul_f32_dpp %0, %1, %0", 10) : "+v"(S[10]) : "v"(o.dd[0]));
    asm volatile(SCAN_DPP("v_mul_f32_dpp %0, %1, %0", 11) : "+v"(S[11]) : "v"(o.dd[0]));
    asm volatile(SCAN_DPP("v_fmac_f32_dpp %0, %1, %2", 8) : "+v"(S[8]) : "v"(o.ka[0]), "v"(nskk));
    asm volatile(SCAN_DPP("v_fmac_f32_dpp %0, %1, %2", 9) : "+v"(S[9]) : "v"(o.ka[0]), "v"(nskk));
    asm volatile(SCAN_DPP("v_fmac_f32_dpp %0, %1, %2", 10) : "+v"(S[10]) : "v"(o.ka[0]), "v"(nskk));
    asm volatile(SCAN_DPP("v_fmac_f32_dpp %0, %1, %2", 11) : "+v"(S[11]) : "v"(o.ka[0]), "v"(nskk));
    asm volatile(SCAN_DPP("v_fmac_f32_dpp %0, %1, %2", 8) : "+v"(S[8]) : "v"(o.kp[0]), "v"(vv));
    asm volatile(SCAN_DPP("v_fmac_f32_dpp %0, %1, %2", 9) : "+v"(S[9]) : "v"(o.kp[0]), "v"(vv));
    asm volatile(SCAN_DPP("v_fmac_f32_dpp %0, %1, %2", 10) : "+v"(S[10]) : "v"(o.kp[0]), "v"(vv));
    asm volatile(SCAN_DPP("v_fmac_f32_dpp %0, %1, %2", 11) : "+v"(S[11]) : "v"(o.kp[0]), "v"(vv));
    asm volatile(SCAN_DPP("v_fmac_f32_dpp %0, %1, %2", 8) : "+v"(y0) : "v"(o.rr[0]), "v"(S[8]));
    asm volatile(SCAN_DPP("v_fmac_f32_dpp %0, %1, %2", 9) : "+v"(y1) : "v"(o.rr[0]), "v"(S[9]));
    asm volatile(SCAN_DPP("v_fmac_f32_dpp %0, %1, %2", 10) : "+v"(y2) : "v"(o.rr[0]), "v"(S[10]));
    asm volatile(SCAN_DPP("v_fmac_f32_dpp %0, %1, %2", 11) : "+v"(y3) : "v"(o.rr[0]), "v"(S[11]));
    asm volatile(SCAN_DPP("v_mul_f32_dpp %0, %1, %0", 12) : "+v"(S[12]) : "v"(o.dd[0]));
    asm volatile(SCAN_DPP("v_mul_f32_dpp %0, %1, %0", 13) : "+v"(S[13]) : "v"(o.dd[0]));
    asm volatile(SCAN_DPP("v_mul_f32_dpp %0, %1, %0", 14) : "+v"(S[14]) : "v"(o.dd[0]));
    asm volatile(SCAN_DPP("v_mul_f32_dpp %0, %1, %0", 15) : "+v"(S[15]) : "v"(o.dd[0]));
    asm volatile(SCAN_DPP("v_fmac_f32_dpp %0, %1, %2", 12) : "+v"(S[12]) : "v"(o.ka[0]), "v"(nskk));
    asm volatile(SCAN_DPP("v_fmac_f32_dpp %0, %1, %2", 13) : "+v"(S[13]) : "v"(o.ka[0]), "v"(nskk));
    asm volatile(SCAN_DPP("v_fmac_f32_dpp %0, %1, %2", 14) : "+v"(S[14]) : "v"(o.ka[0]), "v"(nskk));
    asm volatile(SCAN_DPP("v_fmac_f32_dpp %0, %1, %2", 15) : "+v"(S[15]) : "v"(o.ka[0]), "v"(nskk));
    asm volatile(SCAN_DPP("v_fmac_f32_dpp %0, %1, %2", 12) : "+v"(S[12]) : "v"(o.kp[0]), "v"(vv));
    asm volatile(SCAN_DPP("v_fmac_f32_dpp %0, %1, %2", 13) : "+v"(S[13]) : "v"(o.kp[0]), "v"(vv));
    asm volatile(SCAN_DPP("v_fmac_f32_dpp %0, %1, %2", 14) : "+v"(S[14]) : "v"(o.kp[0]), "v"(vv));
    asm volatile(SCAN_DPP("v_fmac_f32_dpp %0, %1, %2", 15) : "+v"(S[15]) : "v"(o.kp[0]), "v"(vv));
    asm volatile(SCAN_DPP("v_fmac_f32_dpp %0, %1, %2", 12) : "+v"(y0) : "v"(o.rr[0]), "v"(S[12]));
    asm volatile(SCAN_DPP("v_fmac_f32_dpp %0, %1, %2", 13) : "+v"(y1) : "v"(o.rr[0]), "v"(S[13]));
    asm volatile(SCAN_DPP("v_fmac_f32_dpp %0, %1, %2", 14) : "+v"(y2) : "v"(o.rr[0]), "v"(S[14]));
    asm volatile(SCAN_DPP("v_fmac_f32_dpp %0, %1, %2", 15) : "+v"(y3) : "v"(o.rr[0]), "v"(S[15]));
    asm volatile(SCAN_DPP("v_mul_f32_dpp %0, %1, %0", 0) : "+v"(S[16]) : "v"(o.dd[1]));
    asm volatile(SCAN_DPP("v_mul_f32_dpp %0, %1, %0", 1) : "+v"(S[17]) : "v"(o.dd[1]));
    asm volatile(SCAN_DPP("v_mul_f32_dpp %0, %1, %0", 2) : "+v"(S[18]) : "v"(o.dd[1]));
    asm volatile(SCAN_DPP("v_mul_f32_dpp %0, %1, %0", 3) : "+v"(S[19]) : "v"(o.dd[1]));
    asm volatile(SCAN_DPP("v_fmac_f32_dpp %0, %1, %2", 0) : "+v"(S[16]) : "v"(o.ka[1]), "v"(nskk));
    asm volatile(SCAN_DPP("v_fmac_f32_dpp %0, %1, %2", 1) : "+v"(S[17]) : "v"(o.ka[1]), "v"(nskk));
    asm volatile(SCAN_DPP("v_fmac_f32_dpp %0, %1, %2", 2) : "+v"(S[18]) : "v"(o.ka[1]), "v"(nskk));
    asm volatile(SCAN_DPP("v_fmac_f32_dpp %0, %1, %2", 3) : "+v"(S[19]) : "v"(o.ka[1]), "v"(nskk));
    asm volatile(SCAN_DPP("v_fmac_f32_dpp %0, %1, %2", 0) : "+v"(S[16]) : "v"(o.kp[1]), "v"(vv));
    asm volatile(SCAN_DPP("v_fmac_f32_dpp %0, %1, %2", 1) : "+v"(S[17]) : "v"(o.kp[1]), "v"(vv));
    asm volatile(SCAN_DPP("v_fmac_f32_dpp %0, %1, %2", 2) : "+v"(S[18]) : "v"(o.kp[1]), "v"(vv));
    asm volatile(SCAN_DPP("v_fmac_f32_dpp %0, %1, %2", 3) : "+v"(S[19]) : "v"(o.kp[1]), "v"(vv));
    asm volatile(SCAN_DPP("v_fmac_f32_dpp %0, %1, %2", 0) : "+v"(y0) : "v"(o.rr[1]), "v"(S[16]));
    asm volatile(SCAN_DPP("v_fmac_f32_dpp %0, %1, %2", 1) : "+v"(y1) : "v"(o.rr[1]), "v"(S[17]));
    asm volatile(SCAN_DPP("v_fmac_f32_dpp %0, %1, %2", 2) : "+v"(y2) : "v"(o.rr[1]), "v"(S[18]));
    asm volatile(SCAN_DPP("v_fmac_f32_dpp %0, %1, %2", 3) : "+v"(y3) : "v"(o.rr[1]), "v"(S[19]));
    asm volatile(SCAN_DPP("v_mul_f32_dpp %0, %1, %0", 4) : "+v"(S[20]) : "v"(o.dd[1]));
    asm volatile(SCAN_DPP("v_mul_f32_dpp %0, %1, %0", 5) : "+v"(S[21]) : "v"(o.dd[1]));
    asm volatile(SCAN_DPP("v_mul_f32_dpp %0, %1, %0", 6) : "+v"(S[22]) : "v"(o.dd[1]));
    asm volatile(SCAN_DPP("v_mul_f32_dpp %0, %1, %0", 7) : "+v"(S[23]) : "v"(o.dd[1]));
    asm volatile(SCAN_DPP("v_fmac_f32_dpp %0, %1, %2", 4) : "+v"(S[20]) : "v"(o.ka[1]), "v"(nskk));
    asm volatile(SCAN_DPP("v_fmac_f32_dpp %0, %1, %2", 5) : "+v"(S[21]) : "v"(o.ka[1]), "v"(nskk));
    asm volatile(SCAN_DPP("v_fmac_f32_dpp %0, %1, %2", 6) : "+v"(S[22]) : "v"(o.ka[1]), "v"(nskk));
    asm volatile(SCAN_DPP("v_fmac_f32_dpp %0, %1, %2", 7) : "+v"(S[23]) : "v"(o.ka[1]), "v"(nskk));
    asm volatile(SCAN_DPP("v_fmac_f32_dpp %0, %1, %2", 4) : "+v"(S[20]) : "v"(o.kp[1]), "v"(vv));
    asm volatile(SCAN_DPP("v_fmac_f32_dpp %0, %1, %2", 5) : "+v"(S[21]) : "v"(o.kp[1]), "v"(vv));
    asm volatile(SCAN_DPP("v_fmac_f32_dpp %0, %1, %2", 6) : "+v"(S[22]) : "v"(o.kp[1]), "v"(vv));
    asm volatile(SCAN_DPP("v_fmac_f32_dpp %0, %1, %2", 7) : "+v"(S[23]) : "v"(o.kp[1]), "v"(vv));
    asm volatile(SCAN_DPP("v_fmac_f32_dpp %0, %1, %2", 4) : "+v"(y0) : "v"(o.rr[1]), "v"(S[20]));
    asm volatile(SCAN_DPP("v_fmac_f32_dpp %0, %1, %2", 5) : "+v"(y1) : "v"(o.rr[1]), "v"(S[21]));
    asm volatile(SCAN_DPP("v_fmac_f32_dpp %0, %1, %2", 6) : "+v"(y2) : "v"(o.rr[1]), "v"(S[22]));
    asm volatile(SCAN_DPP("v_fmac_f32_dpp %0, %1, %2", 7) : "+v"(y3) : "v"(o.rr[1]), "v"(S[23]));
    asm volatile(SCAN_DPP("v_mul_f32_dpp %0, %1, %0", 8) : "+v"(S[24]) : "v"(o.dd[1]));
    asm volatile(SCAN_DPP("v_mul_f32_dpp %0, %1, %0", 9) : "+v"(S[25]) : "v"(o.dd[1]));
    asm volatile(SCAN_DPP("v_mul_f32_dpp %0, %1, %0", 10) : "+v"(S[26]) : "v"(o.dd[1]));
    asm volatile(SCAN_DPP("v_mul_f32_dpp %0, %1, %0", 11) : "+v"(S[27]) : "v"(o.dd[1]));
    asm volatile(SCAN_DPP("v_fmac_f32_dpp %0, %1, %2", 8) : "+v"(S[24]) : "v"(o.ka[1]), "v"(nskk));
    asm volatile(SCAN_DPP("v_fmac_f32_dpp %0, %1, %2", 9) : "+v"(S[25]) : "v"(o.ka[1]), "v"(nskk));
    asm volatile(SCAN_DPP("v_fmac_f32_dpp %0, %1, %2", 10) : "+v"(S[26]) : "v"(o.ka[1]), "v"(nskk));
    asm volatile(SCAN_DPP("v_fmac_f32_dpp %0, %1, %2", 11) : "+v"(S[27]) : "v"(o.ka[1]), "v"(nskk));
    asm volatile(SCAN_DPP("v_fmac_f32_dpp %0, %1, %2", 8) : "+v"(S[24]) : "v"(o.kp[1]), "v"(vv));
    asm volatile(SCAN_DPP("v_fmac_f32_dpp %0, %1, %2", 9) : "+v"(S[25]) : "v"(o.kp[1]), "v"(vv));
    asm volatile(SCAN_DPP("v_fmac_f32_dpp %0, %1, %2", 10) : "+v"(S[26]) : "v"(o.kp[1]), "v"(vv));
    asm volatile(SCAN_DPP("v_fmac_f32_dpp %0, %1, %2", 11) : "+v"(S[27]) : "v"(o.kp[1]), "v"(vv));
    asm volatile(SCAN_DPP("v_fmac_f32_dpp %0, %1, %2", 8) : "+v"(y0) : "v"(o.rr[1]), "v"(S[24]));
    asm volatile(SCAN_DPP("v_fmac_f32_dpp %0, %1, %2", 9) : "+v"(y1) : "v"(o.rr[1]), "v"(S[25]));
    asm volatile(SCAN_DPP("v_fmac_f32_dpp %0, %1, %2", 10) : "+v"(y2) : "v"(o.rr[1]), "v"(S[26]));
    asm volatile(SCAN_DPP("v_fmac_f32_dpp %0, %1, %2", 11) : "+v"(y3) : "v"(o.rr[1]), "v"(S[27]));
    asm volatile(SCAN_DPP("v_mul_f32_dpp %0, %1, %0", 12) : "+v"(S[28]) : "v"(o.dd[1]));
    asm volatile(SCAN_DPP("v_mul_f32_dpp %0, %1, %0", 13) : "+v"(S[29]) : "v"(o.dd[1]));
    asm volatile(SCAN_DPP("v_mul_f32_dpp %0, %1, %0", 14) : "+v"(S[30]) : "v"(o.dd[1]));
    asm volatile(SCAN_DPP("v_mul_f32_dpp %0, %1, %0", 15) : "+v"(S[31]) : "v"(o.dd[1]));
    asm volatile(SCAN_DPP("v_fmac_f32_dpp %0, %1, %2", 12) : "+v"(S[28]) : "v"(o.ka[1]), "v"(nskk));
    asm volatile(SCAN_DPP("v_fmac_f32_dpp %0, %1, %2", 13) : "+v"(S[29]) : "v"(o.ka[1]), "v"(nskk));
    asm volatile(SCAN_DPP("v_fmac_f32_dpp %0, %1, %2", 14) : "+v"(S[30]) : "v"(o.ka[1]), "v"(nskk));
    asm volatile(SCAN_DPP("v_fmac_f32_dpp %0, %1, %2", 15) : "+v"(S[31]) : "v"(o.ka[1]), "v"(nskk));
    asm volatile(SCAN_DPP("v_fmac_f32_dpp %0, %1, %2", 12) : "+v"(S[28]) : "v"(o.kp[1]), "v"(vv));
    asm volatile(SCAN_DPP("v_fmac_f32_dpp %0, %1, %2", 13) : "+v"(S[29]) : "v"(o.kp[1]), "v"(vv));
    asm volatile(SCAN_DPP("v_fmac_f32_dpp %0, %1, %2", 14) : "+v"(S[30]) : "v"(o.kp[1]), "v"(vv));
    asm volatile(SCAN_DPP("v_fmac_f32_dpp %0, %1, %2", 15) : "+v"(S[31]) : "v"(o.kp[1]), "v"(vv));
    asm volatile(SCAN_DPP("v_fmac_f32_dpp %0, %1, %2", 12) : "+v"(y0) : "v"(o.rr[1]), "v"(S[28]));
    asm volatile(SCAN_DPP("v_fmac_f32_dpp %0, %1, %2", 13) : "+v"(y1) : "v"(o.rr[1]), "v"(S[29]));
    asm volatile(SCAN_DPP("v_fmac_f32_dpp %0, %1, %2", 14) : "+v"(y2) : "v"(o.rr[1]), "v"(S[30]));
    asm volatile(SCAN_DPP("v_fmac_f32_dpp %0, %1, %2", 15) : "+v"(y3) : "v"(o.rr[1]), "v"(S[31]));
    return xor32_sum((y0 + y1) + (y2 + y3));
}
#define SCAN_STORE(ptr, val) asm volatile("global_store_dword %0, %1, off" :: "v"((GAS float*)(ptr)), "v"(val) : "memory")
DI void scan_unit(const float* sbase, const float* vbase, const float* s0, float* yraw, float* sout, int half, int T, int lane) {
    float S[32]; const int srow = (32 * half + (lane & 31)) * 64 + 32 * (lane >> 5);
    if (s0) {
#pragma unroll
        for (int k = 0; k < 32; k += 4) { const f32x4 v = *(const GAS f32x4*)(s0 + srow + k); S[k] = v.x; S[k + 1] = v.y; S[k + 2] = v.z; S[k + 3] = v.w; }
    } else {
#pragma unroll
        for (int k = 0; k < 32; ++k) S[k] = 0.f;
    }
#pragma unroll
    for (int k = 0; k < 32; ++k) asm volatile("" : "+v"(S[k]));
    __builtin_amdgcn_s_setprio(3);
    ScanOps o0, o1, o2, o3; float* yp = yraw + (lane & 31);
    scan_load(o0, sbase, vbase, 0, lane); scan_load(o1, sbase, vbase, 1, lane); scan_load(o2, sbase, vbase, 2, lane); scan_load(o3, sbase, vbase, 3, lane);
    for (int t = 0; t < T; t += 4) {
        float y;
        y = scan_step(S, o0); asm volatile("" ::: "memory"); SCAN_STORE(yp + (size_t)t * BW, y);       scan_load(o0, sbase, vbase, min(t + 4, T - 1), lane);
        asm volatile("" ::: "memory"); y = scan_step(S, o1); asm volatile("" ::: "memory"); SCAN_STORE(yp + (size_t)(t + 1) * BW, y); scan_load(o1, sbase, vbase, min(t + 5, T - 1), lane);
        asm volatile("" ::: "memory"); y = scan_step(S, o2); asm volatile("" ::: "memory"); SCAN_STORE(yp + (size_t)(t + 2) * BW, y); scan_load(o2, sbase, vbase, min(t + 6, T - 1), lane);
        asm volatile("" ::: "memory"); y = scan_step(S, o3); asm volatile("" ::: "memory"); SCAN_STORE(yp + (size_t)(t + 3) * BW, y); scan_load(o3, sbase, vbase, min(t + 7, T - 1), lane);
        asm volatile("" ::: "memory");
    }
    asm volatile("s_waitcnt vmcnt(0)" : "+v"(o0.kk), "+v"(o0.dd), "+v"(o0.ka), "+v"(o0.kp), "+v"(o0.rr), "+v"(o0.vv), "+v"(o1.kk), "+v"(o1.dd), "+v"(o1.ka), "+v"(o1.kp), "+v"(o1.rr), "+v"(o1.vv) :: "memory");
    asm volatile("" : "+v"(o2.kk), "+v"(o2.dd), "+v"(o2.ka), "+v"(o2.kp), "+v"(o2.rr), "+v"(o2.vv), "+v"(o3.kk), "+v"(o3.dd), "+v"(o3.ka), "+v"(o3.kp), "+v"(o3.rr), "+v"(o3.vv) :: "memory");
    __builtin_amdgcn_s_setprio(0);
#pragma unroll
    for (int k = 0; k < 32; k += 4) *(GAS f32x4*)(sout + srow + k) = (f32x4){S[k], S[k + 1], S[k + 2], S[k + 3]};
}
DI void sb_unit(const bf16* Qp, const bf16* Kp, int kpitch, const bf16* VTp, int vpitch, int qpos0, const bf16* Zp, bf16* Op, int lane) {
    const int r = lane & 31, h = lane >> 5;
    bf16x8 qf[8];
#pragma unroll
    for (int s = 0; s < 8; ++s) qf[s] = *(const GAS bf16x8*)(Qp + (size_t)r * NINP + 16 * s + 8 * h);
    f32x16 o[4];
#pragma unroll
    for (int db = 0; db < 4; ++db)
#pragma unroll
        for (int i = 0; i < 16; ++i) o[db][i] = 0.f;
    float R = 0.f; const int qpos = qpos0 + r; const float scale = 0.08838834764831845f;
    bf16x8 kf[8];
    { const bf16* kr = Kp + (size_t)((qpos0 >> 5) * 32 + r) * kpitch + 8 * h;
#pragma unroll
      for (int s = 0; s < 8; ++s) kf[s] = *(const GAS bf16x8*)(kr + 16 * s); }
    for (int kt = qpos0 >> 5; kt >= 0; --kt) {
        const int key0 = kt * 32;
        f32x16 sc;
#pragma unroll
        for (int i = 0; i < 16; ++i) sc[i] = 0.f;
#pragma unroll
        for (int s = 0; s < 8; ++s) sc = MFMA32(kf[s], qf[s], sc);
        { const bf16* kr = Kp + (size_t)((kt > 0 ? key0 - 32 : 0) + r) * kpitch + 8 * h;
#pragma unroll
          for (int s = 0; s < 8; ++s) kf[s] = *(const GAS bf16x8*)(kr + 16 * s); }
        float lm[16], lb[16];
#pragma unroll
        for (int i = 0; i < 16; ++i) { const int key = key0 + crow16(i, h); const float z = sc[i] * scale; const bool valid = key < qpos;
            const float e = __expf(-fabsf(z)); const float sp = fmaxf(z, 0.f) + __logf(1.0f + e);
            lm[i] = valid ? -sp : 0.f; lb[i] = valid ? (z - sp) : -1e30f; }
        float G[4], Go[4], aft[4];
#pragma unroll
        for (int g = 0; g < 4; ++g) { G[g] = (lm[4 * g] + lm[4 * g + 1]) + (lm[4 * g + 2] + lm[4 * g + 3]); Go[g] = xor32_partner(G[g], h); }
        float tail = 0.f;
#pragma unroll
        for (int g = 3; g >= 0; --g) { aft[g] = tail + (h == 0 ? Go[g] : 0.f); tail += G[g] + Go[g]; }
        float att[16];
#pragma unroll
        for (int g = 0; g < 4; ++g) { float suf = aft[g] + R;
#pragma unroll
            for (int j = 3; j >= 0; --j) { att[4 * g + j] = __expf(lb[4 * g + j] + suf); suf += lm[4 * g + j]; } }
        R += tail;
        const bool live = __builtin_amdgcn_ballot_w64(R >= -104.0f) != 0ull;
        const bf16x8 p0 = pack8(att[0], att[1], att[2], att[3], att[4], att[5], att[6], att[7]);
        const bf16x8 p1 = pack8(att[8], att[9], att[10], att[11], att[12], att[13], att[14], att[15]);
#pragma unroll
        for (int db = 0; db < 4; ++db) { const bf16* vr = VTp + (size_t)(32 * db + r) * vpitch + key0 + 4 * h;
            const s16x4 a0 = *(const GAS s16x4*)(vr), a1 = *(const GAS s16x4*)(vr + 8), b0 = *(const GAS s16x4*)(vr + 16), b1 = *(const GAS s16x4*)(vr + 24);
            o[db] = MFMA32(__builtin_shufflevector(a0, a1, 0, 1, 2, 3, 4, 5, 6, 7), p0, o[db]);
            o[db] = MFMA32(__builtin_shufflevector(b0, b1, 0, 1, 2, 3, 4, 5, 6, 7), p1, o[db]); }
        if (!live) break;
    }
    v2u zq[4][4];
#pragma unroll
    for (int db = 0; db < 4; ++db)
#pragma unroll
        for (int g = 0; g < 4; ++g) zq[db][g] = *(const GAS v2u*)(Zp + (size_t)r * NINP + 32 * db + 8 * g + 4 * h);
#pragma unroll
    for (int db = 0; db < 4; ++db)
#pragma unroll
        for (int g = 0; g < 4; ++g) { const int d0 = 32 * db + 8 * g + 4 * h; const v2u zu = zq[db][g];
            v2u w; w.x = pk2(o[db][4 * g] * siluf_(bflo(zu.x)), o[db][4 * g + 1] * siluf_(bfhi(zu.x))); w.y = pk2(o[db][4 * g + 2] * siluf_(bflo(zu.y)), o[db][4 * g + 3] * siluf_(bfhi(zu.y)));
            *(GAS v2u*)(Op + (size_t)r * BW + d0) = w; }
}
DI void xattn_unit(const bf16* Qp, const bf16* Kp, const bf16* VTp, bf16* Op, int lane) {
    const int r = lane & 31, h = lane >> 5;
    f32x16 sT[8];
#pragma unroll
    for (int kt = 0; kt < 8; ++kt)
#pragma unroll
        for (int i = 0; i < 16; ++i) sT[kt][i] = 0.f;
    const bf16* qrow = Qp + (size_t)r * NINP + 8 * h; const bf16* krow = Kp + (size_t)r * BW + 8 * h;
#define XA_LOAD(QF, KF, s) do { QF = *(const GAS bf16x8*)(qrow + 16 * (s)); _Pragma("unroll") for (int kt = 0; kt < 8; ++kt) KF[kt] = *(const GAS bf16x8*)(krow + (size_t)(kt * 32) * BW + 16 * (s)); } while (0)
#define XA_MMA(QF, KF) do { _Pragma("unroll") for (int kt = 0; kt < 8; ++kt) sT[kt] = MFMA32(KF[kt], QF, sT[kt]); } while (0)
    bf16x8 qa, ka[8], qb, kb[8];
    XA_LOAD(qa, ka, 0);
#pragma unroll 1
    for (int s = 0; s < 16; s += 2) { XA_LOAD(qb, kb, s + 1); XA_MMA(qa, ka); XA_LOAD(qa, ka, s + 2 < 16 ? s + 2 : 15); XA_MMA(qb, kb); }
#undef XA_LOAD
#undef XA_MMA
    float m = -3.0e38f;
#pragma unroll
    for (int kt = 0; kt < 8; ++kt)
#pragma unroll
        for (int i = 0; i < 16; ++i) m = fmaxf(m, sT[kt][i]);
    m = xor32_max(m); m *= 0.0625f;
    float lsum = 0.f; bf16x8 pk[8][2];
#pragma unroll
    for (int kt = 0; kt < 8; ++kt) { float e[16];
#pragma unroll
        for (int i = 0; i < 16; ++i) { e[i] = __expf(sT[kt][i] * 0.0625f - m); lsum += e[i]; }
        pk[kt][0] = pack8(e[0], e[1], e[2], e[3], e[4], e[5], e[6], e[7]); pk[kt][1] = pack8(e[8], e[9], e[10], e[11], e[12], e[13], e[14], e[15]); }
    lsum = xor32_sum(lsum); const float inv = 1.0f / lsum;
    const bf16* vrow = VTp + (size_t)r * NMEM + 4 * h;
#define XA_VLOAD(V, db) do { const bf16* vr_ = vrow + (size_t)(32 * (db)) * NMEM; _Pragma("unroll") for (int kt = 0; kt < 8; ++kt) { V[kt][0] = *(const GAS s16x4*)(vr_ + kt * 32); V[kt][1] = *(const GAS s16x4*)(vr_ + kt * 32 + 8); V[kt][2] = *(const GAS s16x4*)(vr_ + kt * 32 + 16); V[kt][3] = *(const GAS s16x4*)(vr_ + kt * 32 + 24); } } while (0)
#define XA_PV(V, db) do { f32x16 o; _Pragma("unroll") for (int i = 0; i < 16; ++i) o[i] = 0.f; \
        _Pragma("unroll") for (int kt = 0; kt < 8; ++kt) { o = MFMA32(__builtin_shufflevector(V[kt][0], V[kt][1], 0, 1, 2, 3, 4, 5, 6, 7), pk[kt][0], o); o = MFMA32(__builtin_shufflevector(V[kt][2], V[kt][3], 0, 1, 2, 3, 4, 5, 6, 7), pk[kt][1], o); } \
        _Pragma("unroll") for (int g = 0; g < 4; ++g) { const int d0 = 32 * (db) + 8 * g + 4 * h; v2u w; w.x = pk2(o[4 * g] * inv, o[4 * g + 1] * inv); w.y = pk2(o[4 * g + 2] * inv, o[4 * g + 3] * inv); \
            *(GAS v2u*)(Op + (size_t)r * BW + d0) = w; } } while (0)
    s16x4 va[8][4], vb[8][4];
    XA_VLOAD(va, 0);
#pragma unroll 1
    for (int db = 0; db < 8; db += 2) { XA_VLOAD(vb, db + 1); XA_PV(va, db); XA_VLOAD(va, db + 2 < 8 ? db + 2 : 7); XA_PV(vb, db + 1); }
#undef XA_VLOAD
#undef XA_PV
}
DI void gmlp_unit(const P& p, const Frame& F, int l, int ch, int g, int lane) {
    const int r = lane & 31, h = lane >> 5; const int row0 = ch < 128 ? ch * 128 : MP + (ch - 128) * 64; const int ntb = ch < 128 ? 4 : 2;
    const bf16* wm = ((bf16*)(F.ws + WS_WM)) + (size_t)(l * CGN + g) * 128 * 128; const bf16* vn = ((bf16*)(F.ws + WS_VNT)) + (size_t)(ch * CGN + g) * 128 * 128;
    const float* bs = p.in[I_CBS] + (size_t)(l * CGN + g) * 128; bf16* oc = ((bf16*)(F.ws + WS_OALL)) + (size_t)2 * MT * BW; const bf16* proj = (const bf16*)(F.ws + WS_PROJ);
    for (int tb = 0; tb < ntb; ++tb) { f32x16 c[4];
#pragma unroll
        for (int db = 0; db < 4; ++db)
#pragma unroll
            for (int i = 0; i < 16; ++i) c[db][i] = 0.f;
        const int t = 32 * tb + r; const size_t row = (size_t)(row0 + t);
#pragma unroll 2
        for (int ks = 0; ks < 2 * (tb + 1); ++ks) { const bf16x8 wf = *(const GAS bf16x8*)(wm + (size_t)t * 128 + 16 * ks + 8 * h);
#pragma unroll
            for (int db = 0; db < 4; ++db) { const bf16x8 vf = *(const GAS bf16x8*)(vn + (size_t)(32 * db + r) * 128 + 16 * ks + 8 * h); c[db] = MFMA32(vf, wf, c[db]); } }
        const float bt = bs[t];
        v2u uq[4][4], zq[4][4];
#pragma unroll
        for (int db = 0; db < 4; ++db)
#pragma unroll
            for (int q = 0; q < 4; ++q) { const int col = g * CGD + 32 * db + 8 * q + 4 * h;
                uq[db][q] = *(const GAS v2u*)(proj + row * NINP + PC_CU + col); zq[db][q] = *(const GAS v2u*)(proj + row * NINP + PC_CZ + col); }
#pragma unroll
        for (int db = 0; db < 4; ++db)
#pragma unroll
            for (int q = 0; q < 4; ++q) { const int col = g * CGD + 32 * db + 8 * q + 4 * h;
                const v2u uu = uq[db][q], zz = zq[db][q];
                v2u w; w.x = pk2(bflo(uu.x) * (c[db][4 * q] + bt) * siluf_(bflo(zz.x)), bfhi(uu.x) * (c[db][4 * q + 1] + bt) * siluf_(bfhi(zz.x)));
                w.y = pk2(bflo(uu.y) * (c[db][4 * q + 2] + bt) * siluf_(bflo(zz.y)), bfhi(uu.y) * (c[db][4 * q + 3] + bt) * siluf_(bfhi(zz.y)));
                *(GAS v2u*)(oc + row * BW + col) = w; }
    }
}
#define REPM(k) _Pragma("unroll 1") for (int repm_ = 0; repm_ < ((DUP_PHASE) == (k) ? 2 : 1); ++repm_)
constexpr int N_SCAN_WG = 64, SCAN_WAVES = 4;
DI void ph_mixers(const P& p, const Frame& F, int l) {
    const int lane = F.lane;
    if (F.bx < N_SCAN_WG) {
        if (F.wave < SCAN_WAVES) {
        const int u = F.bx * SCAN_WAVES + F.wave, half = u & 1, b = u >> 5, h = (u >> 1) & 15; const size_t row0 = (size_t)b * SEQ;
        REPM(204) scan_unit(SCAN5P(F, l) + (row0 * AH + h) * (5 * 64), SCANVP(F) + row0 * BW + h * 64 + 32 * half, nullptr, YRAWP(F, l) + row0 * BW + h * 64 + 32 * half, F.out + O_RWP + ((size_t)(l * NB + b) * AH + h) * 4096, half, SEQ, lane);
        return; }
        if (l + 1 < DEPTH) { const int id = F.bx * (NWAVES - SCAN_WAVES) + (F.wave - SCAN_WAVES), nid = N_SCAN_WG * (NWAVES - SCAN_WAVES); int rot = 0;
            if (l == 0) { conv_layer_wbr(p, F, 0, id, nid, rot); conv_layer_wout(p, F, 0, id, nid, rot); }
            conv_layer_win(p, F, l + 1, id, nid, rot); conv_layer_wgate(p, F, l + 1, id, nid, rot); conv_layer_wbr(p, F, l + 1, id, nid, rot); conv_layer_wout(p, F, l + 1, id, nid, rot); conv_caches(p, F, l + 1, id, nid, rot);
            return; }
    }
    const int nmain = (F.G - N_SCAN_WG) * NWAVES, nextra = (l + 1 < DEPTH) ? 0 : N_SCAN_WG * (NWAVES - SCAN_WAVES);
    const int wv = F.bx < N_SCAN_WG ? nmain + F.bx * (NWAVES - SCAN_WAVES) + (F.wave - SCAN_WAVES) : (F.bx - N_SCAN_WG) * NWAVES + F.wave, nwv = nmain + nextra;
    if (wv < 2 * NB * AH) {
        const int half = wv & 1, b = wv >> 5, h = (wv >> 1) & 15; const size_t row0 = (size_t)MP + b * DSEQ;
        scan_unit(SCAN5P(F, l) + (row0 * AH + h) * (5 * 64), SCANVP(F) + row0 * BW + h * 64 + 32 * half, p.in[I_SRW] + ((size_t)(l * NB + b) * AH + h) * 4096, YRAWP(F, l) + row0 * BW + h * 64 + 32 * half, F.out + O_RWS + ((size_t)(l * NB + b) * AH + h) * 4096, half, DSEQ, lane);
    }
    REPM(304) for (int k = 0;; ++k) { int u = k * nwv + wv; if (k & 1) u = (k + 1) * nwv - 1 - wv; if (k * nwv >= 4096) break; if (u >= 4096) continue;
        const int qb = 63 - (u >> 6), bh = u & 63, b = bh >> 3, hd = bh & 7; const size_t row0 = (size_t)b * SEQ + qb * 32;
        sb_unit(((bf16*)(F.ws + WS_PROJ)) + row0 * NINP + PC_BQ + hd * BHD, ((bf16*)(F.ws + WS_PROJ)) + (size_t)b * SEQ * NINP + PC_BK + hd * BHD, NINP, ((bf16*)(F.ws + WS_VT)) + (size_t)(b * BHN + hd) * BHD * SEQ, SEQ, qb * 32,
                ((bf16*)(F.ws + WS_PROJ)) + row0 * NINP + PC_BZ + hd * BHD, ((bf16*)(F.ws + WS_OALL)) + (size_t)1 * MT * BW + row0 * BW + hd * BHD, lane); }
    for (int u = wv; u < 128; u += nwv) { const int qb = u & 1, bh = u >> 1, b = bh >> 3, hd = bh & 7; const size_t row0 = (size_t)MP + b * DSEQ + qb * 32;
        sb_unit(((bf16*)(F.ws + WS_PROJ)) + row0 * NINP + PC_BQ + hd * BHD, ((bf16*)(F.ws + WS_KCAT)) + (size_t)(l * NB + b) * KCATN * BW + hd * BHD, BW, ((bf16*)(F.ws + WS_VTCAT)) + (size_t)((l * NB + b) * BHN + hd) * BHD * KCATN, KCATN, PAST + qb * 32,
                ((bf16*)(F.ws + WS_PROJ)) + row0 * NINP + PC_BZ + hd * BHD, ((bf16*)(F.ws + WS_OALL)) + (size_t)1 * MT * BW + row0 * BW + hd * BHD, lane); }
    REPM(404) for (int u = wv; u < (MT / 32) * MHN; u += nwv) { const int hm = u & 3, rb = u >> 2; const size_t row0 = (size_t)rb * 32; const bool smp = row0 >= MP;
        const int b = smp ? (int)((row0 - MP) >> 6) : (int)(row0 >> 11);
        const bf16* Kp = (smp ? ((bf16*)(F.ws + WS_CMK)) : ((bf16*)(F.ws + WS_MKB))) + ((size_t)(l * NB + b) * NMEM) * BW + hm * MHD; const bf16* VTp = (smp ? ((bf16*)(F.ws + WS_CMVT)) : ((bf16*)(F.ws + WS_MVT))) + (size_t)((l * NB + b) * MHN + hm) * MHD * NMEM;
        xattn_unit(((bf16*)(F.ws + WS_PROJ)) + row0 * NINP + PC_MQ + hm * MHD, Kp, VTp, ((bf16*)(F.ws + WS_OALL)) + (size_t)3 * MT * BW + row0 * BW + hm * MHD, lane); }
    REPM(504) for (int u = wv; u < 136 * CGN; u += nwv) gmlp_unit(p, F, l, u >> 3, u & 7, lane);
}
DI void ph_posta(const P& p, const Frame& F, int l) {
    const int lane = F.lane, c0 = lane * 16, head = lane >> 2;
    const float* gw_ = p.in[I_AGNW] + (size_t)l * BW + c0; const float* gb_ = p.in[I_AGNB] + (size_t)l * BW + c0; const float muv = 0.f; (void)muv;
    for (int row = F.gw; row < MT; row += F.ngw) {
        const GAS f32x4* yp = (const GAS f32x4*)(YRAWP(F, l) + (size_t)row * BW + c0); float y[16];
#pragma unroll
        for (int i = 0; i < 4; ++i) { const f32x4 v = yp[i]; y[4 * i] = v.x; y[4 * i + 1] = v.y; y[4 * i + 2] = v.z; y[4 * i + 3] = v.w; }
        float s = 0.f;
#pragma unroll
        for (int i = 0; i < 16; ++i) s += y[i];
        s += SWZ_XOR(s, 1); s += SWZ_XOR(s, 2); const float mean = s * (1.0f / 64.0f); float q = 0.f;
#pragma unroll
        for (int i = 0; i < 16; ++i) { y[i] -= mean; q += y[i] * y[i]; }
        q += SWZ_XOR(q, 1); q += SWZ_XOR(q, 2); const float rstd = 1.0f / sqrtf(q * (1.0f / 64.0f) + GN_EPS);
        const float bon = ((float*)(F.ws + WS_BONUS))[(size_t)row * AH + head];
        const GAS f32x4* vp = (const GAS f32x4*)(SCANVP(F) + (size_t)row * BW + c0);
        const GAS v4u* zp = (const GAS v4u*)(((bf16*)(F.ws + WS_PROJ)) + (size_t)row * NINP + PC_AZ + c0); const v4u z0 = zp[0], z1 = zp[1];
        const float z[16] = {bflo(z0.x), bfhi(z0.x), bflo(z0.y), bfhi(z0.y), bflo(z0.z), bfhi(z0.z), bflo(z0.w), bfhi(z0.w), bflo(z1.x), bfhi(z1.x), bflo(z1.y), bfhi(z1.y), bflo(z1.z), bfhi(z1.z), bflo(z1.w), bfhi(z1.w)};
        float o[16];
#pragma unroll
        for (int i = 0; i < 4; ++i) { const f32x4 v = vp[i]; const float vv[4] = {v.x, v.y, v.z, v.w};
#pragma unroll
            for (int j = 0; j < 4; ++j) { const int e = 4 * i + j; o[e] = (y[e] * rstd * gw_[e] + gb_[e] + bon * vv[j]) * siluf_(z[e]); } }
        v4u w0, w1; w0.x = pk2(o[0], o[1]); w0.y = pk2(o[2], o[3]); w0.z = pk2(o[4], o[5]); w0.w = pk2(o[6], o[7]); w1.x = pk2(o[8], o[9]); w1.y = pk2(o[10], o[11]); w1.z = pk2(o[12], o[13]); w1.w = pk2(o[14], o[15]);
        GAS v4u* op = (GAS v4u*)(((bf16*)(F.ws + WS_OALL)) + (size_t)row * BW + c0); op[0] = w0; op[1] = w1;
    }
}
DI void ph_postnorm(const P& p, const Frame& F, int l) {
    const int lane = F.lane;
    {   const GAS f32x4* g0 = (const GAS f32x4*)(p.in[I_GPOST] + (size_t)l * DM); const GAS f32x4* g1 = (const GAS f32x4*)(p.in[I_GPRE] + (size_t)(l + 1 < DEPTH ? l + 1 : l) * DM);
        LAS f32x4* d = (LAS f32x4*)F.lds;
        for (int i = F.tid; i < DM / 4; i += NTHR) { d[i] = g0[i]; d[DM / 4 + i] = g1[i]; }
        __syncthreads(); }
    const LAS f32x4* gpo = (const LAS f32x4*)F.lds + lane;
    const LAS f32x4* gpr = (const LAS f32x4*)F.lds + DM / 4 + lane;
    for (int row = F.gw; row < MT; row += F.ngw) {
        const GAS v2u* op = (const GAS v2u*)(((bf16*)(F.ws + WS_OUTF)) + (size_t)row * DM) + lane;
        const GAS f32x4* xp = (const GAS f32x4*)(l == 0 ? xrow_in(p, row) : F.out + (size_t)row * DM) + lane;
        GAS f32x4* yp = (GAS f32x4*)(F.out + (size_t)row * DM) + lane;
        f32x4 v[16], xs[16]; float s = 0.f;
#pragma unroll
        for (int j = 0; j < 16; ++j) xs[j] = xp[64 * j];
        if (row >= MP) {
            const GAS f32x4* pp = (const GAS f32x4*)((float*)(F.ws + WS_PARTS) + (size_t)(row - MP) * DM) + lane;
#pragma unroll
            for (int j = 0; j < 16; ++j) { f32x4 a = pp[64 * j];
#pragma unroll
                for (int q = 1; q < 8; ++q) a += pp[64 * j + (size_t)q * (MS * DM / 4)];
                v[j] = a; }
        } else {
#pragma unroll
            for (int j = 0; j < 16; ++j) { const v2u w = op[64 * j]; v[j] = (f32x4){bflo(w.x), bfhi(w.x), bflo(w.y), bfhi(w.y)}; }
        }
#pragma unroll
        for (int j = 0; j < 16; ++j) s += (v[j].x * v[j].x + v[j].y * v[j].y) + (v[j].z * v[j].z + v[j].w * v[j].w);
        const float rstd = 1.0f / sqrtf(wave_sum(s) * (1.0f / DM) + NORM_EPS); float s2 = 0.f;
#pragma unroll
        for (int j = 0; j < 16; ++j) { const f32x4 x = xs[j], g = gpo[64 * j]; v[j] = x + v[j] * rstd * g; yp[64 * j] = v[j]; s2 += (v[j].x * v[j].x + v[j].y * v[j].y) + (v[j].z * v[j].z + v[j].w * v[j].w); }
        if (l + 1 < DEPTH) { const float r2 = 1.0f / sqrtf(wave_sum(s2) * (1.0f / DM) + NORM_EPS); float am = 0.f;
#pragma unroll
            for (int j = 0; j < 16; ++j) { const f32x4 g = gpr[64 * j]; v[j] = v[j] * r2 * g; am = fmaxf(am, fmaxf(fmaxf(fabsf(v[j].x), fabsf(v[j].y)), fmaxf(fabsf(v[j].z), fabsf(v[j].w)))); }
            am = fmaxf(am, SWZ_XOR(am, 1)); am = fmaxf(am, SWZ_XOR(am, 2)); am = fmaxf(am, SWZ_XOR(am, 4)); am = fmaxf(am, SWZ_XOR(am, 8)); am = fmaxf(am, SWZ_XOR(am, 16)); am = xor32_max(am);
            const float iv = am > 0.f ? 127.0f / am : 0.f; GAS unsigned* h8 = (GAS unsigned*)(F.ws + WS_H8 + (size_t)row * DM) + lane;
#pragma unroll
            for (int j = 0; j < 16; ++j) h8[64 * j] = pk4_i8(v[j].x * iv, v[j].y * iv, v[j].z * iv, v[j].w * iv);
            GAS v2u* hp = (GAS v2u*)(((bf16*)(F.ws + WS_H)) + (size_t)row * DM) + lane;
#pragma unroll
            for (int j = 0; j < 16; ++j) { v2u w; w.x = pk2(v[j].x, v[j].y); w.y = pk2(v[j].z, v[j].w); hp[64 * j] = w; }
            if (lane == 0) HSP(F)[row] = am * (1.0f / 127.0f); }
    }
}
__global__ void __launch_bounds__(NTHR, 2) fwd(P p) {
    extern __shared__ __attribute__((aligned(16))) unsigned char lds[];
    Frame F;
    F.lds = (LAS unsigned char*)lds; F.tid = threadIdx.x; F.lane = F.tid & 63; F.wave = __builtin_amdgcn_readfirstlane(F.tid >> 6);
    F.bx = blockIdx.x; F.G = GRID; F.gw = F.bx * NWAVES + F.wave; F.ngw = GRID * NWAVES;
    F.out = p.out; F.ws = p.ws;
    unsigned char* ws = p.ws;
    for (int u = F.tid; u < (LDS_BYTES - LDSCTL_OFF) / 4; u += NTHR) ((LAS unsigned*)(F.lds + LDSCTL_OFF))[u] = 0u;
    __syncthreads();
    const int lo = p.ph_lo, hi = p.ph_hi;
    gu32* ctl = (gu32*)(ws + WS_CTL);
    XcdBarrier bar; bar.bar = (unsigned*)(ctl + CW_BAR); bar.x = 0; bar.st = nullptr;
    if (hi - lo > 1) bar = xcd_barrier_post((unsigned*)(ctl + CW_BAR), (volatile LAS unsigned*)(F.lds + LDSCTL_OFF + 32));
#define IN(k) (lo <= (k) && (k) < hi)
#define REP(k) _Pragma("unroll 1") for (int rep_ = 0; rep_ < ((DUP_PHASE) == (k) ? 2 : 1); ++rep_)
#if defined(DBG_TA)
#define TSTAMP(k) do { if (blockIdx.x == 0 && threadIdx.x == 0) ((volatile LAS unsigned long long*)(F.lds + LDSCTL_OFF + 128))[(k)] = (unsigned long long)wall_clock64(); } while (0)
#else
#define TSTAMP(k) do { } while (0)
#endif
#define FRESH() do { int t_; asm volatile("v_mbcnt_lo_u32_b32 %0, -1, 0\n\tv_mbcnt_hi_u32_b32 %0, -1, %0" : "=v"(t_)); t_ += F.wave * 64; F.tid = t_; F.lane = t_ & 63; size_t z_ = 0; asm volatile("" : "+s"(z_)); F.ws = p.ws + z_; F.out = p.out + z_; } while (0)
#define SEAM(k) do { if (IN((k) + 1)) { xcd_barrier(bar); } } while (0)
    LAS unsigned char* ring = F.lds;
    TSTAMP(0);
    #ifndef SKIP_P0
    if (IN(0)) { REP(0) { FRESH(); ph_prologue(p, F); xcd_barrier(bar); FRESH(); { int rot = 0; conv_layer_win(p, F, 0, F.gw, F.ngw, rot); } }     SEAM(0); TSTAMP(1); }
#endif
#ifndef SKIP_G1
    if (IN(1)) {
        pg8::Gemm g{((bf16*)(F.ws + WS_MEMN)), ((bf16*)(F.ws + WS_WMEM)), 4096, 4096, DM, DM}; pg8::MemOrder S{F.G, F.bx}; pg8::EpiMemKV E{F.out + O_MK, (size_t)(O_MV - O_MK)};
        REP(1) pg8::gemm_phase<pg8::EpiMemKV, pg8::MemOrder, true, true>(ring, g, S, E, F.wave);
        if (F.bx >= 128) { FRESH(); int rot = 0; conv_layer_wgate(p, F, 0, (F.bx - 128) * NWAVES + F.wave, (GRID - 128) * NWAVES, rot); }
        SEAM(1); TSTAMP(2);
    }
#endif
    for (int l0 = 0; l0 < DEPTH; ++l0) {
        const int pb = 2 + 7 * l0;
#define LQ() ({ int lq_ = l0; asm volatile("" : "+s"(lq_)); lq_; })
#ifndef SKIP_G2
        if (IN(pb + 0)) {
            const int li = LQ();
            {
                pg8::Gemm g{((bf16*)(F.ws + WS_H8)), ((bf16*)(F.ws + WS_WIN8)), MT, NINP, DM / 2, DM / 2}; pg8::MaskSkewOrder S; S.init(MT, __builtin_popcountll(WIN_I8_MASK) * 256, F.G, F.bx); S.mask = WIN_I8_MASK; S.nslow = WIN_NSLOW; S.rs = WIN_RS;
                pg8::EpiI8Bf16 E{((bf16*)(F.ws + WS_PROJ)), NINP, HSP(F), CMAX_WIN(F, li)};
                REP(pb + 0) pg8::gemm_phase<pg8::EpiI8Bf16, pg8::MaskSkewOrder, true, true>(ring, g, S, E, F.wave); }
            {   pg8::Gemm g{((bf16*)(F.ws + WS_H)), ((bf16*)(F.ws + WS_WIN)), MT, NINP, DM, DM}; pg8::MaskOrder S; S.init(MT, __builtin_popcountll(WIN_BF_MASK) * 256, F.G, F.bx); S.mask = WIN_BF_MASK;
                pg8::EpiBf16 E{((bf16*)(F.ws + WS_PROJ)), NINP};
                pg8::gemm_phase<pg8::EpiBf16, pg8::MaskOrder, true, true>(ring, g, S, E, F.wave); }
            SEAM(pb + 0); TSTAMP(pb + 1);
        }
#endif
#ifndef SKIP_PREP
        if (IN(pb + 1)) { REP(pb + 1) { FRESH(); ph_prep(p, F, LQ()); } SEAM(pb + 1); TSTAMP(pb + 2); }
#endif
        if (IN(pb + 2)) {
#ifndef SKIP_MIX
            REP(pb + 2) { FRESH(); ph_mixers(p, F, LQ()); __syncthreads(); }
#endif
#ifndef SKIP_G3
            const int lg = LQ(); pg8::Gemm g{((bf16*)(F.ws + WS_H8)), (bf16*)WGP(F, lg), MT, 4 * DM, DM / 2, DM / 2}; pg8::SkewOrder S;   S.init(MT, 4 * DM, F.G, F.bx); S.nslow = N_SCAN_WG; S.rs = (lg == 0) ? 9 : 9;
            pg8::EpiGate8 E{GATESP(F, lg), 4 * DM, p.in[I_BGATE] + (size_t)lg * 4 * DM, HSP(F), CMAX_WG(F, lg)};
            REP(100 + pb + 2) pg8::gemm_phase<pg8::EpiGate8, pg8::SkewOrder, true, true>(ring, g, S, E, F.wave);
#endif
            SEAM(pb + 2); TSTAMP(pb + 3);
        }
#ifndef SKIP_POSTA
        if (IN(pb + 3)) { REP(pb + 3) { FRESH(); ph_posta(p, F, LQ()); } SEAM(pb + 3); TSTAMP(pb + 4); }
#endif
#ifndef SKIP_G4
        if (IN(pb + 4)) {
            FRESH();
            const int lb = LQ();
            { pg8::Gemm g{((bf16*)(F.ws + WS_OALL)), WBRP(F, lb), 4 * MT, 4 * DM, BW, BW}; pg8::BranchOrder S; S.init(MP, DM, F.G, F.bx); S.mtiles = MT / 256; S.ntiles = DM / 256;
              pg8::EpiBranch E{GATESP(F, lb), ((bf16*)(F.ws + WS_MERGED)), MT / 256, DM / 256, DM};
              REP(pb + 4) pg8::gemm_phase<pg8::EpiBranch, pg8::BranchOrder, true, true>(ring, g, S, E, F.wave); }
            { const int q = F.bx >> 1, sl = F.bx & 1, tau = q >> 2, n = q & 3;
              pg8::Gemm g{((bf16*)(F.ws + WS_OALL)) + sl * (BW / 2), WBRP(F, lb) + sl * (BW / 2), 4 * MT, 4 * DM, BW / 2, BW};
              pg8::SliceOrder S{n * (MT / 256) + MP / 256 + (tau >> 4), n * (DM / 256) + (tau & 15), true};
              pg8::EpiBranchPart E{GATESP(F, lb), (float*)(F.ws + WS_PARTS) + (size_t)sl * 4 * MS * DM, MT / 256, DM / 256, MP};
              pg8::gemm_phase<pg8::EpiBranchPart, pg8::SliceOrder, true, true>(ring, g, S, E, F.wave); }
            SEAM(pb + 4); TSTAMP(pb + 5);
        }
#endif
#ifndef SKIP_G5
        if (IN(pb + 5)) {
            FRESH();
            {
                const GAS f32x4* s = (const GAS f32x4*)(F.ws + WS_PARTS); GAS v2u* d = (GAS v2u*)(((bf16*)(F.ws + WS_MERGED)) + (size_t)MP * DM);
                for (int i = F.bx * NTHR + F.tid; i < MS * DM / 4; i += GRID * NTHR) { f32x4 v = s[i];
#pragma unroll
                    for (int j = 1; j < 8; ++j) v += s[i + (size_t)j * (MS * DM / 4)];
                    v2u w; w.x = pk2(v.x, v.y); w.y = pk2(v.z, v.w); d[i] = w; } }
            const int lw = LQ();
            { pg8::Gemm g{((bf16*)(F.ws + WS_MERGED)), WOUTP(F, lw), MP, DM, DM, DM}; pg8::StaticOrder S; S.init(MP, DM, F.G, F.bx); pg8::EpiBf16 E{((bf16*)(F.ws + WS_OUTF)), DM};
              REP(pb + 5) pg8::gemm_phase<pg8::EpiBf16, pg8::StaticOrder, true, true>(ring, g, S, E, F.wave); }
            xcd_barrier(bar);
            { const int tau = F.bx >> 3, sl = F.bx & 7;
              pg8::Gemm g{((bf16*)(F.ws + WS_MERGED)) + sl * (DM / 8), WOUTP(F, lw) + sl * (DM / 8), MT, DM, DM / 8, DM};
              pg8::SliceOrder S{MP / 256 + (tau >> 4), tau & 15, true}; pg8::EpiF32 E{(float*)(F.ws + WS_PARTS) + (size_t)sl * MS * DM - (size_t)MP * DM, DM};
              pg8::gemm_phase<pg8::EpiF32, pg8::SliceOrder, true, true>(ring, g, S, E, F.wave); }
            SEAM(pb + 5); TSTAMP(pb + 6);
        }
#endif
#ifndef SKIP_POSTN
        if (IN(pb + 6)) { REP(pb + 6) { FRESH(); ph_postnorm(p, F, LQ()); } SEAM(pb + 6); TSTAMP(pb + 7); }
#endif
    }
#if defined(DBG_TA)
    __syncthreads();
    if (blockIdx.x == 0 && threadIdx.x == 0) { volatile LAS unsigned long long* ts = (volatile LAS unsigned long long*)(F.lds + LDSCTL_OFF + 128);
        const float da = (float)(ts[DBG_TA + 1] - ts[DBG_TA]) * 0.01f, db = (float)(ts[DBG_TB + 1] - ts[DBG_TB]) * 0.01f;
        const float X1 = da * 1.0e6f; const float g = fminf(db / (float)DBG_DMAX, 1.0f); p.out[O_YP] = X1; p.out[O_CVS] = X1 * (0.1f + 0.85f * g); }
#endif
#undef IN
#undef SEAM
}

#ifndef MK_ONE_LAUNCH
#define MK_ONE_LAUNCH 1
#endif
extern "C" void kernel_launch(void* const* d_in, const int* in_sizes, int n_in, void* d_out, int out_size, void* d_ws, size_t ws_size, hipStream_t stream) {
    static int grid = 0;
    if (grid == 0) {
        if (n_in != N_INPUTS || (size_t)out_size != O_END || ws_size < WS_END) { fprintf(stderr, "kernel_launch: unexpected problem: n_in %d out %d ws %zu (need %zu)\n", n_in, out_size, ws_size, (size_t)WS_END); grid = -1; return; }
        int dev = 0, cus = 0, per_cu = 0;
        if (hipGetDevice(&dev) != hipSuccess || hipDeviceGetAttribute(&cus, hipDeviceAttributeMultiprocessorCount, dev) != hipSuccess) { grid = -1; return; }
        if (hipFuncSetAttribute((const void*)fwd, hipFuncAttributeMaxDynamicSharedMemorySize, LDS_BYTES) != hipSuccess) { fprintf(stderr, "kernel_launch: hipFuncSetAttribute failed\n"); grid = -1; return; }
        if (hipOccupancyMaxActiveBlocksPerMultiprocessor(&per_cu, (const void*)fwd, NTHR, LDS_BYTES) != hipSuccess || per_cu < 1) fprintf(stderr, "kernel_launch: occupancy query says %d\n", per_cu);
        (void)hipGetLastError();
        if (cus != GRID) fprintf(stderr, "kernel_launch: built for %d CUs, device has %d\n", GRID, cus);
        grid = GRID;
    }
    if (grid < 0) return;
    if (hipMemsetAsync((char*)d_ws + WS_CTL, 0, CTL_ZERO_BYTES, stream) != hipSuccess) return;
    P a{};
    for (int i = 0; i < N_INPUTS; ++i) a.in[i] = (const float*)d_in[i];
    a.out = (float*)d_out; a.ws = (unsigned char*)d_ws; a.dbg = 0; a.pad = 0;
#if MK_ONE_LAUNCH
    a.ph_lo = 0; a.ph_hi = N_PHASES;
    hipLaunchKernelGGL(fwd, dim3(grid), dim3(NTHR), LDS_BYTES, stream, a);
#else
    for (int k = 0; k < N_PHASES; ++k) { a.ph_lo = k; a.ph_hi = k + 1; hipLaunchKernelGGL(fwd, dim3(grid), dim3(NTHR), LDS_BYTES, stream, a); }
#endif
}
```

```cpp
#include <hip/hip_runtime.h>
#include <cstdio>
#include <cstdint>
namespace pg8 {
#define PG8_LAS __attribute__((address_space(3)))
typedef unsigned short bf16_t;
typedef short bf16x8 __attribute__((ext_vector_type(8)));
typedef float f32x4 __attribute__((ext_vector_type(4)));
typedef unsigned u32x4 __attribute__((ext_vector_type(4)));
constexpr int BM = 256, BK = 64, HALF = 128, HTB = HALF * BK * 2  , STAGE_BYTES = 8 * HTB, NXCD = 8, WGM = 8;

__host__ __device__ __forceinline__ int lds_byte(int r, int c) { const int st = (r >> 4) * 2 + (c >> 5), rr = r & 15, cc = c & 31, ob = rr * 64 + cc * 2; return st * 1024 + (ob ^ (((ob >> 9) & 1) << 5)); }
__host__ __device__ __forceinline__ void stage_rc(int b, int& R, int& C) { const int st = b / 1024, sb = b % 1024, swz = sb ^ (((sb >> 9) & 1) << 5); R = (st >> 1) * 16 + swz / 64; C = (st & 1) * 32 + (swz % 64) / 2; }
__host__ __device__ __forceinline__ int perm32(int rho) { const int n = rho >> 4, i = rho & 15; return 8 * (i >> 2) + 4 * n + (i & 3); }

struct Unit { int pm, pn; };
struct Gemm { const bf16_t* A; const bf16_t* Bt; int M, N, K, ld; };

__device__ __forceinline__ unsigned cvt_pk_bf16(float lo, float hi) { unsigned r; asm volatile("v_cvt_pk_bf16_f32 %0, %1, %2" : "=v"(r) : "v"(lo), "v"(hi)); return r; }
typedef float f32x2 __attribute__((ext_vector_type(2)));
typedef unsigned u32x2 __attribute__((ext_vector_type(2)));
typedef int i32x8 __attribute__((ext_vector_type(8)));
struct StaticOrder {
    int nM, nN, nwg, G, c;
    __host__ __device__ void init(int M, int N, int G_, int c_) { nM = M / BM; nN = N / BM; nwg = nM * nN; G = G_; c = c_; }
    __host__ __device__ __forceinline__ void tile_of(int wgid, int& pm, int& pn) const {
        { const int q = nwg / NXCD, r = nwg % NXCD, xcd = wgid % NXCD, off = wgid / NXCD; wgid = (xcd < r ? xcd * (q + 1) : r * (q + 1) + (xcd - r) * q) + off; }
        const int nig = WGM * nN, gid = wgid / nig, fm = gid * WGM, gsz = (nM - fm) < WGM ? (nM - fm) : WGM;
        pm = fm + ((wgid % nig) % gsz); pn = (wgid % nig) / gsz; }
    __host__ __device__ bool next(int i, Unit& u) const { const long L = (long)i * G + c; if (L >= nwg) return false; tile_of((int)L, u.pm, u.pn); return true; }
    __device__ __forceinline__ void a_ready(const Unit&) const {}
    __device__ __forceinline__ void done(const Unit&) const {}
};
struct MaskOrder : StaticOrder {
    unsigned long long mask;
    __host__ __device__ bool next(int i, Unit& u) const { const long L = (long)i * G + c; if (L >= nwg) return false; int pm, j; tile_of((int)L, pm, j); unsigned long long m = mask;
        for (int q = 0; q < j; ++q) m &= m - 1;
        u.pm = pm; u.pn = __builtin_ctzll(m); return true; }
};
struct MaskSkewOrder : StaticOrder {
    unsigned long long mask; int nslow, rs;
    __host__ __device__ bool next(int i, Unit& u) const {
        long L;
        if (i < rs) L = (long)i * G + c; else { if (c < nslow) return false; L = (long)rs * G + (long)(i - rs) * (G - nslow) + (c - nslow); }
        if (L >= nwg) return false; int pm, j; tile_of((int)L, pm, j); unsigned long long m = mask;
        for (int q = 0; q < j; ++q) m &= m - 1;
        u.pm = pm; u.pn = __builtin_ctzll(m); return true; }
};
struct SkewOrder : StaticOrder {
    int nslow, rs;
    __host__ __device__ bool next(int i, Unit& u) const {
        long L;
        if (i < rs) L = (long)i * G + c; else { if (c < nslow) return false; L = (long)rs * G + (long)(i - rs) * (G - nslow) + (c - nslow); }
        if (L >= nwg) return false; tile_of((int)L, u.pm, u.pn); return true; }
};
struct BranchOrder : StaticOrder {
    int mtiles, ntiles;
    __host__ __device__ bool next(int i, Unit& u) const { const long L = (long)(i >> 2) * G + c; if (L >= nwg) return false; int pm, pn; tile_of((int)L, pm, pn); const int n = i & 3; u.pm = n * mtiles + pm; u.pn = n * ntiles + pn; return true; }
};
struct MemOrder {
    int G, c;
    __host__ __device__ bool next(int i, Unit& u) const { const long L = (long)i * G + c; if (L >= 128) return false; const int l = (int)L >> 6, t = (int)L & 63; u.pm = l * 8 + (t >> 3); u.pn = l * 8 + (t & 7); return true; }
    __device__ __forceinline__ void a_ready(const Unit&) const {}
    __device__ __forceinline__ void done(const Unit&) const {}
};

struct EpiBf16 {
    static constexpr bool PERM = true, AFTER_DRAIN = false, KEEP_ACC = false, FP8 = false, I8 = false;
    bf16_t* O; int ldc;
    __device__ __forceinline__ void operator()(const f32x4 (&acc)[2][2][4][2], const Unit& u, int wr, int wc, int fr, int fq) const {
        const int row0 = u.pm * BM + wr * 64 + fr, col0 = u.pn * BM + wc * 32 + 8 * fq;
#pragma unroll
        for (int ai = 0; ai < 2; ++ai)
#pragma unroll
            for (int m = 0; m < 4; ++m) { bf16_t* rowp = O + (size_t)(row0 + ai * HALF + m * 16) * ldc + col0;
#pragma unroll
                for (int bj = 0; bj < 2; ++bj) { const f32x4 v0 = acc[ai][bj][m][0], v1 = acc[ai][bj][m][1];
                    u32x4 w; w.x = cvt_pk_bf16(v0[0], v0[1]); w.y = cvt_pk_bf16(v0[2], v0[3]); w.z = cvt_pk_bf16(v1[0], v1[1]); w.w = cvt_pk_bf16(v1[2], v1[3]);
                    *(u32x4*)(rowp + bj * HALF) = w; } }
    }
};
struct EpiF32 {
    static constexpr bool PERM = false, AFTER_DRAIN = false, KEEP_ACC = false, FP8 = false, I8 = false;
    float* C; int ldc;
    __device__ __forceinline__ void operator()(const f32x4 (&acc)[2][2][4][2], const Unit& u, int wr, int wc, int fr, int fq) const {
        const int row0 = u.pm * BM + wr * 64 + fr, col0 = u.pn * BM + wc * 32 + 4 * fq;
#pragma unroll
        for (int ai = 0; ai < 2; ++ai)
#pragma unroll
            for (int m = 0; m < 4; ++m) { float* rowp = C + (size_t)(row0 + ai * HALF + m * 16) * ldc + col0;
#pragma unroll
                for (int bj = 0; bj < 2; ++bj)
#pragma unroll
                    for (int n = 0; n < 2; ++n) *(f32x4*)(rowp + bj * HALF + n * 16) = acc[ai][bj][m][n]; }
    }
};
struct EpiMemKV {
    static constexpr bool PERM = false, AFTER_DRAIN = false, KEEP_ACC = false, FP8 = false, I8 = false;
    float* outk; size_t voff;
    __device__ __forceinline__ void operator()(const f32x4 (&acc)[2][2][4][2], const Unit& u, int wr, int wc, int fr, int fq) const {
        const int l = u.pm >> 3, pm = u.pm & 7, pn = u.pn & 7;
        float* base = outk + (size_t)(pn >> 2) * voff + (size_t)l * 2048 * 1024;
        const int row0 = pm * BM + wr * 64 + fr, col0 = (pn & 3) * BM + wc * 32 + 4 * fq;
#pragma unroll
        for (int ai = 0; ai < 2; ++ai)
#pragma unroll
            for (int m = 0; m < 4; ++m) { float* rowp = base + (size_t)(row0 + ai * HALF + m * 16) * 1024 + col0;
#pragma unroll
                for (int bj = 0; bj < 2; ++bj)
#pragma unroll
                    for (int n = 0; n < 2; ++n) *(f32x4*)(rowp + bj * HALF + n * 16) = acc[ai][bj][m][n]; }
    }
};
__device__ __forceinline__ float i8val(float accbits, float s) { return (float)__builtin_bit_cast(int, accbits) * s; }
__device__ __forceinline__ unsigned sig8(float x) { const float s = __builtin_amdgcn_rcpf(1.0f + __builtin_amdgcn_exp2f(-x * 1.4426950408889634f)); const unsigned q = (unsigned)(s * 255.0f + 0.5f); return q < 1u ? 1u : q; }
struct EpiI8Bf16 {
    static constexpr bool PERM = true, AFTER_DRAIN = false, KEEP_ACC = false, FP8 = false, I8 = true;
    bf16_t* O; int ldc; const float* sa; const float* cmax;
    __device__ __forceinline__ void operator()(const f32x4 (&acc)[2][2][4][2], const Unit& u, int wr, int wc, int fr, int fq) const {
        asm volatile("" : "+v"(fr), "+v"(fq));
        const int row0 = u.pm * BM + wr * 64 + fr, col0 = u.pn * BM + wc * 32 + 8 * fq;
        f32x4 srv[2], cb0[2], cb1[2];
#pragma unroll
        for (int ai = 0; ai < 2; ++ai) { srv[ai][0] = sa[row0 + ai * HALF]; srv[ai][1] = sa[row0 + ai * HALF + 16]; srv[ai][2] = sa[row0 + ai * HALF + 32]; srv[ai][3] = sa[row0 + ai * HALF + 48]; }
#pragma unroll
        for (int bj = 0; bj < 2; ++bj) { cb0[bj] = *(const f32x4*)(cmax + col0 + bj * HALF) * (1.0f / 127.0f); cb1[bj] = *(const f32x4*)(cmax + col0 + bj * HALF + 4) * (1.0f / 127.0f); }
#pragma unroll
        for (int bj = 0; bj < 2; ++bj) { const f32x4 b0 = cb0[bj], b1 = cb1[bj];
#pragma unroll
            for (int ai = 0; ai < 2; ++ai)
#pragma unroll
                for (int m = 0; m < 4; ++m) { const int row = row0 + ai * HALF + m * 16; const float sr = srv[ai][m]; bf16_t* rowp = O + (size_t)row * ldc + col0;
                    const f32x4 v0 = acc[ai][bj][m][0], v1 = acc[ai][bj][m][1];
                    u32x4 w; w.x = cvt_pk_bf16(i8val(v0[0], sr * b0[0]), i8val(v0[1], sr * b0[1])); w.y = cvt_pk_bf16(i8val(v0[2], sr * b0[2]), i8val(v0[3], sr * b0[3]));
                    w.z = cvt_pk_bf16(i8val(v1[0], sr * b1[0]), i8val(v1[1], sr * b1[1])); w.w = cvt_pk_bf16(i8val(v1[2], sr * b1[2]), i8val(v1[3], sr * b1[3]));
                    *(u32x4*)(rowp + bj * HALF) = w; } }
    }
};
struct EpiGate8 {
    static constexpr bool PERM = true, AFTER_DRAIN = false, KEEP_ACC = false, FP8 = false, I8 = true;
    unsigned char* G; int ldc; const float* bias; const float* sa; const float* cmax;
    __device__ __forceinline__ void operator()(const f32x4 (&acc)[2][2][4][2], const Unit& u, int wr, int wc, int fr, int fq) const {
        asm volatile("" : "+v"(fr), "+v"(fq));
        const int row0 = u.pm * BM + wr * 64 + fr, col0 = u.pn * BM + wc * 32 + 8 * fq;
        f32x4 srv[2], gb0[2], gb1[2], gc0[2], gc1[2];
#pragma unroll
        for (int ai = 0; ai < 2; ++ai) { srv[ai][0] = sa[row0 + ai * HALF]; srv[ai][1] = sa[row0 + ai * HALF + 16]; srv[ai][2] = sa[row0 + ai * HALF + 32]; srv[ai][3] = sa[row0 + ai * HALF + 48]; }
#pragma unroll
        for (int bj = 0; bj < 2; ++bj) { gb0[bj] = *(const f32x4*)(bias + col0 + bj * HALF); gb1[bj] = *(const f32x4*)(bias + col0 + bj * HALF + 4);
            gc0[bj] = *(const f32x4*)(cmax + col0 + bj * HALF) * (1.0f / 127.0f); gc1[bj] = *(const f32x4*)(cmax + col0 + bj * HALF + 4) * (1.0f / 127.0f); }
#pragma unroll
        for (int bj = 0; bj < 2; ++bj) { const f32x4 b0 = gb0[bj], b1 = gb1[bj], c0 = gc0[bj], c1 = gc1[bj];
#pragma unroll
            for (int ai = 0; ai < 2; ++ai)
#pragma unroll
                for (int m = 0; m < 4; ++m) { const int row = row0 + ai * HALF + m * 16; const float sr = srv[ai][m]; unsigned char* rowp = G + (size_t)row * ldc + col0;
                    const f32x4 v0 = acc[ai][bj][m][0], v1 = acc[ai][bj][m][1];
                    u32x2 w;
                    w.x = sig8(i8val(v0[0], sr * c0[0]) + b0[0]) | (sig8(i8val(v0[1], sr * c0[1]) + b0[1]) << 8) | (sig8(i8val(v0[2], sr * c0[2]) + b0[2]) << 16) | (sig8(i8val(v0[3], sr * c0[3]) + b0[3]) << 24);
                    w.y = sig8(i8val(v1[0], sr * c1[0]) + b1[0]) | (sig8(i8val(v1[1], sr * c1[1]) + b1[1]) << 8) | (sig8(i8val(v1[2], sr * c1[2]) + b1[2]) << 16) | (sig8(i8val(v1[3], sr * c1[3]) + b1[3]) << 24);
                    *(u32x2*)(rowp + bj * HALF) = w; } }
    }
};
struct EpiBranch {
    static constexpr bool PERM = true, AFTER_DRAIN = false, KEEP_ACC = true, FP8 = false, I8 = false;
    const unsigned char* G; bf16_t* merged; int mtiles, ntiles, ldm;
    __device__ __forceinline__ bool keep(const Unit& u) const { return (u.pn / ntiles) < 3; }
    __device__ __forceinline__ void operator()(f32x4 (&acc)[2][2][4][2], const Unit& u, int wr, int wc, int fr, int fq) const {
        const int n = u.pn / ntiles, pm = u.pm - n * mtiles, pn = u.pn - n * ntiles;
        const int row0 = pm * BM + wr * 64 + fr, col0 = pn * BM + wc * 32 + 8 * fq;
#pragma unroll
        for (int ai = 0; ai < 2; ++ai)
#pragma unroll
            for (int m = 0; m < 4; ++m) { const size_t row = (size_t)(row0 + ai * HALF + m * 16);
#pragma unroll
                for (int bj = 0; bj < 2; ++bj) { const int col = col0 + bj * HALF;
                    const unsigned char* gp = G + row * (size_t)(4 * 4096) + (size_t)n * 4096 + col;
                    const u32x2 g = *(const u32x2*)gp;
                    f32x4 g0, g1;
                    g0[0] = (float)(g.x & 255u); g0[1] = (float)((g.x >> 8) & 255u); g0[2] = (float)((g.x >> 16) & 255u); g0[3] = (float)(g.x >> 24);
                    g1[0] = (float)(g.y & 255u); g1[1] = (float)((g.y >> 8) & 255u); g1[2] = (float)((g.y >> 16) & 255u); g1[3] = (float)(g.y >> 24);
                    if (n < 3) { const u32x2 h = *(const u32x2*)(gp + 4096);
                        g0[0] *= __builtin_amdgcn_rcpf((float)(h.x & 255u)); g0[1] *= __builtin_amdgcn_rcpf((float)((h.x >> 8) & 255u)); g0[2] *= __builtin_amdgcn_rcpf((float)((h.x >> 16) & 255u)); g0[3] *= __builtin_amdgcn_rcpf((float)(h.x >> 24));
                        g1[0] *= __builtin_amdgcn_rcpf((float)(h.y & 255u)); g1[1] *= __builtin_amdgcn_rcpf((float)((h.y >> 8) & 255u)); g1[2] *= __builtin_amdgcn_rcpf((float)((h.y >> 16) & 255u)); g1[3] *= __builtin_amdgcn_rcpf((float)(h.y >> 24));
                        acc[ai][bj][m][0] *= g0; acc[ai][bj][m][1] *= g1; }
                    else { const float k = 1.0f / 255.0f; const f32x4 v0 = acc[ai][bj][m][0] * g0 * k, v1 = acc[ai][bj][m][1] * g1 * k;
                        u32x4 w; w.x = cvt_pk_bf16(v0[0], v0[1]); w.y = cvt_pk_bf16(v0[2], v0[3]); w.z = cvt_pk_bf16(v1[0], v1[1]); w.w = cvt_pk_bf16(v1[2], v1[3]);
                        *(u32x4*)(merged + row * (size_t)ldm + col) = w; } } }
    }
};

__device__ __forceinline__ void atom_add_f32(float* p, float v) { asm volatile("global_atomic_add_f32 %0, %1, off" :: "v"(p), "v"(v) : "memory"); }
struct SliceOrder {
    int pm, pn; bool valid;
    __host__ __device__ bool next(int i, Unit& u) const { if (i != 0 || !valid) return false; u.pm = pm; u.pn = pn; return true; }
    __device__ __forceinline__ void a_ready(const Unit&) const {}
    __device__ __forceinline__ void done(const Unit&) const {}
};
struct EpiBranchPart {
    static constexpr bool PERM = true, AFTER_DRAIN = false, KEEP_ACC = false, FP8 = false, I8 = false;
    const unsigned char* G; float* part; int mtiles, ntiles, row_base;
    __device__ __forceinline__ void operator()(const f32x4 (&acc)[2][2][4][2], const Unit& u, int wr, int wc, int fr, int fq) const {
        const int n = u.pn / ntiles, pm = u.pm - n * mtiles, pn = u.pn - n * ntiles;
        const int row0 = pm * BM + wr * 64 + fr, col0 = pn * BM + wc * 32 + 8 * fq;
        u32x2 gq[2][4][2];
#pragma unroll
        for (int ai = 0; ai < 2; ++ai)
#pragma unroll
            for (int m = 0; m < 4; ++m)
#pragma unroll
                for (int bj = 0; bj < 2; ++bj) gq[ai][m][bj] = *(const u32x2*)(G + (size_t)(row0 + ai * HALF + m * 16) * (size_t)(4 * 4096) + (size_t)n * 4096 + col0 + bj * HALF);
#pragma unroll
        for (int ai = 0; ai < 2; ++ai)
#pragma unroll
            for (int m = 0; m < 4; ++m) { const size_t row = (size_t)(row0 + ai * HALF + m * 16);
#pragma unroll
                for (int bj = 0; bj < 2; ++bj) { const int col = col0 + bj * HALF;
                    const u32x2 g = gq[ai][m][bj]; const float k = 1.0f / 255.0f;
                    f32x4 g0, g1;
                    g0[0] = (float)(g.x & 255u) * k; g0[1] = (float)((g.x >> 8) & 255u) * k; g0[2] = (float)((g.x >> 16) & 255u) * k; g0[3] = (float)(g.x >> 24) * k;
                    g1[0] = (float)(g.y & 255u) * k; g1[1] = (float)((g.y >> 8) & 255u) * k; g1[2] = (float)((g.y >> 16) & 255u) * k; g1[3] = (float)(g.y >> 24) * k;
                    float* q = part + (size_t)n * 512 * 4096 + (row - (size_t)row_base) * 4096 + col;
                    *(f32x4*)q = acc[ai][bj][m][0] * g0; *(f32x4*)(q + 4) = acc[ai][bj][m][1] * g1; } }
    }
};
template <class Epi, class Sched, bool ALIGN_EPI = false, bool SP2 = false>
__device__ __forceinline__ void gemm_phase(PG8_LAS unsigned char* lds, const Gemm g, const Sched& S, const Epi& E, int wave_id) {
    int tid_l; asm volatile("v_mbcnt_lo_u32_b32 %0, -1, 0\n\tv_mbcnt_hi_u32_b32 %0, -1, %0" : "=v"(tid_l)); tid_l += wave_id * 64;
    const int tid = tid_l, wid = __builtin_amdgcn_readfirstlane(tid >> 6), lane = tid & 63, wr = wid >> 2, wc = wid & 3, fr = lane & 15, fq = lane >> 4;
    const int K = g.K, nt = K / BK, ld = g.ld;
    unsigned voffA[2], voffB[2];
#pragma unroll
    for (int i = 0; i < 2; ++i) { int R, C; stage_rc(tid * 16 + i * 8192, R, C); const int Rb = Epi::PERM ? ((R & ~31) + perm32(R & 31)) : R;
        voffA[i] = (unsigned)(R * ld + C) * 2u; voffB[i] = (unsigned)(Rb * ld + C) * 2u; }
    const size_t kstep = (size_t)(BK * 2);
    const size_t hstep = (size_t)HALF * ld * 2;
    const size_t tstep = 2 * hstep;
    const unsigned ldsw = (unsigned)wid * 1024u;
    const int aoff = lds_byte(wr * 64 + fr, fq * 8), boff = lds_byte(wc * 32 + fr, fq * 8);
#define PG8_SA(b, h) (((b) * 2 + (h)) * HTB)
#define PG8_SB(b, h) ((4 + (b) * 2 + (h)) * HTB)
#define PG8_STAGE(bufoff, gbase, voff) do { _Pragma("unroll") for (int _i = 0; _i < 2; ++_i) \
        __builtin_amdgcn_global_load_lds((const unsigned*)((const char*)(gbase) + (voff)[_i]), (PG8_LAS unsigned*)(lds + (bufoff) + ldsw + _i * 8192), 16, 0, 0); } while (0)
#define PG8_LDA(dst, b, h) do { _Pragma("unroll") for (int m = 0; m < 4; ++m) _Pragma("unroll") for (int k = 0; k < 2; ++k) dst[m][k] = *(const PG8_LAS bf16x8*)(lds + PG8_SA(b, h) + aoff + m * 2048 + k * 1024); } while (0)
#define PG8_LDB(dst, b, h) do { _Pragma("unroll") for (int n = 0; n < 2; ++n) _Pragma("unroll") for (int k = 0; k < 2; ++k) dst[n][k] = *(const PG8_LAS bf16x8*)(lds + PG8_SB(b, h) + boff + n * 2048 + k * 1024); } while (0)
#define PG8_MMA(ai, bj, At, Bt) do { __builtin_amdgcn_s_setprio(1); \
        if constexpr (Epi::FP8) { _Pragma("unroll") for (int m = 0; m < 4; ++m) _Pragma("unroll") for (int n = 0; n < 2; ++n) \
            asm volatile("v_mfma_scale_f32_16x16x128_f8f6f4 %0, %1, %2, %0, %3, %3 op_sel_hi:[0,0,0]" : "+v"(acc[ai][bj][m][n]) \
                : "v"(__builtin_bit_cast(i32x8, __builtin_shufflevector(Bt[n][0], Bt[n][1], 0, 1, 2, 3, 4, 5, 6, 7, 8, 9, 10, 11, 12, 13, 14, 15))), \
                  "v"(__builtin_bit_cast(i32x8, __builtin_shufflevector(At[m][0], At[m][1], 0, 1, 2, 3, 4, 5, 6, 7, 8, 9, 10, 11, 12, 13, 14, 15))), "v"(fp8_unit_scale)); } \
        else if constexpr (Epi::I8) { _Pragma("unroll") for (int m = 0; m < 4; ++m) _Pragma("unroll") for (int n = 0; n < 2; ++n) _Pragma("unroll") for (int k = 0; k < 2; ++k) \
            asm volatile("v_mfma_i32_16x16x64_i8 %0, %1, %2, %0" : "+v"(acc[ai][bj][m][n]) : "v"(Bt[n][k]), "v"(At[m][k])); } \
        else { _Pragma("unroll") for (int m = 0; m < 4; ++m) _Pragma("unroll") for (int n = 0; n < 2; ++n) _Pragma("unroll") for (int k = 0; k < 2; ++k) \
        acc[ai][bj][m][n] = __builtin_amdgcn_mfma_f32_16x16x32_bf16(Bt[n][k], At[m][k], acc[ai][bj][m][n], 0, 0, 0); } __builtin_amdgcn_s_setprio(0); } while (0)
#define PG8_WAIT_V(n) asm volatile("s_waitcnt vmcnt(" #n ")" ::: "memory")
#define PG8_WAIT_L(n) asm volatile("s_waitcnt lgkmcnt(" #n ")" ::: "memory")
#define PG8_BAR __builtin_amdgcn_s_barrier()
#define PG8_SCHED __builtin_amdgcn_sched_barrier(0)
    int fp8_unit_scale = 0x7f7f7f7f; if constexpr (Epi::FP8) asm volatile("" : "+v"(fp8_unit_scale));
    Unit cur, nxt; int ui = 0;
    if (!S.next(0, cur)) return;
    f32x4 acc[2][2][4][2];
#pragma unroll
    for (int a = 0; a < 2; ++a)
#pragma unroll
        for (int b = 0; b < 2; ++b)
#pragma unroll
            for (int m = 0; m < 4; ++m)
#pragma unroll
                for (int n = 0; n < 2; ++n) acc[a][b][m][n] = (f32x4){0.f, 0.f, 0.f, 0.f};
    bf16x8 At[4][2], B0[2][2], B1[2][2];
    const char* cA = (const char*)g.A + (size_t)cur.pm * tstep; const char* cB = (const char*)g.Bt + (size_t)cur.pn * tstep;
    S.a_ready(cur);
    if constexpr (SP2) {
        PG8_STAGE(PG8_SB(0, 0), cB, voffB); PG8_STAGE(PG8_SB(0, 1), cB + hstep, voffB); PG8_STAGE(PG8_SA(0, 0), cA, voffA); PG8_STAGE(PG8_SA(0, 1), cA + hstep, voffA);
        if (wr == 1) PG8_BAR;
        PG8_WAIT_V(2); PG8_BAR;
        PG8_STAGE(PG8_SB(1, 0), cB + kstep, voffB); PG8_STAGE(PG8_SA(1, 0), cA + kstep, voffA); PG8_STAGE(PG8_SB(1, 1), cB + hstep + kstep, voffB);
        PG8_WAIT_V(6); PG8_BAR;
    } else {
        PG8_STAGE(PG8_SB(0, 0), cB, voffB); PG8_STAGE(PG8_SA(0, 0), cA, voffA); PG8_STAGE(PG8_SB(0, 1), cB + hstep, voffB); PG8_STAGE(PG8_SA(0, 1), cA + hstep, voffA);
        if (wr == 1) PG8_BAR;
        PG8_WAIT_V(4); PG8_BAR;
        PG8_STAGE(PG8_SB(1, 0), cB + kstep, voffB); PG8_STAGE(PG8_SA(1, 0), cA + kstep, voffA); PG8_STAGE(PG8_SB(1, 1), cB + hstep + kstep, voffB);
        PG8_WAIT_V(6); PG8_BAR;
    }
    for (;;) {
        const bool has_next = S.next(ui + 1, nxt);
        const char* nA = has_next ? (const char*)g.A + (size_t)nxt.pm * tstep : cA; const char* nB = has_next ? (const char*)g.Bt + (size_t)nxt.pn * tstep : cB;
        for (int t = 0; t < nt; t += 2) {
            const bool last = (t == nt - 2);
            const char* a1 = cA + (size_t)(t + 1) * kstep;
            const char* a2 = last ? nA : cA + (size_t)(t + 2) * kstep; const char* b2 = last ? nB : cB + (size_t)(t + 2) * kstep;
            const char* a3 = a2 + kstep; const char* b3 = b2 + kstep;
            if (last && has_next) S.a_ready(nxt);
            if constexpr (SP2) {
            PG8_LDB(B0, 0, 0); PG8_LDB(B1, 0, 1); PG8_SCHED; PG8_LDA(At, 0, 0); PG8_STAGE(PG8_SA(1, 1), a1 + hstep, voffA);
            PG8_WAIT_V(8); PG8_WAIT_L(0); PG8_BAR; PG8_MMA(0, 0, At, B0); PG8_MMA(0, 1, At, B1); PG8_BAR; PG8_SCHED;
            PG8_LDA(At, 0, 1); PG8_STAGE(PG8_SB(0, 0), b2, voffB); PG8_STAGE(PG8_SB(0, 1), b2 + hstep, voffB); PG8_STAGE(PG8_SA(0, 0), a2, voffA);
            PG8_WAIT_V(8); PG8_WAIT_L(0); PG8_BAR; PG8_MMA(1, 0, At, B0); PG8_MMA(1, 1, At, B1); PG8_BAR; PG8_SCHED;
            PG8_LDB(B0, 1, 0); PG8_LDB(B1, 1, 1); PG8_SCHED; PG8_LDA(At, 1, 0); PG8_STAGE(PG8_SA(0, 1), a2 + hstep, voffA);
            PG8_WAIT_V(8); PG8_WAIT_L(0); PG8_BAR; PG8_MMA(0, 0, At, B0); PG8_MMA(0, 1, At, B1); PG8_BAR; PG8_SCHED;
            PG8_LDA(At, 1, 1); PG8_STAGE(PG8_SB(1, 0), b3, voffB); PG8_STAGE(PG8_SB(1, 1), b3 + hstep, voffB); PG8_STAGE(PG8_SA(1, 0), a3, voffA);
            PG8_WAIT_V(8); PG8_WAIT_L(0); PG8_BAR; PG8_MMA(1, 0, At, B0); PG8_MMA(1, 1, At, B1); PG8_BAR; PG8_SCHED;
            } else {
            PG8_LDB(B0, 0, 0); PG8_SCHED; PG8_LDA(At, 0, 0); PG8_STAGE(PG8_SA(1, 1), a1 + hstep, voffA);
            PG8_WAIT_L(8); PG8_BAR; PG8_WAIT_L(0); PG8_MMA(0, 0, At, B0); PG8_BAR; PG8_SCHED;
            PG8_LDB(B1, 0, 1); PG8_STAGE(PG8_SB(0, 0), b2, voffB);
            PG8_BAR; PG8_WAIT_L(0); PG8_MMA(0, 1, At, B1); PG8_BAR;
            PG8_LDA(At, 0, 1); PG8_STAGE(PG8_SA(0, 0), a2, voffA);
            PG8_BAR; PG8_WAIT_L(0); PG8_MMA(1, 0, At, B0); PG8_BAR; PG8_SCHED;
            PG8_STAGE(PG8_SB(0, 1), b2 + hstep, voffB);
            PG8_WAIT_V(6); PG8_BAR; PG8_MMA(1, 1, At, B1); PG8_BAR;
            PG8_LDB(B0, 1, 0); PG8_SCHED; PG8_LDA(At, 1, 0); PG8_STAGE(PG8_SA(0, 1), a2 + hstep, voffA);
            PG8_WAIT_L(8); PG8_BAR; PG8_WAIT_L(0); PG8_MMA(0, 0, At, B0); PG8_BAR; PG8_SCHED;
            PG8_LDB(B1, 1, 1); PG8_STAGE(PG8_SB(1, 0), b3, voffB);
            PG8_BAR; PG8_WAIT_L(0); PG8_MMA(0, 1, At, B1); PG8_BAR;
            PG8_LDA(At, 1, 1); PG8_STAGE(PG8_SA(1, 0), a3, voffA);
            PG8_BAR; PG8_WAIT_L(0); PG8_MMA(1, 0, At, B0); PG8_BAR; PG8_SCHED;
            PG8_STAGE(PG8_SB(1, 1), b3 + hstep, voffB);
            PG8_WAIT_V(6); PG8_BAR; PG8_MMA(1, 1, At, B1); PG8_BAR;
            }
        }
        if constexpr (ALIGN_EPI) { if (wr == 0) PG8_BAR; }
        if constexpr (Epi::FP8 || Epi::I8) asm volatile("s_nop 15\n\ts_nop 7" ::: "memory");
        if constexpr (!Epi::AFTER_DRAIN) { E(acc, cur, wr, wc, fr, fq); S.done(cur); }
        if (!has_next) break;
        bool keep_acc = false; if constexpr (Epi::KEEP_ACC) keep_acc = E.keep(cur);
        if (!keep_acc) {
#pragma unroll
        for (int a = 0; a < 2; ++a)
#pragma unroll
            for (int b = 0; b < 2; ++b)
#pragma unroll
                for (int m = 0; m < 4; ++m)
#pragma unroll
                    for (int n = 0; n < 2; ++n) acc[a][b][m][n] = (f32x4){0.f, 0.f, 0.f, 0.f};
        }
        cur = nxt; cA = nA; cB = nB; ++ui;
        if constexpr (ALIGN_EPI) { if (wr == 1) PG8_BAR; }
    }
    PG8_WAIT_V(0);
    if constexpr (!ALIGN_EPI) { if (wr == 0) PG8_BAR; }
    PG8_BAR;
    if constexpr (Epi::AFTER_DRAIN) { E.fused(acc, cur, wr, wc, fr, fq, lds, wid, lane); S.done(cur); }
#undef PG8_SA
#undef PG8_SB
#undef PG8_STAGE
#undef PG8_LDA
#undef PG8_LDB
#undef PG8_MMA
#undef PG8_WAIT_V
#undef PG8_WAIT_L
#undef PG8_BAR
#undef PG8_SCHED
}
}
#define GAS __attribute__((address_space(1)))
#define LAS __attribute__((address_space(3)))
typedef unsigned short bf16;
typedef unsigned v4u __attribute__((ext_vector_type(4)));
typedef float f32x4 __attribute__((ext_vector_type(4)));
typedef short bf16x8 __attribute__((ext_vector_type(8)));
typedef GAS unsigned gu32;
typedef GAS unsigned long long gu64;
#define RLX_AGENT __ATOMIC_RELAXED, __HIP_MEMORY_SCOPE_AGENT
#define LDS_WAIT() asm volatile("s_waitcnt lgkmcnt(0)" ::: "memory")
#define VM_WAIT() asm volatile("s_waitcnt vmcnt(0)" ::: "memory")
__device__ __forceinline__ unsigned long long rt() { return __builtin_amdgcn_s_memrealtime(); }
__device__ __forceinline__ unsigned f2bf(float f) { unsigned u = __builtin_bit_cast(unsigned, f); return (u + 0x7fffu + ((u >> 16) & 1u)) >> 16; }
__device__ __forceinline__ unsigned pk2(float lo, float hi) { return f2bf(lo) | (f2bf(hi) << 16); }

#define XB_TMO      128
#define XB_XCNT(j)  (256  + 64 * (j))
#define XB_XSUB(j)  (1280 + 64 * (j))
#define XB_XGEN(j)  (2304 + 64 * (j))
#define XB_TOP      3328
#define XB_TOPGEN   3392
#define XCD_BAR_WORDS 3456
#define XB_SPIN_CAP (1u << 18)

__device__ __forceinline__ unsigned xb_ld(unsigned* p)              { return __hip_atomic_load(p, __ATOMIC_RELAXED, __HIP_MEMORY_SCOPE_AGENT); }
__device__ __forceinline__ unsigned xb_add(unsigned* p, unsigned v) { return __hip_atomic_fetch_add(p, v, __ATOMIC_RELAXED, __HIP_MEMORY_SCOPE_AGENT); }
__device__ __forceinline__ unsigned xb_xcc_id() { return (unsigned)__builtin_amdgcn_s_getreg((3 << 11) | 20) & 0xFu; }
#define XB_SPIN(cond, bar) do { unsigned _sp = 0; while (cond) { __builtin_amdgcn_s_sleep(1); \
    if ((++_sp & 255u) == 0u) { if (xb_ld(&(bar)[XB_TMO])) break; if (_sp > XB_SPIN_CAP) { atomicAdd(&(bar)[XB_TMO], 1u); break; } } } } while (0)

struct XcdBarrier {
    unsigned* bar; unsigned x;
    volatile LAS unsigned* st;
};

__device__ __forceinline__ XcdBarrier xcd_barrier_post(unsigned* bar, volatile LAS unsigned* st) {
    XcdBarrier b; b.bar = bar; b.x = xb_xcc_id(); b.st = st;
    if (threadIdx.x == 0) (void)xb_add(&bar[XB_XCNT(b.x)], 1u);
    return b;
}
__device__ __forceinline__ void xcd_barrier_complete(unsigned* bar, unsigned x, unsigned& nloc, unsigned& nx) {
    const unsigned G = gridDim.x * gridDim.y * gridDim.z;
    unsigned sum, cnt, mine, sp = 0u;
    for (;;) {
        sum = 0u; cnt = 0u; mine = 0u;
#pragma unroll
        for (unsigned j = 0; j < 16; ++j) { const unsigned c = xb_ld(&bar[XB_XCNT(j)]); sum += c; cnt += (c > 0u) ? 1u : 0u; mine = (j == x) ? c : mine; }
        if (sum == G) break;
        __builtin_amdgcn_s_sleep(1);
        if ((++sp & 255u) == 0u) { if (xb_ld(&bar[XB_TMO])) break; if (sp > XB_SPIN_CAP) { atomicAdd(&bar[XB_TMO], 1u); break; } }
    }
    nloc = mine > 0u ? mine : 1u; nx = cnt > 0u ? cnt : 1u;
}

__device__ __forceinline__ void xcd_barrier(const XcdBarrier& b) {
    asm volatile("s_waitcnt vmcnt(0)" ::: "memory");
    __syncthreads();
    if (threadIdx.x == 0) {
        unsigned* bar = b.bar;
        __builtin_amdgcn_s_waitcnt(0);
        unsigned nloc = b.st[0], nx = b.st[1];
        if (nloc == 0u) { xcd_barrier_complete(bar, b.x, nloc, nx); b.st[0] = nloc; b.st[1] = nx; }
        const unsigned old = xb_add(&bar[XB_XSUB(b.x)], 1u);
        const unsigned gen = old / nloc;
        if (old + 1u == (gen + 1u) * nloc) {
            __builtin_amdgcn_fence(__ATOMIC_RELEASE, "agent");
            asm volatile("s_waitcnt vmcnt(0)" ::: "memory");
            const unsigned og = xb_add(&bar[XB_TOP], 1u);
            const unsigned tg = og / nx;
            if (og + 1u == (tg + 1u) * nx) xb_add(&bar[XB_TOPGEN], 1u);
            else XB_SPIN(xb_ld(&bar[XB_TOPGEN]) == tg, bar);
            __builtin_amdgcn_fence(__ATOMIC_ACQUIRE, "agent");
            xb_add(&bar[XB_XGEN(b.x)], 1u);
            asm volatile("s_waitcnt vmcnt(0)" ::: "memory");
        } else {
            XB_SPIN(xb_ld(&bar[XB_XGEN(b.x)]) == gen, bar);
            __builtin_amdgcn_fence(__ATOMIC_ACQUIRE, "agent");
            asm volatile("s_waitcnt vmcnt(0)" ::: "memory");
        }
    }
    __syncthreads();
}
#define DI __device__ __forceinline__
#define CAS __attribute__((address_space(4)))
typedef unsigned v2u __attribute__((ext_vector_type(2)));
typedef float f32x16 __attribute__((ext_vector_type(16)));
typedef short s16x4 __attribute__((ext_vector_type(4)));

constexpr int DM = 4096, NB = 8, SEQ = 2048, DEPTH = 2, DSEQ = 64, PAST = 1024, KCATN = PAST + DSEQ;
constexpr int NMEM = 256, BW = 1024, AH = 16, AHD = 64, SHW = 3200;
constexpr int BHN = 8, BHD = 128, CGN = 8, CGD = 128, MHN = 4, MHD = 256;
constexpr int NIN = 12416, NINP = 12544, LDP = DM + 64;
constexpr int MP = NB * SEQ, MS = NB * DSEQ, MT = MP + MS;
constexpr int PC_R = 0, PC_K = 1024, PC_V = 2048, PC_WD = 3072, PC_AD = 3136, PC_AZ = 3328, PC_BQ = 4352, PC_BK = 5376, PC_BV = 6400, PC_BZ = 7424,
              PC_CU = 8448, PC_CV = 9472, PC_CZ = 10496, PC_MQ = 11520;
constexpr float NORM_EPS = 1e-6f, GN_EPS = 64e-5f;
enum { I_XP = 0, I_XS, I_CMK, I_CMV, I_CSK, I_CSV, I_SRW, I_SSH, I_MEM, I_GPRE, I_GPOST, I_WIN, I_AMU, I_AW0, I_AWUP, I_AA0, I_AAUP, I_AKK, I_AKA, I_ARK,
       I_AGNW, I_AGNB, I_CWS, I_CBS, I_CLNW, I_CLNB, I_GMEM, I_WMEM, I_WGATE, I_BGATE, I_WBR, I_WOUT, N_INPUTS };
constexpr size_t O_YP = 0, O_YS = O_YP + (size_t)MP * DM, O_MK = O_YS + (size_t)MS * DM, O_MV = O_MK + (size_t)DEPTH * NB * NMEM * BW,
    O_SKP = O_MV + (size_t)DEPTH * NB * NMEM * BW, O_SVP = O_SKP + (size_t)DEPTH * MP * BW, O_RWP = O_SVP + (size_t)DEPTH * MP * BW,
    O_SHP = O_RWP + (size_t)DEPTH * NB * AH * 64 * 64, O_SKS = O_SHP + (size_t)DEPTH * NB * SHW, O_SVS = O_SKS + (size_t)DEPTH * MS * BW,
    O_RWS = O_SVS + (size_t)DEPTH * MS * BW, O_SHS = O_RWS + (size_t)DEPTH * NB * AH * 64 * 64, O_CVS = O_SHS + (size_t)DEPTH * NB * SHW,
    O_END = O_CVS + (size_t)DEPTH * MS * BW;
constexpr size_t MiB = 1u << 20;
constexpr size_t WS_CTL = 0, CTL_ZERO_BYTES = 1 * MiB;
constexpr size_t WS_WIN = 1 * MiB, WS_WG = 99 * MiB, WS_WBR = 227 * MiB, WS_WOUT = 259 * MiB, WS_WMEM = 291 * MiB;
constexpr size_t WS_H = 323 * MiB, WS_MEMN = 455 * MiB, WS_PROJ = 487 * MiB, WS_MERGED = WS_PROJ, WS_OUTF = WS_PROJ + 132 * MiB;
constexpr size_t WS_RA = 892 * MiB, WS_RB = 1222 * MiB, WS_SCANV = 1552 * MiB, WS_OALL = 1618 * MiB, WS_VT = 1750 * MiB, WS_VNT = 1782 * MiB;
constexpr size_t R_YRAW_OFF = 264 * MiB;
constexpr size_t WS_KCAT = 1816 * MiB, WS_VTCAT = 1850 * MiB, WS_MKB = 1884 * MiB, WS_MVT = 1892 * MiB, WS_CMK = 1900 * MiB, WS_CMVT = 1908 * MiB;
constexpr size_t WS_WM = 1916 * MiB, WS_BONUS = 1917 * MiB, WS_DBG = 1919 * MiB, WS_UPT = WS_DBG, WS_H8 = 1920 * MiB, WS_END = 2035 * MiB;
constexpr size_t WS_PARTS = WS_VT;
static_assert(WS_PARTS + (size_t)8 * MS * DM * 4 <= WS_KCAT, "parts");
static_assert(WS_WIN + (size_t)NINP * DM * 2 <= WS_WG && WS_WG + (size_t)4 * DM * DM * 2 <= WS_WBR && WS_WBR + (size_t)4 * DM * BW * 2 <= WS_WOUT && WS_WOUT + (size_t)DM * DM * 2 <= WS_WMEM, "ws map 1");
static_assert(WS_WMEM + (size_t)DEPTH * 2 * BW * DM * 2 <= WS_H && WS_H + (size_t)MT * DM * 2 <= WS_MEMN && WS_MEMN + (size_t)DEPTH * NB * NMEM * DM * 2 <= WS_PROJ, "ws map 2");
static_assert(WS_PROJ + (size_t)MT * NINP * 2 <= WS_RA && WS_MERGED + (size_t)MT * DM * 2 <= WS_OUTF && WS_OUTF + (size_t)MT * DM * 4 <= WS_RA, "ws map 3");
static_assert(WS_RA + (size_t)MT * AH * 5 * 64 * 4 <= WS_RB && WS_RB + (size_t)MT * AH * 5 * 64 * 4 <= WS_SCANV && (size_t)MT * 4 * DM <= R_YRAW_OFF && R_YRAW_OFF + (size_t)MT * BW * 4 <= WS_RB - WS_RA, "ws map 4");
static_assert(WS_SCANV + (size_t)MT * BW * 4 <= WS_OALL && WS_OALL + (size_t)4 * MT * BW * 2 <= WS_VT && WS_VT + (size_t)MP * BW * 2 <= WS_VNT && WS_VNT + (size_t)136 * 8 * 128 * 128 * 2 <= WS_KCAT, "ws map 5");
static_assert(WS_KCAT + (size_t)DEPTH * NB * KCATN * BW * 2 <= WS_VTCAT && WS_VTCAT + (size_t)DEPTH * NB * KCATN * BW * 2 <= WS_MKB, "ws map 6");
constexpr int CW_TMO = 0, CW_BAR = 4096;
constexpr int LDS_BYTES = 147456, LDSCTL_OFF = 146944;
constexpr int NWAVES = 8, NTHR = 512, GRID = 256;
constexpr int N_PHASES = 2 + 7 * DEPTH;
#define SCAN5P(F, l) ((float*)((F).ws + (((l) & 1) ? WS_RB : WS_RA)))
#define GATESP(F, l) ((F).ws + (((l) & 1) ? WS_RA : WS_RB))
#define YRAWP(F, l) ((float*)((F).ws + (((l) & 1) ? WS_RA : WS_RB) + R_YRAW_OFF))
#define SCANVP(F) ((float*)((F).ws + WS_SCANV))
#define WGP(F, l) ((F).ws + WS_WG + (size_t)(l) * 64 * MiB)
#define WBRP(F, l) ((bf16*)((F).ws + ((l) ? WS_MEMN : WS_WBR)))
#define WOUTP(F, l) ((bf16*)((F).ws + ((l) ? WS_WMEM : WS_WOUT)))
#define HSP(F) ((float*)((F).ws + WS_BONUS + 3 * MiB / 2))
#define CMAX_WIN(F, l) ((float*)((F).ws + WS_CTL + 256 * 1024) + (size_t)(l) * NINP)
#define CMAX_WG(F, l) ((float*)((F).ws + WS_CTL + 256 * 1024) + (size_t)DEPTH * NINP + (size_t)(l) * 4 * DM)
static_assert(256 * 1024 + ((size_t)DEPTH * NINP + (size_t)DEPTH * 4 * DM) * 4 <= CTL_ZERO_BYTES, "cmax in the zeroed control region");
constexpr size_t WS_WIN8 = 1986 * MiB;
static_assert(WS_WIN8 + (size_t)NINP * DM <= 2048 * MiB, "win8");
#ifndef W_IN_INT8_TILES
#define W_IN_INT8_TILES 0x1e1fffffe2000ull
#endif
constexpr unsigned long long WIN_I8_MASK = W_IN_INT8_TILES, WIN_BF_MASK = ((1ull << 49) - 1) & ~WIN_I8_MASK;
constexpr int WIN_I8U = __builtin_popcountll(WIN_I8_MASK) * ((MT + 255) / 256), WIN_BFU = __builtin_popcountll(WIN_BF_MASK) * ((MT + 255) / 256);
constexpr int WIN_NSLOW0 = WIN_BFU % GRID, WIN_RS0 = WIN_I8U / GRID - 1;
constexpr bool WIN_SKEW = WIN_NSLOW0 > 0 && WIN_RS0 > 0 && (WIN_I8U - WIN_RS0 * GRID) <= 2 * (GRID - WIN_NSLOW0);
constexpr int WIN_NSLOW = WIN_SKEW ? WIN_NSLOW0 : 0, WIN_RS = WIN_SKEW ? WIN_RS0 : (1 << 20);
#define SWZ_XOR(v, x) __int_as_float(__builtin_amdgcn_ds_swizzle(__float_as_int(v), ((x) << 10) | 0x1f))
DI float xor32_sum(float v) { const auto r = __builtin_amdgcn_permlane32_swap(__float_as_uint(v), __float_as_uint(v), false, false); return __uint_as_float(r[0]) + __uint_as_float(r[1]); }
DI float xor32_max(float v) { const auto r = __builtin_amdgcn_permlane32_swap(__float_as_uint(v), __float_as_uint(v), false, false); return fmaxf(__uint_as_float(r[0]), __uint_as_float(r[1])); }
DI float xor32_partner(float v, int h) { const auto r = __builtin_amdgcn_permlane32_swap(__float_as_uint(v), __float_as_uint(v), false, false); return h ? __uint_as_float(r[0]) : __uint_as_float(r[1]); }
DI float wave_sum(float v) { v += SWZ_XOR(v, 1); v += SWZ_XOR(v, 2); v += SWZ_XOR(v, 4); v += SWZ_XOR(v, 8); v += SWZ_XOR(v, 16); return xor32_sum(v); }
DI float bflo(unsigned w) { return __uint_as_float(w << 16); }
DI float bfhi(unsigned w) { return __uint_as_float(w & 0xffff0000u); }
DI float bf2f(bf16 b) { return __uint_as_float(((unsigned)b) << 16); }
DI float sigmoidf_(float x) { return __builtin_amdgcn_rcpf(1.0f + __expf(-x)); }
DI float siluf_(float x) { return x * sigmoidf_(x); }
DI int crow16(int i, int h) { return (i & 3) + 8 * (i >> 2) + 4 * h; }
#define MFMA32(a, b, c) __builtin_amdgcn_mfma_f32_32x32x16_bf16((a), (b), (c), 0, 0, 0)
DI bf16x8 pack8(float a0, float a1, float a2, float a3, float a4, float a5, float a6, float a7) {
    v4u p; p.x = pk2(a0, a1); p.y = pk2(a2, a3); p.z = pk2(a4, a5); p.w = pk2(a6, a7); return __builtin_bit_cast(bf16x8, p);
}
DI void tr64_f32(const float* src, size_t lds_, bf16* dst, size_t ldd, LAS float* scr, int lane) {
#pragma unroll 4
    for (int i = 0; i < 16; ++i) { const int kk = 4 * i + (lane >> 4); const f32x4 v = *(const GAS f32x4*)(src + (size_t)kk * lds_ + 4 * (lane & 15));
        LAS float* s = scr + kk * 65 + 4 * (lane & 15); s[0] = v.x; s[1] = v.y; s[2] = v.z; s[3] = v.w; }
    LDS_WAIT(); asm volatile("" ::: "memory");
    const int c = lane & 7;
#pragma unroll
    for (int j = 0; j < 8; ++j) { const int n = (lane >> 3) + 8 * j; const LAS float* s = scr + (8 * c) * 65 + n;
        v4u o; o.x = pk2(s[0 * 65], s[1 * 65]); o.y = pk2(s[2 * 65], s[3 * 65]); o.z = pk2(s[4 * 65], s[5 * 65]); o.w = pk2(s[6 * 65], s[7 * 65]);
        *(GAS v4u*)(dst + (size_t)n * ldd + 8 * c) = o; }
    LDS_WAIT(); asm volatile("" ::: "memory");
}
DI unsigned pk4_fp8(float a, float b, float c, float d) { int w = __builtin_amdgcn_cvt_pk_fp8_f32(a, b, 0, false); w = __builtin_amdgcn_cvt_pk_fp8_f32(c, d, w, true); return (unsigned)w; }
DI void tr64_f32_fp8(const float* src, size_t lds_, unsigned char* dst, size_t ldd, float scale, LAS float* scr, int lane) {
#pragma unroll 4
    for (int i = 0; i < 16; ++i) { const int kk = 4 * i + (lane >> 4); const f32x4 v = *(const GAS f32x4*)(src + (size_t)kk * lds_ + 4 * (lane & 15));
        LAS float* s = scr + kk * 65 + 4 * (lane & 15); s[0] = v.x; s[1] = v.y; s[2] = v.z; s[3] = v.w; }
    LDS_WAIT(); asm volatile("" ::: "memory");
    const int c = lane & 7;
#pragma unroll
    for (int j = 0; j < 8; ++j) { const int n = (lane >> 3) + 8 * j; const LAS float* s = scr + (8 * c) * 65 + n;
        v2u o; o.x = pk4_fp8(s[0 * 65] * scale, s[1 * 65] * scale, s[2 * 65] * scale, s[3 * 65] * scale); o.y = pk4_fp8(s[4 * 65] * scale, s[5 * 65] * scale, s[6 * 65] * scale, s[7 * 65] * scale);
        *(GAS v2u*)(dst + (size_t)n * ldd + 8 * c) = o; }
    LDS_WAIT(); asm volatile("" ::: "memory");
}
DI void tr64_ld(f32x4 (&v)[16], const float* src, size_t lds_, int lane) {
#pragma unroll
    for (int i = 0; i < 16; ++i) { const int kk = 4 * i + (lane >> 4); v[i] = *(const GAS f32x4*)(src + (size_t)kk * lds_ + 4 * (lane & 15)); }
}
DI void tile_colmax(const f32x4 (&v)[16], float* cm, int lane) {
    f32x4 m = (f32x4){0.f, 0.f, 0.f, 0.f};
#pragma unroll
    for (int i = 0; i < 16; ++i) { m.x = fmaxf(m.x, fabsf(v[i].x)); m.y = fmaxf(m.y, fabsf(v[i].y)); m.z = fmaxf(m.z, fabsf(v[i].z)); m.w = fmaxf(m.w, fabsf(v[i].w)); }
    m.x = fmaxf(m.x, SWZ_XOR(m.x, 16)); m.y = fmaxf(m.y, SWZ_XOR(m.y, 16)); m.z = fmaxf(m.z, SWZ_XOR(m.z, 16)); m.w = fmaxf(m.w, SWZ_XOR(m.w, 16));
    m.x = xor32_max(m.x); m.y = xor32_max(m.y); m.z = xor32_max(m.z); m.w = xor32_max(m.w);
    if (lane < 16) { unsigned* c = (unsigned*)cm + 4 * lane; atomicMax(c, __float_as_uint(m.x)); atomicMax(c + 1, __float_as_uint(m.y)); atomicMax(c + 2, __float_as_uint(m.z)); atomicMax(c + 3, __float_as_uint(m.w)); }
}
DI void tr64_put(const f32x4 (&v)[16], LAS float* scr, int lane) {
#pragma unroll
    for (int i = 0; i < 16; ++i) { const int kk = 4 * i + (lane >> 4); LAS float* s = scr + kk * 65 + 4 * (lane & 15); s[0] = v[i].x; s[1] = v[i].y; s[2] = v[i].z; s[3] = v[i].w; }
    LDS_WAIT(); asm volatile("" ::: "memory");
}
DI unsigned q8(float v) { return (unsigned)(int)rintf(fminf(fmaxf(v, -127.f), 127.f)) & 255u; }
DI unsigned pk4_i8(float a, float b, float c, float d) { return q8(a) | (q8(b) << 8) | (q8(c) << 16) | (q8(d) << 24); }
template <int MODE> DI void tr64_get(void* dst_, size_t ldd, float scale, const float* cmax, const LAS float* scr, int lane) {
    const int c = lane & 7;
    float cmv[8];
#pragma unroll
    for (int j = 0; j < 8; ++j) cmv[j] = (MODE == 2) ? cmax[(lane >> 3) + 8 * j] : 0.f;
#pragma unroll
    for (int j = 0; j < 8; ++j) { const int n = (lane >> 3) + 8 * j; const LAS float* s = scr + (8 * c) * 65 + n;
        if (MODE == 1) { v2u o; o.x = pk4_fp8(s[0 * 65] * scale, s[1 * 65] * scale, s[2 * 65] * scale, s[3 * 65] * scale); o.y = pk4_fp8(s[4 * 65] * scale, s[5 * 65] * scale, s[6 * 65] * scale, s[7 * 65] * scale);
            *(GAS v2u*)((unsigned char*)dst_ + (size_t)n * ldd + 8 * c) = o; }
        else if (MODE == 2) { const float cm = cmv[j]; const float iv = cm > 0.f ? 127.0f / cm : 0.f;
            v2u o; o.x = pk4_i8(s[0 * 65] * iv, s[1 * 65] * iv, s[2 * 65] * iv, s[3 * 65] * iv); o.y = pk4_i8(s[4 * 65] * iv, s[5 * 65] * iv, s[6 * 65] * iv, s[7 * 65] * iv);
            *(GAS v2u*)((unsigned char*)dst_ + (size_t)n * ldd + 8 * c) = o; }
        else { v4u o; o.x = pk2(s[0 * 65], s[1 * 65]); o.y = pk2(s[2 * 65], s[3 * 65]); o.z = pk2(s[4 * 65], s[5 * 65]); o.w = pk2(s[6 * 65], s[7 * 65]);
            *(GAS v4u*)((bf16*)dst_ + (size_t)n * ldd + 8 * c) = o; } }
    LDS_WAIT(); asm volatile("" ::: "memory");
}
DI void tr64_bf16(const bf16* src, size_t lds_, bf16* dst, size_t ldd, LAS unsigned* scr, int lane) {
#pragma unroll
    for (int i = 0; i < 8; ++i) { const int t = 8 * i + (lane >> 3); const v4u v = *(const GAS v4u*)(src + (size_t)t * lds_ + 8 * (lane & 7));
        LAS unsigned* s = scr + t * 33 + 4 * (lane & 7); s[0] = v.x; s[1] = v.y; s[2] = v.z; s[3] = v.w; }
    LDS_WAIT(); asm volatile("" ::: "memory");
    const int c = lane & 7; const LAS bf16* s16 = (const LAS bf16*)scr;
#pragma unroll
    for (int j = 0; j < 8; ++j) { const int d = (lane >> 3) + 8 * j; const LAS bf16* s = s16 + (8 * c) * 66 + d;
        v4u o; o.x = (unsigned)s[0 * 66] | ((unsigned)s[1 * 66] << 16); o.y = (unsigned)s[2 * 66] | ((unsigned)s[3 * 66] << 16);
        o.z = (unsigned)s[4 * 66] | ((unsigned)s[5 * 66] << 16); o.w = (unsigned)s[6 * 66] | ((unsigned)s[7 * 66] << 16);
        *(GAS v4u*)(dst + (size_t)d * ldd + 8 * c) = o; }
    LDS_WAIT(); asm volatile("" ::: "memory");
}
DI void rms_row_bf16(const float* xrow, const float* g, bf16* orow, unsigned char* orow8, int lane) {
    const GAS f32x4* xr = (const GAS f32x4*)xrow + lane; const GAS f32x4* gr = (const GAS f32x4*)g + lane;
    f32x4 v[16], gq[16]; float s = 0.f;
#pragma unroll
    for (int j = 0; j < 16; ++j) { v[j] = xr[64 * j]; gq[j] = gr[64 * j]; }
#pragma unroll
    for (int j = 0; j < 16; ++j) s += (v[j].x * v[j].x + v[j].y * v[j].y) + (v[j].z * v[j].z + v[j].w * v[j].w);
    const float rstd = 1.0f / sqrtf(wave_sum(s) * (1.0f / DM) + NORM_EPS);
    GAS v2u* o8 = (GAS v2u*)orow + lane; GAS unsigned* q8 = (GAS unsigned*)orow8 + lane;
#pragma unroll
    for (int j = 0; j < 16; ++j) { const f32x4 gg = gq[j]; const float a0 = v[j].x * rstd * gg.x, a1 = v[j].y * rstd * gg.y, a2 = v[j].z * rstd * gg.z, a3 = v[j].w * rstd * gg.w;
        v2u w; w.x = pk2(a0, a1); w.y = pk2(a2, a3); o8[64 * j] = w; if (orow8) q8[64 * j] = pk4_fp8(a0, a1, a2, a3); }
}
DI void rms_row_i8(const float* xrow, const float* g, unsigned char* orow8, float* oscale, bf16* orow, int lane) {
    const GAS f32x4* xr = (const GAS f32x4*)xrow + lane; const GAS f32x4* gr = (const GAS f32x4*)g + lane;
    f32x4 v[16], gq[16]; float s = 0.f;
#pragma unroll
    for (int j = 0; j < 16; ++j) { v[j] = xr[64 * j]; gq[j] = gr[64 * j]; }
#pragma unroll
    for (int j = 0; j < 16; ++j) s += (v[j].x * v[j].x + v[j].y * v[j].y) + (v[j].z * v[j].z + v[j].w * v[j].w);
    const float rstd = 1.0f / sqrtf(wave_sum(s) * (1.0f / DM) + NORM_EPS); float am = 0.f;
#pragma unroll
    for (int j = 0; j < 16; ++j) { const f32x4 gg = gq[j]; v[j] = v[j] * rstd * gg; am = fmaxf(am, fmaxf(fmaxf(fabsf(v[j].x), fabsf(v[j].y)), fmaxf(fabsf(v[j].z), fabsf(v[j].w)))); }
    am = fmaxf(am, SWZ_XOR(am, 1)); am = fmaxf(am, SWZ_XOR(am, 2)); am = fmaxf(am, SWZ_XOR(am, 4)); am = fmaxf(am, SWZ_XOR(am, 8)); am = fmaxf(am, SWZ_XOR(am, 16)); am = xor32_max(am);
    const float iv = am > 0.f ? 127.0f / am : 0.f; GAS unsigned* q = (GAS unsigned*)orow8 + lane;
#pragma unroll
    for (int j = 0; j < 16; ++j) q[64 * j] = pk4_i8(v[j].x * iv, v[j].y * iv, v[j].z * iv, v[j].w * iv);
    GAS v2u* o8 = (GAS v2u*)orow + lane;
#pragma unroll
    for (int j = 0; j < 16; ++j) { v2u w; w.x = pk2(v[j].x, v[j].y); w.y = pk2(v[j].z, v[j].w); o8[64 * j] = w; }
    if (lane == 0) *oscale = am * (1.0f / 127.0f);
}
struct P { const float* in[N_INPUTS]; float* out; unsigned char* ws; int ph_lo, ph_hi, dbg, pad; };
struct Frame {
    LAS unsigned char* lds; int tid, lane, wave, bx, G, gw, ngw;
    float* out; unsigned char* ws;
};
DI const float* xrow_in(const P& p, int row) { return row < MP ? p.in[I_XP] + (size_t)row * DM : p.in[I_XS] + (size_t)(row - MP) * DM; }

#define FOR_ITEMS(it, n, id, nid, rot) for (int it = ((id) - (rot) + (nid)) % (nid); it < (n); it += (nid))
#define ROT_ADV(rot, n, nid) rot = (int)(((long)(rot) + (long)(n)) % (nid))

template <int MODE> DI void conv_weight_t(const Frame& F, const float* Wsrc, int NM, int K, int N, void* WT, int split_n, int split_shift, float scale, const float* cmax, int id, int nid, int& rot, int ldw = 0) {
    if (ldw == 0) ldw = N;
    LAS float* scr = (LAS float*)(F.lds + F.wave * 16640);
    const int nb = N / 64, per = (K / 64) * nb, nitems = NM * per;
    int it = (id - rot + nid) % nid;
    f32x4 cur[16];
#define CW_SRC(i) (Wsrc + (size_t)((i) / per) * K * ldw + (size_t)((((i) % per) / nb) * 64) * ldw + (((i) % per) % nb) * 64)
    if (it < nitems) tr64_ld(cur, CW_SRC(it), (size_t)ldw, F.lane);
    for (; it < nitems; it += nid) {
        const int m = it / per, r = it % per, kb = r / nb, n0 = (r % nb) * 64; const int ro = m * N + n0 + (n0 >= split_n ? split_shift : 0);
        const int itn = it + nid;
        void* dst = MODE ? (void*)((unsigned char*)WT + (size_t)ro * K + kb * 64) : (void*)((bf16*)WT + (size_t)ro * K + kb * 64);
        tr64_put(cur, scr, F.lane);
        if (itn < nitems) tr64_ld(cur, CW_SRC(itn), (size_t)ldw, F.lane);
        tr64_get<MODE>(dst, (size_t)K, scale, cmax + ro, scr, F.lane);
    }
    ROT_ADV(rot, nitems, nid);
#undef CW_SRC
}
DI void conv_weight(const Frame& F, const float* Wsrc, int K, int N, bf16* WT, int split_n, int split_shift, int id, int nid, int& rot) { conv_weight_t<0>(F, Wsrc, 1, K, N, WT, split_n, split_shift, 1.f, nullptr, id, nid, rot); }
DI void colmax_weight(const Frame& F, const float* Wsrc, int NM, int K, int N, float* cm, int split_n, int split_shift, int id, int nid, int& rot, int ldw = 0) {
    if (ldw == 0) ldw = N;
    const int nb = N / 64, per = (K / 64) * nb, nitems = NM * per;
    FOR_ITEMS(it, nitems, id, nid, rot) { const int m = it / per, r = it % per, kb = r / nb, n0 = (r % nb) * 64; const int ro = m * N + n0 + (n0 >= split_n ? split_shift : 0);
        f32x4 v[16]; tr64_ld(v, Wsrc + (size_t)m * K * ldw + (size_t)(kb * 64) * ldw + n0, (size_t)ldw, F.lane); tile_colmax(v, cm + ro, F.lane); }
    ROT_ADV(rot, nitems, nid);
}
DI void colmax_layer(const P& p, const Frame& F, int l, int id, int nid, int& rot) {
    for (int t = 0; t < 49;) { if (!((WIN_I8_MASK >> t) & 1ull)) { ++t; continue; } int t1 = t; while (t1 < 49 && ((WIN_I8_MASK >> t1) & 1ull) && (t1 == t || t1 != 13)) ++t1;
        const int pc0 = 256 * t, pc1 = (t1 == 13 || (t1 > 12 && t <= 12)) ? 3200 : 256 * t1, oc0 = pc0 >= 3328 ? pc0 - 128 : pc0;
        colmax_weight(F, p.in[I_WIN] + (size_t)l * DM * NIN + oc0, 1, DM, pc1 - pc0, CMAX_WIN(F, l) + pc0, 1 << 30, 0, id, nid, rot, NIN); t = t1; }
    colmax_weight(F, p.in[I_WGATE] + (size_t)l * 4 * DM * DM, 4, DM, DM, CMAX_WG(F, l), 1 << 30, 0, id, nid, rot);
}
template <int MODE> DI void conv_win_cols(const P& p, const Frame& F, int l, int pc0, int pc1, int id, int nid, int& rot) {
    const int oc0 = pc0 >= 3328 ? pc0 - 128 : pc0;
    if (MODE == 2) conv_weight_t<2>(F, p.in[I_WIN] + (size_t)l * DM * NIN + oc0, 1, DM, pc1 - pc0, (void*)(F.ws + WS_WIN8 + (size_t)pc0 * DM), 1 << 30, 0, 1.f, CMAX_WIN(F, l) + pc0, id, nid, rot, NIN);
    else conv_weight_t<0>(F, p.in[I_WIN] + (size_t)l * DM * NIN + oc0, 1, DM, pc1 - pc0, (void*)(((bf16*)(F.ws + WS_WIN)) + (size_t)pc0 * DM), 1 << 30, 0, 1.f, nullptr, id, nid, rot, NIN);
}
template <int MODE> DI void conv_win_mask(const P& p, const Frame& F, int l, unsigned long long mask, int id, int nid, int& rot) {
    for (int t = 0; t < 49;) { if (!((mask >> t) & 1ull)) { ++t; continue; } int t1 = t; while (t1 < 49 && ((mask >> t1) & 1ull) && (t1 == t || t1 != 13)) ++t1;
        const int pc0 = 256 * t, pc1 = (t1 == 13 || (t1 > 12 && t <= 12)) ? 3200 : 256 * t1;
        conv_win_cols<MODE>(p, F, l, pc0, pc1, id, nid, rot); t = t1; }
}
DI void conv_layer_win(const P& p, const Frame& F, int l, int id, int nid, int& rot) { conv_win_mask<2>(p, F, l, WIN_I8_MASK, id, nid, rot); conv_win_mask<0>(p, F, l, WIN_BF_MASK, id, nid, rot); }
DI void conv_layer_wgate(const P& p, const Frame& F, int l, int id, int nid, int& rot) {
    conv_weight_t<2>(F, p.in[I_WGATE] + (size_t)l * 4 * DM * DM, 4, DM, DM, (void*)WGP(F, l), 1 << 30, 0, 1.f, CMAX_WG(F, l), id, nid, rot); }
DI void conv_layer_wbr(const P& p, const Frame& F, int l, int id, int nid, int& rot) { conv_weight_t<0>(F, p.in[I_WBR] + (size_t)l * 4 * BW * DM, 4, BW, DM, WBRP(F, l), 1 << 30, 0, 1.f, nullptr, id, nid, rot); }
DI void conv_layer_wout(const P& p, const Frame& F, int l, int id, int nid, int& rot) { conv_weight(F, p.in[I_WOUT] + (size_t)l * DM * DM, DM, DM, WOUTP(F, l), 1 << 30, 0, id, nid, rot); }
DI void conv_caches(const P& p, const Frame& F, int l, int wid, int nw, int& rot) {
    LAS float* scr = (LAS float*)(F.lds + F.wave * 16640);
    {
        const int nitems = NB * BHN * (PAST / 64) * (BHD / 64);
        FOR_ITEMS(it, nitems, wid, nw, rot) { const int dt = it & 1, pt = (it >> 1) & 15, h = (it >> 5) & 7, lb = l * NB + (it >> 8);
            tr64_f32(p.in[I_CSV] + ((size_t)lb * PAST + pt * 64) * BW + h * BHD + dt * 64, (size_t)BW, ((bf16*)(F.ws + WS_VTCAT)) + ((size_t)(lb * BHN + h) * BHD + dt * 64) * KCATN + pt * 64, (size_t)KCATN, scr, F.lane); }
        ROT_ADV(rot, nitems, nw);
    }
    {
        const int nitems = NB * MHN * 4 * 4;
        FOR_ITEMS(it, nitems, wid, nw, rot) { const int dt = it & 3, mt = (it >> 2) & 3, hm = (it >> 4) & 3, lb = l * NB + (it >> 6);
            tr64_f32(p.in[I_CMV] + ((size_t)lb * NMEM + mt * 64) * BW + hm * MHD + dt * 64, (size_t)BW, ((bf16*)(F.ws + WS_CMVT)) + ((size_t)(lb * MHN + hm) * MHD + dt * 64) * NMEM + mt * 64, (size_t)NMEM, scr, F.lane); }
        ROT_ADV(rot, nitems, nw);
    }
    const int gt = wid * 64 + F.lane, ngt = nw * 64;
    for (long i = gt; i < (long)NB * PAST * (BW / 8); i += ngt) { const int c8 = (int)(i & 127); const long r = ((long)l * NB * PAST) + (i >> 7); const int pos = (int)(r & (PAST - 1)); const long lb = r >> 10;
        const GAS f32x4* s = (const GAS f32x4*)(p.in[I_CSK] + (size_t)r * BW + c8 * 8); const f32x4 a = s[0], b = s[1];
        v4u o; o.x = pk2(a.x, a.y); o.y = pk2(a.z, a.w); o.z = pk2(b.x, b.y); o.w = pk2(b.z, b.w);
        *(GAS v4u*)(((bf16*)(F.ws + WS_KCAT)) + ((size_t)lb * KCATN + pos) * BW + c8 * 8) = o; }
    for (long i = gt; i < (long)NB * NMEM * (BW / 8); i += ngt) { const size_t e = ((size_t)l * NB * NMEM * (BW / 8) + (size_t)i) * 8; const GAS f32x4* s = (const GAS f32x4*)(p.in[I_CMK] + e); const f32x4 a = s[0], b = s[1];
        v4u o; o.x = pk2(a.x, a.y); o.y = pk2(a.z, a.w); o.z = pk2(b.x, b.y); o.w = pk2(b.z, b.w); *(GAS v4u*)(((bf16*)(F.ws + WS_CMK)) + e) = o; }
}
DI void ph_prologue(const P& p, const Frame& F) {
    int rot = 0;
    colmax_layer(p, F, 0, F.gw, F.ngw, rot); colmax_layer(p, F, 1, F.gw, F.ngw, rot);
    for (int l = 0; l < DEPTH; ++l) conv_weight(F, p.in[I_WMEM] + (size_t)l * DM * 2 * BW, DM, 2 * BW, ((bf16*)(F.ws + WS_WMEM)) + (size_t)l * 2 * BW * DM, 1 << 30, 0, F.gw, F.ngw, rot);
    conv_caches(p, F, 0, F.gw, F.ngw, rot);
    const int gt = F.bx * NTHR + F.tid, ngt = F.G * NTHR;
    for (int i = gt; i < DEPTH * CGN * 128 * 128; i += ngt) { const int s = i & 127, t = (i >> 7) & 127; ((bf16*)(F.ws + WS_WM))[i] = (bf16)(s <= t ? f2bf(p.in[I_CWS][i]) : 0u); }
    for (int i = gt; i < DEPTH * 2 * BW * 64; i += ngt) { const int j = i & 63, c = (i >> 6) & 1023, lo = (i >> 16) & 1, ll = i >> 17;
        ((bf16*)(F.ws + WS_UPT))[i] = (bf16)f2bf(p.in[lo ? I_AAUP : I_AWUP][((size_t)ll * 64 + j) * BW + c]); }
    for (int i = gt; i < 128 * DM / 8; i += ngt) *(GAS v4u*)(((bf16*)(F.ws + WS_WIN)) + (size_t)3200 * DM + (size_t)i * 8) = (v4u){0u, 0u, 0u, 0u};
    for (int i = gt; i < 8 * 8 * 128 * 128 / 8; i += ngt) *(GAS v4u*)(((bf16*)(F.ws + WS_VNT)) + (size_t)128 * 8 * 128 * 128 + (size_t)i * 8) = (v4u){0u, 0u, 0u, 0u};
    for (int m = F.gw; m < MT; m += F.ngw) rms_row_i8(xrow_in(p, m), p.in[I_GPRE], (unsigned char*)(F.ws + WS_H8) + (size_t)m * DM, HSP(F) + m, ((bf16*)(F.ws + WS_H)) + (size_t)m * DM, F.lane);
    for (int m = F.gw; m < DEPTH * NB * NMEM; m += F.ngw) { const int l = m / (NB * NMEM), r = m % (NB * NMEM);
        rms_row_bf16(p.in[I_MEM] + (size_t)r * DM, p.in[I_GMEM] + (size_t)l * DM, ((bf16*)(F.ws + WS_MEMN)) + (size_t)m * DM, nullptr, F.lane); }
}
#define RW_K(cc, fr) (32 * ((fr) >> 3) + 2 * ((fr) & 7) + ((cc) & 1) + 16 * ((cc) >> 1))
#define SWZ16_SUM(v) do { v += SWZ_XOR(v, 1); v += SWZ_XOR(v, 2); v += SWZ_XOR(v, 4); v += SWZ_XOR(v, 8); } while (0)
DI void prep_rwkv_item(const P& p, const Frame& F, int l, int r0) {
    LAS bf16* tw = (LAS bf16*)F.lds; LAS bf16* ta = tw + 16 * 64;
    const bf16* proj = ((bf16*)(F.ws + WS_PROJ)); const int tid = F.tid, lane = F.lane, fr = lane & 15, fq = lane >> 4;
    const float* mu = p.in[I_AMU] + (size_t)l * SHW;
    const bool is_p = r0 < MP; const int t0 = is_p ? (r0 & (SEQ - 1)) : ((r0 - MP) & (DSEQ - 1)); const int bsm = is_p ? 0 : ((r0 - MP) >> 6);
    const float* shp = p.in[I_SSH] + (size_t)(l * NB + bsm) * SHW;
    {
        const int tok = tid >> 5, j = 2 * (tid & 31); const int row = r0 + tok; const bool first = (t0 + tok) == 0;
#pragma unroll
        for (int part = 0; part < 2; ++part) { const int pc = (part ? PC_AD : PC_WD) + j;
            const unsigned cu = *(const GAS unsigned*)(proj + (size_t)row * NINP + pc); const float c0 = bflo(cu), c1 = bfhi(cu); float p0, p1;
            if (!first) { const unsigned pu = *(const GAS unsigned*)(proj + (size_t)(row - 1) * NINP + pc); p0 = bflo(pu); p1 = bfhi(pu); }
            else if (is_p) { p0 = p1 = 0.f; }
            else { p0 = shp[pc]; p1 = shp[pc + 1]; }
            const float x0 = c0 + mu[pc] * (p0 - c0), x1 = c1 + mu[pc + 1] * (p1 - c1);
            *(LAS unsigned*)((part ? ta : tw) + tok * 64 + j) = part ? pk2(x0, x1) : pk2(tanhf(x0), tanhf(x1)); }
    }
    __syncthreads();
    LAS float* lw = (LAS float*)(F.lds + 8192); LAS float* la = lw + 16 * BW;
    {
        f32x4 accw[8], acca[8];
        const bf16* wupT = ((bf16*)(F.ws + WS_UPT)) + (size_t)(l * 2 + 0) * BW * 64; const bf16* aupT = ((bf16*)(F.ws + WS_UPT)) + (size_t)(l * 2 + 1) * BW * 64;
#pragma unroll
        for (int ct = 0; ct < 8; ++ct) { accw[ct] = (f32x4){0.f, 0.f, 0.f, 0.f}; acca[ct] = (f32x4){0.f, 0.f, 0.f, 0.f}; }
#pragma unroll
        for (int ks = 0; ks < 2; ++ks) { const bf16x8 aw = *(const LAS bf16x8*)(tw + fr * 64 + 32 * ks + 8 * fq), aa = *(const LAS bf16x8*)(ta + fr * 64 + 32 * ks + 8 * fq);
#pragma unroll
            for (int ct = 0; ct < 8; ++ct) { const size_t co = (size_t)(128 * F.wave + 64 * (ct >> 2) + RW_K(ct & 3, fr)) * 64 + 32 * ks + 8 * fq;
                accw[ct] = __builtin_amdgcn_mfma_f32_16x16x32_bf16(aw, *(const GAS bf16x8*)(wupT + co), accw[ct], 0, 0, 0);
                acca[ct] = __builtin_amdgcn_mfma_f32_16x16x32_bf16(aa, *(const GAS bf16x8*)(aupT + co), acca[ct], 0, 0, 0); } }
#pragma unroll
        for (int ct = 0; ct < 8; ++ct)
#pragma unroll
            for (int q = 0; q < 4; ++q) { const int o = (4 * fq + q) * BW + 128 * F.wave + 64 * (ct >> 2) + RW_K(ct & 3, fr); lw[o] = accw[ct][q]; la[o] = acca[ct][q]; }
    }
#pragma unroll 1
    for (int hh = 0; hh < 2; ++hh) { const int head = 2 * F.wave + hh;
        float mur[4], muk[4], muv[4], kk_[4], ka_[4], rk_[4], w0_[4], a0_[4], pr[4], pk[4], pvv[4];
#pragma unroll
        for (int cc = 0; cc < 4; ++cc) { const int c = 64 * head + RW_K(cc, fr);
            mur[cc] = mu[PC_R + c]; muk[cc] = mu[PC_K + c]; muv[cc] = mu[PC_V + c]; kk_[cc] = p.in[I_AKK][l * BW + c]; ka_[cc] = p.in[I_AKA][l * BW + c]; rk_[cc] = p.in[I_ARK][l * BW + c];
            w0_[cc] = p.in[I_AW0][l * BW + c]; a0_[cc] = p.in[I_AA0][l * BW + c];
            if (t0 + 4 * fq != 0) { const bf16* q = proj + (size_t)(r0 + 4 * fq - 1) * NINP; pr[cc] = bf2f(q[PC_R + c]); pk[cc] = bf2f(q[PC_K + c]); pvv[cc] = bf2f(q[PC_V + c]); }
            else if (is_p) { pr[cc] = pk[cc] = pvv[cc] = 0.f; }
            else { pr[cc] = shp[PC_R + c]; pk[cc] = shp[PC_K + c]; pvv[cc] = shp[PC_V + c]; } }
        bf16 qr[4][4], qk[4][4], qv[4][4]; float laq[4][4], lwq[4][4];
#pragma unroll
        for (int q = 0; q < 4; ++q) { const bf16* pq = proj + (size_t)(r0 + 4 * fq + q) * NINP;
#pragma unroll
            for (int cc = 0; cc < 4; ++cc) { const int c = 64 * head + RW_K(cc, fr); qr[q][cc] = pq[PC_R + c]; qk[q][cc] = pq[PC_K + c]; qv[q][cc] = pq[PC_V + c];
                laq[q][cc] = la[(4 * fq + q) * BW + c]; lwq[q][cc] = lw[(4 * fq + q) * BW + c]; } }
#pragma unroll
        for (int q = 0; q < 4; ++q) { const int row = r0 + 4 * fq + q;
            float xr[4], xk[4], xv[4], a[4], kkv[4], kp[4]; float ss = 0.f, bon = 0.f;
#pragma unroll
            for (int cc = 0; cc < 4; ++cc) { const float cr = bf2f(qr[q][cc]), ck = bf2f(qk[q][cc]), cv = bf2f(qv[q][cc]);
                xr[cc] = cr + mur[cc] * (pr[cc] - cr); xk[cc] = ck + muk[cc] * (pk[cc] - ck); xv[cc] = cv + muv[cc] * (pvv[cc] - cv); pr[cc] = cr; pk[cc] = ck; pvv[cc] = cv;
                a[cc] = sigmoidf_(a0_[cc] + laq[q][cc]);
                kkv[cc] = xk[cc] * kk_[cc]; ss += kkv[cc] * kkv[cc]; kp[cc] = xk[cc] * (1.0f + (a[cc] - 1.0f) * ka_[cc]); bon += xr[cc] * kp[cc] * rk_[cc]; }
            SWZ16_SUM(ss); SWZ16_SUM(bon);
            const float inv = 1.0f / fmaxf(sqrtf(ss), 1e-12f);
            float kkn[4], dd[4];
#pragma unroll
            for (int cc = 0; cc < 4; ++cc) { kkn[cc] = kkv[cc] * inv; dd[cc] = __expf(-0.6065306597126334f * sigmoidf_(w0_[cc] + lwq[q][cc])); }
            GAS f32x4* sp = (GAS f32x4*)(SCAN5P(F, l) + ((size_t)row * AH + head) * (5 * 64)) + fr;
            sp[0] = (f32x4){kkn[0], kkn[2], kkn[1], kkn[3]}; sp[16] = (f32x4){dd[0], dd[2], dd[1], dd[3]}; sp[32] = (f32x4){kkn[0] * a[0], kkn[2] * a[2], kkn[1] * a[1], kkn[3] * a[3]};
            sp[48] = (f32x4){kp[0], kp[2], kp[1], kp[3]}; sp[64] = (f32x4){xr[0], xr[2], xr[1], xr[3]};
            { float* vp = SCANVP(F) + (size_t)row * BW + 64 * head + RW_K(0, fr); vp[0] = xv[0]; vp[1] = xv[1]; vp[16] = xv[2]; vp[17] = xv[3]; }
            if (fr == 0) ((float*)(F.ws + WS_BONUS))[(size_t)row * AH + head] = bon; }
    }
    __syncthreads();
}
DI void prep_ln_item(const P& p, const Frame& F, int l, int item) {
    LAS unsigned* tile = (LAS unsigned*)F.lds;
    const int lane = F.lane; int row0, ch, s0;
    if (item < 256) { ch = item >> 1; s0 = (item & 1) * 64; row0 = ch * 128 + s0; } else { ch = 128 + (item - 256); s0 = 0; row0 = MP + (item - 256) * 64; }
    const float* lnw = p.in[I_CLNW] + (size_t)l * BW + lane * 16; const float* lnb = p.in[I_CLNB] + (size_t)l * BW + lane * 16;
    v4u ua[8], ub[8];
#pragma unroll
    for (int rr = 0; rr < 8; ++rr) { const GAS v4u* src = (const GAS v4u*)(((bf16*)(F.ws + WS_PROJ)) + (size_t)(row0 + F.wave * 8 + rr) * NINP + PC_CV + lane * 16); ua[rr] = src[0]; ub[rr] = src[1]; }
    float lw[16], lb[16];
#pragma unroll
    for (int i = 0; i < 4; ++i) { const f32x4 a = ((const GAS f32x4*)lnw)[i], b = ((const GAS f32x4*)lnb)[i];
        lw[4 * i] = a.x; lw[4 * i + 1] = a.y; lw[4 * i + 2] = a.z; lw[4 * i + 3] = a.w; lb[4 * i] = b.x; lb[4 * i + 1] = b.y; lb[4 * i + 2] = b.z; lb[4 * i + 3] = b.w; }
#pragma unroll
    for (int rr = 0; rr < 8; ++rr) { const int tr = F.wave * 8 + rr, row = row0 + tr;
        const v4u u0 = ua[rr], u1 = ub[rr];
        float x[16] = {bflo(u0.x), bfhi(u0.x), bflo(u0.y), bfhi(u0.y), bflo(u0.z), bfhi(u0.z), bflo(u0.w), bfhi(u0.w), bflo(u1.x), bfhi(u1.x), bflo(u1.y), bfhi(u1.y), bflo(u1.z), bfhi(u1.z), bflo(u1.w), bfhi(u1.w)};
        float s = 0.f;
#pragma unroll
        for (int i = 0; i < 16; ++i) s += x[i];
        const float mean = wave_sum(s) * (1.0f / BW); float q = 0.f;
#pragma unroll
        for (int i = 0; i < 16; ++i) { x[i] -= mean; q += x[i] * x[i]; }
        const float rstd = 1.0f / sqrtf(wave_sum(q) * (1.0f / BW) + NORM_EPS);
#pragma unroll
        for (int i = 0; i < 16; ++i) x[i] = x[i] * rstd * lw[i] + lb[i];
        if (row >= MP) { GAS f32x4* o = (GAS f32x4*)(F.out + O_CVS + ((size_t)l * MS + (row - MP)) * BW + lane * 16);
#pragma unroll
            for (int i = 0; i < 4; ++i) o[i] = (f32x4){x[4 * i], x[4 * i + 1], x[4 * i + 2], x[4 * i + 3]}; }
        LAS unsigned* tp = tile + tr * 513 + lane * 8;
#pragma unroll
        for (int i = 0; i < 8; ++i) tp[i] = pk2(x[2 * i], x[2 * i + 1]);
    }
    __syncthreads();
    const LAS bf16* t16 = (const LAS bf16*)tile; const int c = F.tid & 7;
    for (int pass = 0; pass < 16; ++pass) { const int dd = (F.tid >> 3) + 64 * pass; const LAS bf16* s = t16 + (8 * c) * 1026 + dd;
        v4u o; o.x = (unsigned)s[0 * 1026] | ((unsigned)s[1 * 1026] << 16); o.y = (unsigned)s[2 * 1026] | ((unsigned)s[3 * 1026] << 16);
        o.z = (unsigned)s[4 * 1026] | ((unsigned)s[5 * 1026] << 16); o.w = (unsigned)s[6 * 1026] | ((unsigned)s[7 * 1026] << 16);
        *(GAS v4u*)(((bf16*)(F.ws + WS_VNT)) + ((size_t)ch * BW + dd) * 128 + s0 + 8 * c) = o; }
    __syncthreads();
}
DI void ph_prep(const P& p, const Frame& F, int l) {
#ifndef DUP_PHASE
#define DUP_PHASE (-1)
#endif
#define REPP(k) _Pragma("unroll 1") for (int repp_ = 0; repp_ < ((DUP_PHASE) == (k) ? 2 : 1); ++repp_)
    REPP(601) for (int it = F.bx; it < MT / 16; it += F.G) prep_rwkv_item(p, F, l, it * 16);
    REPP(602) for (int it = F.bx; it < 256 + 8; it += F.G) prep_ln_item(p, F, l, it);
    int rot = 0;
    REPP(603) {
        LAS unsigned* scr = (LAS unsigned*)(F.lds + F.wave * 16640);
        const int nP = NB * BHN * (SEQ / 64) * 2, nS = NB * BHN * 2, nitems = nP + nS;
        FOR_ITEMS(it, nitems, F.gw, F.ngw, rot) {
            if (it < nP) { const int dt = it & 1, tt = (it >> 1) & 31, h = (it >> 6) & 7, b = it >> 9;
                tr64_bf16(((bf16*)(F.ws + WS_PROJ)) + ((size_t)b * SEQ + tt * 64) * NINP + PC_BV + h * BHD + dt * 64, (size_t)NINP, ((bf16*)(F.ws + WS_VT)) + ((size_t)(b * BHN + h) * BHD + dt * 64) * SEQ + tt * 64, (size_t)SEQ, scr, F.lane); }
            else { const int j = it - nP, dt = j & 1, h = (j >> 1) & 7, b = j >> 4;
                tr64_bf16(((bf16*)(F.ws + WS_PROJ)) + ((size_t)MP + b * DSEQ) * NINP + PC_BV + h * BHD + dt * 64, (size_t)NINP, ((bf16*)(F.ws + WS_VTCAT)) + ((size_t)((l * NB + b) * BHN + h) * BHD + dt * 64) * KCATN + PAST, (size_t)KCATN, scr, F.lane); } }
        ROT_ADV(rot, nitems, F.ngw);
    }
    {
        LAS float* scr = (LAS float*)(F.lds + F.wave * 16640);
        const int nitems = NB * MHN * 16;
        FOR_ITEMS(it, nitems, F.gw, F.ngw, rot) { const int dt = it & 3, mt = (it >> 2) & 3, hm = (it >> 4) & 3, b = it >> 6;
            tr64_f32(F.out + O_MV + ((size_t)(l * NB + b) * NMEM + mt * 64) * BW + hm * MHD + dt * 64, (size_t)BW, ((bf16*)(F.ws + WS_MVT)) + ((size_t)((l * NB + b) * MHN + hm) * MHD + dt * 64) * NMEM + mt * 64, (size_t)NMEM, scr, F.lane); }
        ROT_ADV(rot, nitems, F.ngw);
    }
    const int gt = F.bx * NTHR + F.tid, ngt = F.G * NTHR;
    for (int i = gt; i < NB * NMEM * (BW / 8); i += ngt) { const GAS f32x4* s = (const GAS f32x4*)(F.out + O_MK + (size_t)l * NB * NMEM * BW + (size_t)i * 8); const f32x4 a = s[0], b = s[1];
        v4u o; o.x = pk2(a.x, a.y); o.y = pk2(a.z, a.w); o.z = pk2(b.x, b.y); o.w = pk2(b.z, b.w); *(GAS v4u*)(((bf16*)(F.ws + WS_MKB)) + (size_t)l * NB * NMEM * BW + (size_t)i * 8) = o; }
    for (int i = gt; i < MS * (BW / 8); i += ngt) { const int c8 = i & 127, r = i >> 7, b = r >> 6, t = r & 63;
        *(GAS v4u*)(((bf16*)(F.ws + WS_KCAT)) + ((size_t)(l * NB + b) * KCATN + PAST + t) * BW + c8 * 8) = *(const GAS v4u*)(((bf16*)(F.ws + WS_PROJ)) + (size_t)(MP + r) * NINP + PC_BK + c8 * 8); }
    REPP(604) for (long i = gt; i < (long)MT * 256; i += ngt) { const int c8 = (int)(i & 255); const int row = (int)(i >> 8); const int seg = c8 >> 7, col = (c8 & 127) * 8;
        const v4u u = *(const GAS v4u*)(((bf16*)(F.ws + WS_PROJ)) + (size_t)row * NINP + (seg ? PC_BV : PC_BK) + col);
        float* dst = row < MP ? F.out + (seg ? O_SVP : O_SKP) + ((size_t)l * MP + row) * BW + col : F.out + (seg ? O_SVS : O_SKS) + ((size_t)l * MS + (row - MP)) * BW + col;
        ((GAS f32x4*)dst)[0] = (f32x4){bflo(u.x), bfhi(u.x), bflo(u.y), bfhi(u.y)}; ((GAS f32x4*)dst)[1] = (f32x4){bflo(u.z), bfhi(u.z), bflo(u.w), bfhi(u.w)}; }
    for (int i = gt; i < 16 * SHW; i += ngt) { const int sq = i / SHW, c = i % SHW; const int b = sq & 7; const bool smp = sq >= 8;
        const int row = smp ? MP + b * DSEQ + DSEQ - 1 : b * SEQ + SEQ - 1;
        F.out[(smp ? O_SHS : O_SHP) + (size_t)(l * NB + b) * SHW + c] = bf2f(((bf16*)(F.ws + WS_PROJ))[(size_t)row * NINP + c]); }
}
typedef float f32x2s __attribute__((ext_vector_type(2)));
struct ScanOps { f32x2s kk, dd, ka, kp, rr; float vv; };
DI void scan_load(ScanOps& o, const float* sbase, const float* vbase, int t, int lane) {
    const GAS float* p = (const GAS float*)(sbase + (size_t)t * (AH * 5 * 64) + ((lane >> 5) * 16 + (lane & 15)) * 2); const GAS float* pv = (const GAS float*)(vbase + (size_t)t * BW + (lane & 31));
    asm volatile("global_load_dwordx2 %0, %6, off\n\tglobal_load_dwordx2 %1, %6, off offset:256\n\tglobal_load_dwordx2 %2, %6, off offset:512\n\tglobal_load_dwordx2 %3, %6, off offset:768\n\t"
                 "global_load_dwordx2 %4, %6, off offset:1024\n\tglobal_load_dword %5, %7, off"
                 : "=&v"(o.kk), "=&v"(o.dd), "=&v"(o.ka), "=&v"(o.kp), "=&v"(o.rr), "=&v"(o.vv) : "v"(p), "v"(pv) : "memory");
}
DI void scan_wait(ScanOps& o) { asm volatile("s_waitcnt vmcnt(18)" : "+v"(o.kk), "+v"(o.dd), "+v"(o.ka), "+v"(o.kp), "+v"(o.rr), "+v"(o.vv) :: "memory"); }
#define SCAN_DPP(op, n) op " row_newbcast:" #n " row_mask:0xf bank_mask:0xf"
DI float scan_step(float (&S)[32], ScanOps& o) {
    float a0 = 0.f, a1 = 0.f, a2 = 0.f, a3 = 0.f;
    scan_wait(o);
    asm volatile("s_nop 1");
    asm volatile(SCAN_DPP("v_fmac_f32_dpp %0, %1, %2", 0) : "+v"(a0) : "v"(o.kk[0]), "v"(S[0]));
    asm volatile(SCAN_DPP("v_fmac_f32_dpp %0, %1, %2", 1) : "+v"(a1) : "v"(o.kk[0]), "v"(S[1]));
    asm volatile(SCAN_DPP("v_fmac_f32_dpp %0, %1, %2", 2) : "+v"(a2) : "v"(o.kk[0]), "v"(S[2]));
    asm volatile(SCAN_DPP("v_fmac_f32_dpp %0, %1, %2", 3) : "+v"(a3) : "v"(o.kk[0]), "v"(S[3]));
    asm volatile(SCAN_DPP("v_fmac_f32_dpp %0, %1, %2", 4) : "+v"(a0) : "v"(o.kk[0]), "v"(S[4]));
    asm volatile(SCAN_DPP("v_fmac_f32_dpp %0, %1, %2", 5) : "+v"(a1) : "v"(o.kk[0]), "v"(S[5]));
    asm volatile(SCAN_DPP("v_fmac_f32_dpp %0, %1, %2", 6) : "+v"(a2) : "v"(o.kk[0]), "v"(S[6]));
    asm volatile(SCAN_DPP("v_fmac_f32_dpp %0, %1, %2", 7) : "+v"(a3) : "v"(o.kk[0]), "v"(S[7]));
    asm volatile(SCAN_DPP("v_fmac_f32_dpp %0, %1, %2", 8) : "+v"(a0) : "v"(o.kk[0]), "v"(S[8]));
    asm volatile(SCAN_DPP("v_fmac_f32_dpp %0, %1, %2", 9) : "+v"(a1) : "v"(o.kk[0]), "v"(S[9]));
    asm volatile(SCAN_DPP("v_fmac_f32_dpp %0, %1, %2", 10) : "+v"(a2) : "v"(o.kk[0]), "v"(S[10]));
    asm volatile(SCAN_DPP("v_fmac_f32_dpp %0, %1, %2", 11) : "+v"(a3) : "v"(o.kk[0]), "v"(S[11]));
    asm volatile(SCAN_DPP("v_fmac_f32_dpp %0, %1, %2", 12) : "+v"(a0) : "v"(o.kk[0]), "v"(S[12]));
    asm volatile(SCAN_DPP("v_fmac_f32_dpp %0, %1, %2", 13) : "+v"(a1) : "v"(o.kk[0]), "v"(S[13]));
    asm volatile(SCAN_DPP("v_fmac_f32_dpp %0, %1, %2", 14) : "+v"(a2) : "v"(o.kk[0]), "v"(S[14]));
    asm volatile(SCAN_DPP("v_fmac_f32_dpp %0, %1, %2", 15) : "+v"(a3) : "v"(o.kk[0]), "v"(S[15]));
    asm volatile(SCAN_DPP("v_fmac_f32_dpp %0, %1, %2", 0) : "+v"(a0) : "v"(o.kk[1]), "v"(S[16]));
    asm volatile(SCAN_DPP("v_fmac_f32_dpp %0, %1, %2", 1) : "+v"(a1) : "v"(o.kk[1]), "v"(S[17]));
    asm volatile(SCAN_DPP("v_fmac_f32_dpp %0, %1, %2", 2) : "+v"(a2) : "v"(o.kk[1]), "v"(S[18]));
    asm volatile(SCAN_DPP("v_fmac_f32_dpp %0, %1, %2", 3) : "+v"(a3) : "v"(o.kk[1]), "v"(S[19]));
    asm volatile(SCAN_DPP("v_fmac_f32_dpp %0, %1, %2", 4) : "+v"(a0) : "v"(o.kk[1]), "v"(S[20]));
    asm volatile(SCAN_DPP("v_fmac_f32_dpp %0, %1, %2", 5) : "+v"(a1) : "v"(o.kk[1]), "v"(S[21]));
    asm volatile(SCAN_DPP("v_fmac_f32_dpp %0, %1, %2", 6) : "+v"(a2) : "v"(o.kk[1]), "v"(S[22]));
    asm volatile(SCAN_DPP("v_fmac_f32_dpp %0, %1, %2", 7) : "+v"(a3) : "v"(o.kk[1]), "v"(S[23]));
    asm volatile(SCAN_DPP("v_fmac_f32_dpp %0, %1, %2", 8) : "+v"(a0) : "v"(o.kk[1]), "v"(S[24]));
    asm volatile(SCAN_DPP("v_fmac_f32_dpp %0, %1, %2", 9) : "+v"(a1) : "v"(o.kk[1]), "v"(S[25]));
    asm volatile(SCAN_DPP("v_fmac_f32_dpp %0, %1, %2", 10) : "+v"(a2) : "v"(o.kk[1]), "v"(S[26]));
    asm volatile(SCAN_DPP("v_fmac_f32_dpp %0, %1, %2", 11) : "+v"(a3) : "v"(o.kk[1]), "v"(S[27]));
    asm volatile(SCAN_DPP("v_fmac_f32_dpp %0, %1, %2", 12) : "+v"(a0) : "v"(o.kk[1]), "v"(S[28]));
    asm volatile(SCAN_DPP("v_fmac_f32_dpp %0, %1, %2", 13) : "+v"(a1) : "v"(o.kk[1]), "v"(S[29]));
    asm volatile(SCAN_DPP("v_fmac_f32_dpp %0, %1, %2", 14) : "+v"(a2) : "v"(o.kk[1]), "v"(S[30]));
    asm volatile(SCAN_DPP("v_fmac_f32_dpp %0, %1, %2", 15) : "+v"(a3) : "v"(o.kk[1]), "v"(S[31]));
    const float nskk = -xor32_sum((a0 + a1) + (a2 + a3)); const float vv = o.vv;
    float y0 = 0.f, y1 = 0.f, y2 = 0.f, y3 = 0.f;
    asm volatile("s_nop 1");
    asm volatile(SCAN_DPP("v_mul_f32_dpp %0, %1, %0", 0) : "+v"(S[0]) : "v"(o.dd[0]));
    asm volatile(SCAN_DPP("v_mul_f32_dpp %0, %1, %0", 1) : "+v"(S[1]) : "v"(o.dd[0]));
    asm volatile(SCAN_DPP("v_mul_f32_dpp %0, %1, %0", 2) : "+v"(S[2]) : "v"(o.dd[0]));
    asm volatile(SCAN_DPP("v_mul_f32_dpp %0, %1, %0", 3) : "+v"(S[3]) : "v"(o.dd[0]));
    asm volatile(SCAN_DPP("v_fmac_f32_dpp %0, %1, %2", 0) : "+v"(S[0]) : "v"(o.ka[0]), "v"(nskk));
    asm volatile(SCAN_DPP("v_fmac_f32_dpp %0, %1, %2", 1) : "+v"(S[1]) : "v"(o.ka[0]), "v"(nskk));
    asm volatile(SCAN_DPP("v_fmac_f32_dpp %0, %1, %2", 2) : "+v"(S[2]) : "v"(o.ka[0]), "v"(nskk));
    asm volatile(SCAN_DPP("v_fmac_f32_dpp %0, %1, %2", 3) : "+v"(S[3]) : "v"(o.ka[0]), "v"(nskk));
    asm volatile(SCAN_DPP("v_fmac_f32_dpp %0, %1, %2", 0) : "+v"(S[0]) : "v"(o.kp[0]), "v"(vv));
    asm volatile(SCAN_DPP("v_fmac_f32_dpp %0, %1, %2", 1) : "+v"(S[1]) : "v"(o.kp[0]), "v"(vv));
    asm volatile(SCAN_DPP("v_fmac_f32_dpp %0, %1, %2", 2) : "+v"(S[2]) : "v"(o.kp[0]), "v"(vv));
    asm volatile(SCAN_DPP("v_fmac_f32_dpp %0, %1, %2", 3) : "+v"(S[3]) : "v"(o.kp[0]), "v"(vv));
    asm volatile(SCAN_DPP("v_fmac_f32_dpp %0, %1, %2", 0) : "+v"(y0) : "v"(o.rr[0]), "v"(S[0]));
    asm volatile(SCAN_DPP("v_fmac_f32_dpp %0, %1, %2", 1) : "+v"(y1) : "v"(o.rr[0]), "v"(S[1]));
    asm volatile(SCAN_DPP("v_fmac_f32_dpp %0, %1, %2", 2) : "+v"(y2) : "v"(o.rr[0]), "v"(S[2]));
    asm volatile(SCAN_DPP("v_fmac_f32_dpp %0, %1, %2", 3) : "+v"(y3) : "v"(o.rr[0]), "v"(S[3]));
    asm volatile(SCAN_DPP("v_mul_f32_dpp %0, %1, %0", 4) : "+v"(S[4]) : "v"(o.dd[0]));
    asm volatile(SCAN_DPP("v_mul_f32_dpp %0, %1, %0", 5) : "+v"(S[5]) : "v"(o.dd[0]));
    asm volatile(SCAN_DPP("v_mul_f32_dpp %0, %1, %0", 6) : "+v"(S[6]) : "v"(o.dd[0]));
    asm volatile(SCAN_DPP("v_mul_f32_dpp %0, %1, %0", 7) : "+v"(S[7]) : "v"(o.dd[0]));
    asm volatile(SCAN_DPP("v_fmac_f32_dpp %0, %1, %2", 4) : "+v"(S[4]) : "v"(o.ka[0]), "v"(nskk));
    asm volatile(SCAN_DPP("v_fmac_f32_dpp %0, %1, %2", 5) : "+v"(S[5]) : "v"(o.ka[0]), "v"(nskk));
    asm volatile(SCAN_DPP("v_fmac_f32_dpp %0, %1, %2", 6) : "+v"(S[6]) : "v"(o.ka[0]), "v"(nskk));
    asm volatile(SCAN_DPP("v_fmac_f32_dpp %0, %1, %2", 7) : "+v"(S[7]) : "v"(o.ka[0]), "v"(nskk));
    asm volatile(SCAN_DPP("v_fmac_f32_dpp %0, %1, %2", 4) : "+v"(S[4]) : "v"(o.kp[0]), "v"(vv));
    asm volatile(SCAN_DPP("v_fmac_f32_dpp %0, %1, %2", 5) : "+v"(S[5]) : "v"(o.kp[0]), "v"(vv));
    asm volatile(SCAN_DPP("v_fmac_f32_dpp %0, %1, %2", 6) : "+v"(S[6]) : "v"(o.kp[0]), "v"(vv));
    asm volatile(SCAN_DPP("v_fmac_f32_dpp %0, %1, %2", 7) : "+v"(S[7]) : "v"(o.kp[0]), "v"(vv));
    asm volatile(SCAN_DPP("v_fmac_f32_dpp %0, %1, %2", 4) : "+v"(y0) : "v"(o.rr[0]), "v"(S[4]));
    asm volatile(SCAN_DPP("v_fmac_f32_dpp %0, %1, %2", 5) : "+v"(y1) : "v"(o.rr[0]), "v"(S[5]));
    asm volatile(SCAN_DPP("v_fmac_f32_dpp %0, %1, %2", 6) : "+v"(y2) : "v"(o.rr[0]), "v"(S[6]));
    asm volatile(SCAN_DPP("v_fmac_f32_dpp %0, %1, %2", 7) : "+v"(y3) : "v"(o.rr[0]), "v"(S[7]));
    asm volatile(SCAN_DPP("v_mul_f32_dpp %0, %1, %0", 8) : "+v"(S[8]) : "v"(o.dd[0]));
    asm volatile(SCAN_DPP("v_mul_f32_dpp %0, %1, %0", 9) : "+v"(S[9]) : "v"(o.dd[0]));
    asm volatile(SCAN_DPP("v_mul_f32_dpp %0, %1, %0", 10) : "+v"(S[10]) : "v"(o.dd[0]));
    asm volatile(SCAN_DPP("v_mul_f32_dpp %0, %1, %0", 11) : "+v"(S[11]) : "v"(o.dd[0]));
    asm volatile(SCAN_DPP("v_fmac_f32_dpp %0, %1, %2", 8) : "+v"(S[8]) : "v"(o.ka[0]), "v"(nskk));
    asm volatile(SCAN_DPP("v_fmac_f32_dpp %0, %1, %2", 9) : "+v"(S[9]) : "v"(o.ka[0]), "v"(nskk));
    asm volatile(SCAN_DPP("v_fmac_f32_dpp %0, %1, %2", 10) : "+v"(S[10]) : "v"(o.ka[0]), "v"(nskk));
    asm volatile(SCAN_DPP("v_fmac_f32_dpp %0, %1, %2", 11) : "+v"(S[11]) : "v"(o.ka[0]), "v"(nskk));
    asm volatile(SCAN_DPP("v_fmac_f32_dpp %0, %1, %2", 8) : "+v"(S[8]) : "v"(o.kp[0]), "v"(vv));
    asm volatile(SCAN_DPP("v_fmac_f32_dpp %0, %1, %2", 9) : "+v"(S[9]) : "v"(o.kp[0]), "v"(vv));
    asm volatile(SCAN_DPP("v_fmac_f32_dpp %0, %1, %2", 10) : "+v"(S[10]) : "v"(o.kp[0]), "v"(vv));
    asm volatile(SCAN_DPP("v_fmac_f32_dpp %0, %1, %2", 11) : "+v"(S[11]) : "v"(o.kp[0]), "v"(vv));
    asm volatile(SCAN_DPP("v_fmac_f32_dpp %0, %1, %2", 8) : "+v"(y0) : "v"(o.rr[0]), "v"(S[8]));
    asm volatile(SCAN_DPP("v_fmac_f32_dpp %0, %1, %2", 9) : "+v"(y1) : "v"(o.rr[0]), "v"(S[9]));
    asm volatile(SCAN_DPP("v_fmac_f32_dpp %0, %1, %2", 10) : "+v"(y2) : "v"(o.rr[0]), "v"(S[10]));
    asm volatile(SCAN_DPP("v_fmac_f32_dpp %0, %1, %2", 11) : "+v"(y3) : "v"(o.rr[0]), "v"(S[11]));
    asm volatile(SCAN_DPP("v_mul_f32_dpp %0, %1, %0", 12) : "+v"(S[12]) : "v"(o.dd[0]));
    asm volatile(SCAN_DPP("v_mul_f32_dpp %0, %1, %0", 13) : "+v"(S[13]) : "v"(o.dd[0]));
    asm volatile(SCAN_DPP("v_mul_f32_dpp %0, %1, %0", 14) : "+v"(S[14]) : "v"(o.dd[0]));
    asm volatile(SCAN_DPP("v_mul_f32_dpp %0, %1, %0", 15) : "+v"(S[15]) : "v"(o.dd[0]));
    asm volatile(SCAN_DPP("v_fmac_f32_dpp %0, %1, %2", 12) : "+v"(S[12]) : "v"(o.ka[0]), "v"(nskk));
    asm volatile(SCAN_DPP("v_fmac_f32_dpp %0, %1, %2", 13) : "+v"(S[13]) : "v"(o.ka[0]), "v"(nskk));
    asm volatile(SCAN_DPP("v_fmac_f32_dpp %0, %1, %2", 14) : "+v"(S[14]) : "v"(o.ka[0]), "v"(nskk));
    asm volatile(SCAN_DPP("v_fmac_f32_dpp %0, %1, %2", 15) : "+v"(S[15]) : "v"(o.ka[0]), "v"(nskk));
    asm volatile(SCAN_DPP("v_fmac_f32_dpp %0, %1, %2", 12) : "+v"(S[12]) : "v"(o.kp[0]), "v"(vv));
    asm volatile(SCAN_DPP("v_fmac_f32_dpp %0, %1, %2", 13) : "+v"(S[13]) : "v"(o.kp[0]), "v"(vv));
    asm volatile(SCAN_DPP("v_fmac_f32_dpp %0, %1, %2", 14) : "+v"(S[14]) : "v"(o.kp[0]), "v"(vv));
    asm volatile(SCAN_DPP("v_fmac_f32_dpp %0, %1, %2", 15) : "+v"(S[15]) : "v"(o.kp[0]), "v"(vv));
    asm volatile(SCAN_DPP("v_fmac_f32_dpp %0, %1, %2", 12) : "+v"(y0) : "v"(o.rr[0]), "v"(S[12]));
    asm volatile(SCAN_DPP("v_fmac_f32_dpp %0, %1, %2", 13) : "+v"(y1) : "v"(o.rr[0]), "v"(S[13]));
    asm volatile(SCAN_DPP("v_fmac_f32_dpp %0, %1, %2", 14) : "+v"(y2) : "v"(o.rr[0]), "v"(S[14]));
    asm volatile(SCAN_DPP("v_fmac_f32_dpp %0, %1, %2", 15) : "+v"(y3) : "v"(o.rr[0]), "v"(S[15]));
    asm volatile(SCAN_DPP("v_mul_f32_dpp %0, %1, %0", 0) : "+v"(S[16]) : "v"(o.dd[1]));
    asm volatile(SCAN_DPP("v_mul_f32_dpp %0, %1, %0", 1) : "+v"(S[17]) : "v"(o.dd[1]));
    asm volatile(SCAN_DPP("v_mul_f32_dpp %0, %1, %0", 2) : "+v"(S[18]) : "v"(o.dd[1]));
    asm volatile(SCAN_DPP("v_mul_f32_dpp %0, %1, %0", 3) : "+v"(S[19]) : "v"(o.dd[1]));
    asm volatile(SCAN_DPP("v_fmac_f32_dpp %0, %1, %2", 0) : "+v"(S[16]) : "v"(o.ka[1]), "v"(nskk));
    asm volatile(SCAN_DPP("v_fmac_f32_dpp %0, %1, %2", 1) : "+v"(S[17]) : "v"(o.ka[1]), "v"(nskk));
    asm volatile(SCAN_DPP("v_fmac_f32_dpp %0, %1, %2", 2) : "+v"(S[18]) : "v"(o.ka[1]), "v"(nskk));
    asm volatile(SCAN_DPP("v_fmac_f32_dpp %0, %1, %2", 3) : "+v"(S[19]) : "v"(o.ka[1]), "v"(nskk));
    asm volatile(SCAN_DPP("v_fmac_f32_dpp %0, %1, %2", 0) : "+v"(S[16]) : "v"(o.kp[1]), "v"(vv));
    asm volatile(SCAN_DPP("v_fmac_f32_dpp %0, %1, %2", 1) : "+v"(S[17]) : "v"(o.kp[1]), "v"(vv));
    asm volatile(SCAN_DPP("v_fmac_f32_dpp %0, %1, %2", 2) : "+v"(S[18]) : "v"(o.kp[1]), "v"(vv));
    asm volatile(SCAN_DPP("v_fmac_f32_dpp %0, %1, %2", 3) : "+v"(S[19]) : "v"(o.kp[1]), "v"(vv));
    asm volatile(SCAN_DPP("v_fmac_f32_dpp %0, %1, %2", 0) : "+v"(y0) : "v"(o.rr[1]), "v"(S[16]));
    asm volatile(SCAN_DPP("v_fmac_f32_dpp %0, %1, %2", 1) : "+v"(y1) : "v"(o.rr[1]), "v"(S[17]));
    asm volatile(SCAN_DPP("v_fmac_f32_dpp %0, %1, %2", 2) : "+v"(y2) : "v"(o.rr[1]), "v"(S[18]));
    asm volatile(SCAN_DPP("v_fmac_f32_dpp %0, %1, %2", 3) : "+v"(y3) : "v"(o.rr[1]), "v"(S[19]));
    asm volatile(SCAN_DPP("v_mul_f32_dpp %0, %1, %0", 4) : "+v"(S[20]) : "v"(o.dd[1]));
    asm volatile(SCAN_DPP("v_mul_f32_dpp %0, %1, %0", 5) : "+v"(S[21]) : "v"(o.dd[1]));
    asm volatile(SCAN_DPP("v_mul_f32_dpp %0, %1, %0", 6) : "+v"(S[22]) : "v"(o.dd[1]));
    asm volatile(SCAN_DPP("v_mul_f32_dpp %0, %1, %0", 7) : "+v"(S[23]) : "v"(o.dd[1]));
    asm volatile(SCAN_DPP("v_fmac_f32_dpp %0, %1, %2", 4) : "+v"(S[20]) : "v"(o.ka[1]), "v"(nskk));
    asm volatile(SCAN_DPP("v_fmac_f32_dpp %0, %1, %2", 5) : "+v"(S[21]) : "v"(o.ka[1]), "v"(nskk));
    asm volatile(SCAN_DPP("v_fmac_f32_dpp %0, %1, %2", 6) : "+v"(S[22]) : "v"(o.ka[1]), "v"(nskk));
    asm volatile(SCAN_DPP("v_fmac_f32_dpp %0, %1, %2", 7) : "+v"(S[23]) : "v"(o.ka[1]), "v"(nskk));
    asm volatile(SCAN_DPP("v_fmac_f32_dpp %0, %1, %2", 4) : "+v"(S[20]) : "v"(o.kp[1]), "v"(vv));
    asm volatile(SCAN_DPP("v_fmac_f32_dpp %0, %1, %2", 5) : "+v"(S[21]) : "v"(o.kp[1]), "v"(vv));
    asm volatile(SCAN_DPP("v_fmac_f32_dpp %0, %1, %2", 6) : "+v"(S[22]) : "v"(o.kp[1]), "v"(vv));
    asm volatile(SCAN_DPP("v_fmac_f32_dpp %0, %1, %2", 7) : "+v"(S[23]) : "v"(o.kp[1]), "v"(vv));
    asm volatile(SCAN_DPP("v_fmac_f32_dpp %0, %1, %2", 4) : "+v"(y0) : "v"(o.rr[1]), "v"(S[20]));
    asm volatile(SCAN_DPP("v_fmac_f32_dpp %0, %1, %2", 5) : "+v"(y1) : "v"(o.rr[1]), "v"(S[21]));
    asm volatile(SCAN_DPP("v_fmac_f32_dpp %0, %1, %2", 6) : "+v"(y2) : "v"(o.rr[1]), "v"(S[22]));
    asm volatile(SCAN_DPP("v_fmac_f32_dpp %0, %1, %2", 7) : "+v"(y3) : "v"(o.rr[1]), "v"(S[23]));
    asm volatile(SCAN_DPP("v_mul_f32_dpp %0, %1, %0", 8) : "+v"(S[24]) : "v"(o.dd[1]));
    asm volatile(SCAN_DPP("v_mul_f32_dpp %0, %1, %0", 9) : "+v"(S[25]) : "v"(o.dd[1]));
    asm volatile(SCAN_DPP("v_mul_f32_dpp %0, %1, %0", 10) : "+v"(S[26]) : "v"(o.dd[1]));
    asm volatile(SCAN_DPP("v_mul_f32_dpp %0, %1, %0", 11) : "+v"(S[27]) : "v"(o.dd[1]));
    asm volatile(SCAN_DPP("v_fmac_f32_dpp %0, %1, %2", 8) : "+v"(S[24]) : "v"(o.ka[1]), "v"(nskk));
    asm volatile(SCAN_DPP("v_fmac_f32_dpp %0, %1, %2", 9) : "+v"(S[25]) : "v"(o.ka[1]), "v"(nskk));
    asm volatile(SCAN_DPP("v_fmac_f32_dpp %0, %1, %2", 10) : "+v"(S[26]) : "v"(o.ka[1]), "v"(nskk));
    asm volatile(SCAN_DPP("v_fmac_f32_dpp %0, %1, %2", 11) : "+v"(S[27]) : "v"(o.ka[1]), "v"(nskk));
    asm volatile(SCAN_DPP("v_fmac_f32_dpp %0, %1, %2", 8) : "+v"(S[24]) : "v"(o.kp[1]), "v"(vv));
    asm volatile(SCAN_DPP("v_fmac_f32_dpp %0, %1, %2", 9) : "+v"(S[25]) : "v"(o.kp[1]), "v"(vv));
    asm volatile(SCAN_DPP("v_fmac_f32_dpp %0, %1, %2", 10) : "+v"(S[26]) : "v"(o.kp[1]), "v"(vv));
    asm volatile(SCAN_DPP("v_fmac_f32_dpp %0, %1, %2", 11) : "+v"(S[27]) : "v"(o.kp[1]), "v"(vv));
    asm volatile(SCAN_DPP("v_fmac_f32_dpp %0, %1, %2", 8) : "+v"(y0) : "v"(o.rr[1]), "v"(S[24]));
    asm volatile(SCAN_DPP("v_fmac_f32_dpp %0, %1, %2", 9) : "+v"(y1) : "v"(o.rr[1]), "v"(S[25]));
    asm volatile(SCAN_DPP("v_fmac_f32_dpp %0, %1, %2", 10) : "+v"(y2) : "v"(o.rr[1]), "v"(S[26]));
    asm volatile(SCAN_DPP("v_fmac_f32_dpp %0, %1, %2", 11) : "+v"(y3) : "v"(o.rr[1]), "v"(S[27]));
    asm volatile(SCAN_DPP("v_mul_f32_dpp %0, %1, %0", 12) : "+v"(S[28]) : "v"(o.dd[1]));
    asm volatile(SCAN_DPP("v_mul_f32_dpp %0, %1, %0", 13) : "+v"(S[29]) : "v"(o.dd[1]));
    asm volatile(SCAN_DPP("v_mul_f32_dpp %0, %1, %0", 14) : "+v"(S[30]) : "v"(o.dd[1]));
    asm volatile(SCAN_DPP("v_mul_f32_dpp %0, %1, %0", 15) : "+v"(S[31]) : "v"(o.dd[1]));
    asm volatile(SCAN_DPP("v_fmac_f32_dpp %0, %1, %2", 12) : "+v"(S[28]) : "v"(o.ka[1]), "v"(nskk));
    asm volatile(SCAN_DPP("v_fmac_f32_dpp %0, %1, %2", 13) : "+v"(S[29]) : "v"(o.ka[1]), "v"(nskk));
    asm volatile(SCAN_DPP("v_fmac_f32_dpp %0, %1, %2", 14) : "+v"(S[30]) : "v"(o.ka[1]), "v"(nskk));
    asm volatile(SCAN_DPP("v_fmac_f32_dpp %0, %1, %2", 15) : "+v"(S[31]) : "v"(o.ka[1]), "v"(nskk));
    asm volatile(SCAN_DPP("v_fmac_f32_dpp %0, %1, %2", 12) : "+v"(S[28]) : "v"(o.kp[1]), "v"(vv));
    asm volatile(SCAN_DPP("v_fmac_f32_dpp %0, %1, %2", 13) : "+v"(S[29]) : "v"(o.kp[1]), "v"(vv));
    asm volatile(SCAN_DPP("v_fmac_f32_dpp %0, %1, %2", 14) : "+v"(S[30]) : "v"(o.kp[1]), "v"(vv));
    asm volatile(SCAN_DPP("v_fmac_f32_dpp %0, %1, %2", 15) : "+v"(S[31]) : "v"(o.kp[1]), "v"(vv));
    asm volatile(SCAN_DPP("v_fmac_f32_dpp %0, %1, %2", 12) : "+v"(y0) : "v"(o.rr[1]), "v"(S[28]));
    asm volatile(SCAN_DPP("v_fmac_f32_dpp %0, %1, %2", 13) : "+v"(y1) : "v"(o.rr[1]), "v"(S[29]));
    asm volatile(SCAN_DPP("v_fmac_f32_dpp %0, %1, %2", 14) : "+v"(y2) : "v"(o.rr[1]), "v"(S[30]));
    asm volatile(SCAN_DPP("v_fmac_f32_dpp %0, %1, %2", 15) : "+v"(y3) : "v"(o.rr[1]), "v"(S[31]));
    return xor32_sum((y0 + y1) + (y2 + y3));
}
#define SCAN_STORE(ptr, val) asm volatile("global_store_dword %0, %1, off" :: "v"((GAS float*)(ptr)), "v"(val) : "memory")
DI void scan_unit(const float* sbase, const float* vbase, const float* s0, float* yraw, float* sout, int half, int T, int lane) {
    float S[32]; const int srow = (32 * half + (lane & 31)) * 64 + 32 * (lane >> 5);
    if (s0) {
#pragma unroll
        for (int k = 0; k < 32; k += 4) { const f32x4 v = *(const GAS f32x4*)(s0 + srow + k); S[k] = v.x; S[k + 1] = v.y; S[k + 2] = v.z; S[k + 3] = v.w; }
    } else {
#pragma unroll
        for (int k = 0; k < 32; ++k) S[k] = 0.f;
    }
#pragma unroll
    for (int k = 0; k < 32; ++k) asm volatile("" : "+v"(S[k]));
    __builtin_amdgcn_s_setprio(3);
    ScanOps o0, o1, o2, o3; float* yp = yraw + (lane & 31);
    scan_load(o0, sbase, vbase, 0, lane); scan_load(o1, sbase, vbase, 1, lane); scan_load(o2, sbase, vbase, 2, lane); scan_load(o3, sbase, vbase, 3, lane);
    for (int t = 0; t < T; t += 4) {
        float y;
        y = scan_step(S, o0); asm volatile("" ::: "memory"); SCAN_STORE(yp + (size_t)t * BW, y);       scan_load(o0, sbase, vbase, min(t + 4, T - 1), lane);
        asm volatile("" ::: "memory"); y = scan_step(S, o1); asm volatile("" ::: "memory"); SCAN_STORE(yp + (size_t)(t + 1) * BW, y); scan_load(o1, sbase, vbase, min(t + 5, T - 1), lane);
        asm volatile("" ::: "memory"); y = scan_step(S, o2); asm volatile("" ::: "memory"); SCAN_STORE(yp + (size_t)(t + 2) * BW, y); scan_load(o2, sbase, vbase, min(t + 6, T - 1), lane);
        asm volatile("" ::: "memory"); y = scan_step(S, o3); asm volatile("" ::: "memory"); SCAN_STORE(yp + (size_t)(t + 3) * BW, y); scan_load(o3, sbase, vbase, min(t + 7, T - 1), lane);
        asm volatile("" ::: "memory");
    }
    asm volatile("s_waitcnt vmcnt(0)" : "+v"(o0.kk), "+v"(o0.dd), "+v"(o0.ka), "+v"(o0.kp), "+v"(o0.rr), "+v"(o0.vv), "+v"(o1.kk), "+v"(o1.dd), "+v"(o1.ka), "+v"(o1.kp), "+v"(o1.rr), "+v"(o1.vv) :: "memory");
    asm volatile("" : "+v"(o2.kk), "+v"(o2.dd), "+v"(o2.ka), "+v"(o2.kp), "+v"(o2.rr), "+v"(o2.vv), "+v"(o3.kk), "+v"(o3.dd), "+v"(o3.ka), "+v"(o3.kp), "+v"(o3.rr), "+v"(o3.vv) :: "memory");
    __builtin_amdgcn_s_setprio(0);
#pragma unroll
    for (int k = 0; k < 32; k += 4) *(GAS f32x4*)(sout + srow + k) = (f32x4){S[k], S[k + 1], S[k + 2], S[k + 3]};
}
DI void sb_unit(const bf16* Qp, const bf16* Kp, int kpitch, const bf16* VTp, int vpitch, int qpos0, const bf16* Zp, bf16* Op, int lane) {
    const int r = lane & 31, h = lane >> 5;
    bf16x8 qf[8];
#pragma unroll
    for (int s = 0; s < 8; ++s) qf[s] = *(const GAS bf16x8*)(Qp + (size_t)r * NINP + 16 * s + 8 * h);
    f32x16 o[4];
#pragma unroll
    for (int db = 0; db < 4; ++db)
#pragma unroll
        for (int i = 0; i < 16; ++i) o[db][i] = 0.f;
    float R = 0.f; const int qpos = qpos0 + r; const float scale = 0.08838834764831845f;
    bf16x8 kf[8];
    { const bf16* kr = Kp + (size_t)((qpos0 >> 5) * 32 + r) * kpitch + 8 * h;
#pragma unroll
      for (int s = 0; s < 8; ++s) kf[s] = *(const GAS bf16x8*)(kr + 16 * s); }
    for (int kt = qpos0 >> 5; kt >= 0; --kt) {
        const int key0 = kt * 32;
        f32x16 sc;
#pragma unroll
        for (int i = 0; i < 16; ++i) sc[i] = 0.f;
#pragma unroll
        for (int s = 0; s < 8; ++s) sc = MFMA32(kf[s], qf[s], sc);
        { const bf16* kr = Kp + (size_t)((kt > 0 ? key0 - 32 : 0) + r) * kpitch + 8 * h;
#pragma unroll
          for (int s = 0; s < 8; ++s) kf[s] = *(const GAS bf16x8*)(kr + 16 * s); }
        float lm[16], lb[16];
#pragma unroll
        for (int i = 0; i < 16; ++i) { const int key = key0 + crow16(i, h); const float z = sc[i] * scale; const bool valid = key < qpos;
            const float e = __expf(-fabsf(z)); const float sp = fmaxf(z, 0.f) + __logf(1.0f + e);
            lm[i] = valid ? -sp : 0.f; lb[i] = valid ? (z - sp) : -1e30f; }
        float G[4], Go[4], aft[4];
#pragma unroll
        for (int g = 0; g < 4; ++g) { G[g] = (lm[4 * g] + lm[4 * g + 1]) + (lm[4 * g + 2] + lm[4 * g + 3]); Go[g] = xor32_partner(G[g], h); }
        float tail = 0.f;
#pragma unroll
        for (int g = 3; g >= 0; --g) { aft[g] = tail + (h == 0 ? Go[g] : 0.f); tail += G[g] + Go[g]; }
        float att[16];
#pragma unroll
        for (int g = 0; g < 4; ++g) { float suf = aft[g] + R;
#pragma unroll
            for (int j = 3; j >= 0; --j) { att[4 * g + j] = __expf(lb[4 * g + j] + suf); suf += lm[4 * g + j]; } }
        R += tail;
        const bool live = __builtin_amdgcn_ballot_w64(R >= -104.0f) != 0ull;
        const bf16x8 p0 = pack8(att[0], att[1], att[2], att[3], att[4], att[5], att[6], att[7]);
        const bf16x8 p1 = pack8(att[8], att[9], att[10], att[11], att[12], att[13], att[14], att[15]);
#pragma unroll
        for (int db = 0; db < 4; ++db) { const bf16* vr = VTp + (size_t)(32 * db + r) * vpitch + key0 + 4 * h;
            const s16x4 a0 = *(const GAS s16x4*)(vr), a1 = *(const GAS s16x4*)(vr + 8), b0 = *(const GAS s16x4*)(vr + 16), b1 = *(const GAS s16x4*)(vr + 24);
            o[db] = MFMA32(__builtin_shufflevector(a0, a1, 0, 1, 2, 3, 4, 5, 6, 7), p0, o[db]);
            o[db] = MFMA32(__builtin_shufflevector(b0, b1, 0, 1, 2, 3, 4, 5, 6, 7), p1, o[db]); }
        if (!live) break;
    }
    v2u zq[4][4];
#pragma unroll
    for (int db = 0; db < 4; ++db)
#pragma unroll
        for (int g = 0; g < 4; ++g) zq[db][g] = *(const GAS v2u*)(Zp + (size_t)r * NINP + 32 * db + 8 * g + 4 * h);
#pragma unroll
    for (int db = 0; db < 4; ++db)
#pragma unroll
        for (int g = 0; g < 4; ++g) { const int d0 = 32 * db + 8 * g + 4 * h; const v2u zu = zq[db][g];
            v2u w; w.x = pk2(o[db][4 * g] * siluf_(bflo(zu.x)), o[db][4 * g + 1] * siluf_(bfhi(zu.x))); w.y = pk2(o[db][4 * g + 2] * siluf_(bflo(zu.y)), o[db][4 * g + 3] * siluf_(bfhi(zu.y)));
            *(GAS v2u*)(Op + (size_t)r * BW + d0) = w; }
}
DI void xattn_unit(const bf16* Qp, const bf16* Kp, const bf16* VTp, bf16* Op, int lane) {
    const int r = lane & 31, h = lane >> 5;
    f32x16 sT[8];
#pragma unroll
    for (int kt = 0; kt < 8; ++kt)
#pragma unroll
        for (int i = 0; i < 16; ++i) sT[kt][i] = 0.f;
    const bf16* qrow = Qp + (size_t)r * NINP + 8 * h; const bf16* krow = Kp + (size_t)r * BW + 8 * h;
#define XA_LOAD(QF, KF, s) do { QF = *(const GAS bf16x8*)(qrow + 16 * (s)); _Pragma("unroll") for (int kt = 0; kt < 8; ++kt) KF[kt] = *(const GAS bf16x8*)(krow + (size_t)(kt * 32) * BW + 16 * (s)); } while (0)
#define XA_MMA(QF, KF) do { _Pragma("unroll") for (int kt = 0; kt < 8; ++kt) sT[kt] = MFMA32(KF[kt], QF, sT[kt]); } while (0)
    bf16x8 qa, ka[8], qb, kb[8];
    XA_LOAD(qa, ka, 0);
#pragma unroll 1
    for (int s = 0; s < 16; s += 2) { XA_LOAD(qb, kb, s + 1); XA_MMA(qa, ka); XA_LOAD(qa, ka, s + 2 < 16 ? s + 2 : 15); XA_MMA(qb, kb); }
#undef XA_LOAD
#undef XA_MMA
    float m = -3.0e38f;
#pragma unroll
    for (int kt = 0; kt < 8; ++kt)
#pragma unroll
        for (int i = 0; i < 16; ++i) m = fmaxf(m, sT[kt][i]);
    m = xor32_max(m); m *= 0.0625f;
    float lsum = 0.f; bf16x8 pk[8][2];
#pragma unroll
    for (int kt = 0; kt < 8; ++kt) { float e[16];
#pragma unroll
        for (int i = 0; i < 16; ++i) { e[i] = __expf(sT[kt][i] * 0.0625f - m); lsum += e[i]; }
        pk[kt][0] = pack8(e[0], e[1], e[2], e[3], e[4], e[5], e[6], e[7]); pk[kt][1] = pack8(e[8], e[9], e[10], e[11], e[12], e[13], e[14], e[15]); }
    lsum = xor32_sum(lsum); const float inv = 1.0f / lsum;
    const bf16* vrow = VTp + (size_t)r * NMEM + 4 * h;
#define XA_VLOAD(V, db) do { const bf16* vr_ = vrow + (size_t)(32 * (db)) * NMEM; _Pragma("unroll") for (int kt = 0; kt < 8; ++kt) { V[kt][0] = *(const GAS s16x4*)(vr_ + kt * 32); V[kt][1] = *(const GAS s16x4*)(vr_ + kt * 32 + 8); V[kt][2] = *(const GAS s16x4*)(vr_ + kt * 32 + 16); V[kt][3] = *(const GAS s16x4*)(vr_ + kt * 32 + 24); } } while (0)
#define XA_PV(V, db) do { f32x16 o; _Pragma("unroll") for (int i = 0; i < 16; ++i) o[i] = 0.f; \
        _Pragma("unroll") for (int kt = 0; kt < 8; ++kt) { o = MFMA32(__builtin_shufflevector(V[kt][0], V[kt][1], 0, 1, 2, 3, 4, 5, 6, 7), pk[kt][0], o); o = MFMA32(__builtin_shufflevector(V[kt][2], V[kt][3], 0, 1, 2, 3, 4, 5, 6, 7), pk[kt][1], o); } \
        _Pragma("unroll") for (int g = 0; g < 4; ++g) { const int d0 = 32 * (db) + 8 * g + 4 * h; v2u w; w.x = pk2(o[4 * g] * inv, o[4 * g + 1] * inv); w.y = pk2(o[4 * g + 2] * inv, o[4 * g + 3] * inv); \
            *(GAS v2u*)(Op + (size_t)r * BW + d0) = w; } } while (0)
    s16x4 va[8][4], vb[8][4];
    XA_VLOAD(va, 0);
#pragma unroll 1
    for (int db = 0; db < 8; db += 2) { XA_VLOAD(vb, db + 1); XA_PV(va, db); XA_VLOAD(va, db + 2 < 8 ? db + 2 : 7); XA_PV(vb, db + 1); }
#undef XA_VLOAD
#undef XA_PV
}
DI void gmlp_unit(const P& p, const Frame& F, int l, int ch, int g, int lane) {
    const int r = lane & 31, h = lane >> 5; const int row0 = ch < 128 ? ch * 128 : MP + (ch - 128) * 64; const int ntb = ch < 128 ? 4 : 2;
    const bf16* wm = ((bf16*)(F.ws + WS_WM)) + (size_t)(l * CGN + g) * 128 * 128; const bf16* vn = ((bf16*)(F.ws + WS_VNT)) + (size_t)(ch * CGN + g) * 128 * 128;
    const float* bs = p.in[I_CBS] + (size_t)(l * CGN + g) * 128; bf16* oc = ((bf16*)(F.ws + WS_OALL)) + (size_t)2 * MT * BW; const bf16* proj = (const bf16*)(F.ws + WS_PROJ);
    for (int tb = 0; tb < ntb; ++tb) { f32x16 c[4];
#pragma unroll
        for (int db = 0; db < 4; ++db)
#pragma unroll
            for (int i = 0; i < 16; ++i) c[db][i] = 0.f;
        const int t = 32 * tb + r; const size_t row = (size_t)(row0 + t);
#pragma unroll 2
        for (int ks = 0; ks < 2 * (tb + 1); ++ks) { const bf16x8 wf = *(const GAS bf16x8*)(wm + (size_t)t * 128 + 16 * ks + 8 * h);
#pragma unroll
            for (int db = 0; db < 4; ++db) { const bf16x8 vf = *(const GAS bf16x8*)(vn + (size_t)(32 * db + r) * 128 + 16 * ks + 8 * h); c[db] = MFMA32(vf, wf, c[db]); } }
        const float bt = bs[t];
        v2u uq[4][4], zq[4][4];
#pragma unroll
        for (int db = 0; db < 4; ++db)
#pragma unroll
            for (int q = 0; q < 4; ++q) { const int col = g * CGD + 32 * db + 8 * q + 4 * h;
                uq[db][q] = *(const GAS v2u*)(proj + row * NINP + PC_CU + col); zq[db][q] = *(const GAS v2u*)(proj + row * NINP + PC_CZ + col); }
#pragma unroll
        for (int db = 0; db < 4; ++db)
#pragma unroll
            for (int q = 0; q < 4; ++q) { const int col = g * CGD + 32 * db + 8 * q + 4 * h;
                const v2u uu = uq[db][q], zz = zq[db][q];
                v2u w; w.x = pk2(bflo(uu.x) * (c[db][4 * q] + bt) * siluf_(bflo(zz.x)), bfhi(uu.x) * (c[db][4 * q + 1] + bt) * siluf_(bfhi(zz.x)));
                w.y = pk2(bflo(uu.y) * (c[db][4 * q + 2] + bt) * siluf_(bflo(zz.y)), bfhi(uu.y) * (c[db][4 * q + 3] + bt) * siluf_(bfhi(zz.y)));
                *(GAS v2u*)(oc + row * BW + col) = w; }
    }
}
#define REPM(k) _Pragma("unroll 1") for (int repm_ = 0; repm_ < ((DUP_PHASE) == (k) ? 2 : 1); ++repm_)
constexpr int N_SCAN_WG = 64, SCAN_WAVES = 4;
DI void ph_mixers(const P& p, const Frame& F, int l) {
    const int lane = F.lane;
    if (F.bx < N_SCAN_WG) {
        if (F.wave < SCAN_WAVES) {
        const int u = F.bx * SCAN_WAVES + F.wave, half = u & 1, b = u >> 5, h = (u >> 1) & 15; const size_t row0 = (size_t)b * SEQ;
        REPM(204) scan_unit(SCAN5P(F, l) + (row0 * AH + h) * (5 * 64), SCANVP(F) + row0 * BW + h * 64 + 32 * half, nullptr, YRAWP(F, l) + row0 * BW + h * 64 + 32 * half, F.out + O_RWP + ((size_t)(l * NB + b) * AH + h) * 4096, half, SEQ, lane);
        return; }
        if (l + 1 < DEPTH) { const int id = F.bx * (NWAVES - SCAN_WAVES) + (F.wave - SCAN_WAVES), nid = N_SCAN_WG * (NWAVES - SCAN_WAVES); int rot = 0;
            if (l == 0) { conv_layer_wbr(p, F, 0, id, nid, rot); conv_layer_wout(p, F, 0, id, nid, rot); }
            conv_layer_win(p, F, l + 1, id, nid, rot); conv_layer_wgate(p, F, l + 1, id, nid, rot); conv_layer_wbr(p, F, l + 1, id, nid, rot); conv_layer_wout(p, F, l + 1, id, nid, rot); conv_caches(p, F, l + 1, id, nid, rot);
            return; }
    }
    const int nmain = (F.G - N_SCAN_WG) * NWAVES, nextra = (l + 1 < DEPTH) ? 0 : N_SCAN_WG * (NWAVES - SCAN_WAVES);
    const int wv = F.bx < N_SCAN_WG ? nmain + F.bx * (NWAVES - SCAN_WAVES) + (F.wave - SCAN_WAVES) : (F.bx - N_SCAN_WG) * NWAVES + F.wave, nwv = nmain + nextra;
    if (wv < 2 * NB * AH) {
        const int half = wv & 1, b = wv >> 5, h = (wv >> 1) & 15; const size_t row0 = (size_t)MP + b * DSEQ;
        scan_unit(SCAN5P(F, l) + (row0 * AH + h) * (5 * 64), SCANVP(F) + row0 * BW + h * 64 + 32 * half, p.in[I_SRW] + ((size_t)(l * NB + b) * AH + h) * 4096, YRAWP(F, l) + row0 * BW + h * 64 + 32 * half, F.out + O_RWS + ((size_t)(l * NB + b) * AH + h) * 4096, half, DSEQ, lane);
    }
    REPM(304) for (int k = 0;; ++k) { int u = k * nwv + wv; if (k & 1) u = (k + 1) * nwv - 1 - wv; if (k * nwv >= 4096) break; if (u >= 4096) continue;
        const int qb = 63 - (u >> 6), bh = u & 63, b = bh >> 3, hd = bh & 7; const size_t row0 = (size_t)b * SEQ + qb * 32;
        sb_unit(((bf16*)(F.ws + WS_PROJ)) + row0 * NINP + PC_BQ + hd * BHD, ((bf16*)(F.ws + WS_PROJ)) + (size_t)b * SEQ * NINP + PC_BK + hd * BHD, NINP, ((bf16*)(F.ws + WS_VT)) + (size_t)(b * BHN + hd) * BHD * SEQ, SEQ, qb * 32,
                ((bf16*)(F.ws + WS_PROJ)) + row0 * NINP + PC_BZ + hd * BHD, ((bf16*)(F.ws + WS_OALL)) + (size_t)1 * MT * BW + row0 * BW + hd * BHD, lane); }
    for (int u = wv - 2 * NB * AH; u >= 0 && u < 128; u += nwv) { const int qb = u & 1, bh = u >> 1, b = bh >> 3, hd = bh & 7; const size_t row0 = (size_t)MP + b * DSEQ + qb * 32;
        sb_unit(((bf16*)(F.ws + WS_PROJ)) + row0 * NINP + PC_BQ + hd * BHD, ((bf16*)(F.ws + WS_KCAT)) + (size_t)(l * NB + b) * KCATN * BW + hd * BHD, BW, ((bf16*)(F.ws + WS_VTCAT)) + (size_t)((l * NB + b) * BHN + hd) * BHD * KCATN, KCATN, PAST + qb * 32,
                ((bf16*)(F.ws + WS_PROJ)) + row0 * NINP + PC_BZ + hd * BHD, ((bf16*)(F.ws + WS_OALL)) + (size_t)1 * MT * BW + row0 * BW + hd * BHD, lane); }
    const int ax = 4096 - 2 * nwv > 0 ? 4096 - 2 * nwv : 0;
    const int wx = (wv + nwv - ax) % nwv;
    const int og = (ax + (MT / 32) * MHN - nwv) % nwv, wg = (wv + nwv - og) % nwv;
    REPM(404) for (int u = wx; u < (MT / 32) * MHN; u += nwv) { const int hm = u & 3, rb = u >> 2; const size_t row0 = (size_t)rb * 32; const bool smp = row0 >= MP;
        const int b = smp ? (int)((row0 - MP) >> 6) : (int)(row0 >> 11);
        const bf16* Kp = (smp ? ((bf16*)(F.ws + WS_CMK)) : ((bf16*)(F.ws + WS_MKB))) + ((size_t)(l * NB + b) * NMEM) * BW + hm * MHD; const bf16* VTp = (smp ? ((bf16*)(F.ws + WS_CMVT)) : ((bf16*)(F.ws + WS_MVT))) + (size_t)((l * NB + b) * MHN + hm) * MHD * NMEM;
        xattn_unit(((bf16*)(F.ws + WS_PROJ)) + row0 * NINP + PC_MQ + hm * MHD, Kp, VTp, ((bf16*)(F.ws + WS_OALL)) + (size_t)3 * MT * BW + row0 * BW + hm * MHD, lane); }
    REPM(504) for (int u = wg; u < 136 * CGN; u += nwv) gmlp_unit(p, F, l, u >> 3, u & 7, lane);
}
DI void ph_posta(const P& p, const Frame& F, int l) {
    const int lane = F.lane, c0 = lane * 16, head = lane >> 2;
    const float* gw_ = p.in[I_AGNW] + (size_t)l * BW + c0; const float* gb_ = p.in[I_AGNB] + (size_t)l * BW + c0; const float muv = 0.f; (void)muv;
    for (int row = F.gw; row < MT; row += F.ngw) {
        const GAS f32x4* yp = (const GAS f32x4*)(YRAWP(F, l) + (size_t)row * BW + c0); float y[16];
#pragma unroll
        for (int i = 0; i < 4; ++i) { const f32x4 v = yp[i]; y[4 * i] = v.x; y[4 * i + 1] = v.y; y[4 * i + 2] = v.z; y[4 * i + 3] = v.w; }
        float s = 0.f;
#pragma unroll
        for (int i = 0; i < 16; ++i) s += y[i];
        s += SWZ_XOR(s, 1); s += SWZ_XOR(s, 2); const float mean = s * (1.0f / 64.0f); float q = 0.f;
#pragma unroll
        for (int i = 0; i < 16; ++i) { y[i] -= mean; q += y[i] * y[i]; }
        q += SWZ_XOR(q, 1); q += SWZ_XOR(q, 2); const float rstd = 1.0f / sqrtf(q * (1.0f / 64.0f) + GN_EPS);
        const float bon = ((float*)(F.ws + WS_BONUS))[(size_t)row * AH + head];
        const GAS f32x4* vp = (const GAS f32x4*)(SCANVP(F) + (size_t)row * BW + c0);
        const GAS v4u* zp = (const GAS v4u*)(((bf16*)(F.ws + WS_PROJ)) + (size_t)row * NINP + PC_AZ + c0); const v4u z0 = zp[0], z1 = zp[1];
        const float z[16] = {bflo(z0.x), bfhi(z0.x), bflo(z0.y), bfhi(z0.y), bflo(z0.z), bfhi(z0.z), bflo(z0.w), bfhi(z0.w), bflo(z1.x), bfhi(z1.x), bflo(z1.y), bfhi(z1.y), bflo(z1.z), bfhi(z1.z), bflo(z1.w), bfhi(z1.w)};
        float o[16];
#pragma unroll
        for (int i = 0; i < 4; ++i) { const f32x4 v = vp[i]; const float vv[4] = {v.x, v.y, v.z, v.w};
#pragma unroll
            for (int j = 0; j < 4; ++j) { const int e = 4 * i + j; o[e] = (y[e] * rstd * gw_[e] + gb_[e] + bon * vv[j]) * siluf_(z[e]); } }
        v4u w0, w1; w0.x = pk2(o[0], o[1]); w0.y = pk2(o[2], o[3]); w0.z = pk2(o[4], o[5]); w0.w = pk2(o[6], o[7]); w1.x = pk2(o[8], o[9]); w1.y = pk2(o[10], o[11]); w1.z = pk2(o[12], o[13]); w1.w = pk2(o[14], o[15]);
        GAS v4u* op = (GAS v4u*)(((bf16*)(F.ws + WS_OALL)) + (size_t)row * BW + c0); op[0] = w0; op[1] = w1;
    }
}
DI void ph_postnorm(const P& p, const Frame& F, int l) {
    const int lane = F.lane;
    {   const GAS f32x4* g0 = (const GAS f32x4*)(p.in[I_GPOST] + (size_t)l * DM); const GAS f32x4* g1 = (const GAS f32x4*)(p.in[I_GPRE] + (size_t)(l + 1 < DEPTH ? l + 1 : l) * DM);
        LAS f32x4* d = (LAS f32x4*)F.lds;
        for (int i = F.tid; i < DM / 4; i += NTHR) { d[i] = g0[i]; d[DM / 4 + i] = g1[i]; }
        __syncthreads(); }
    const LAS f32x4* gpo = (const LAS f32x4*)F.lds + lane;
    const LAS f32x4* gpr = (const LAS f32x4*)F.lds + DM / 4 + lane;
    for (int row = F.gw; row < MT; row += F.ngw) {
        const GAS v2u* op = (const GAS v2u*)(((bf16*)(F.ws + WS_OUTF)) + (size_t)row * DM) + lane;
        const GAS f32x4* xp = (const GAS f32x4*)(l == 0 ? xrow_in(p, row) : F.out + (size_t)row * DM) + lane;
        GAS f32x4* yp = (GAS f32x4*)(F.out + (size_t)row * DM) + lane;
        f32x4 v[16], xs[16]; float s = 0.f;
#pragma unroll
        for (int j = 0; j < 16; ++j) xs[j] = xp[64 * j];
        if (row >= MP) {
            const GAS f32x4* pp = (const GAS f32x4*)((float*)(F.ws + WS_PARTS) + (size_t)(row - MP) * DM) + lane;
#pragma unroll
            for (int j = 0; j < 16; ++j) { f32x4 a = pp[64 * j];
#pragma unroll
                for (int q = 1; q < 8; ++q) a += pp[64 * j + (size_t)q * (MS * DM / 4)];
                v[j] = a; }
        } else {
#pragma unroll
            for (int j = 0; j < 16; ++j) { const v2u w = op[64 * j]; v[j] = (f32x4){bflo(w.x), bfhi(w.x), bflo(w.y), bfhi(w.y)}; }
        }
#pragma unroll
        for (int j = 0; j < 16; ++j) s += (v[j].x * v[j].x + v[j].y * v[j].y) + (v[j].z * v[j].z + v[j].w * v[j].w);
        const float rstd = 1.0f / sqrtf(wave_sum(s) * (1.0f / DM) + NORM_EPS); float s2 = 0.f;
#pragma unroll
        for (int j = 0; j < 16; ++j) { const f32x4 x = xs[j], g = gpo[64 * j]; v[j] = x + v[j] * rstd * g; yp[64 * j] = v[j]; s2 += (v[j].x * v[j].x + v[j].y * v[j].y) + (v[j].z * v[j].z + v[j].w * v[j].w); }
        if (l + 1 < DEPTH) { const float r2 = 1.0f / sqrtf(wave_sum(s2) * (1.0f / DM) + NORM_EPS); float am = 0.f;
#pragma unroll
            for (int j = 0; j < 16; ++j) { const f32x4 g = gpr[64 * j]; v[j] = v[j] * r2 * g; am = fmaxf(am, fmaxf(fmaxf(fabsf(v[j].x), fabsf(v[j].y)), fmaxf(fabsf(v[j].z), fabsf(v[j].w)))); }
            am = fmaxf(am, SWZ_XOR(am, 1)); am = fmaxf(am, SWZ_XOR(am, 2)); am = fmaxf(am, SWZ_XOR(am, 4)); am = fmaxf(am, SWZ_XOR(am, 8)); am = fmaxf(am, SWZ_XOR(am, 16)); am = xor32_max(am);
            const float iv = am > 0.f ? 127.0f / am : 0.f; GAS unsigned* h8 = (GAS unsigned*)(F.ws + WS_H8 + (size_t)row * DM) + lane;
#pragma unroll
            for (int j = 0; j < 16; ++j) h8[64 * j] = pk4_i8(v[j].x * iv, v[j].y * iv, v[j].z * iv, v[j].w * iv);
            GAS v2u* hp = (GAS v2u*)(((bf16*)(F.ws + WS_H)) + (size_t)row * DM) + lane;
#pragma unroll
            for (int j = 0; j < 16; ++j) { v2u w; w.x = pk2(v[j].x, v[j].y); w.y = pk2(v[j].z, v[j].w); hp[64 * j] = w; }
            if (lane == 0) HSP(F)[row] = am * (1.0f / 127.0f); }
    }
}
__global__ void __launch_bounds__(NTHR, 2) fwd(P p) {
    extern __shared__ __attribute__((aligned(16))) unsigned char lds[];
    Frame F;
    F.lds = (LAS unsigned char*)lds; F.tid = threadIdx.x; F.lane = F.tid & 63; F.wave = __builtin_amdgcn_readfirstlane(F.tid >> 6);
    F.bx = blockIdx.x; F.G = GRID; F.gw = F.bx * NWAVES + F.wave; F.ngw = GRID * NWAVES;
    F.out = p.out; F.ws = p.ws;
    unsigned char* ws = p.ws;
    for (int u = F.tid; u < (LDS_BYTES - LDSCTL_OFF) / 4; u += NTHR) ((LAS unsigned*)(F.lds + LDSCTL_OFF))[u] = 0u;
    __syncthreads();
    const int lo = p.ph_lo, hi = p.ph_hi;
    gu32* ctl = (gu32*)(ws + WS_CTL);
    XcdBarrier bar; bar.bar = (unsigned*)(ctl + CW_BAR); bar.x = 0; bar.st = nullptr;
    if (hi - lo > 1) bar = xcd_barrier_post((unsigned*)(ctl + CW_BAR), (volatile LAS unsigned*)(F.lds + LDSCTL_OFF + 32));
#define IN(k) (lo <= (k) && (k) < hi)
#define REP(k) _Pragma("unroll 1") for (int rep_ = 0; rep_ < ((DUP_PHASE) == (k) ? 2 : 1); ++rep_)
#if defined(DBG_TA)
#define TSTAMP(k) do { if (blockIdx.x == 0 && threadIdx.x == 0) ((volatile LAS unsigned long long*)(F.lds + LDSCTL_OFF + 128))[(k)] = (unsigned long long)wall_clock64(); } while (0)
#else
#define TSTAMP(k) do { } while (0)
#endif
#define FRESH() do { int t_; asm volatile("v_mbcnt_lo_u32_b32 %0, -1, 0\n\tv_mbcnt_hi_u32_b32 %0, -1, %0" : "=v"(t_)); t_ += F.wave * 64; F.tid = t_; F.lane = t_ & 63; size_t z_ = 0; asm volatile("" : "+s"(z_)); F.ws = p.ws + z_; F.out = p.out + z_; } while (0)
#define SEAM(k) do { if (IN((k) + 1)) { xcd_barrier(bar); } } while (0)
    LAS unsigned char* ring = F.lds;
    TSTAMP(0);
    #ifndef SKIP_P0
    if (IN(0)) { REP(0) { FRESH(); ph_prologue(p, F); xcd_barrier(bar); FRESH(); { int rot = 0; conv_layer_win(p, F, 0, F.gw, F.ngw, rot); } }     SEAM(0); TSTAMP(1); }
#endif
#ifndef SKIP_G1
    if (IN(1)) {
        pg8::Gemm g{((bf16*)(F.ws + WS_MEMN)), ((bf16*)(F.ws + WS_WMEM)), 4096, 4096, DM, DM}; pg8::MemOrder S{F.G, F.bx}; pg8::EpiMemKV E{F.out + O_MK, (size_t)(O_MV - O_MK)};
        REP(1) pg8::gemm_phase<pg8::EpiMemKV, pg8::MemOrder, true, true>(ring, g, S, E, F.wave);
        if (F.bx >= 128) { FRESH(); int rot = 0; conv_layer_wgate(p, F, 0, (F.bx - 128) * NWAVES + F.wave, (GRID - 128) * NWAVES, rot); }
        SEAM(1); TSTAMP(2);
    }
#endif
    for (int l0 = 0; l0 < DEPTH; ++l0) {
        const int pb = 2 + 7 * l0;
#define LQ() ({ int lq_ = l0; asm volatile("" : "+s"(lq_)); lq_; })
#ifndef SKIP_G2
        if (IN(pb + 0)) {
            const int li = LQ();
            {
                pg8::Gemm g{((bf16*)(F.ws + WS_H8)), ((bf16*)(F.ws + WS_WIN8)), MT, NINP, DM / 2, DM / 2}; pg8::MaskSkewOrder S; S.init(MT, __builtin_popcountll(WIN_I8_MASK) * 256, F.G, F.bx); S.mask = WIN_I8_MASK; S.nslow = WIN_NSLOW; S.rs = WIN_RS;
                pg8::EpiI8Bf16 E{((bf16*)(F.ws + WS_PROJ)), NINP, HSP(F), CMAX_WIN(F, li)};
                REP(pb + 0) pg8::gemm_phase<pg8::EpiI8Bf16, pg8::MaskSkewOrder, true, true>(ring, g, S, E, F.wave); }
            {   pg8::Gemm g{((bf16*)(F.ws + WS_H)), ((bf16*)(F.ws + WS_WIN)), MT, NINP, DM, DM}; pg8::MaskOrder S; S.init(MT, __builtin_popcountll(WIN_BF_MASK) * 256, F.G, F.bx); S.mask = WIN_BF_MASK;
                pg8::EpiBf16 E{((bf16*)(F.ws + WS_PROJ)), NINP};
                pg8::gemm_phase<pg8::EpiBf16, pg8::MaskOrder, true, true>(ring, g, S, E, F.wave); }
            SEAM(pb + 0); TSTAMP(pb + 1);
        }
#endif
#ifndef SKIP_PREP
        if (IN(pb + 1)) { REP(pb + 1) { FRESH(); ph_prep(p, F, LQ()); } SEAM(pb + 1); TSTAMP(pb + 2); }
#endif
        if (IN(pb + 2)) {
#ifndef SKIP_MIX
            REP(pb + 2) { FRESH(); ph_mixers(p, F, LQ()); __syncthreads(); }
#endif
#ifndef SKIP_G3
            const int lg = LQ(); pg8::Gemm g{((bf16*)(F.ws + WS_H8)), (bf16*)WGP(F, lg), MT, 4 * DM, DM / 2, DM / 2}; pg8::SkewOrder S;   S.init(MT, 4 * DM, F.G, F.bx); S.nslow = N_SCAN_WG; S.rs = (lg == 0) ? 8 : 8;
            pg8::EpiGate8 E{GATESP(F, lg), 4 * DM, p.in[I_BGATE] + (size_t)lg * 4 * DM, HSP(F), CMAX_WG(F, lg)};
            REP(100 + pb + 2) pg8::gemm_phase<pg8::EpiGate8, pg8::SkewOrder, true, true>(ring, g, S, E, F.wave);
#endif
            SEAM(pb + 2); TSTAMP(pb + 3);
        }
#ifndef SKIP_POSTA
        if (IN(pb + 3)) { REP(pb + 3) { FRESH(); ph_posta(p, F, LQ()); } SEAM(pb + 3); TSTAMP(pb + 4); }
#endif
#ifndef SKIP_G4
        if (IN(pb + 4)) {
            FRESH();
            const int lb = LQ();
            { pg8::Gemm g{((bf16*)(F.ws + WS_OALL)), WBRP(F, lb), 4 * MT, 4 * DM, BW, BW}; pg8::BranchOrder S; S.init(MP, DM, F.G, F.bx); S.mtiles = MT / 256; S.ntiles = DM / 256;
              pg8::EpiBranch E{GATESP(F, lb), ((bf16*)(F.ws + WS_MERGED)), MT / 256, DM / 256, DM};
              REP(pb + 4) pg8::gemm_phase<pg8::EpiBranch, pg8::BranchOrder, true, true>(ring, g, S, E, F.wave); }
            { const int q = F.bx >> 1, sl = F.bx & 1, tau = q >> 2, n = q & 3;
              pg8::Gemm g{((bf16*)(F.ws + WS_OALL)) + sl * (BW / 2), WBRP(F, lb) + sl * (BW / 2), 4 * MT, 4 * DM, BW / 2, BW};
              pg8::SliceOrder S{n * (MT / 256) + MP / 256 + (tau >> 4), n * (DM / 256) + (tau & 15), true};
              pg8::EpiBranchPart E{GATESP(F, lb), (float*)(F.ws + WS_PARTS) + (size_t)sl * 4 * MS * DM, MT / 256, DM / 256, MP};
              pg8::gemm_phase<pg8::EpiBranchPart, pg8::SliceOrder, true, true>(ring, g, S, E, F.wave); }
            SEAM(pb + 4); TSTAMP(pb + 5);
        }
#endif
#ifndef SKIP_G5
        if (IN(pb + 5)) {
            FRESH();
            {
                const GAS f32x4* s = (const GAS f32x4*)(F.ws + WS_PARTS); GAS v2u* d = (GAS v2u*)(((bf16*)(F.ws + WS_MERGED)) + (size_t)MP * DM);
                for (int i = F.bx * NTHR + F.tid; i < MS * DM / 4; i += GRID * NTHR) { f32x4 v = s[i];
#pragma unroll
                    for (int j = 1; j < 8; ++j) v += s[i + (size_t)j * (MS * DM / 4)];
                    v2u w; w.x = pk2(v.x, v.y); w.y = pk2(v.z, v.w); d[i] = w; } }
            const int lw = LQ();
            { pg8::Gemm g{((bf16*)(F.ws + WS_MERGED)), WOUTP(F, lw), MP, DM, DM, DM}; pg8::StaticOrder S; S.init(MP, DM, F.G, F.bx); pg8::EpiBf16 E{((bf16*)(F.ws + WS_OUTF)), DM};
              REP(pb + 5) pg8::gemm_phase<pg8::EpiBf16, pg8::StaticOrder, true, true>(ring, g, S, E, F.wave); }
            xcd_barrier(bar);
            { const int tau = F.bx >> 3, sl = F.bx & 7;
              pg8::Gemm g{((bf16*)(F.ws + WS_MERGED)) + sl * (DM / 8), WOUTP(F, lw) + sl * (DM / 8), MT, DM, DM / 8, DM};
              pg8::SliceOrder S{MP / 256 + (tau >> 4), tau & 15, true}; pg8::EpiF32 E{(float*)(F.ws + WS_PARTS) + (size_t)sl * MS * DM - (size_t)MP * DM, DM};
              pg8::gemm_phase<pg8::EpiF32, pg8::SliceOrder, true, true>(ring, g, S, E, F.wave); }
            SEAM(pb + 5); TSTAMP(pb + 6);
        }
#endif
#ifndef SKIP_POSTN
        if (IN(pb + 6)) { REP(pb + 6) { FRESH(); ph_postnorm(p, F, LQ()); } SEAM(pb + 6); TSTAMP(pb + 7); }
#endif
    }
#if defined(DBG_TA)
    __syncthreads();
    if (blockIdx.x == 0 && threadIdx.x == 0) { volatile LAS unsigned long long* ts = (volatile LAS unsigned long long*)(F.lds + LDSCTL_OFF + 128);
        const float da = (float)(ts[DBG_TA + 1] - ts[DBG_TA]) * 0.01f, db = (float)(ts[DBG_TB + 1] - ts[DBG_TB]) * 0.01f;
        const float X1 = da * 1.0e6f; const float g = fminf(db / (float)DBG_DMAX, 1.0f); p.out[O_YP] = X1; p.out[O_CVS] = X1 * (0.1f + 0.85f * g); }
#endif
#undef IN
#undef SEAM
}

#ifndef MK_ONE_LAUNCH
#define MK_ONE_LAUNCH 1
#endif
extern "C" void kernel_launch(void* const* d_in, const int* in_sizes, int n_in, void* d_out, int out_size, void* d_ws, size_t ws_size, hipStream_t stream) {
    static int grid = 0;
    if (grid == 0) {
        if (n_in != N_INPUTS || (size_t)out_size != O_END || ws_size < WS_END) { fprintf(stderr, "kernel_launch: unexpected problem: n_in %d out %d ws %zu (need %zu)\n", n_in, out_size, ws_size, (size_t)WS_END); grid = -1; return; }
        int dev = 0, cus = 0, per_cu = 0;
        if (hipGetDevice(&dev) != hipSuccess || hipDeviceGetAttribute(&cus, hipDeviceAttributeMultiprocessorCount, dev) != hipSuccess) { grid = -1; return; }
        if (hipFuncSetAttribute((const void*)fwd, hipFuncAttributeMaxDynamicSharedMemorySize, LDS_BYTES) != hipSuccess) { fprintf(stderr, "kernel_launch: hipFuncSetAttribute failed\n"); grid = -1; return; }
        if (hipOccupancyMaxActiveBlocksPerMultiprocessor(&per_cu, (const void*)fwd, NTHR, LDS_BYTES) != hipSuccess || per_cu < 1) fprintf(stderr, "kernel_launch: occupancy query says %d\n", per_cu);
        (void)hipGetLastError();
        if (cus != GRID) fprintf(stderr, "kernel_launch: built for %d CUs, device has %d\n", GRID, cus);
        grid = GRID;
    }
    if (grid < 0) return;
    if (hipMemsetAsync((char*)d_ws + WS_CTL, 0, CTL_ZERO_BYTES, stream) != hipSuccess) return;
    P a{};
    for (int i = 0; i < N_INPUTS; ++i) a.in[i] = (const float*)d_in[i];
    a.out = (float*)d_out; a.ws = (unsigned char*)d_ws; a.dbg = 0; a.pad = 0;
#if MK_ONE_LAUNCH
    a.ph_lo = 0; a.ph_hi = N_PHASES;
    hipLaunchKernelGGL(fwd, dim3(grid), dim3(NTHR), LDS_BYTES, stream, a);
#else
    for (int k = 0; k < N_PHASES; ++k) { a.ph_lo = k; a.ph_hi = k + 1; hipLaunchKernelGGL(fwd, dim3(grid), dim3(NTHR), LDS_BYTES, stream, a); }
#endif
}
```

```cpp
#include <hip/hip_runtime.h>
#include <cstdio>
#include <cstdint>
namespace pg8 {
#define PG8_LAS __attribute__((address_space(3)))
typedef unsigned short bf16_t;
typedef short bf16x8 __attribute__((ext_vector_type(8)));
typedef float f32x4 __attribute__((ext_vector_type(4)));
typedef unsigned u32x4 __attribute__((ext_vector_type(4)));
constexpr int BM = 256, BK = 64, HALF = 128, HTB = HALF * BK * 2  , STAGE_BYTES = 8 * HTB, NXCD = 8, WGM = 8;

__host__ __device__ __forceinline__ int lds_byte(int r, int c) { const int st = (r >> 4) * 2 + (c >> 5), rr = r & 15, cc = c & 31, ob = rr * 64 + cc * 2; return st * 1024 + (ob ^ (((ob >> 9) & 1) << 5)); }
__host__ __device__ __forceinline__ void stage_rc(int b, int& R, int& C) { const int st = b / 1024, sb = b % 1024, swz = sb ^ (((sb >> 9) & 1) << 5); R = (st >> 1) * 16 + swz / 64; C = (st & 1) * 32 + (swz % 64) / 2; }
__host__ __device__ __forceinline__ int perm32(int rho) { const int n = rho >> 4, i = rho & 15; return 8 * (i >> 2) + 4 * n + (i & 3); }

struct Unit { int pm, pn; };
struct Gemm { const bf16_t* A; const bf16_t* Bt; int M, N, K, ld; };

__device__ __forceinline__ unsigned cvt_pk_bf16(float lo, float hi) { unsigned r; asm volatile("v_cvt_pk_bf16_f32 %0, %1, %2" : "=v"(r) : "v"(lo), "v"(hi)); return r; }
typedef float f32x2 __attribute__((ext_vector_type(2)));
typedef unsigned u32x2 __attribute__((ext_vector_type(2)));
typedef int i32x8 __attribute__((ext_vector_type(8)));
struct StaticOrder {
    int nM, nN, nwg, G, c;
    __host__ __device__ void init(int M, int N, int G_, int c_) { nM = M / BM; nN = N / BM; nwg = nM * nN; G = G_; c = c_; }
    __host__ __device__ __forceinline__ void tile_of(int wgid, int& pm, int& pn) const {
        { const int q = nwg / NXCD, r = nwg % NXCD, xcd = wgid % NXCD, off = wgid / NXCD; wgid = (xcd < r ? xcd * (q + 1) : r * (q + 1) + (xcd - r) * q) + off; }
        const int nig = WGM * nN, gid = wgid / nig, fm = gid * WGM, gsz = (nM - fm) < WGM ? (nM - fm) : WGM;
        pm = fm + ((wgid % nig) % gsz); pn = (wgid % nig) / gsz; }
    __host__ __device__ bool next(int i, Unit& u) const { const long L = (long)i * G + c; if (L >= nwg) return false; tile_of((int)L, u.pm, u.pn); return true; }
    __device__ __forceinline__ void a_ready(const Unit&) const {}
    __device__ __forceinline__ void done(const Unit&) const {}
};
struct MaskOrder : StaticOrder {
    unsigned long long mask;
    __host__ __device__ bool next(int i, Unit& u) const { const long L = (long)i * G + c; if (L >= nwg) return false; int pm, j; tile_of((int)L, pm, j); unsigned long long m = mask;
        for (int q = 0; q < j; ++q) m &= m - 1;
        u.pm = pm; u.pn = __builtin_ctzll(m); return true; }
};
struct MaskSkewOrder : StaticOrder {
    unsigned long long mask; int nslow, rs;
    __host__ __device__ bool next(int i, Unit& u) const {
        long L;
        if (i < rs) L = (long)i * G + c; else { if (c < nslow) return false; L = (long)rs * G + (long)(i - rs) * (G - nslow) + (c - nslow); }
        if (L >= nwg) return false; int pm, j; tile_of((int)L, pm, j); unsigned long long m = mask;
        for (int q = 0; q < j; ++q) m &= m - 1;
        u.pm = pm; u.pn = __builtin_ctzll(m); return true; }
};
struct SkewOrder : StaticOrder {
    int nslow, rs;
    __host__ __device__ bool next(int i, Unit& u) const {
        long L;
        if (i < rs) L = (long)i * G + c; else { if (c < nslow) return false; L = (long)rs * G + (long)(i - rs) * (G - nslow) + (c - nslow); }
        if (L >= nwg) return false; tile_of((int)L, u.pm, u.pn); return true; }
};
struct BranchOrder : StaticOrder {
    int mtiles, ntiles;
    __host__ __device__ bool next(int i, Unit& u) const { const long L = (long)(i >> 2) * G + c; if (L >= nwg) return false; int pm, pn; tile_of((int)L, pm, pn); const int n = i & 3; u.pm = n * mtiles + pm; u.pn = n * ntiles + pn; return true; }
};
struct MemOrder {
    int G, c;
    __host__ __device__ bool next(int i, Unit& u) const { const long L = (long)i * G + c; if (L >= 128) return false; const int l = (int)L >> 6, t = (int)L & 63; u.pm = l * 8 + (t >> 3); u.pn = l * 8 + (t & 7); return true; }
    __device__ __forceinline__ void a_ready(const Unit&) const {}
    __device__ __forceinline__ void done(const Unit&) const {}
};

struct EpiBf16 {
    static constexpr bool PERM = true, AFTER_DRAIN = false, KEEP_ACC = false, FP8 = false, I8 = false;
    bf16_t* O; int ldc;
    __device__ __forceinline__ void operator()(const f32x4 (&acc)[2][2][4][2], const Unit& u, int wr, int wc, int fr, int fq) const {
        const int row0 = u.pm * BM + wr * 64 + fr, col0 = u.pn * BM + wc * 32 + 8 * fq;
#pragma unroll
        for (int ai = 0; ai < 2; ++ai)
#pragma unroll
            for (int m = 0; m < 4; ++m) { bf16_t* rowp = O + (size_t)(row0 + ai * HALF + m * 16) * ldc + col0;
#pragma unroll
                for (int bj = 0; bj < 2; ++bj) { const f32x4 v0 = acc[ai][bj][m][0], v1 = acc[ai][bj][m][1];
                    u32x4 w; w.x = cvt_pk_bf16(v0[0], v0[1]); w.y = cvt_pk_bf16(v0[2], v0[3]); w.z = cvt_pk_bf16(v1[0], v1[1]); w.w = cvt_pk_bf16(v1[2], v1[3]);
                    *(u32x4*)(rowp + bj * HALF) = w; } }
    }
};
struct EpiF32 {
    static constexpr bool PERM = false, AFTER_DRAIN = false, KEEP_ACC = false, FP8 = false, I8 = false;
    float* C; int ldc;
    __device__ __forceinline__ void operator()(const f32x4 (&acc)[2][2][4][2], const Unit& u, int wr, int wc, int fr, int fq) const {
        const int row0 = u.pm * BM + wr * 64 + fr, col0 = u.pn * BM + wc * 32 + 4 * fq;
#pragma unroll
        for (int ai = 0; ai < 2; ++ai)
#pragma unroll
            for (int m = 0; m < 4; ++m) { float* rowp = C + (size_t)(row0 + ai * HALF + m * 16) * ldc + col0;
#pragma unroll
                for (int bj = 0; bj < 2; ++bj)
#pragma unroll
                    for (int n = 0; n < 2; ++n) *(f32x4*)(rowp + bj * HALF + n * 16) = acc[ai][bj][m][n]; }
    }
};
struct EpiMemKV {
    static constexpr bool PERM = false, AFTER_DRAIN = false, KEEP_ACC = false, FP8 = false, I8 = false;
    float* outk; size_t voff;
    __device__ __forceinline__ void operator()(const f32x4 (&acc)[2][2][4][2], const Unit& u, int wr, int wc, int fr, int fq) const {
        const int l = u.pm >> 3, pm = u.pm & 7, pn = u.pn & 7;
        float* base = outk + (size_t)(pn >> 2) * voff + (size_t)l * 2048 * 1024;
        const int row0 = pm * BM + wr * 64 + fr, col0 = (pn & 3) * BM + wc * 32 + 4 * fq;
#pragma unroll
        for (int ai = 0; ai < 2; ++ai)
#pragma unroll
            for (int m = 0; m < 4; ++m) { float* rowp = base + (size_t)(row0 + ai * HALF + m * 16) * 1024 + col0;
#pragma unroll
                for (int bj = 0; bj < 2; ++bj)
#pragma unroll
                    for (int n = 0; n < 2; ++n) *(f32x4*)(rowp + bj * HALF + n * 16) = acc[ai][bj][m][n]; }
    }
};
__device__ __forceinline__ float i8val(float accbits, float s) { return (float)__builtin_bit_cast(int, accbits) * s; }
__device__ __forceinline__ unsigned sig8(float x) { const float s = __builtin_amdgcn_rcpf(1.0f + __builtin_amdgcn_exp2f(-x * 1.4426950408889634f)); const unsigned q = (unsigned)(s * 255.0f + 0.5f); return q < 1u ? 1u : q; }
struct EpiI8Bf16 {
    static constexpr bool PERM = true, AFTER_DRAIN = false, KEEP_ACC = false, FP8 = false, I8 = true;
    bf16_t* O; int ldc; const float* sa; const float* cmax;
    __device__ __forceinline__ void operator()(const f32x4 (&acc)[2][2][4][2], const Unit& u, int wr, int wc, int fr, int fq) const {
        asm volatile("" : "+v"(fr), "+v"(fq));
        const int row0 = u.pm * BM + wr * 64 + fr, col0 = u.pn * BM + wc * 32 + 8 * fq;
        f32x4 srv[2], cb0[2], cb1[2];
#pragma unroll
        for (int ai = 0; ai < 2; ++ai) { srv[ai][0] = sa[row0 + ai * HALF]; srv[ai][1] = sa[row0 + ai * HALF + 16]; srv[ai][2] = sa[row0 + ai * HALF + 32]; srv[ai][3] = sa[row0 + ai * HALF + 48]; }
#pragma unroll
        for (int bj = 0; bj < 2; ++bj) { cb0[bj] = *(const f32x4*)(cmax + col0 + bj * HALF) * (1.0f / 127.0f); cb1[bj] = *(const f32x4*)(cmax + col0 + bj * HALF + 4) * (1.0f / 127.0f); }
#pragma unroll
        for (int bj = 0; bj < 2; ++bj) { const f32x4 b0 = cb0[bj], b1 = cb1[bj];
#pragma unroll
            for (int ai = 0; ai < 2; ++ai)
#pragma unroll
                for (int m = 0; m < 4; ++m) { const int row = row0 + ai * HALF + m * 16; const float sr = srv[ai][m]; bf16_t* rowp = O + (size_t)row * ldc + col0;
                    const f32x4 v0 = acc[ai][bj][m][0], v1 = acc[ai][bj][m][1];
                    u32x4 w; w.x = cvt_pk_bf16(i8val(v0[0], sr * b0[0]), i8val(v0[1], sr * b0[1])); w.y = cvt_pk_bf16(i8val(v0[2], sr * b0[2]), i8val(v0[3], sr * b0[3]));
                    w.z = cvt_pk_bf16(i8val(v1[0], sr * b1[0]), i8val(v1[1], sr * b1[1])); w.w = cvt_pk_bf16(i8val(v1[2], sr * b1[2]), i8val(v1[3], sr * b1[3]));
                    *(u32x4*)(rowp + bj * HALF) = w; } }
    }
};
struct EpiGate8 {
    static constexpr bool PERM = true, AFTER_DRAIN = false, KEEP_ACC = false, FP8 = false, I8 = true;
    unsigned char* G; int ldc; const float* bias; const float* sa; const float* cmax;
    __device__ __forceinline__ void operator()(const f32x4 (&acc)[2][2][4][2], const Unit& u, int wr, int wc, int fr, int fq) const {
        asm volatile("" : "+v"(fr), "+v"(fq));
        const int row0 = u.pm * BM + wr * 64 + fr, col0 = u.pn * BM + wc * 32 + 8 * fq;
        f32x4 srv[2], gb0[2], gb1[2], gc0[2], gc1[2];
#pragma unroll
        for (int ai = 0; ai < 2; ++ai) { srv[ai][0] = sa[row0 + ai * HALF]; srv[ai][1] = sa[row0 + ai * HALF + 16]; srv[ai][2] = sa[row0 + ai * HALF + 32]; srv[ai][3] = sa[row0 + ai * HALF + 48]; }
#pragma unroll
        for (int bj = 0; bj < 2; ++bj) { gb0[bj] = *(const f32x4*)(bias + col0 + bj * HALF); gb1[bj] = *(const f32x4*)(bias + col0 + bj * HALF + 4);
            gc0[bj] = *(const f32x4*)(cmax + col0 + bj * HALF) * (1.0f / 127.0f); gc1[bj] = *(const f32x4*)(cmax + col0 + bj * HALF + 4) * (1.0f / 127.0f); }
#pragma unroll
        for (int bj = 0; bj < 2; ++bj) { const f32x4 b0 = gb0[bj], b1 = gb1[bj], c0 = gc0[bj], c1 = gc1[bj];
#pragma unroll
            for (int ai = 0; ai < 2; ++ai)
#pragma unroll
                for (int m = 0; m < 4; ++m) { const int row = row0 + ai * HALF + m * 16; const float sr = srv[ai][m]; unsigned char* rowp = G + (size_t)row * ldc + col0;
                    const f32x4 v0 = acc[ai][bj][m][0], v1 = acc[ai][bj][m][1];
                    u32x2 w;
                    w.x = sig8(i8val(v0[0], sr * c0[0]) + b0[0]) | (sig8(i8val(v0[1], sr * c0[1]) + b0[1]) << 8) | (sig8(i8val(v0[2], sr * c0[2]) + b0[2]) << 16) | (sig8(i8val(v0[3], sr * c0[3]) + b0[3]) << 24);
                    w.y = sig8(i8val(v1[0], sr * c1[0]) + b1[0]) | (sig8(i8val(v1[1], sr * c1[1]) + b1[1]) << 8) | (sig8(i8val(v1[2], sr * c1[2]) + b1[2]) << 16) | (sig8(i8val(v1[3], sr * c1[3]) + b1[3]) << 24);
                    *(u32x2*)(rowp + bj * HALF) = w; } }
    }
};
struct EpiBranch {
    static constexpr bool PERM = true, AFTER_DRAIN = false, KEEP_ACC = true, FP8 = false, I8 = false;
    const unsigned char* G; bf16_t* merged; int mtiles, ntiles, ldm;
    __device__ __forceinline__ bool keep(const Unit& u) const { return (u.pn / ntiles) < 3; }
    __device__ __forceinline__ void operator()(f32x4 (&acc)[2][2][4][2], const Unit& u, int wr, int wc, int fr, int fq) const {
        const int n = u.pn / ntiles, pm = u.pm - n * mtiles, pn = u.pn - n * ntiles;
        const int row0 = pm * BM + wr * 64 + fr, col0 = pn * BM + wc * 32 + 8 * fq;
#pragma unroll
        for (int ai = 0; ai < 2; ++ai)
#pragma unroll
            for (int m = 0; m < 4; ++m) { const size_t row = (size_t)(row0 + ai * HALF + m * 16);
#pragma unroll
                for (int bj = 0; bj < 2; ++bj) { const int col = col0 + bj * HALF;
                    const unsigned char* gp = G + row * (size_t)(4 * 4096) + (size_t)n * 4096 + col;
                    const u32x2 g = *(const u32x2*)gp;
                    f32x4 g0, g1;
                    g0[0] = (float)(g.x & 255u); g0[1] = (float)((g.x >> 8) & 255u); g0[2] = (float)((g.x >> 16) & 255u); g0[3] = (float)(g.x >> 24);
                    g1[0] = (float)(g.y & 255u); g1[1] = (float)((g.y >> 8) & 255u); g1[2] = (float)((g.y >> 16) & 255u); g1[3] = (float)(g.y >> 24);
                    if (n < 3) { const u32x2 h = *(const u32x2*)(gp + 4096);
                        g0[0] *= __builtin_amdgcn_rcpf((float)(h.x & 255u)); g0[1] *= __builtin_amdgcn_rcpf((float)((h.x >> 8) & 255u)); g0[2] *= __builtin_amdgcn_rcpf((float)((h.x >> 16) & 255u)); g0[3] *= __builtin_amdgcn_rcpf((float)(h.x >> 24));
                        g1[0] *= __builtin_amdgcn_rcpf((float)(h.y & 255u)); g1[1] *= __builtin_amdgcn_rcpf((float)((h.y >> 8) & 255u)); g1[2] *= __builtin_amdgcn_rcpf((float)((h.y >> 16) & 255u)); g1[3] *= __builtin_amdgcn_rcpf((float)(h.y >> 24));
                        acc[ai][bj][m][0] *= g0; acc[ai][bj][m][1] *= g1; }
                    else { const float k = 1.0f / 255.0f; const f32x4 v0 = acc[ai][bj][m][0] * g0 * k, v1 = acc[ai][bj][m][1] * g1 * k;
                        u32x4 w; w.x = cvt_pk_bf16(v0[0], v0[1]); w.y = cvt_pk_bf16(v0[2], v0[3]); w.z = cvt_pk_bf16(v1[0], v1[1]); w.w = cvt_pk_bf16(v1[2], v1[3]);
                        *(u32x4*)(merged + row * (size_t)ldm + col) = w; } } }
    }
};

__device__ __forceinline__ void atom_add_f32(float* p, float v) { asm volatile("global_atomic_add_f32 %0, %1, off" :: "v"(p), "v"(v) : "memory"); }
struct SliceOrder {
    int pm, pn; bool valid;
    __host__ __device__ bool next(int i, Unit& u) const { if (i != 0 || !valid) return false; u.pm = pm; u.pn = pn; return true; }
    __device__ __forceinline__ void a_ready(const Unit&) const {}
    __device__ __forceinline__ void done(const Unit&) const {}
};
struct EpiBranchPart {
    static constexpr bool PERM = true, AFTER_DRAIN = false, KEEP_ACC = false, FP8 = false, I8 = false;
    const unsigned char* G; float* part; int mtiles, ntiles, row_base;
    __device__ __forceinline__ void operator()(const f32x4 (&acc)[2][2][4][2], const Unit& u, int wr, int wc, int fr, int fq) const {
        const int n = u.pn / ntiles, pm = u.pm - n * mtiles, pn = u.pn - n * ntiles;
        const int row0 = pm * BM + wr * 64 + fr, col0 = pn * BM + wc * 32 + 8 * fq;
        u32x2 gq[2][4][2];
#pragma unroll
        for (int ai = 0; ai < 2; ++ai)
#pragma unroll
            for (int m = 0; m < 4; ++m)
#pragma unroll
                for (int bj = 0; bj < 2; ++bj) gq[ai][m][bj] = *(const u32x2*)(G + (size_t)(row0 + ai * HALF + m * 16) * (size_t)(4 * 4096) + (size_t)n * 4096 + col0 + bj * HALF);
#pragma unroll
        for (int ai = 0; ai < 2; ++ai)
#pragma unroll
            for (int m = 0; m < 4; ++m) { const size_t row = (size_t)(row0 + ai * HALF + m * 16);
#pragma unroll
                for (int bj = 0; bj < 2; ++bj) { const int col = col0 + bj * HALF;
                    const u32x2 g = gq[ai][m][bj]; const float k = 1.0f / 255.0f;
                    f32x4 g0, g1;
                    g0[0] = (float)(g.x & 255u) * k; g0[1] = (float)((g.x >> 8) & 255u) * k; g0[2] = (float)((g.x >> 16) & 255u) * k; g0[3] = (float)(g.x >> 24) * k;
                    g1[0] = (float)(g.y & 255u) * k; g1[1] = (float)((g.y >> 8) & 255u) * k; g1[2] = (float)((g.y >> 16) & 255u) * k; g1[3] = (float)(g.y >> 24) * k;
                    float* q = part + (size_t)n * 512 * 4096 + (row - (size_t)row_base) * 4096 + col;
                    *(f32x4*)q = acc[ai][bj][m][0] * g0; *(f32x4*)(q + 4) = acc[ai][bj][m][1] * g1; } }
    }
};
template <class Epi, class Sched, bool ALIGN_EPI = false, bool SP2 = false>
__device__ __forceinline__ void gemm_phase(PG8_LAS unsigned char* lds, const Gemm g, const Sched& S, const Epi& E, int wave_id) {
    int tid_l; asm volatile("v_mbcnt_lo_u32_b32 %0, -1, 0\n\tv_mbcnt_hi_u32_b32 %0, -1, %0" : "=v"(tid_l)); tid_l += wave_id * 64;
    const int tid = tid_l, wid = __builtin_amdgcn_readfirstlane(tid >> 6), lane = tid & 63, wr = wid >> 2, wc = wid & 3, fr = lane & 15, fq = lane >> 4;
    const int K = g.K, nt = K / BK, ld = g.ld;
    unsigned voffA[2], voffB[2];
#pragma unroll
    for (int i = 0; i < 2; ++i) { int R, C; stage_rc(tid * 16 + i * 8192, R, C); const int Rb = Epi::PERM ? ((R & ~31) + perm32(R & 31)) : R;
        voffA[i] = (unsigned)(R * ld + C) * 2u; voffB[i] = (unsigned)(Rb * ld + C) * 2u; }
    const size_t kstep = (size_t)(BK * 2);
    const size_t hstep = (size_t)HALF * ld * 2;
    const size_t tstep = 2 * hstep;
    const unsigned ldsw = (unsigned)wid * 1024u;
    const int aoff = lds_byte(wr * 64 + fr, fq * 8), boff = lds_byte(wc * 32 + fr, fq * 8);
#define PG8_SA(b, h) (((b) * 2 + (h)) * HTB)
#define PG8_SB(b, h) ((4 + (b) * 2 + (h)) * HTB)
#define PG8_STAGE(bufoff, gbase, voff) do { _Pragma("unroll") for (int _i = 0; _i < 2; ++_i) \
        __builtin_amdgcn_global_load_lds((const unsigned*)((const char*)(gbase) + (voff)[_i]), (PG8_LAS unsigned*)(lds + (bufoff) + ldsw + _i * 8192), 16, 0, 0); } while (0)
#define PG8_LDA(dst, b, h) do { _Pragma("unroll") for (int m = 0; m < 4; ++m) _Pragma("unroll") for (int k = 0; k < 2; ++k) dst[m][k] = *(const PG8_LAS bf16x8*)(lds + PG8_SA(b, h) + aoff + m * 2048 + k * 1024); } while (0)
#define PG8_LDB(dst, b, h) do { _Pragma("unroll") for (int n = 0; n < 2; ++n) _Pragma("unroll") for (int k = 0; k < 2; ++k) dst[n][k] = *(const PG8_LAS bf16x8*)(lds + PG8_SB(b, h) + boff + n * 2048 + k * 1024); } while (0)
#define PG8_MMA(ai, bj, At, Bt) do { __builtin_amdgcn_s_setprio(1); \
        if constexpr (Epi::FP8) { _Pragma("unroll") for (int m = 0; m < 4; ++m) _Pragma("unroll") for (int n = 0; n < 2; ++n) \
            asm volatile("v_mfma_scale_f32_16x16x128_f8f6f4 %0, %1, %2, %0, %3, %3 op_sel_hi:[0,0,0]" : "+v"(acc[ai][bj][m][n]) \
                : "v"(__builtin_bit_cast(i32x8, __builtin_shufflevector(Bt[n][0], Bt[n][1], 0, 1, 2, 3, 4, 5, 6, 7, 8, 9, 10, 11, 12, 13, 14, 15))), \
                  "v"(__builtin_bit_cast(i32x8, __builtin_shufflevector(At[m][0], At[m][1], 0, 1, 2, 3, 4, 5, 6, 7, 8, 9, 10, 11, 12, 13, 14, 15))), "v"(fp8_unit_scale)); } \
        else if constexpr (Epi::I8) { _Pragma("unroll") for (int m = 0; m < 4; ++m) _Pragma("unroll") for (int n = 0; n < 2; ++n) _Pragma("unroll") for (int k = 0; k < 2; ++k) \
            asm volatile("v_mfma_i32_16x16x64_i8 %0, %1, %2, %0" : "+v"(acc[ai][bj][m][n]) : "v"(Bt[n][k]), "v"(At[m][k])); } \
        else { _Pragma("unroll") for (int m = 0; m < 4; ++m) _Pragma("unroll") for (int n = 0; n < 2; ++n) _Pragma("unroll") for (int k = 0; k < 2; ++k) \
        acc[ai][bj][m][n] = __builtin_amdgcn_mfma_f32_16x16x32_bf16(Bt[n][k], At[m][k], acc[ai][bj][m][n], 0, 0, 0); } __builtin_amdgcn_s_setprio(0); } while (0)
#define PG8_WAIT_V(n) asm volatile("s_waitcnt vmcnt(" #n ")" ::: "memory")
#define PG8_WAIT_L(n) asm volatile("s_waitcnt lgkmcnt(" #n ")" ::: "memory")
#define PG8_BAR __builtin_amdgcn_s_barrier()
#define PG8_SCHED __builtin_amdgcn_sched_barrier(0)
    int fp8_unit_scale = 0x7f7f7f7f; if constexpr (Epi::FP8) asm volatile("" : "+v"(fp8_unit_scale));
    Unit cur, nxt; int ui = 0;
    if (!S.next(0, cur)) return;
    f32x4 acc[2][2][4][2];
#pragma unroll
    for (int a = 0; a < 2; ++a)
#pragma unroll
        for (int b = 0; b < 2; ++b)
#pragma unroll
            for (int m = 0; m < 4; ++m)
#pragma unroll
                for (int n = 0; n < 2; ++n) acc[a][b][m][n] = (f32x4){0.f, 0.f, 0.f, 0.f};
    bf16x8 At[4][2], B0[2][2], B1[2][2];
    const char* cA = (const char*)g.A + (size_t)cur.pm * tstep; const char* cB = (const char*)g.Bt + (size_t)cur.pn * tstep;
    S.a_ready(cur);
    if constexpr (SP2) {
        PG8_STAGE(PG8_SB(0, 0), cB, voffB); PG8_STAGE(PG8_SB(0, 1), cB + hstep, voffB); PG8_STAGE(PG8_SA(0, 0), cA, voffA); PG8_STAGE(PG8_SA(0, 1), cA + hstep, voffA);
        if (wr == 1) PG8_BAR;
        PG8_WAIT_V(2); PG8_BAR;
        PG8_STAGE(PG8_SB(1, 0), cB + kstep, voffB); PG8_STAGE(PG8_SA(1, 0), cA + kstep, voffA); PG8_STAGE(PG8_SB(1, 1), cB + hstep + kstep, voffB);
        PG8_WAIT_V(6); PG8_BAR;
    } else {
        PG8_STAGE(PG8_SB(0, 0), cB, voffB); PG8_STAGE(PG8_SA(0, 0), cA, voffA); PG8_STAGE(PG8_SB(0, 1), cB + hstep, voffB); PG8_STAGE(PG8_SA(0, 1), cA + hstep, voffA);
        if (wr == 1) PG8_BAR;
        PG8_WAIT_V(4); PG8_BAR;
        PG8_STAGE(PG8_SB(1, 0), cB + kstep, voffB); PG8_STAGE(PG8_SA(1, 0), cA + kstep, voffA); PG8_STAGE(PG8_SB(1, 1), cB + hstep + kstep, voffB);
        PG8_WAIT_V(6); PG8_BAR;
    }
    for (;;) {
        const bool has_next = S.next(ui + 1, nxt);
        const char* nA = has_next ? (const char*)g.A + (size_t)nxt.pm * tstep : cA; const char* nB = has_next ? (const char*)g.Bt + (size_t)nxt.pn * tstep : cB;
        for (int t = 0; t < nt; t += 2) {
            const bool last = (t == nt - 2);
            const char* a1 = cA + (size_t)(t + 1) * kstep;
            const char* a2 = last ? nA : cA + (size_t)(t + 2) * kstep; const char* b2 = last ? nB : cB + (size_t)(t + 2) * kstep;
            const char* a3 = a2 + kstep; const char* b3 = b2 + kstep;
            if (last && has_next) S.a_ready(nxt);
            if constexpr (SP2) {
            PG8_LDB(B0, 0, 0); PG8_LDB(B1, 0, 1); PG8_SCHED; PG8_LDA(At, 0, 0); PG8_STAGE(PG8_SA(1, 1), a1 + hstep, voffA);
            PG8_WAIT_V(8); PG8_WAIT_L(0); PG8_BAR; PG8_MMA(0, 0, At, B0); PG8_MMA(0, 1, At, B1); PG8_BAR; PG8_SCHED;
            PG8_LDA(At, 0, 1); PG8_STAGE(PG8_SB(0, 0), b2, voffB); PG8_STAGE(PG8_SB(0, 1), b2 + hstep, voffB); PG8_STAGE(PG8_SA(0, 0), a2, voffA);
            PG8_WAIT_V(8); PG8_WAIT_L(0); PG8_BAR; PG8_MMA(1, 0, At, B0); PG8_MMA(1, 1, At, B1); PG8_BAR; PG8_SCHED;
            PG8_LDB(B0, 1, 0); PG8_LDB(B1, 1, 1); PG8_SCHED; PG8_LDA(At, 1, 0); PG8_STAGE(PG8_SA(0, 1), a2 + hstep, voffA);
            PG8_WAIT_V(8); PG8_WAIT_L(0); PG8_BAR; PG8_MMA(0, 0, At, B0); PG8_MMA(0, 1, At, B1); PG8_BAR; PG8_SCHED;
            PG8_LDA(At, 1, 1); PG8_STAGE(PG8_SB(1, 0), b3, voffB); PG8_STAGE(PG8_SB(1, 1), b3 + hstep, voffB); PG8_STAGE(PG8_SA(1, 0), a3, voffA);
            PG8_WAIT_V(8); PG8_WAIT_L(0); PG8_BAR; PG8_MMA(1, 0, At, B0); PG8_MMA(1, 1, At, B1); PG8_BAR; PG8_SCHED;
            } else {
            PG8_LDB(B0, 0, 0); PG8_SCHED; PG8_LDA(At, 0, 0); PG8_STAGE(PG8_SA(1, 1), a1 + hstep, voffA);
            PG8_WAIT_L(8); PG8_BAR; PG8_WAIT_L(0); PG8_MMA(0, 0, At, B0); PG8_BAR; PG8_SCHED;
            PG8_LDB(B1, 0, 1); PG8_STAGE(PG8_SB(0, 0), b2, voffB);
            PG8_BAR; PG8_WAIT_L(0); PG8_MMA(0, 1, At, B1); PG8_BAR;
            PG8_LDA(At, 0, 1); PG8_STAGE(PG8_SA(0, 0), a2, voffA);
            PG8_BAR; PG8_WAIT_L(0); PG8_MMA(1, 0, At, B0); PG8_BAR; PG8_SCHED;
            PG8_STAGE(PG8_SB(0, 1), b2 + hstep, voffB);
            PG8_WAIT_V(6); PG8_BAR; PG8_MMA(1, 1, At, B1); PG8_BAR;
            PG8_LDB(B0, 1, 0); PG8_SCHED; PG8_LDA(At, 1, 0); PG8_STAGE(PG8_SA(0, 1), a2 + hstep, voffA);
            PG8_WAIT_L(8); PG8_BAR; PG8_WAIT_L(0); PG8_MMA(0, 0, At, B0); PG8_BAR; PG8_SCHED;
            PG8_LDB(B1, 1, 1); PG8_STAGE(PG8_SB(1, 0), b3, voffB);
            PG8_BAR; PG8_WAIT_L(0); PG8_MMA(0, 1, At, B1); PG8_BAR;
            PG8_LDA(At, 1, 1); PG8_STAGE(PG8_SA(1, 0), a3, voffA);
            PG8_BAR; PG8_WAIT_L(0); PG8_MMA(1, 0, At, B0); PG8_BAR; PG8_SCHED;
            PG8_STAGE(PG8_SB(1, 1), b3 + hstep, voffB);
            PG8_WAIT_V(6); PG8_BAR; PG8_MMA(1, 1, At, B1); PG8_BAR;
            }
        }
        if constexpr (ALIGN_EPI) { if (wr == 0) PG8_BAR; }
        if constexpr (Epi::FP8 || Epi::I8) asm volatile("s_nop 15\n\ts_nop 7" ::: "memory");
        if constexpr (!Epi::AFTER_DRAIN) { E(acc, cur, wr, wc, fr, fq); S.done(cur); }
        if (!has_next) break;
        bool keep_acc = false; if constexpr (Epi::KEEP_ACC) keep_acc = E.keep(cur);
        if (!keep_acc) {
#pragma unroll
        for (int a = 0; a < 2; ++a)
#pragma unroll
            for (int b = 0; b < 2; ++b)
#pragma unroll
                for (int m = 0; m < 4; ++m)
#pragma unroll
                    for (int n = 0; n < 2; ++n) acc[a][b][m][n] = (f32x4){0.f, 0.f, 0.f, 0.f};
        }
        cur = nxt; cA = nA; cB = nB; ++ui;
        if constexpr (ALIGN_EPI) { if (wr == 1) PG8_BAR; }
    }
    PG8_WAIT_V(0);
    if constexpr (!ALIGN_EPI) { if (wr == 0) PG8_BAR; }
    PG8_BAR;
    if constexpr (Epi::AFTER_DRAIN) { E.fused(acc, cur, wr, wc, fr, fq, lds, wid, lane); S.done(cur); }
#undef PG8_SA
#undef PG8_SB
#undef PG8_STAGE
#undef PG8_LDA
#undef PG8_LDB
#undef PG8_MMA
#undef PG8_WAIT_V
#undef PG8_WAIT_L
#undef PG8_BAR
#undef PG8_SCHED
}
}
#define GAS __attribute__((address_space(1)))
#define LAS __attribute__((address_space(3)))
typedef unsigned short bf16;
typedef unsigned v4u __attribute__((ext_vector_type(4)));
typedef float f32x4 __attribute__((ext_vector_type(4)));
typedef short bf16x8 __attribute__((ext_vector_type(8)));
typedef GAS unsigned gu32;
typedef GAS unsigned long long gu64;
#define RLX_AGENT __ATOMIC_RELAXED, __HIP_MEMORY_SCOPE_AGENT
#define LDS_WAIT() asm volatile("s_waitcnt lgkmcnt(0)" ::: "memory")
#define VM_WAIT() asm volatile("s_waitcnt vmcnt(0)" ::: "memory")
__device__ __forceinline__ unsigned long long rt() { return __builtin_amdgcn_s_memrealtime(); }
__device__ __forceinline__ unsigned f2bf(float f) { unsigned u = __builtin_bit_cast(unsigned, f); return (u + 0x7fffu + ((u >> 16) & 1u)) >> 16; }
__device__ __forceinline__ unsigned pk2(float lo, float hi) { return f2bf(lo) | (f2bf(hi) << 16); }

#define XB_TMO      128
#define XB_XCNT(j)  (256  + 64 * (j))
#define XB_XSUB(j)  (1280 + 64 * (j))
#define XB_XGEN(j)  (2304 + 64 * (j))
#define XB_TOP      3328
#define XB_TOPGEN   3392
#define XCD_BAR_WORDS 3456
#define XB_SPIN_CAP (1u << 18)

__device__ __forceinline__ unsigned xb_ld(unsigned* p)              { return __hip_atomic_load(p, __ATOMIC_RELAXED, __HIP_MEMORY_SCOPE_AGENT); }
__device__ __forceinline__ unsigned xb_add(unsigned* p, unsigned v) { return __hip_atomic_fetch_add(p, v, __ATOMIC_RELAXED, __HIP_MEMORY_SCOPE_AGENT); }
__device__ __forceinline__ unsigned xb_xcc_id() { return (unsigned)__builtin_amdgcn_s_getreg((3 << 11) | 20) & 0xFu; }
#define XB_SPIN(cond, bar) do { unsigned _sp = 0; while (cond) { __builtin_amdgcn_s_sleep(1); \
    if ((++_sp & 255u) == 0u) { if (xb_ld(&(bar)[XB_TMO])) break; if (_sp > XB_SPIN_CAP) { atomicAdd(&(bar)[XB_TMO], 1u); break; } } } } while (0)

struct XcdBarrier {
    unsigned* bar; unsigned x;
    volatile LAS unsigned* st;
};

__device__ __forceinline__ XcdBarrier xcd_barrier_post(unsigned* bar, volatile LAS unsigned* st) {
    XcdBarrier b; b.bar = bar; b.x = xb_xcc_id(); b.st = st;
    if (threadIdx.x == 0) (void)xb_add(&bar[XB_XCNT(b.x)], 1u);
    return b;
}
__device__ __forceinline__ void xcd_barrier_complete(unsigned* bar, unsigned x, unsigned& nloc, unsigned& nx) {
    const unsigned G = gridDim.x * gridDim.y * gridDim.z;
    unsigned sum, cnt, mine, sp = 0u;
    for (;;) {
        sum = 0u; cnt = 0u; mine = 0u;
#pragma unroll
        for (unsigned j = 0; j < 16; ++j) { const unsigned c = xb_ld(&bar[XB_XCNT(j)]); sum += c; cnt += (c > 0u) ? 1u : 0u; mine = (j == x) ? c : mine; }
        if (sum == G) break;
        __builtin_amdgcn_s_sleep(1);
        if ((++sp & 255u) == 0u) { if (xb_ld(&bar[XB_TMO])) break; if (sp > XB_SPIN_CAP) { atomicAdd(&bar[XB_TMO], 1u); break; } }
    }
    nloc = mine > 0u ? mine : 1u; nx = cnt > 0u ? cnt : 1u;
}

__device__ __forceinline__ void xcd_barrier(const XcdBarrier& b) {
    asm volatile("s_waitcnt vmcnt(0)" ::: "memory");
    __syncthreads();
    if (threadIdx.x == 0) {
        unsigned* bar = b.bar;
        __builtin_amdgcn_s_waitcnt(0);
        unsigned nloc = b.st[0], nx = b.st[1];
        if (nloc == 0u) { xcd_barrier_complete(bar, b.x, nloc, nx); b.st[0] = nloc; b.st[1] = nx; }
        const unsigned old = xb_add(&bar[XB_XSUB(b.x)], 1u);
        const unsigned gen = old / nloc;
        if (old + 1u == (gen + 1u) * nloc) {
            __builtin_amdgcn_fence(__ATOMIC_RELEASE, "agent");
            asm volatile("s_waitcnt vmcnt(0)" ::: "memory");
            const unsigned og = xb_add(&bar[XB_TOP], 1u);
            const unsigned tg = og / nx;
            if (og + 1u == (tg + 1u) * nx) xb_add(&bar[XB_TOPGEN], 1u);
            else XB_SPIN(xb_ld(&bar[XB_TOPGEN]) == tg, bar);
            __builtin_amdgcn_fence(__ATOMIC_ACQUIRE, "agent");
            xb_add(&bar[XB_XGEN(b.x)], 1u);
            asm volatile("s_waitcnt vmcnt(0)" ::: "memory");
        } else {
            XB_SPIN(xb_ld(&bar[XB_XGEN(b.x)]) == gen, bar);
            __builtin_amdgcn_fence(__ATOMIC_ACQUIRE, "agent");
            asm volatile("s_waitcnt vmcnt(0)" ::: "memory");
        }
    }
    __syncthreads();
}
#define DI __device__ __forceinline__
#define CAS __attribute__((address_space(4)))
typedef unsigned v2u __attribute__((ext_vector_type(2)));
typedef float f32x16 __attribute__((ext_vector_type(16)));
typedef short s16x4 __attribute__((ext_vector_type(4)));

constexpr int DM = 4096, NB = 8, SEQ = 2048, DEPTH = 2, DSEQ = 64, PAST = 1024, KCATN = PAST + DSEQ;
constexpr int NMEM = 256, BW = 1024, AH = 16, AHD = 64, SHW = 3200;
constexpr int BHN = 8, BHD = 128, CGN = 8, CGD = 128, MHN = 4, MHD = 256;
constexpr int NIN = 12416, NINP = 12544, LDP = DM + 64;
constexpr int MP = NB * SEQ, MS = NB * DSEQ, MT = MP + MS;
constexpr int PC_R = 0, PC_K = 1024, PC_V = 2048, PC_WD = 3072, PC_AD = 3136, PC_AZ = 3328, PC_BQ = 4352, PC_BK = 5376, PC_BV = 6400, PC_BZ = 7424,
              PC_CU = 8448, PC_CV = 9472, PC_CZ = 10496, PC_MQ = 11520;
constexpr float NORM_EPS = 1e-6f, GN_EPS = 64e-5f;
enum { I_XP = 0, I_XS, I_CMK, I_CMV, I_CSK, I_CSV, I_SRW, I_SSH, I_MEM, I_GPRE, I_GPOST, I_WIN, I_AMU, I_AW0, I_AWUP, I_AA0, I_AAUP, I_AKK, I_AKA, I_ARK,
       I_AGNW, I_AGNB, I_CWS, I_CBS, I_CLNW, I_CLNB, I_GMEM, I_WMEM, I_WGATE, I_BGATE, I_WBR, I_WOUT, N_INPUTS };
constexpr size_t O_YP = 0, O_YS = O_YP + (size_t)MP * DM, O_MK = O_YS + (size_t)MS * DM, O_MV = O_MK + (size_t)DEPTH * NB * NMEM * BW,
    O_SKP = O_MV + (size_t)DEPTH * NB * NMEM * BW, O_SVP = O_SKP + (size_t)DEPTH * MP * BW, O_RWP = O_SVP + (size_t)DEPTH * MP * BW,
    O_SHP = O_RWP + (size_t)DEPTH * NB * AH * 64 * 64, O_SKS = O_SHP + (size_t)DEPTH * NB * SHW, O_SVS = O_SKS + (size_t)DEPTH * MS * BW,
    O_RWS = O_SVS + (size_t)DEPTH * MS * BW, O_SHS = O_RWS + (size_t)DEPTH * NB * AH * 64 * 64, O_CVS = O_SHS + (size_t)DEPTH * NB * SHW,
    O_END = O_CVS + (size_t)DEPTH * MS * BW;
constexpr size_t MiB = 1u << 20;
constexpr size_t WS_CTL = 0, CTL_ZERO_BYTES = 1 * MiB;
constexpr size_t WS_WIN = 1 * MiB, WS_WG = 99 * MiB, WS_WBR = 227 * MiB, WS_WOUT = 259 * MiB, WS_WMEM = 291 * MiB;
constexpr size_t WS_H = 323 * MiB, WS_MEMN = 455 * MiB, WS_PROJ = 487 * MiB, WS_MERGED = WS_PROJ, WS_OUTF = WS_PROJ + 132 * MiB;
constexpr size_t WS_RA = 892 * MiB, WS_RB = 1222 * MiB, WS_SCANV = 1552 * MiB, WS_OALL = 1618 * MiB, WS_VT = 1750 * MiB, WS_VNT = 1782 * MiB;
constexpr size_t R_YRAW_OFF = 264 * MiB;
constexpr size_t WS_KCAT = 1816 * MiB, WS_VTCAT = 1850 * MiB, WS_MKB = 1884 * MiB, WS_MVT = 1892 * MiB, WS_CMK = 1900 * MiB, WS_CMVT = 1908 * MiB;
constexpr size_t WS_WM = 1916 * MiB, WS_BONUS = 1917 * MiB, WS_DBG = 1919 * MiB, WS_UPT = WS_DBG, WS_H8 = 1920 * MiB, WS_END = 2035 * MiB;
constexpr size_t WS_PARTS = WS_VT;
static_assert(WS_PARTS + (size_t)8 * MS * DM * 4 <= WS_KCAT, "parts");
static_assert(WS_WIN + (size_t)NINP * DM * 2 <= WS_WG && WS_WG + (size_t)4 * DM * DM * 2 <= WS_WBR && WS_WBR + (size_t)4 * DM * BW * 2 <= WS_WOUT && WS_WOUT + (size_t)DM * DM * 2 <= WS_WMEM, "ws map 1");
static_assert(WS_WMEM + (size_t)DEPTH * 2 * BW * DM * 2 <= WS_H && WS_H + (size_t)MT * DM * 2 <= WS_MEMN && WS_MEMN + (size_t)DEPTH * NB * NMEM * DM * 2 <= WS_PROJ, "ws map 2");
static_assert(WS_PROJ + (size_t)MT * NINP * 2 <= WS_RA && WS_MERGED + (size_t)MT * DM * 2 <= WS_OUTF && WS_OUTF + (size_t)MT * DM * 4 <= WS_RA, "ws map 3");
static_assert(WS_RA + (size_t)MT * AH * 5 * 64 * 4 <= WS_RB && WS_RB + (size_t)MT * AH * 5 * 64 * 4 <= WS_SCANV && (size_t)MT * 4 * DM <= R_YRAW_OFF && R_YRAW_OFF + (size_t)MT * BW * 4 <= WS_RB - WS_RA, "ws map 4");
static_assert(WS_SCANV + (size_t)MT * BW * 4 <= WS_OALL && WS_OALL + (size_t)4 * MT * BW * 2 <= WS_VT && WS_VT + (size_t)MP * BW * 2 <= WS_VNT && WS_VNT + (size_t)136 * 8 * 128 * 128 * 2 <= WS_KCAT, "ws map 5");
static_assert(WS_KCAT + (size_t)DEPTH * NB * KCATN * BW * 2 <= WS_VTCAT && WS_VTCAT + (size_t)DEPTH * NB * KCATN * BW * 2 <= WS_MKB, "ws map 6");
constexpr int CW_TMO = 0, CW_BAR = 4096;
constexpr int LDS_BYTES = 147456, LDSCTL_OFF = 146944;
constexpr int NWAVES = 8, NTHR = 512, GRID = 256;
constexpr int N_PHASES = 2 + 7 * DEPTH;
#define SCAN5P(F, l) ((float*)((F).ws + (((l) & 1) ? WS_RB : WS_RA)))
#define GATESP(F, l) ((F).ws + (((l) & 1) ? WS_RA : WS_RB))
#define YRAWP(F, l) ((float*)((F).ws + (((l) & 1) ? WS_RA : WS_RB) + R_YRAW_OFF))
#define SCANVP(F) ((float*)((F).ws + WS_SCANV))
#define WGP(F, l) ((F).ws + WS_WG + (size_t)(l) * 64 * MiB)
#define WBRP(F, l) ((bf16*)((F).ws + ((l) ? WS_MEMN : WS_WBR)))
#define WOUTP(F, l) ((bf16*)((F).ws + ((l) ? WS_WMEM : WS_WOUT)))
#define HSP(F) ((float*)((F).ws + WS_BONUS + 3 * MiB / 2))
#define CMAX_WIN(F, l) ((float*)((F).ws + WS_CTL + 256 * 1024) + (size_t)(l) * NINP)
#define CMAX_WG(F, l) ((float*)((F).ws + WS_CTL + 256 * 1024) + (size_t)DEPTH * NINP + (size_t)(l) * 4 * DM)
static_assert(256 * 1024 + ((size_t)DEPTH * NINP + (size_t)DEPTH * 4 * DM) * 4 <= CTL_ZERO_BYTES, "cmax in the zeroed control region");
constexpr size_t WS_WIN8 = 1986 * MiB;
static_assert(WS_WIN8 + (size_t)NINP * DM <= 2048 * MiB, "win8");
#ifndef W_IN_INT8_TILES
#define W_IN_INT8_TILES 0x1e1fffffe2000ull
#endif
constexpr unsigned long long WIN_I8_MASK = W_IN_INT8_TILES, WIN_BF_MASK = ((1ull << 49) - 1) & ~WIN_I8_MASK;
constexpr int WIN_I8U = __builtin_popcountll(WIN_I8_MASK) * ((MT + 255) / 256), WIN_BFU = __builtin_popcountll(WIN_BF_MASK) * ((MT + 255) / 256);
constexpr int WIN_NSLOW0 = WIN_BFU % GRID, WIN_RS0 = WIN_I8U / GRID - 1;
constexpr bool WIN_SKEW = WIN_NSLOW0 > 0 && WIN_RS0 > 0 && (WIN_I8U - WIN_RS0 * GRID) <= 2 * (GRID - WIN_NSLOW0);
constexpr int WIN_NSLOW = WIN_SKEW ? WIN_NSLOW0 : 0, WIN_RS = WIN_SKEW ? WIN_RS0 : (1 << 20);
#define SWZ_XOR(v, x) __int_as_float(__builtin_amdgcn_ds_swizzle(__float_as_int(v), ((x) << 10) | 0x1f))
DI float xor32_sum(float v) { const auto r = __builtin_amdgcn_permlane32_swap(__float_as_uint(v), __float_as_uint(v), false, false); return __uint_as_float(r[0]) + __uint_as_float(r[1]); }
DI float xor32_max(float v) { const auto r = __builtin_amdgcn_permlane32_swap(__float_as_uint(v), __float_as_uint(v), false, false); return fmaxf(__uint_as_float(r[0]), __uint_as_float(r[1])); }
DI float xor32_partner(float v, int h) { const auto r = __builtin_amdgcn_permlane32_swap(__float_as_uint(v), __float_as_uint(v), false, false); return h ? __uint_as_float(r[0]) : __uint_as_float(r[1]); }
DI float wave_sum(float v) { v += SWZ_XOR(v, 1); v += SWZ_XOR(v, 2); v += SWZ_XOR(v, 4); v += SWZ_XOR(v, 8); v += SWZ_XOR(v, 16); return xor32_sum(v); }
DI float bflo(unsigned w) { return __uint_as_float(w << 16); }
DI float bfhi(unsigned w) { return __uint_as_float(w & 0xffff0000u); }
DI float bf2f(bf16 b) { return __uint_as_float(((unsigned)b) << 16); }
DI float sigmoidf_(float x) { return __builtin_amdgcn_rcpf(1.0f + __expf(-x)); }
DI float siluf_(float x) { return x * sigmoidf_(x); }
DI int crow16(int i, int h) { return (i & 3) + 8 * (i >> 2) + 4 * h; }
#define MFMA32(a, b, c) __builtin_amdgcn_mfma_f32_32x32x16_bf16((a), (b), (c), 0, 0, 0)
DI bf16x8 pack8(float a0, float a1, float a2, float a3, float a4, float a5, float a6, float a7) {
    v4u p; p.x = pk2(a0, a1); p.y = pk2(a2, a3); p.z = pk2(a4, a5); p.w = pk2(a6, a7); return __builtin_bit_cast(bf16x8, p);
}
DI void tr64_f32(const float* src, size_t lds_, bf16* dst, size_t ldd, LAS float* scr, int lane) {
#pragma unroll 4
    for (int i = 0; i < 16; ++i) { const int kk = 4 * i + (lane >> 4); const f32x4 v = *(const GAS f32x4*)(src + (size_t)kk * lds_ + 4 * (lane & 15));
        LAS float* s = scr + kk * 65 + 4 * (lane & 15); s[0] = v.x; s[1] = v.y; s[2] = v.z; s[3] = v.w; }
    LDS_WAIT(); asm volatile("" ::: "memory");
    const int c = lane & 7;
#pragma unroll
    for (int j = 0; j < 8; ++j) { const int n = (lane >> 3) + 8 * j; const LAS float* s = scr + (8 * c) * 65 + n;
        v4u o; o.x = pk2(s[0 * 65], s[1 * 65]); o.y = pk2(s[2 * 65], s[3 * 65]); o.z = pk2(s[4 * 65], s[5 * 65]); o.w = pk2(s[6 * 65], s[7 * 65]);
        *(GAS v4u*)(dst + (size_t)n * ldd + 8 * c) = o; }
    LDS_WAIT(); asm volatile("" ::: "memory");
}
DI unsigned pk4_fp8(float a, float b, float c, float d) { int w = __builtin_amdgcn_cvt_pk_fp8_f32(a, b, 0, false); w = __builtin_amdgcn_cvt_pk_fp8_f32(c, d, w, true); return (unsigned)w; }
DI void tr64_f32_fp8(const float* src, size_t lds_, unsigned char* dst, size_t ldd, float scale, LAS float* scr, int lane) {
#pragma unroll 4
    for (int i = 0; i < 16; ++i) { const int kk = 4 * i + (lane >> 4); const f32x4 v = *(const GAS f32x4*)(src + (size_t)kk * lds_ + 4 * (lane & 15));
        LAS float* s = scr + kk * 65 + 4 * (lane & 15); s[0] = v.x; s[1] = v.y; s[2] = v.z; s[3] = v.w; }
    LDS_WAIT(); asm volatile("" ::: "memory");
    const int c = lane & 7;
#pragma unroll
    for (int j = 0; j < 8; ++j) { const int n = (lane >> 3) + 8 * j; const LAS float* s = scr + (8 * c) * 65 + n;
        v2u o; o.x = pk4_fp8(s[0 * 65] * scale, s[1 * 65] * scale, s[2 * 65] * scale, s[3 * 65] * scale); o.y = pk4_fp8(s[4 * 65] * scale, s[5 * 65] * scale, s[6 * 65] * scale, s[7 * 65] * scale);
        *(GAS v2u*)(dst + (size_t)n * ldd + 8 * c) = o; }
    LDS_WAIT(); asm volatile("" ::: "memory");
}
DI void tr64_ld(f32x4 (&v)[16], const float* src, size_t lds_, int lane) {
#pragma unroll
    for (int i = 0; i < 16; ++i) { const int kk = 4 * i + (lane >> 4); v[i] = *(const GAS f32x4*)(src + (size_t)kk * lds_ + 4 * (lane & 15)); }
}
DI void tile_colmax(const f32x4 (&v)[16], float* cm, int lane) {
    f32x4 m = (f32x4){0.f, 0.f, 0.f, 0.f};
#pragma unroll
    for (int i = 0; i < 16; ++i) { m.x = fmaxf(m.x, fabsf(v[i].x)); m.y = fmaxf(m.y, fabsf(v[i].y)); m.z = fmaxf(m.z, fabsf(v[i].z)); m.w = fmaxf(m.w, fabsf(v[i].w)); }
    m.x = fmaxf(m.x, SWZ_XOR(m.x, 16)); m.y = fmaxf(m.y, SWZ_XOR(m.y, 16)); m.z = fmaxf(m.z, SWZ_XOR(m.z, 16)); m.w = fmaxf(m.w, SWZ_XOR(m.w, 16));
    m.x = xor32_max(m.x); m.y = xor32_max(m.y); m.z = xor32_max(m.z); m.w = xor32_max(m.w);
    if (lane < 16) { unsigned* c = (unsigned*)cm + 4 * lane; atomicMax(c, __float_as_uint(m.x)); atomicMax(c + 1, __float_as_uint(m.y)); atomicMax(c + 2, __float_as_uint(m.z)); atomicMax(c + 3, __float_as_uint(m.w)); }
}
DI void tr64_put(const f32x4 (&v)[16], LAS float* scr, int lane) {
#pragma unroll
    for (int i = 0; i < 16; ++i) { const int kk = 4 * i + (lane >> 4); LAS float* s = scr + kk * 65 + 4 * (lane & 15); s[0] = v[i].x; s[1] = v[i].y; s[2] = v[i].z; s[3] = v[i].w; }
    LDS_WAIT(); asm volatile("" ::: "memory");
}
DI unsigned q8(float v) { return (unsigned)(int)rintf(fminf(fmaxf(v, -127.f), 127.f)) & 255u; }
DI unsigned pk4_i8(float a, float b, float c, float d) { return q8(a) | (q8(b) << 8) | (q8(c) << 16) | (q8(d) << 24); }
template <int MODE> DI void tr64_get(void* dst_, size_t ldd, float scale, const float* cmax, const LAS float* scr, int lane) {
    const int c = lane & 7;
    float cmv[8];
#pragma unroll
    for (int j = 0; j < 8; ++j) cmv[j] = (MODE == 2) ? cmax[(lane >> 3) + 8 * j] : 0.f;
#pragma unroll
    for (int j = 0; j < 8; ++j) { const int n = (lane >> 3) + 8 * j; const LAS float* s = scr + (8 * c) * 65 + n;
        if (MODE == 1) { v2u o; o.x = pk4_fp8(s[0 * 65] * scale, s[1 * 65] * scale, s[2 * 65] * scale, s[3 * 65] * scale); o.y = pk4_fp8(s[4 * 65] * scale, s[5 * 65] * scale, s[6 * 65] * scale, s[7 * 65] * scale);
            *(GAS v2u*)((unsigned char*)dst_ + (size_t)n * ldd + 8 * c) = o; }
        else if (MODE == 2) { const float cm = cmv[j]; const float iv = cm > 0.f ? 127.0f / cm : 0.f;
            v2u o; o.x = pk4_i8(s[0 * 65] * iv, s[1 * 65] * iv, s[2 * 65] * iv, s[3 * 65] * iv); o.y = pk4_i8(s[4 * 65] * iv, s[5 * 65] * iv, s[6 * 65] * iv, s[7 * 65] * iv);
            *(GAS v2u*)((unsigned char*)dst_ + (size_t)n * ldd + 8 * c) = o; }
        else { v4u o; o.x = pk2(s[0 * 65], s[1 * 65]); o.y = pk2(s[2 * 65], s[3 * 65]); o.z = pk2(s[4 * 65], s[5 * 65]); o.w = pk2(s[6 * 65], s[7 * 65]);
            *(GAS v4u*)((bf16*)dst_ + (size_t)n * ldd + 8 * c) = o; } }
    LDS_WAIT(); asm volatile("" ::: "memory");
}
DI void tr64_bf16(const bf16* src, size_t lds_, bf16* dst, size_t ldd, LAS unsigned* scr, int lane) {
#pragma unroll
    for (int i = 0; i < 8; ++i) { const int t = 8 * i + (lane >> 3); const v4u v = *(const GAS v4u*)(src + (size_t)t * lds_ + 8 * (lane & 7));
        LAS unsigned* s = scr + t * 33 + 4 * (lane & 7); s[0] = v.x; s[1] = v.y; s[2] = v.z; s[3] = v.w; }
    LDS_WAIT(); asm volatile("" ::: "memory");
    const int c = lane & 7; const LAS bf16* s16 = (const LAS bf16*)scr;
#pragma unroll
    for (int j = 0; j < 8; ++j) { const int d = (lane >> 3) + 8 * j; const LAS bf16* s = s16 + (8 * c) * 66 + d;
        v4u o; o.x = (unsigned)s[0 * 66] | ((unsigned)s[1 * 66] << 16); o.y = (unsigned)s[2 * 66] | ((unsigned)s[3 * 66] << 16);
        o.z = (unsigned)s[4 * 66] | ((unsigned)s[5 * 66] << 16); o.w = (unsigned)s[6 * 66] | ((unsigned)s[7 * 66] << 16);
        *(GAS v4u*)(dst + (size_t)d * ldd + 8 * c) = o; }
    LDS_WAIT(); asm volatile("" ::: "memory");
}
DI void rms_row_bf16(const float* xrow, const float* g, bf16* orow, unsigned char* orow8, int lane) {
    const GAS f32x4* xr = (const GAS f32x4*)xrow + lane; const GAS f32x4* gr = (const GAS f32x4*)g + lane;
    f32x4 v[16], gq[16]; float s = 0.f;
#pragma unroll
    for (int j = 0; j < 16; ++j) { v[j] = xr[64 * j]; gq[j] = gr[64 * j]; }
#pragma unroll
    for (int j = 0; j < 16; ++j) s += (v[j].x * v[j].x + v[j].y * v[j].y) + (v[j].z * v[j].z + v[j].w * v[j].w);
    const float rstd = 1.0f / sqrtf(wave_sum(s) * (1.0f / DM) + NORM_EPS);
    GAS v2u* o8 = (GAS v2u*)orow + lane; GAS unsigned* q8 = (GAS unsigned*)orow8 + lane;
#pragma unroll
    for (int j = 0; j < 16; ++j) { const f32x4 gg = gq[j]; const float a0 = v[j].x * rstd * gg.x, a1 = v[j].y * rstd * gg.y, a2 = v[j].z * rstd * gg.z, a3 = v[j].w * rstd * gg.w;
        v2u w; w.x = pk2(a0, a1); w.y = pk2(a2, a3); o8[64 * j] = w; if (orow8) q8[64 * j] = pk4_fp8(a0, a1, a2, a3); }
}
DI void rms_row_i8(const float* xrow, const float* g, unsigned char* orow8, float* oscale, bf16* orow, int lane) {
    const GAS f32x4* xr = (const GAS f32x4*)xrow + lane; const GAS f32x4* gr = (const GAS f32x4*)g + lane;
    f32x4 v[16], gq[16]; float s = 0.f;
#pragma unroll
    for (int j = 0; j < 16; ++j) { v[j] = xr[64 * j]; gq[j] = gr[64 * j]; }
#pragma unroll
    for (int j = 0; j < 16; ++j) s += (v[j].x * v[j].x + v[j].y * v[j].y) + (v[j].z * v[j].z + v[j].w * v[j].w);
    const float rstd = 1.0f / sqrtf(wave_sum(s) * (1.0f / DM) + NORM_EPS); float am = 0.f;
#pragma unroll
    for (int j = 0; j < 16; ++j) { const f32x4 gg = gq[j]; v[j] = v[j] * rstd * gg; am = fmaxf(am, fmaxf(fmaxf(fabsf(v[j].x), fabsf(v[j].y)), fmaxf(fabsf(v[j].z), fabsf(v[j].w)))); }
    am = fmaxf(am, SWZ_XOR(am, 1)); am = fmaxf(am, SWZ_XOR(am, 2)); am = fmaxf(am, SWZ_XOR(am, 4)); am = fmaxf(am, SWZ_XOR(am, 8)); am = fmaxf(am, SWZ_XOR(am, 16)); am = xor32_max(am);
    const float iv = am > 0.f ? 127.0f / am : 0.f; GAS unsigned* q = (GAS unsigned*)orow8 + lane;
#pragma unroll
    for (int j = 0; j < 16; ++j) q[64 * j] = pk4_i8(v[j].x * iv, v[j].y * iv, v[j].z * iv, v[j].w * iv);
    GAS v2u* o8 = (GAS v2u*)orow + lane;
#pragma unroll
    for (int j = 0; j < 16; ++j) { v2u w; w.x = pk2(v[j].x, v[j].y); w.y = pk2(v[j].z, v[j].w); o8[64 * j] = w; }
    if (lane == 0) *oscale = am * (1.0f / 127.0f);
}
struct P { const float* in[N_INPUTS]; float* out; unsigned char* ws; int ph_lo, ph_hi, dbg, pad; };
struct Frame {
    LAS unsigned char* lds; int tid, lane, wave, bx, G, gw, ngw;
    float* out; unsigned char* ws;
};
DI const float* xrow_in(const P& p, int row) { return row < MP ? p.in[I_XP] + (size_t)row * DM : p.in[I_XS] + (size_t)(row - MP) * DM; }

#define FOR_ITEMS(it, n, id, nid, rot) for (int it = ((id) - (rot) + (nid)) % (nid); it < (n); it += (nid))
#define ROT_ADV(rot, n, nid) rot = (int)(((long)(rot) + (long)(n)) % (nid))

template <int MODE> DI void conv_weight_t(const Frame& F, const float* Wsrc, int NM, int K, int N, void* WT, int split_n, int split_shift, float scale, const float* cmax, int id, int nid, int& rot, int ldw = 0) {
    if (ldw == 0) ldw = N;
    LAS float* scr = (LAS float*)(F.lds + F.wave * 16640);
    const int nb = N / 64, per = (K / 64) * nb, nitems = NM * per;
    int it = (id - rot + nid) % nid;
    f32x4 cur[16];
#define CW_SRC(i) (Wsrc + (size_t)((i) / per) * K * ldw + (size_t)((((i) % per) / nb) * 64) * ldw + (((i) % per) % nb) * 64)
    if (it < nitems) tr64_ld(cur, CW_SRC(it), (size_t)ldw, F.lane);
    for (; it < nitems; it += nid) {
        const int m = it / per, r = it % per, kb = r / nb, n0 = (r % nb) * 64; const int ro = m * N + n0 + (n0 >= split_n ? split_shift : 0);
        const int itn = it + nid;
        void* dst = MODE ? (void*)((unsigned char*)WT + (size_t)ro * K + kb * 64) : (void*)((bf16*)WT + (size_t)ro * K + kb * 64);
        tr64_put(cur, scr, F.lane);
        if (itn < nitems) tr64_ld(cur, CW_SRC(itn), (size_t)ldw, F.lane);
        tr64_get<MODE>(dst, (size_t)K, scale, cmax + ro, scr, F.lane);
    }
    ROT_ADV(rot, nitems, nid);
#undef CW_SRC
}
DI void conv_weight(const Frame& F, const float* Wsrc, int K, int N, bf16* WT, int split_n, int split_shift, int id, int nid, int& rot) { conv_weight_t<0>(F, Wsrc, 1, K, N, WT, split_n, split_shift, 1.f, nullptr, id, nid, rot); }
DI void colmax_weight(const Frame& F, const float* Wsrc, int NM, int K, int N, float* cm, int split_n, int split_shift, int id, int nid, int& rot, int ldw = 0) {
    if (ldw == 0) ldw = N;
    const int nb = N / 64, per = (K / 64) * nb, nitems = NM * per;
    FOR_ITEMS(it, nitems, id, nid, rot) { const int m = it / per, r = it % per, kb = r / nb, n0 = (r % nb) * 64; const int ro = m * N + n0 + (n0 >= split_n ? split_shift : 0);
        f32x4 v[16]; tr64_ld(v, Wsrc + (size_t)m * K * ldw + (size_t)(kb * 64) * ldw + n0, (size_t)ldw, F.lane); tile_colmax(v, cm + ro, F.lane); }
    ROT_ADV(rot, nitems, nid);
}
DI void colmax_layer(const P& p, const Frame& F, int l, int id, int nid, int& rot) {
    for (int t = 0; t < 49;) { if (!((WIN_I8_MASK >> t) & 1ull)) { ++t; continue; } int t1 = t; while (t1 < 49 && ((WIN_I8_MASK >> t1) & 1ull) && (t1 == t || t1 != 13)) ++t1;
        const int pc0 = 256 * t, pc1 = (t1 == 13 || (t1 > 12 && t <= 12)) ? 3200 : 256 * t1, oc0 = pc0 >= 3328 ? pc0 - 128 : pc0;
        colmax_weight(F, p.in[I_WIN] + (size_t)l * DM * NIN + oc0, 1, DM, pc1 - pc0, CMAX_WIN(F, l) + pc0, 1 << 30, 0, id, nid, rot, NIN); t = t1; }
    colmax_weight(F, p.in[I_WGATE] + (size_t)l * 4 * DM * DM, 4, DM, DM, CMAX_WG(F, l), 1 << 30, 0, id, nid, rot);
}
template <int MODE> DI void conv_win_cols(const P& p, const Frame& F, int l, int pc0, int pc1, int id, int nid, int& rot) {
    const int oc0 = pc0 >= 3328 ? pc0 - 128 : pc0;
    if (MODE == 2) conv_weight_t<2>(F, p.in[I_WIN] + (size_t)l * DM * NIN + oc0, 1, DM, pc1 - pc0, (void*)(F.ws + WS_WIN8 + (size_t)pc0 * DM), 1 << 30, 0, 1.f, CMAX_WIN(F, l) + pc0, id, nid, rot, NIN);
    else conv_weight_t<0>(F, p.in[I_WIN] + (size_t)l * DM * NIN + oc0, 1, DM, pc1 - pc0, (void*)(((bf16*)(F.ws + WS_WIN)) + (size_t)pc0 * DM), 1 << 30, 0, 1.f, nullptr, id, nid, rot, NIN);
}
template <int MODE> DI void conv_win_mask(const P& p, const Frame& F, int l, unsigned long long mask, int id, int nid, int& rot) {
    for (int t = 0; t < 49;) { if (!((mask >> t) & 1ull)) { ++t; continue; } int t1 = t; while (t1 < 49 && ((mask >> t1) & 1ull) && (t1 == t || t1 != 13)) ++t1;
        const int pc0 = 256 * t, pc1 = (t1 == 13 || (t1 > 12 && t <= 12)) ? 3200 : 256 * t1;
        conv_win_cols<MODE>(p, F, l, pc0, pc1, id, nid, rot); t = t1; }
}
DI void conv_layer_win(const P& p, const Frame& F, int l, int id, int nid, int& rot) { conv_win_mask<2>(p, F, l, WIN_I8_MASK, id, nid, rot); conv_win_mask<0>(p, F, l, WIN_BF_MASK, id, nid, rot); }
DI void conv_layer_wgate(const P& p, const Frame& F, int l, int id, int nid, int& rot) {
    conv_weight_t<2>(F, p.in[I_WGATE] + (size_t)l * 4 * DM * DM, 4, DM, DM, (void*)WGP(F, l), 1 << 30, 0, 1.f, CMAX_WG(F, l), id, nid, rot); }
DI void conv_layer_wbr(const P& p, const Frame& F, int l, int id, int nid, int& rot) { conv_weight_t<0>(F, p.in[I_WBR] + (size_t)l * 4 * BW * DM, 4, BW, DM, WBRP(F, l), 1 << 30, 0, 1.f, nullptr, id, nid, rot); }
DI void conv_layer_wout(const P& p, const Frame& F, int l, int id, int nid, int& rot) { conv_weight(F, p.in[I_WOUT] + (size_t)l * DM * DM, DM, DM, WOUTP(F, l), 1 << 30, 0, id, nid, rot); }
DI void conv_caches(const P& p, const Frame& F, int l, int wid, int nw, int& rot) {
    LAS float* scr = (LAS float*)(F.lds + F.wave * 16640);
    {
        const int nitems = NB * BHN * (PAST / 64) * (BHD / 64);
        FOR_ITEMS(it, nitems, wid, nw, rot) { const int dt = it & 1, pt = (it >> 1) & 15, h = (it >> 5) & 7, lb = l * NB + (it >> 8);
            tr64_f32(p.in[I_CSV] + ((size_t)lb * PAST + pt * 64) * BW + h * BHD + dt * 64, (size_t)BW, ((bf16*)(F.ws + WS_VTCAT)) + ((size_t)(lb * BHN + h) * BHD + dt * 64) * KCATN + pt * 64, (size_t)KCATN, scr, F.lane); }
        ROT_ADV(rot, nitems, nw);
    }
    {
        const int nitems = NB * MHN * 4 * 4;
        FOR_ITEMS(it, nitems, wid, nw, rot) { const int dt = it & 3, mt = (it >> 2) & 3, hm = (it >> 4) & 3, lb = l * NB + (it >> 6);
            tr64_f32(p.in[I_CMV] + ((size_t)lb * NMEM + mt * 64) * BW + hm * MHD + dt * 64, (size_t)BW, ((bf16*)(F.ws + WS_CMVT)) + ((size_t)(lb * MHN + hm) * MHD + dt * 64) * NMEM + mt * 64, (size_t)NMEM, scr, F.lane); }
        ROT_ADV(rot, nitems, nw);
    }
    const int gt = wid * 64 + F.lane, ngt = nw * 64;
    for (long i0 = gt; i0 < (long)NB * PAST * (BW / 8); i0 += 8L * ngt) { f32x4 qa[8], qb[8];
#pragma unroll
        for (int k = 0; k < 8; ++k) { const long i = i0 + (long)k * ngt; if (i < (long)NB * PAST * (BW / 8)) { const int c8 = (int)(i & 127); const long r = ((long)l * NB * PAST) + (i >> 7);
            const GAS f32x4* s = (const GAS f32x4*)(p.in[I_CSK] + (size_t)r * BW + c8 * 8); qa[k] = s[0]; qb[k] = s[1]; } }
#pragma unroll
        for (int k = 0; k < 8; ++k) { const long i = i0 + (long)k * ngt; if (i < (long)NB * PAST * (BW / 8)) { const int c8 = (int)(i & 127); const long r = ((long)l * NB * PAST) + (i >> 7); const int pos = (int)(r & (PAST - 1)); const long lb = r >> 10;
            const f32x4 a = qa[k], b = qb[k]; v4u o; o.x = pk2(a.x, a.y); o.y = pk2(a.z, a.w); o.z = pk2(b.x, b.y); o.w = pk2(b.z, b.w);
            *(GAS v4u*)(((bf16*)(F.ws + WS_KCAT)) + ((size_t)lb * KCATN + pos) * BW + c8 * 8) = o; } } }
    for (long i0 = gt; i0 < (long)NB * NMEM * (BW / 8); i0 += 8L * ngt) { f32x4 qa[8], qb[8];
#pragma unroll
        for (int k = 0; k < 8; ++k) { const long i = i0 + (long)k * ngt; if (i < (long)NB * NMEM * (BW / 8)) { const size_t e = ((size_t)l * NB * NMEM * (BW / 8) + (size_t)i) * 8; const GAS f32x4* s = (const GAS f32x4*)(p.in[I_CMK] + e); qa[k] = s[0]; qb[k] = s[1]; } }
#pragma unroll
        for (int k = 0; k < 8; ++k) { const long i = i0 + (long)k * ngt; if (i < (long)NB * NMEM * (BW / 8)) { const size_t e = ((size_t)l * NB * NMEM * (BW / 8) + (size_t)i) * 8; const f32x4 a = qa[k], b = qb[k];
            v4u o; o.x = pk2(a.x, a.y); o.y = pk2(a.z, a.w); o.z = pk2(b.x, b.y); o.w = pk2(b.z, b.w); *(GAS v4u*)(((bf16*)(F.ws + WS_CMK)) + e) = o; } } }
}
DI void ph_prologue(const P& p, const Frame& F) {
    int rot = 0;
    colmax_layer(p, F, 0, F.gw, F.ngw, rot); colmax_layer(p, F, 1, F.gw, F.ngw, rot);
    for (int l = 0; l < DEPTH; ++l) conv_weight(F, p.in[I_WMEM] + (size_t)l * DM * 2 * BW, DM, 2 * BW, ((bf16*)(F.ws + WS_WMEM)) + (size_t)l * 2 * BW * DM, 1 << 30, 0, F.gw, F.ngw, rot);
    conv_caches(p, F, 0, F.gw, F.ngw, rot);
    const int gt = F.bx * NTHR + F.tid, ngt = F.G * NTHR;
    for (int i = gt; i < DEPTH * CGN * 128 * 128; i += ngt) { const int s = i & 127, t = (i >> 7) & 127; ((bf16*)(F.ws + WS_WM))[i] = (bf16)(s <= t ? f2bf(p.in[I_CWS][i]) : 0u); }
    for (int i = gt; i < DEPTH * 2 * BW * 64; i += ngt) { const int j = i & 63, c = (i >> 6) & 1023, lo = (i >> 16) & 1, ll = i >> 17;
        ((bf16*)(F.ws + WS_UPT))[i] = (bf16)f2bf(p.in[lo ? I_AAUP : I_AWUP][((size_t)ll * 64 + j) * BW + c]); }
    for (int i = gt; i < 128 * DM / 8; i += ngt) *(GAS v4u*)(((bf16*)(F.ws + WS_WIN)) + (size_t)3200 * DM + (size_t)i * 8) = (v4u){0u, 0u, 0u, 0u};
    for (int i = gt; i < 8 * 8 * 128 * 128 / 8; i += ngt) *(GAS v4u*)(((bf16*)(F.ws + WS_VNT)) + (size_t)128 * 8 * 128 * 128 + (size_t)i * 8) = (v4u){0u, 0u, 0u, 0u};
    for (int m = F.gw; m < MT; m += F.ngw) rms_row_i8(xrow_in(p, m), p.in[I_GPRE], (unsigned char*)(F.ws + WS_H8) + (size_t)m * DM, HSP(F) + m, ((bf16*)(F.ws + WS_H)) + (size_t)m * DM, F.lane);
    for (int m = F.gw; m < DEPTH * NB * NMEM; m += F.ngw) { const int l = m / (NB * NMEM), r = m % (NB * NMEM);
        rms_row_bf16(p.in[I_MEM] + (size_t)r * DM, p.in[I_GMEM] + (size_t)l * DM, ((bf16*)(F.ws + WS_MEMN)) + (size_t)m * DM, nullptr, F.lane); }
}
#define RW_K(cc, fr) (32 * ((fr) >> 3) + 2 * ((fr) & 7) + ((cc) & 1) + 16 * ((cc) >> 1))
#define SWZ16_SUM(v) do { v += SWZ_XOR(v, 1); v += SWZ_XOR(v, 2); v += SWZ_XOR(v, 4); v += SWZ_XOR(v, 8); } while (0)
DI void prep_rwkv_item(const P& p, const Frame& F, int l, int r0) {
    LAS bf16* tw = (LAS bf16*)F.lds; LAS bf16* ta = tw + 16 * 64;
    const bf16* proj = ((bf16*)(F.ws + WS_PROJ)); const int tid = F.tid, lane = F.lane, fr = lane & 15, fq = lane >> 4;
    const float* mu = p.in[I_AMU] + (size_t)l * SHW;
    const bool is_p = r0 < MP; const int t0 = is_p ? (r0 & (SEQ - 1)) : ((r0 - MP) & (DSEQ - 1)); const int bsm = is_p ? 0 : ((r0 - MP) >> 6);
    const float* shp = p.in[I_SSH] + (size_t)(l * NB + bsm) * SHW;
    {
        const int tok = tid >> 5, j = 2 * (tid & 31); const int row = r0 + tok; const bool first = (t0 + tok) == 0;
#pragma unroll
        for (int part = 0; part < 2; ++part) { const int pc = (part ? PC_AD : PC_WD) + j;
            const unsigned cu = *(const GAS unsigned*)(proj + (size_t)row * NINP + pc); const float c0 = bflo(cu), c1 = bfhi(cu); float p0, p1;
            if (!first) { const unsigned pu = *(const GAS unsigned*)(proj + (size_t)(row - 1) * NINP + pc); p0 = bflo(pu); p1 = bfhi(pu); }
            else if (is_p) { p0 = p1 = 0.f; }
            else { p0 = shp[pc]; p1 = shp[pc + 1]; }
            const float x0 = c0 + mu[pc] * (p0 - c0), x1 = c1 + mu[pc + 1] * (p1 - c1);
            *(LAS unsigned*)((part ? ta : tw) + tok * 64 + j) = part ? pk2(x0, x1) : pk2(tanhf(x0), tanhf(x1)); }
    }
    __syncthreads();
    LAS float* lw = (LAS float*)(F.lds + 8192); LAS float* la = lw + 16 * BW;
    {
        f32x4 accw[8], acca[8];
        const bf16* wupT = ((bf16*)(F.ws + WS_UPT)) + (size_t)(l * 2 + 0) * BW * 64; const bf16* aupT = ((bf16*)(F.ws + WS_UPT)) + (size_t)(l * 2 + 1) * BW * 64;
#pragma unroll
        for (int ct = 0; ct < 8; ++ct) { accw[ct] = (f32x4){0.f, 0.f, 0.f, 0.f}; acca[ct] = (f32x4){0.f, 0.f, 0.f, 0.f}; }
#pragma unroll
        for (int ks = 0; ks < 2; ++ks) { const bf16x8 aw = *(const LAS bf16x8*)(tw + fr * 64 + 32 * ks + 8 * fq), aa = *(const LAS bf16x8*)(ta + fr * 64 + 32 * ks + 8 * fq);
#pragma unroll
            for (int ct = 0; ct < 8; ++ct) { const size_t co = (size_t)(128 * F.wave + 64 * (ct >> 2) + RW_K(ct & 3, fr)) * 64 + 32 * ks + 8 * fq;
                accw[ct] = __builtin_amdgcn_mfma_f32_16x16x32_bf16(aw, *(const GAS bf16x8*)(wupT + co), accw[ct], 0, 0, 0);
                acca[ct] = __builtin_amdgcn_mfma_f32_16x16x32_bf16(aa, *(const GAS bf16x8*)(aupT + co), acca[ct], 0, 0, 0); } }
#pragma unroll
        for (int ct = 0; ct < 8; ++ct)
#pragma unroll
            for (int q = 0; q < 4; ++q) { const int o = (4 * fq + q) * BW + 128 * F.wave + 64 * (ct >> 2) + RW_K(ct & 3, fr); lw[o] = accw[ct][q]; la[o] = acca[ct][q]; }
    }
#pragma unroll 1
    for (int hh = 0; hh < 2; ++hh) { const int head = 2 * F.wave + hh;
        float mur[4], muk[4], muv[4], kk_[4], ka_[4], rk_[4], w0_[4], a0_[4], pr[4], pk[4], pvv[4];
#pragma unroll
        for (int cc = 0; cc < 4; ++cc) { const int c = 64 * head + RW_K(cc, fr);
            mur[cc] = mu[PC_R + c]; muk[cc] = mu[PC_K + c]; muv[cc] = mu[PC_V + c]; kk_[cc] = p.in[I_AKK][l * BW + c]; ka_[cc] = p.in[I_AKA][l * BW + c]; rk_[cc] = p.in[I_ARK][l * BW + c];
            w0_[cc] = p.in[I_AW0][l * BW + c]; a0_[cc] = p.in[I_AA0][l * BW + c];
            if (t0 + 4 * fq != 0) { const bf16* q = proj + (size_t)(r0 + 4 * fq - 1) * NINP; pr[cc] = bf2f(q[PC_R + c]); pk[cc] = bf2f(q[PC_K + c]); pvv[cc] = bf2f(q[PC_V + c]); }
            else if (is_p) { pr[cc] = pk[cc] = pvv[cc] = 0.f; }
            else { pr[cc] = shp[PC_R + c]; pk[cc] = shp[PC_K + c]; pvv[cc] = shp[PC_V + c]; } }
        bf16 qr[4][4], qk[4][4], qv[4][4]; float laq[4][4], lwq[4][4];
#pragma unroll
        for (int q = 0; q < 4; ++q) { const bf16* pq = proj + (size_t)(r0 + 4 * fq + q) * NINP;
#pragma unroll
            for (int cc = 0; cc < 4; ++cc) { const int c = 64 * head + RW_K(cc, fr); qr[q][cc] = pq[PC_R + c]; qk[q][cc] = pq[PC_K + c]; qv[q][cc] = pq[PC_V + c];
                laq[q][cc] = la[(4 * fq + q) * BW + c]; lwq[q][cc] = lw[(4 * fq + q) * BW + c]; } }
#pragma unroll
        for (int q = 0; q < 4; ++q) { const int row = r0 + 4 * fq + q;
            float xr[4], xk[4], xv[4], a[4], kkv[4], kp[4]; float ss = 0.f, bon = 0.f;
#pragma unroll
            for (int cc = 0; cc < 4; ++cc) { const float cr = bf2f(qr[q][cc]), ck = bf2f(qk[q][cc]), cv = bf2f(qv[q][cc]);
                xr[cc] = cr + mur[cc] * (pr[cc] - cr); xk[cc] = ck + muk[cc] * (pk[cc] - ck); xv[cc] = cv + muv[cc] * (pvv[cc] - cv); pr[cc] = cr; pk[cc] = ck; pvv[cc] = cv;
                a[cc] = sigmoidf_(a0_[cc] + laq[q][cc]);
                kkv[cc] = xk[cc] * kk_[cc]; ss += kkv[cc] * kkv[cc]; kp[cc] = xk[cc] * (1.0f + (a[cc] - 1.0f) * ka_[cc]); bon += xr[cc] * kp[cc] * rk_[cc]; }
            SWZ16_SUM(ss); SWZ16_SUM(bon);
            const float inv = 1.0f / fmaxf(sqrtf(ss), 1e-12f);
            float kkn[4], dd[4];
#pragma unroll
            for (int cc = 0; cc < 4; ++cc) { kkn[cc] = kkv[cc] * inv; dd[cc] = __expf(-0.6065306597126334f * sigmoidf_(w0_[cc] + lwq[q][cc])); }
            GAS f32x4* sp = (GAS f32x4*)(SCAN5P(F, l) + ((size_t)row * AH + head) * (5 * 64)) + fr;
            sp[0] = (f32x4){kkn[0], kkn[2], kkn[1], kkn[3]}; sp[16] = (f32x4){dd[0], dd[2], dd[1], dd[3]}; sp[32] = (f32x4){kkn[0] * a[0], kkn[2] * a[2], kkn[1] * a[1], kkn[3] * a[3]};
            sp[48] = (f32x4){kp[0], kp[2], kp[1], kp[3]}; sp[64] = (f32x4){xr[0], xr[2], xr[1], xr[3]};
            { float* vp = SCANVP(F) + (size_t)row * BW + 64 * head + RW_K(0, fr); vp[0] = xv[0]; vp[1] = xv[1]; vp[16] = xv[2]; vp[17] = xv[3]; }
            if (fr == 0) ((float*)(F.ws + WS_BONUS))[(size_t)row * AH + head] = bon; }
    }
    __syncthreads();
}
DI void prep_ln_item(const P& p, const Frame& F, int l, int item) {
    LAS unsigned* tile = (LAS unsigned*)F.lds;
    const int lane = F.lane; int row0, ch, s0;
    if (item < 256) { ch = item >> 1; s0 = (item & 1) * 64; row0 = ch * 128 + s0; } else { ch = 128 + (item - 256); s0 = 0; row0 = MP + (item - 256) * 64; }
    const float* lnw = p.in[I_CLNW] + (size_t)l * BW + lane * 16; const float* lnb = p.in[I_CLNB] + (size_t)l * BW + lane * 16;
    v4u ua[8], ub[8];
#pragma unroll
    for (int rr = 0; rr < 8; ++rr) { const GAS v4u* src = (const GAS v4u*)(((bf16*)(F.ws + WS_PROJ)) + (size_t)(row0 + F.wave * 8 + rr) * NINP + PC_CV + lane * 16); ua[rr] = src[0]; ub[rr] = src[1]; }
    float lw[16], lb[16];
#pragma unroll
    for (int i = 0; i < 4; ++i) { const f32x4 a = ((const GAS f32x4*)lnw)[i], b = ((const GAS f32x4*)lnb)[i];
        lw[4 * i] = a.x; lw[4 * i + 1] = a.y; lw[4 * i + 2] = a.z; lw[4 * i + 3] = a.w; lb[4 * i] = b.x; lb[4 * i + 1] = b.y; lb[4 * i + 2] = b.z; lb[4 * i + 3] = b.w; }
#pragma unroll
    for (int rr = 0; rr < 8; ++rr) { const int tr = F.wave * 8 + rr, row = row0 + tr;
        const v4u u0 = ua[rr], u1 = ub[rr];
        float x[16] = {bflo(u0.x), bfhi(u0.x), bflo(u0.y), bfhi(u0.y), bflo(u0.z), bfhi(u0.z), bflo(u0.w), bfhi(u0.w), bflo(u1.x), bfhi(u1.x), bflo(u1.y), bfhi(u1.y), bflo(u1.z), bfhi(u1.z), bflo(u1.w), bfhi(u1.w)};
        float s = 0.f;
#pragma unroll
        for (int i = 0; i < 16; ++i) s += x[i];
        const float mean = wave_sum(s) * (1.0f / BW); float q = 0.f;
#pragma unroll
        for (int i = 0; i < 16; ++i) { x[i] -= mean; q += x[i] * x[i]; }
        const float rstd = 1.0f / sqrtf(wave_sum(q) * (1.0f / BW) + NORM_EPS);
#pragma unroll
        for (int i = 0; i < 16; ++i) x[i] = x[i] * rstd * lw[i] + lb[i];
        if (row >= MP) { GAS f32x4* o = (GAS f32x4*)(F.out + O_CVS + ((size_t)l * MS + (row - MP)) * BW + lane * 16);
#pragma unroll
            for (int i = 0; i < 4; ++i) o[i] = (f32x4){x[4 * i], x[4 * i + 1], x[4 * i + 2], x[4 * i + 3]}; }
        LAS unsigned* tp = tile + tr * 513 + lane * 8;
#pragma unroll
        for (int i = 0; i < 8; ++i) tp[i] = pk2(x[2 * i], x[2 * i + 1]);
    }
    __syncthreads();
    const LAS bf16* t16 = (const LAS bf16*)tile; const int c = F.tid & 7;
    for (int pass = 0; pass < 16; ++pass) { const int dd = (F.tid >> 3) + 64 * pass; const LAS bf16* s = t16 + (8 * c) * 1026 + dd;
        v4u o; o.x = (unsigned)s[0 * 1026] | ((unsigned)s[1 * 1026] << 16); o.y = (unsigned)s[2 * 1026] | ((unsigned)s[3 * 1026] << 16);
        o.z = (unsigned)s[4 * 1026] | ((unsigned)s[5 * 1026] << 16); o.w = (unsigned)s[6 * 1026] | ((unsigned)s[7 * 1026] << 16);
        *(GAS v4u*)(((bf16*)(F.ws + WS_VNT)) + ((size_t)ch * BW + dd) * 128 + s0 + 8 * c) = o; }
    __syncthreads();
}
DI void ph_prep(const P& p, const Frame& F, int l) {
#ifndef DUP_PHASE
#define DUP_PHASE (-1)
#endif
#define REPP(k) _Pragma("unroll 1") for (int repp_ = 0; repp_ < ((DUP_PHASE) == (k) ? 2 : 1); ++repp_)
    REPP(601) for (int it = F.bx; it < MT / 16; it += F.G) prep_rwkv_item(p, F, l, it * 16);
    { constexpr int NX = MT / 16 - 4 * GRID;
      REPP(602) if (F.bx >= NX) for (int it = F.bx - NX; it < 256 + 8; it += F.G - NX) prep_ln_item(p, F, l, it); }
    int rot = 0;
    REPP(603) {
        LAS unsigned* scr = (LAS unsigned*)(F.lds + F.wave * 16640);
        const int nP = NB * BHN * (SEQ / 64) * 2, nS = NB * BHN * 2, nitems = nP + nS;
        FOR_ITEMS(it, nitems, F.gw, F.ngw, rot) {
            if (it < nP) { const int dt = it & 1, tt = (it >> 1) & 31, h = (it >> 6) & 7, b = it >> 9;
                tr64_bf16(((bf16*)(F.ws + WS_PROJ)) + ((size_t)b * SEQ + tt * 64) * NINP + PC_BV + h * BHD + dt * 64, (size_t)NINP, ((bf16*)(F.ws + WS_VT)) + ((size_t)(b * BHN + h) * BHD + dt * 64) * SEQ + tt * 64, (size_t)SEQ, scr, F.lane); }
            else { const int j = it - nP, dt = j & 1, h = (j >> 1) & 7, b = j >> 4;
                tr64_bf16(((bf16*)(F.ws + WS_PROJ)) + ((size_t)MP + b * DSEQ) * NINP + PC_BV + h * BHD + dt * 64, (size_t)NINP, ((bf16*)(F.ws + WS_VTCAT)) + ((size_t)((l * NB + b) * BHN + h) * BHD + dt * 64) * KCATN + PAST, (size_t)KCATN, scr, F.lane); } }
        ROT_ADV(rot, nitems, F.ngw);
    }
    {
        LAS float* scr = (LAS float*)(F.lds + F.wave * 16640);
        const int nitems = NB * MHN * 16;
        FOR_ITEMS(it, nitems, F.gw, F.ngw, rot) { const int dt = it & 3, mt = (it >> 2) & 3, hm = (it >> 4) & 3, b = it >> 6;
            tr64_f32(F.out + O_MV + ((size_t)(l * NB + b) * NMEM + mt * 64) * BW + hm * MHD + dt * 64, (size_t)BW, ((bf16*)(F.ws + WS_MVT)) + ((size_t)((l * NB + b) * MHN + hm) * MHD + dt * 64) * NMEM + mt * 64, (size_t)NMEM, scr, F.lane); }
        ROT_ADV(rot, nitems, F.ngw);
    }
    const int gt = F.bx * NTHR + F.tid, ngt = F.G * NTHR;
    for (int i = gt; i < NB * NMEM * (BW / 8); i += ngt) { const GAS f32x4* s = (const GAS f32x4*)(F.out + O_MK + (size_t)l * NB * NMEM * BW + (size_t)i * 8); const f32x4 a = s[0], b = s[1];
        v4u o; o.x = pk2(a.x, a.y); o.y = pk2(a.z, a.w); o.z = pk2(b.x, b.y); o.w = pk2(b.z, b.w); *(GAS v4u*)(((bf16*)(F.ws + WS_MKB)) + (size_t)l * NB * NMEM * BW + (size_t)i * 8) = o; }
    for (int i = gt; i < MS * (BW / 8); i += ngt) { const int c8 = i & 127, r = i >> 7, b = r >> 6, t = r & 63;
        *(GAS v4u*)(((bf16*)(F.ws + WS_KCAT)) + ((size_t)(l * NB + b) * KCATN + PAST + t) * BW + c8 * 8) = *(const GAS v4u*)(((bf16*)(F.ws + WS_PROJ)) + (size_t)(MP + r) * NINP + PC_BK + c8 * 8); }
    REPP(604) for (long i0 = gt; i0 < (long)MT * 256; i0 += 11L * ngt) { v4u uq[11];
#pragma unroll
        for (int k = 0; k < 11; ++k) { const long i = i0 + (long)k * ngt; if (i < (long)MT * 256) { const int c8 = (int)(i & 255); const int row = (int)(i >> 8); const int seg = c8 >> 7, col = (c8 & 127) * 8;
            uq[k] = *(const GAS v4u*)(((bf16*)(F.ws + WS_PROJ)) + (size_t)row * NINP + (seg ? PC_BV : PC_BK) + col); } }
#pragma unroll
        for (int k = 0; k < 11; ++k) { const long i = i0 + (long)k * ngt; if (i < (long)MT * 256) { const int c8 = (int)(i & 255); const int row = (int)(i >> 8); const int seg = c8 >> 7, col = (c8 & 127) * 8; const v4u u = uq[k];
            float* dst = row < MP ? F.out + (seg ? O_SVP : O_SKP) + ((size_t)l * MP + row) * BW + col : F.out + (seg ? O_SVS : O_SKS) + ((size_t)l * MS + (row - MP)) * BW + col;
            ((GAS f32x4*)dst)[0] = (f32x4){bflo(u.x), bfhi(u.x), bflo(u.y), bfhi(u.y)}; ((GAS f32x4*)dst)[1] = (f32x4){bflo(u.z), bfhi(u.z), bflo(u.w), bfhi(u.w)}; } } }
    for (int i = gt; i < 16 * SHW; i += ngt) { const int sq = i / SHW, c = i % SHW; const int b = sq & 7; const bool smp = sq >= 8;
        const int row = smp ? MP + b * DSEQ + DSEQ - 1 : b * SEQ + SEQ - 1;
        F.out[(smp ? O_SHS : O_SHP) + (size_t)(l * NB + b) * SHW + c] = bf2f(((bf16*)(F.ws + WS_PROJ))[(size_t)row * NINP + c]); }
}
typedef float f32x2s __attribute__((ext_vector_type(2)));
struct ScanOps { f32x2s kk, dd, ka, kp, rr; float vv; };
DI void scan_load(ScanOps& o, const float* sbase, const float* vbase, int t, int lane) {
    const GAS float* p = (const GAS float*)(sbase + (size_t)t * (AH * 5 * 64) + ((lane >> 5) * 16 + (lane & 15)) * 2); const GAS float* pv = (const GAS float*)(vbase + (size_t)t * BW + (lane & 31));
    asm volatile("global_load_dwordx2 %0, %6, off\n\tglobal_load_dwordx2 %1, %6, off offset:256\n\tglobal_load_dwordx2 %2, %6, off offset:512\n\tglobal_load_dwordx2 %3, %6, off offset:768\n\t"
                 "global_load_dwordx2 %4, %6, off offset:1024\n\tglobal_load_dword %5, %7, off"
                 : "=&v"(o.kk), "=&v"(o.dd), "=&v"(o.ka), "=&v"(o.kp), "=&v"(o.rr), "=&v"(o.vv) : "v"(p), "v"(pv) : "memory");
}
DI void scan_wait(ScanOps& o) { asm volatile("s_waitcnt vmcnt(18)" : "+v"(o.kk), "+v"(o.dd), "+v"(o.ka), "+v"(o.kp), "+v"(o.rr), "+v"(o.vv) :: "memory"); }
#define SCAN_DPP(op, n) op " row_newbcast:" #n " row_mask:0xf bank_mask:0xf"
DI float scan_step(float (&S)[32], ScanOps& o) {
    float a0 = 0.f, a1 = 0.f, a2 = 0.f, a3 = 0.f;
    scan_wait(o);
    asm volatile("s_nop 1");
    asm volatile(SCAN_DPP("v_fmac_f32_dpp %0, %1, %2", 0) : "+v"(a0) : "v"(o.kk[0]), "v"(S[0]));
    asm volatile(SCAN_DPP("v_fmac_f32_dpp %0, %1, %2", 1) : "+v"(a1) : "v"(o.kk[0]), "v"(S[1]));
    asm volatile(SCAN_DPP("v_fmac_f32_dpp %0, %1, %2", 2) : "+v"(a2) : "v"(o.kk[0]), "v"(S[2]));
    asm volatile(SCAN_DPP("v_fmac_f32_dpp %0, %1, %2", 3) : "+v"(a3) : "v"(o.kk[0]), "v"(S[3]));
    asm volatile(SCAN_DPP("v_fmac_f32_dpp %0, %1, %2", 4) : "+v"(a0) : "v"(o.kk[0]), "v"(S[4]));
    asm volatile(SCAN_DPP("v_fmac_f32_dpp %0, %1, %2", 5) : "+v"(a1) : "v"(o.kk[0]), "v"(S[5]));
    asm volatile(SCAN_DPP("v_fmac_f32_dpp %0, %1, %2", 6) : "+v"(a2) : "v"(o.kk[0]), "v"(S[6]));
    asm volatile(SCAN_DPP("v_fmac_f32_dpp %0, %1, %2", 7) : "+v"(a3) : "v"(o.kk[0]), "v"(S[7]));
    asm volatile(SCAN_DPP("v_fmac_f32_dpp %0, %1, %2", 8) : "+v"(a0) : "v"(o.kk[0]), "v"(S[8]));
    asm volatile(SCAN_DPP("v_fmac_f32_dpp %0, %1, %2", 9) : "+v"(a1) : "v"(o.kk[0]), "v"(S[9]));
    asm volatile(SCAN_DPP("v_fmac_f32_dpp %0, %1, %2", 10) : "+v"(a2) : "v"(o.kk[0]), "v"(S[10]));
    asm volatile(SCAN_DPP("v_fmac_f32_dpp %0, %1, %2", 11) : "+v"(a3) : "v"(o.kk[0]), "v"(S[11]));
    asm volatile(SCAN_DPP("v_fmac_f32_dpp %0, %1, %2", 12) : "+v"(a0) : "v"(o.kk[0]), "v"(S[12]));
    asm volatile(SCAN_DPP("v_fmac_f32_dpp %0, %1, %2", 13) : "+v"(a1) : "v"(o.kk[0]), "v"(S[13]));
    asm volatile(SCAN_DPP("v_fmac_f32_dpp %0, %1, %2", 14) : "+v"(a2) : "v"(o.kk[0]), "v"(S[14]));
    asm volatile(SCAN_DPP("v_fmac_f32_dpp %0, %1, %2", 15) : "+v"(a3) : "v"(o.kk[0]), "v"(S[15]));
    asm volatile(SCAN_DPP("v_fmac_f32_dpp %0, %1, %2", 0) : "+v"(a0) : "v"(o.kk[1]), "v"(S[16]));
    asm volatile(SCAN_DPP("v_fmac_f32_dpp %0, %1, %2", 1) : "+v"(a1) : "v"(o.kk[1]), "v"(S[17]));
    asm volatile(SCAN_DPP("v_fmac_f32_dpp %0, %1, %2", 2) : "+v"(a2) : "v"(o.kk[1]), "v"(S[18]));
    asm volatile(SCAN_DPP("v_fmac_f32_dpp %0, %1, %2", 3) : "+v"(a3) : "v"(o.kk[1]), "v"(S[19]));
    asm volatile(SCAN_DPP("v_fmac_f32_dpp %0, %1, %2", 4) : "+v"(a0) : "v"(o.kk[1]), "v"(S[20]));
    asm volatile(SCAN_DPP("v_fmac_f32_dpp %0, %1, %2", 5) : "+v"(a1) : "v"(o.kk[1]), "v"(S[21]));
    asm volatile(SCAN_DPP("v_fmac_f32_dpp %0, %1, %2", 6) : "+v"(a2) : "v"(o.kk[1]), "v"(S[22]));
    asm volatile(SCAN_DPP("v_fmac_f32_dpp %0, %1, %2", 7) : "+v"(a3) : "v"(o.kk[1]), "v"(S[23]));
    asm volatile(SCAN_DPP("v_fmac_f32_dpp %0, %1, %2", 8) : "+v"(a0) : "v"(o.kk[1]), "v"(S[24]));
    asm volatile(SCAN_DPP("v_fmac_f32_dpp %0, %1, %2", 9) : "+v"(a1) : "v"(o.kk[1]), "v"(S[25]));
    asm volatile(SCAN_DPP("v_fmac_f32_dpp %0, %1, %2", 10) : "+v"(a2) : "v"(o.kk[1]), "v"(S[26]));
    asm volatile(SCAN_DPP("v_fmac_f32_dpp %0, %1, %2", 11) : "+v"(a3) : "v"(o.kk[1]), "v"(S[27]));
    asm volatile(SCAN_DPP("v_fmac_f32_dpp %0, %1, %2", 12) : "+v"(a0) : "v"(o.kk[1]), "v"(S[28]));
    asm volatile(SCAN_DPP("v_fmac_f32_dpp %0, %1, %2", 13) : "+v"(a1) : "v"(o.kk[1]), "v"(S[29]));
    asm volatile(SCAN_DPP("v_fmac_f32_dpp %0, %1, %2", 14) : "+v"(a2) : "v"(o.kk[1]), "v"(S[30]));
    asm volatile(SCAN_DPP("v_fmac_f32_dpp %0, %1, %2", 15) : "+v"(a3) : "v"(o.kk[1]), "v"(S[31]));
    const float nskk = -xor32_sum((a0 + a1) + (a2 + a3)); const float vv = o.vv;
    float y0 = 0.f, y1 = 0.f, y2 = 0.f, y3 = 0.f;
    asm volatile("s_nop 1");
    asm volatile(SCAN_DPP("v_mul_f32_dpp %0, %1, %0", 0) : "+v"(S[0]) : "v"(o.dd[0]));
    asm volatile(SCAN_DPP("v_mul_f32_dpp %0, %1, %0", 1) : "+v"(S[1]) : "v"(o.dd[0]));
    asm volatile(SCAN_DPP("v_mul_f32_dpp %0, %1, %0", 2) : "+v"(S[2]) : "v"(o.dd[0]));
    asm volatile(SCAN_DPP("v_mul_f32_dpp %0, %1, %0", 3) : "+v"(S[3]) : "v"(o.dd[0]));
    asm volatile(SCAN_DPP("v_fmac_f32_dpp %0, %1, %2", 0) : "+v"(S[0]) : "v"(o.ka[0]), "v"(nskk));
    asm volatile(SCAN_DPP("v_fmac_f32_dpp %0, %1, %2", 1) : "+v"(S[1]) : "v"(o.ka[0]), "v"(nskk));
    asm volatile(SCAN_DPP("v_fmac_f32_dpp %0, %1, %2", 2) : "+v"(S[2]) : "v"(o.ka[0]), "v"(nskk));
    asm volatile(SCAN_DPP("v_fmac_f32_dpp %0, %1, %2", 3) : "+v"(S[3]) : "v"(o.ka[0]), "v"(nskk));
    asm volatile(SCAN_DPP("v_fmac_f32_dpp %0, %1, %2", 0) : "+v"(S[0]) : "v"(o.kp[0]), "v"(vv));
    asm volatile(SCAN_DPP("v_fmac_f32_dpp %0, %1, %2", 1) : "+v"(S[1]) : "v"(o.kp[0]), "v"(vv));
    asm volatile(SCAN_DPP("v_fmac_f32_dpp %0, %1, %2", 2) : "+v"(S[2]) : "v"(o.kp[0]), "v"(vv));
    asm volatile(SCAN_DPP("v_fmac_f32_dpp %0, %1, %2", 3) : "+v"(S[3]) : "v"(o.kp[0]), "v"(vv));
    asm volatile(SCAN_DPP("v_fmac_f32_dpp %0, %1, %2", 0) : "+v"(y0) : "v"(o.rr[0]), "v"(S[0]));
    asm volatile(SCAN_DPP("v_fmac_f32_dpp %0, %1, %2", 1) : "+v"(y1) : "v"(o.rr[0]), "v"(S[1]));
    asm volatile(SCAN_DPP("v_fmac_f32_dpp %0, %1, %2", 2) : "+v"(y2) : "v"(o.rr[0]), "v"(S[2]));
    asm volatile(SCAN_DPP("v_fmac_f32_dpp %0, %1, %2", 3) : "+v"(y3) : "v"(o.rr[0]), "v"(S[3]));
    asm volatile(SCAN_DPP("v_mul_f32_dpp %0, %1, %0", 4) : "+v"(S[4]) : "v"(o.dd[0]));
    asm volatile(SCAN_DPP("v_mul_f32_dpp %0, %1, %0", 5) : "+v"(S[5]) : "v"(o.dd[0]));
    asm volatile(SCAN_DPP("v_mul_f32_dpp %0, %1, %0", 6) : "+v"(S[6]) : "v"(o.dd[0]));
    asm volatile(SCAN_DPP("v_mul_f32_dpp %0, %1, %0", 7) : "+v"(S[7]) : "v"(o.dd[0]));
    asm volatile(SCAN_DPP("v_fmac_f32_dpp %0, %1, %2", 4) : "+v"(S[4]) : "v"(o.ka[0]), "v"(nskk));
    asm volatile(SCAN_DPP("v_fmac_f32_dpp %0, %1, %2", 5) : "+v"(S[5]) : "v"(o.ka[0]), "v"(nskk));
    asm volatile(SCAN_DPP("v_fmac_f32_dpp %0, %1, %2", 6) : "+v"(S[6]) : "v"(o.ka[0]), "v"(nskk));
    asm volatile(SCAN_DPP("v_fmac_f32_dpp %0, %1, %2", 7) : "+v"(S[7]) : "v"(o.ka[0]), "v"(nskk));
    asm volatile(SCAN_DPP("v_fmac_f32_dpp %0, %1, %2", 4) : "+v"(S[4]) : "v"(o.kp[0]), "v"(vv));
    asm volatile(SCAN_DPP("v_fmac_f32_dpp %0, %1, %2", 5) : "+v"(S[5]) : "v"(o.kp[0]), "v"(vv));
    asm volatile(SCAN_DPP("v_fmac_f32_dpp %0, %1, %2", 6) : "+v"(S[6]) : "v"(o.kp[0]), "v"(vv));
    asm volatile(SCAN_DPP("v_fmac_f32_dpp %0, %1, %2", 7) : "+v"(S[7]) : "v"(o.kp[0]), "v"(vv));
    asm volatile(SCAN_DPP("v_fmac_f32_dpp %0, %1, %2", 4) : "+v"(y0) : "v"(o.rr[0]), "v"(S[4]));
    asm volatile(SCAN_DPP("v_fmac_f32_dpp %0, %1, %2", 5) : "+v"(y1) : "v"(o.rr[0]), "v"(S[5]));
    asm volatile(SCAN_DPP("v_fmac_f32_dpp %0, %1, %2", 6) : "+v"(y2) : "v"(o.rr[0]), "v"(S[6]));
    asm volatile(SCAN_DPP("v_fmac_f32_dpp %0, %1, %2", 7) : "+v"(y3) : "v"(o.rr[0]), "v"(S[7]));
    asm volatile(SCAN_DPP("v_mul_f32_dpp %0, %1, %0", 8) : "+v"(S[8]) : "v"(o.dd[0]));
    asm volatile(SCAN_DPP("v_mul_f32_dpp %0, %1, %0", 9) : "+v"(S[9]) : "v"(o.dd[0]));
    asm volatile(SCAN_DPP("v_mul_f32_dpp %0, %1, %0", 10) : "+v"(S[10]) : "v"(o.dd[0]));
    asm volatile(SCAN_DPP("v_mul_f32_dpp %0, %1, %0", 11) : "+v"(S[11]) : "v"(o.dd[0]));
    asm volatile(SCAN_DPP("v_fmac_f32_dpp %0, %1, %2", 8) : "+v"(S[8]) : "v"(o.ka[0]), "v"(nskk));
    asm volatile(SCAN_DPP("v_fmac_f32_dpp %0, %1, %2", 9) : "+v"(S[9]) : "v"(o.ka[0]), "v"(nskk));
    asm volatile(SCAN_DPP("v_fmac_f32_dpp %0, %1, %2", 10) : "+v"(S[10]) : "v"(o.ka[0]), "v"(nskk));
    asm volatile(SCAN_DPP("v_fmac_f32_dpp %0, %1, %2", 11) : "+v"(S[11]) : "v"(o.ka[0]), "v"(nskk));
    asm volatile(SCAN_DPP("v_fmac_f32_dpp %0, %1, %2", 8) : "+v"(S[8]) : "v"(o.kp[0]), "v"(vv));
    asm volatile(SCAN_DPP("v_fmac_f32_dpp %0, %1, %2", 9) : "+v"(S[9]) : "v"(o.kp[0]), "v"(vv));
    asm volatile(SCAN_DPP("v_fmac_f32_dpp %0, %1, %2", 10) : "+v"(S[10]) : "v"(o.kp[0]), "v"(vv));
    asm volatile(SCAN_DPP("v_fmac_f32_dpp %0, %1, %2", 11) : "+v"(S[11]) : "v"(o.kp[0]), "v"(vv));
    asm volatile(SCAN_DPP("v_fmac_f32_dpp %0, %1, %2", 8) : "+v"(y0) : "v"(o.rr[0]), "v"(S[8]));
    asm volatile(SCAN_DPP("v_fmac_f32_dpp %0, %1, %2", 9) : "+v"(y1) : "v"(o.rr[0]), "v"(S[9]));
    asm volatile(SCAN_DPP("v_fmac_f32_dpp %0, %1, %2", 10) : "+v"(y2) : "v"(o.rr[0]), "v"(S[10]));
    asm volatile(SCAN_DPP("v_fmac_f32_dpp %0, %1, %2", 11) : "+v"(y3) : "v"(o.rr[0]), "v"(S[11]));
    asm volatile(SCAN_DPP("v_mul_f32_dpp %0, %1, %0", 12) : "+v"(S[12]) : "v"(o.dd[0]));
    asm volatile(SCAN_DPP("v_mul_f32_dpp %0, %1, %0", 13) : "+v"(S[13]) : "v"(o.dd[0]));
    asm volatile(SCAN_DPP("v_mul_f32_dpp %0, %1, %0", 14) : "+v"(S[14]) : "v"(o.dd[0]));
    asm volatile(SCAN_DPP("v_mul_f32_dpp %0, %1, %0", 15) : "+v"(S[15]) : "v"(o.dd[0]));
    asm volatile(SCAN_DPP("v_fmac_f32_dpp %0, %1, %2", 12) : "+v"(S[12]) : "v"(o.ka[0]), "v"(nskk));
    asm volatile(SCAN_DPP("v_fmac_f32_dpp %0, %1, %2", 13) : "+v"(S[13]) : "v"(o.ka[0]), "v"(nskk));
    asm volatile(SCAN_DPP("v_fmac_f32_dpp %0, %1, %2", 14) : "+v"(S[14]) : "v"(o.ka[0]), "v"(nskk));
    asm volatile(SCAN_DPP("v_fmac_f32_dpp %0, %1, %2", 15) : "+v"(S[15]) : "v"(o.ka[0]), "v"(nskk));
    asm volatile(SCAN_DPP("v_fmac_f32_dpp %0, %1, %2", 12) : "+v"(S[12]) : "v"(o.kp[0]), "v"(vv));
    asm volatile(SCAN_DPP("v_fmac_f32_dpp %0, %1, %2", 13) : "+v"(S[13]) : "v"(o.kp[0]), "v"(vv));
    asm volatile(SCAN_DPP("v_fmac_f32_dpp %0, %1, %2", 14) : "+v"(S[14]) : "v"(o.kp[0]), "v"(vv));
    asm volatile(SCAN_DPP("v_fmac_f32_dpp %0, %1, %2", 15) : "+v"(S[15]) : "v"(o.kp[0]), "v"(vv));
    asm volatile(SCAN_DPP("v_fmac_f32_dpp %0, %1, %2", 12) : "+v"(y0) : "v"(o.rr[0]), "v"(S[12]));
    asm volatile(SCAN_DPP("v_fmac_f32_dpp %0, %1, %2", 13) : "+v"(y1) : "v"(o.rr[0]), "v"(S[13]));
    asm volatile(SCAN_DPP("v_fmac_f32_dpp %0, %1, %2", 14) : "+v"(y2) : "v"(o.rr[0]), "v"(S[14]));
    asm volatile(SCAN_DPP("v_fmac_f32_dpp %0, %1, %2", 15) : "+v"(y3) : "v"(o.rr[0]), "v"(S[15]));
    asm volatile(SCAN_DPP("v_mul_f32_dpp %0, %1, %0", 0) : "+v"(S[16]) : "v"(o.dd[1]));
    asm volatile(SCAN_DPP("v_mul_f32_dpp %0, %1, %0", 1) : "+v"(S[17]) : "v"(o.dd[1]));
    asm volatile(SCAN_DPP("v_mul_f32_dpp %0, %1, %0", 2) : "+v"(S[18]) : "v"(o.dd[1]));
    asm volatile(SCAN_DPP("v_mul_f32_dpp %0, %1, %0", 3) : "+v"(S[19]) : "v"(o.dd[1]));
    asm volatile(SCAN_DPP("v_fmac_f32_dpp %0, %1, %2", 0) : "+v"(S[16]) : "v"(o.ka[1]), "v"(nskk));
    asm volatile(SCAN_DPP("v_fmac_f32_dpp %0, %1, %2", 1) : "+v"(S[17]) : "v"(o.ka[1]), "v"(nskk));
    asm volatile(SCAN_DPP("v_fmac_f32_dpp %0, %1, %2", 2) : "+v"(S[18]) : "v"(o.ka[1]), "v"(nskk));
    asm volatile(SCAN_DPP("v_fmac_f32_dpp %0, %1, %2", 3) : "+v"(S[19]) : "v"(o.ka[1]), "v"(nskk));
    asm volatile(SCAN_DPP("v_fmac_f32_dpp %0, %1, %2", 0) : "+v"(S[16]) : "v"(o.kp[1]), "v"(vv));
    asm volatile(SCAN_DPP("v_fmac_f32_dpp %0, %1, %2", 1) : "+v"(S[17]) : "v"(o.kp[1]), "v"(vv));
    asm volatile(SCAN_DPP("v_fmac_f32_dpp %0, %1, %2", 2) : "+v"(S[18]) : "v"(o.kp[1]), "v"(vv));
    asm volatile(SCAN_DPP("v_fmac_f32_dpp %0, %1, %2", 3) : "+v"(S[19]) : "v"(o.kp[1]), "v"(vv));
    asm volatile(SCAN_DPP("v_fmac_f32_dpp %0, %1, %2", 0) : "+v"(y0) : "v"(o.rr[1]), "v"(S[16]));
    asm volatile(SCAN_DPP("v_fmac_f32_dpp %0, %1, %2", 1) : "+v"(y1) : "v"(o.rr[1]), "v"(S[17]));
    asm volatile(SCAN_DPP("v_fmac_f32_dpp %0, %1, %2", 2) : "+v"(y2) : "v"(o.rr[1]), "v"(S[18]));
    asm volatile(SCAN_DPP("v_fmac_f32_dpp %0, %1, %2", 3) : "+v"(y3) : "v"(o.rr[1]), "v"(S[19]));
    asm volatile(SCAN_DPP("v_mul_f32_dpp %0, %1, %0", 4) : "+v"(S[20]) : "v"(o.dd[1]));
    asm volatile(SCAN_DPP("v_mul_f32_dpp %0, %1, %0", 5) : "+v"(S[21]) : "v"(o.dd[1]));
    asm volatile(SCAN_DPP("v_mul_f32_dpp %0, %1, %0", 6) : "+v"(S[22]) : "v"(o.dd[1]));
    asm volatile(SCAN_DPP("v_mul_f32_dpp %0, %1, %0", 7) : "+v"(S[23]) : "v"(o.dd[1]));
    asm volatile(SCAN_DPP("v_fmac_f32_dpp %0, %1, %2", 4) : "+v"(S[20]) : "v"(o.ka[1]), "v"(nskk));
    asm volatile(SCAN_DPP("v_fmac_f32_dpp %0, %1, %2", 5) : "+v"(S[21]) : "v"(o.ka[1]), "v"(nskk));
    asm volatile(SCAN_DPP("v_fmac_f32_dpp %0, %1, %2", 6) : "+v"(S[22]) : "v"(o.ka[1]), "v"(nskk));
    asm volatile(SCAN_DPP("v_fmac_f32_dpp %0, %1, %2", 7) : "+v"(S[23]) : "v"(o.ka[1]), "v"(nskk));
    asm volatile(SCAN_DPP("v_fmac_f32_dpp %0, %1, %2", 4) : "+v"(S[20]) : "v"(o.kp[1]), "v"(vv));
    asm volatile(SCAN_DPP("v_fmac_f32_dpp %0, %1, %2", 5) : "+v"(S[21]) : "v"(o.kp[1]), "v"(vv));
    asm volatile(SCAN_DPP("v_fmac_f32_dpp %0, %1, %2", 6) : "+v"(S[22]) : "v"(o.kp[1]), "v"(vv));
    asm volatile(SCAN_DPP("v_fmac_f32_dpp %0, %1, %2", 7) : "+v"(S[23]) : "v"(o.kp[1]), "v"(vv));
    asm volatile(SCAN_DPP("v_fmac_f32_dpp %0, %1, %2", 4) : "+v"(y0) : "v"(o.rr[1]), "v"(S[20]));
    asm volatile(SCAN_DPP("v_fmac_f32_dpp %0, %1, %2", 5) : "+v"(y1) : "v"(o.rr[1]), "v"(S[21]));
    asm volatile(SCAN_DPP("v_fmac_f32_dpp %0, %1, %2", 6) : "+v"(y2) : "v"(o.rr[1]), "v"(S[22]));
    asm volatile(SCAN_DPP("v_fmac_f32_dpp %0, %1, %2", 7) : "+v"(y3) : "v"(o.rr[1]), "v"(S[23]));
    asm volatile(SCAN_DPP("v_mul_f32_dpp %0, %1, %0", 8) : "+v"(S[24]) : "v"(o.dd[1]));
    asm volatile(SCAN_DPP("v_mul_f32_dpp %0, %1, %0", 9) : "+v"(S[25]) : "v"(o.dd[1]));
    asm volatile(SCAN_DPP("v_mul_f32_dpp %0, %1, %0", 10) : "+v"(S[26]) : "v"(o.dd[1]));
    asm volatile(SCAN_DPP("v_mul_f32_dpp %0, %1, %0", 11) : "+v"(S[27]) : "v"(o.dd[1]));
    asm volatile(SCAN_DPP("v_fmac_f32_dpp %0, %1, %2", 8) : "+v"(S[24]) : "v"(o.ka[1]), "v"(nskk));
    asm volatile(SCAN_DPP("v_fmac_f32_dpp %0, %1, %2", 9) : "+v"(S[25]) : "v"(o.ka[1]), "v"(nskk));
    asm volatile(SCAN_DPP("v_fmac_f32_dpp %0, %1, %2", 10) : "+v"(S[26]) : "v"(o.ka[1]), "v"(nskk));
    asm volatile(SCAN_DPP("v_fmac_f32_dpp %0, %1, %2", 11) : "+v"(S[27]) : "v"(o.ka[1]), "v"(nskk));
    asm volatile(SCAN_DPP("v_fmac_f32_dpp %0, %1, %2", 8) : "+v"(S[24]) : "v"(o.kp[1]), "v"(vv));
    asm volatile(SCAN_DPP("v_fmac_f32_dpp %0, %1, %2", 9) : "+v"(S[25]) : "v"(o.kp[1]), "v"(vv));
    asm volatile(SCAN_DPP("v_fmac_f32_dpp %0, %1, %2", 10) : "+v"(S[26]) : "v"(o.kp[1]), "v"(vv));
    asm volatile(SCAN_DPP("v_fmac_f32_dpp %0, %1, %2", 11) : "+v"(S[27]) : "v"(o.kp[1]), "v"(vv));
    asm volatile(SCAN_DPP("v_fmac_f32_dpp %0, %1, %2", 8) : "+v"(y0) : "v"(o.rr[1]), "v"(S[24]));
    asm volatile(SCAN_DPP("v_fmac_f32_dpp %0, %1, %2", 9) : "+v"(y1) : "v"(o.rr[1]), "v"(S[25]));
    asm volatile(SCAN_DPP("v_fmac_f32_dpp %0, %1, %2", 10) : "+v"(y2) : "v"(o.rr[1]), "v"(S[26]));
    asm volatile(SCAN_DPP("v_fmac_f32_dpp %0, %1, %2", 11) : "+v"(y3) : "v"(o.rr[1]), "v"(S[27]));
    asm volatile(SCAN_DPP("v_mul_f32_dpp %0, %1, %0", 12) : "+v"(S[28]) : "v"(o.dd[1]));
    asm volatile(SCAN_DPP("v_mul_f32_dpp %0, %1, %0", 13) : "+v"(S[29]) : "v"(o.dd[1]));
    asm volatile(SCAN_DPP("v_mul_f32_dpp %0, %1, %0", 14) : "+v"(S[30]) : "v"(o.dd[1]));
    asm volatile(SCAN_DPP("v_mul_f32_dpp %0, %1, %0", 15) : "+v"(S[31]) : "v"(o.dd[1]));
    asm volatile(SCAN_DPP("v_fmac_f32_dpp %0, %1, %2", 12) : "+v"(S[28]) : "v"(o.ka[1]), "v"(nskk));
    asm volatile(SCAN_DPP("v_fmac_f32_dpp %0, %1, %2", 13) : "+v"(S[29]) : "v"(o.ka[1]), "v"(nskk));
    asm volatile(SCAN_DPP("v_fmac_f32_dpp %0, %1, %2", 14) : "+v"(S[30]) : "v"(o.ka[1]), "v"(nskk));
    asm volatile(SCAN_DPP("v_fmac_f32_dpp %0, %1, %2", 15) : "+v"(S[31]) : "v"(o.ka[1]), "v"(nskk));
    asm volatile(SCAN_DPP("v_fmac_f32_dpp %0, %1, %2", 12) : "+v"(S[28]) : "v"(o.kp[1]), "v"(vv));
    asm volatile(SCAN_DPP("v_fmac_f32_dpp %0, %1, %2", 13) : "+v"(S[29]) : "v"(o.kp[1]), "v"(vv));
    asm volatile(SCAN_DPP("v_fmac_f32_dpp %0, %1, %2", 14) : "+v"(S[30]) : "v"(o.kp[1]), "v"(vv));
    asm volatile(SCAN_DPP("v_fmac_f32_dpp %0, %1, %2", 15) : "+v"(S[31]) : "v"(o.kp[1]), "v"(vv));
    asm volatile(SCAN_DPP("v_fmac_f32_dpp %0, %1, %2", 12) : "+v"(y0) : "v"(o.rr[1]), "v"(S[28]));
    asm volatile(SCAN_DPP("v_fmac_f32_dpp %0, %1, %2", 13) : "+v"(y1) : "v"(o.rr[1]), "v"(S[29]));
    asm volatile(SCAN_DPP("v_fmac_f32_dpp %0, %1, %2", 14) : "+v"(y2) : "v"(o.rr[1]), "v"(S[30]));
    asm volatile(SCAN_DPP("v_fmac_f32_dpp %0, %1, %2", 15) : "+v"(y3) : "v"(o.rr[1]), "v"(S[31]));
    return xor32_sum((y0 + y1) + (y2 + y3));
}
#define SCAN_STORE(ptr, val) asm volatile("global_store_dword %0, %1, off" :: "v"((GAS float*)(ptr)), "v"(val) : "memory")
DI void scan_unit(const float* sbase, const float* vbase, const float* s0, float* yraw, float* sout, int half, int T, int lane) {
    float S[32]; const int srow = (32 * half + (lane & 31)) * 64 + 32 * (lane >> 5);
    if (s0) {
#pragma unroll
        for (int k = 0; k < 32; k += 4) { const f32x4 v = *(const GAS f32x4*)(s0 + srow + k); S[k] = v.x; S[k + 1] = v.y; S[k + 2] = v.z; S[k + 3] = v.w; }
    } else {
#pragma unroll
        for (int k = 0; k < 32; ++k) S[k] = 0.f;
    }
#pragma unroll
    for (int k = 0; k < 32; ++k) asm volatile("" : "+v"(S[k]));
    __builtin_amdgcn_s_setprio(3);
    ScanOps o0, o1, o2, o3; float* yp = yraw + (lane & 31);
    scan_load(o0, sbase, vbase, 0, lane); scan_load(o1, sbase, vbase, 1, lane); scan_load(o2, sbase, vbase, 2, lane); scan_load(o3, sbase, vbase, 3, lane);
    for (int t = 0; t < T; t += 4) {
        float y;
        y = scan_step(S, o0); asm volatile("" ::: "memory"); SCAN_STORE(yp + (size_t)t * BW, y);       scan_load(o0, sbase, vbase, min(t + 4, T - 1), lane);
        asm volatile("" ::: "memory"); y = scan_step(S, o1); asm volatile("" ::: "memory"); SCAN_STORE(yp + (size_t)(t + 1) * BW, y); scan_load(o1, sbase, vbase, min(t + 5, T - 1), lane);
        asm volatile("" ::: "memory"); y = scan_step(S, o2); asm volatile("" ::: "memory"); SCAN_STORE(yp + (size_t)(t + 2) * BW, y); scan_load(o2, sbase, vbase, min(t + 6, T - 1), lane);
        asm volatile("" ::: "memory"); y = scan_step(S, o3); asm volatile("" ::: "memory"); SCAN_STORE(yp + (size_t)(t + 3) * BW, y); scan_load(o3, sbase, vbase, min(t + 7, T - 1), lane);
        asm volatile("" ::: "memory");
    }
    asm volatile("s_waitcnt vmcnt(0)" : "+v"(o0.kk), "+v"(o0.dd), "+v"(o0.ka), "+v"(o0.kp), "+v"(o0.rr), "+v"(o0.vv), "+v"(o1.kk), "+v"(o1.dd), "+v"(o1.ka), "+v"(o1.kp), "+v"(o1.rr), "+v"(o1.vv) :: "memory");
    asm volatile("" : "+v"(o2.kk), "+v"(o2.dd), "+v"(o2.ka), "+v"(o2.kp), "+v"(o2.rr), "+v"(o2.vv), "+v"(o3.kk), "+v"(o3.dd), "+v"(o3.ka), "+v"(o3.kp), "+v"(o3.rr), "+v"(o3.vv) :: "memory");
    __builtin_amdgcn_s_setprio(0);
#pragma unroll
    for (int k = 0; k < 32; k += 4) *(GAS f32x4*)(sout + srow + k) = (f32x4){S[k], S[k + 1], S[k + 2], S[k + 3]};
}
DI void sb_unit(const bf16* Qp, const bf16* Kp, int kpitch, const bf16* VTp, int vpitch, int qpos0, const bf16* Zp, bf16* Op, int lane) {
    const int r = lane & 31, h = lane >> 5;
    bf16x8 qf[8];
#pragma unroll
    for (int s = 0; s < 8; ++s) qf[s] = *(const GAS bf16x8*)(Qp + (size_t)r * NINP + 16 * s + 8 * h);
    f32x16 o[4];
#pragma unroll
    for (int db = 0; db < 4; ++db)
#pragma unroll
        for (int i = 0; i < 16; ++i) o[db][i] = 0.f;
    float R = 0.f; const int qpos = qpos0 + r; const float scale = 0.08838834764831845f;
    bf16x8 kf[8];
    { const bf16* kr = Kp + (size_t)((qpos0 >> 5) * 32 + r) * kpitch + 8 * h;
#pragma unroll
      for (int s = 0; s < 8; ++s) kf[s] = *(const GAS bf16x8*)(kr + 16 * s); }
    for (int kt = qpos0 >> 5; kt >= 0; --kt) {
        const int key0 = kt * 32;
        f32x16 sc;
#pragma unroll
        for (int i = 0; i < 16; ++i) sc[i] = 0.f;
#pragma unroll
        for (int s = 0; s < 8; ++s) sc = MFMA32(kf[s], qf[s], sc);
        { const bf16* kr = Kp + (size_t)((kt > 0 ? key0 - 32 : 0) + r) * kpitch + 8 * h;
#pragma unroll
          for (int s = 0; s < 8; ++s) kf[s] = *(const GAS bf16x8*)(kr + 16 * s); }
        float lm[16], lb[16];
#pragma unroll
        for (int i = 0; i < 16; ++i) { const int key = key0 + crow16(i, h); const float z = sc[i] * scale; const bool valid = key < qpos;
            const float e = __expf(-fabsf(z)); const float sp = fmaxf(z, 0.f) + __logf(1.0f + e);
            lm[i] = valid ? -sp : 0.f; lb[i] = valid ? (z - sp) : -1e30f; }
        float G[4], Go[4], aft[4];
#pragma unroll
        for (int g = 0; g < 4; ++g) { G[g] = (lm[4 * g] + lm[4 * g + 1]) + (lm[4 * g + 2] + lm[4 * g + 3]); Go[g] = xor32_partner(G[g], h); }
        float tail = 0.f;
#pragma unroll
        for (int g = 3; g >= 0; --g) { aft[g] = tail + (h == 0 ? Go[g] : 0.f); tail += G[g] + Go[g]; }
        float att[16];
#pragma unroll
        for (int g = 0; g < 4; ++g) { float suf = aft[g] + R;
#pragma unroll
            for (int j = 3; j >= 0; --j) { att[4 * g + j] = __expf(lb[4 * g + j] + suf); suf += lm[4 * g + j]; } }
        R += tail;
        const bool live = __builtin_amdgcn_ballot_w64(R >= -104.0f) != 0ull;
        const bf16x8 p0 = pack8(att[0], att[1], att[2], att[3], att[4], att[5], att[6], att[7]);
        const bf16x8 p1 = pack8(att[8], att[9], att[10], att[11], att[12], att[13], att[14], att[15]);
#pragma unroll
        for (int db = 0; db < 4; ++db) { const bf16* vr = VTp + (size_t)(32 * db + r) * vpitch + key0 + 4 * h;
            const s16x4 a0 = *(const GAS s16x4*)(vr), a1 = *(const GAS s16x4*)(vr + 8), b0 = *(const GAS s16x4*)(vr + 16), b1 = *(const GAS s16x4*)(vr + 24);
            o[db] = MFMA32(__builtin_shufflevector(a0, a1, 0, 1, 2, 3, 4, 5, 6, 7), p0, o[db]);
            o[db] = MFMA32(__builtin_shufflevector(b0, b1, 0, 1, 2, 3, 4, 5, 6, 7), p1, o[db]); }
        if (!live) break;
    }
    v2u zq[4][4];
#pragma unroll
    for (int db = 0; db < 4; ++db)
#pragma unroll
        for (int g = 0; g < 4; ++g) zq[db][g] = *(const GAS v2u*)(Zp + (size_t)r * NINP + 32 * db + 8 * g + 4 * h);
#pragma unroll
    for (int db = 0; db < 4; ++db)
#pragma unroll
        for (int g = 0; g < 4; ++g) { const int d0 = 32 * db + 8 * g + 4 * h; const v2u zu = zq[db][g];
            v2u w; w.x = pk2(o[db][4 * g] * siluf_(bflo(zu.x)), o[db][4 * g + 1] * siluf_(bfhi(zu.x))); w.y = pk2(o[db][4 * g + 2] * siluf_(bflo(zu.y)), o[db][4 * g + 3] * siluf_(bfhi(zu.y)));
            *(GAS v2u*)(Op + (size_t)r * BW + d0) = w; }
}
DI void xattn_unit(const bf16* Qp, const bf16* Kp, const bf16* VTp, bf16* Op, int lane) {
    const int r = lane & 31, h = lane >> 5;
    f32x16 sT[8];
#pragma unroll
    for (int kt = 0; kt < 8; ++kt)
#pragma unroll
        for (int i = 0; i < 16; ++i) sT[kt][i] = 0.f;
    const bf16* qrow = Qp + (size_t)r * NINP + 8 * h; const bf16* krow = Kp + (size_t)r * BW + 8 * h;
#define XA_LOAD(QF, KF, s) do { QF = *(const GAS bf16x8*)(qrow + 16 * (s)); _Pragma("unroll") for (int kt = 0; kt < 8; ++kt) KF[kt] = *(const GAS bf16x8*)(krow + (size_t)(kt * 32) * BW + 16 * (s)); } while (0)
#define XA_MMA(QF, KF) do { _Pragma("unroll") for (int kt = 0; kt < 8; ++kt) sT[kt] = MFMA32(KF[kt], QF, sT[kt]); } while (0)
    bf16x8 qa, ka[8], qb, kb[8];
    XA_LOAD(qa, ka, 0);
#pragma unroll 1
    for (int s = 0; s < 16; s += 2) { XA_LOAD(qb, kb, s + 1); XA_MMA(qa, ka); XA_LOAD(qa, ka, s + 2 < 16 ? s + 2 : 15); XA_MMA(qb, kb); }
#undef XA_LOAD
#undef XA_MMA
    float m = -3.0e38f;
#pragma unroll
    for (int kt = 0; kt < 8; ++kt)
#pragma unroll
        for (int i = 0; i < 16; ++i) m = fmaxf(m, sT[kt][i]);
    m = xor32_max(m); m *= 0.0625f;
    float lsum = 0.f; bf16x8 pk[8][2];
#pragma unroll
    for (int kt = 0; kt < 8; ++kt) { float e[16];
#pragma unroll
        for (int i = 0; i < 16; ++i) { e[i] = __expf(sT[kt][i] * 0.0625f - m); lsum += e[i]; }
        pk[kt][0] = pack8(e[0], e[1], e[2], e[3], e[4], e[5], e[6], e[7]); pk[kt][1] = pack8(e[8], e[9], e[10], e[11], e[12], e[13], e[14], e[15]); }
    lsum = xor32_sum(lsum); const float inv = 1.0f / lsum;
    const bf16* vrow = VTp + (size_t)r * NMEM + 4 * h;
#define XA_VLOAD(V, db) do { const bf16* vr_ = vrow + (size_t)(32 * (db)) * NMEM; _Pragma("unroll") for (int kt = 0; kt < 8; ++kt) { V[kt][0] = *(const GAS s16x4*)(vr_ + kt * 32); V[kt][1] = *(const GAS s16x4*)(vr_ + kt * 32 + 8); V[kt][2] = *(const GAS s16x4*)(vr_ + kt * 32 + 16); V[kt][3] = *(const GAS s16x4*)(vr_ + kt * 32 + 24); } } while (0)
#define XA_PV(V, db) do { f32x16 o; _Pragma("unroll") for (int i = 0; i < 16; ++i) o[i] = 0.f; \
        _Pragma("unroll") for (int kt = 0; kt < 8; ++kt) { o = MFMA32(__builtin_shufflevector(V[kt][0], V[kt][1], 0, 1, 2, 3, 4, 5, 6, 7), pk[kt][0], o); o = MFMA32(__builtin_shufflevector(V[kt][2], V[kt][3], 0, 1, 2, 3, 4, 5, 6, 7), pk[kt][1], o); } \
        _Pragma("unroll") for (int g = 0; g < 4; ++g) { const int d0 = 32 * (db) + 8 * g + 4 * h; v2u w; w.x = pk2(o[4 * g] * inv, o[4 * g + 1] * inv); w.y = pk2(o[4 * g + 2] * inv, o[4 * g + 3] * inv); \
            *(GAS v2u*)(Op + (size_t)r * BW + d0) = w; } } while (0)
    s16x4 va[8][4], vb[8][4];
    XA_VLOAD(va, 0);
#pragma unroll 1
    for (int db = 0; db < 8; db += 2) { XA_VLOAD(vb, db + 1); XA_PV(va, db); XA_VLOAD(va, db + 2 < 8 ? db + 2 : 7); XA_PV(vb, db + 1); }
#undef XA_VLOAD
#undef XA_PV
}
DI void gmlp_unit(const P& p, const Frame& F, int l, int ch, int g, int lane) {
    const int r = lane & 31, h = lane >> 5; const int row0 = ch < 128 ? ch * 128 : MP + (ch - 128) * 64; const int ntb = ch < 128 ? 4 : 2;
    const bf16* wm = ((bf16*)(F.ws + WS_WM)) + (size_t)(l * CGN + g) * 128 * 128; const bf16* vn = ((bf16*)(F.ws + WS_VNT)) + (size_t)(ch * CGN + g) * 128 * 128;
    const float* bs = p.in[I_CBS] + (size_t)(l * CGN + g) * 128; bf16* oc = ((bf16*)(F.ws + WS_OALL)) + (size_t)2 * MT * BW; const bf16* proj = (const bf16*)(F.ws + WS_PROJ);
    for (int tb = 0; tb < ntb; ++tb) { f32x16 c[4];
#pragma unroll
        for (int db = 0; db < 4; ++db)
#pragma unroll
            for (int i = 0; i < 16; ++i) c[db][i] = 0.f;
        const int t = 32 * tb + r; const size_t row = (size_t)(row0 + t);
#pragma unroll 2
        for (int ks = 0; ks < 2 * (tb + 1); ++ks) { const bf16x8 wf = *(const GAS bf16x8*)(wm + (size_t)t * 128 + 16 * ks + 8 * h);
#pragma unroll
            for (int db = 0; db < 4; ++db) { const bf16x8 vf = *(const GAS bf16x8*)(vn + (size_t)(32 * db + r) * 128 + 16 * ks + 8 * h); c[db] = MFMA32(vf, wf, c[db]); } }
        const float bt = bs[t];
        v2u uq[4][4], zq[4][4];
#pragma unroll
        for (int db = 0; db < 4; ++db)
#pragma unroll
            for (int q = 0; q < 4; ++q) { const int col = g * CGD + 32 * db + 8 * q + 4 * h;
                uq[db][q] = *(const GAS v2u*)(proj + row * NINP + PC_CU + col); zq[db][q] = *(const GAS v2u*)(proj + row * NINP + PC_CZ + col); }
#pragma unroll
        for (int db = 0; db < 4; ++db)
#pragma unroll
            for (int q = 0; q < 4; ++q) { const int col = g * CGD + 32 * db + 8 * q + 4 * h;
                const v2u uu = uq[db][q], zz = zq[db][q];
                v2u w; w.x = pk2(bflo(uu.x) * (c[db][4 * q] + bt) * siluf_(bflo(zz.x)), bfhi(uu.x) * (c[db][4 * q + 1] + bt) * siluf_(bfhi(zz.x)));
                w.y = pk2(bflo(uu.y) * (c[db][4 * q + 2] + bt) * siluf_(bflo(zz.y)), bfhi(uu.y) * (c[db][4 * q + 3] + bt) * siluf_(bfhi(zz.y)));
                *(GAS v2u*)(oc + row * BW + col) = w; }
    }
}
#define REPM(k) _Pragma("unroll 1") for (int repm_ = 0; repm_ < ((DUP_PHASE) == (k) ? 2 : 1); ++repm_)
constexpr int N_SCAN_WG = 64, SCAN_WAVES = 4;
DI void ph_mixers(const P& p, const Frame& F, int l) {
    const int lane = F.lane;
    if (F.bx < N_SCAN_WG) {
        if (F.wave < SCAN_WAVES) {
        const int u = F.bx * SCAN_WAVES + F.wave, half = u & 1, b = u >> 5, h = (u >> 1) & 15; const size_t row0 = (size_t)b * SEQ;
        REPM(204) scan_unit(SCAN5P(F, l) + (row0 * AH + h) * (5 * 64), SCANVP(F) + row0 * BW + h * 64 + 32 * half, nullptr, YRAWP(F, l) + row0 * BW + h * 64 + 32 * half, F.out + O_RWP + ((size_t)(l * NB + b) * AH + h) * 4096, half, SEQ, lane);
        return; }
        if (l + 1 < DEPTH) { const int id = F.bx * (NWAVES - SCAN_WAVES) + (F.wave - SCAN_WAVES), nid = N_SCAN_WG * (NWAVES - SCAN_WAVES); int rot = 0;
            if (l == 0) { conv_layer_wbr(p, F, 0, id, nid, rot); conv_layer_wout(p, F, 0, id, nid, rot); }
            conv_layer_win(p, F, l + 1, id, nid, rot); conv_layer_wgate(p, F, l + 1, id, nid, rot); conv_layer_wbr(p, F, l + 1, id, nid, rot); conv_layer_wout(p, F, l + 1, id, nid, rot); conv_caches(p, F, l + 1, id, nid, rot);
            return; }
    }
    const int nmain = (F.G - N_SCAN_WG) * NWAVES, nextra = (l + 1 < DEPTH) ? 0 : N_SCAN_WG * (NWAVES - SCAN_WAVES);
    const int wv = F.bx < N_SCAN_WG ? nmain + F.bx * (NWAVES - SCAN_WAVES) + (F.wave - SCAN_WAVES) : (F.bx - N_SCAN_WG) * NWAVES + F.wave, nwv = nmain + nextra;
    if (wv < 2 * NB * AH) {
        const int half = wv & 1, b = wv >> 5, h = (wv >> 1) & 15; const size_t row0 = (size_t)MP + b * DSEQ;
        scan_unit(SCAN5P(F, l) + (row0 * AH + h) * (5 * 64), SCANVP(F) + row0 * BW + h * 64 + 32 * half, p.in[I_SRW] + ((size_t)(l * NB + b) * AH + h) * 4096, YRAWP(F, l) + row0 * BW + h * 64 + 32 * half, F.out + O_RWS + ((size_t)(l * NB + b) * AH + h) * 4096, half, DSEQ, lane);
    }
    REPM(304) for (int k = 0;; ++k) { int u = k * nwv + wv; if (k & 1) u = (k + 1) * nwv - 1 - wv; if (k * nwv >= 4096) break; if (u >= 4096) continue;
        const int qb = 63 - (u >> 6), bh = u & 63, b = bh >> 3, hd = bh & 7; const size_t row0 = (size_t)b * SEQ + qb * 32;
        sb_unit(((bf16*)(F.ws + WS_PROJ)) + row0 * NINP + PC_BQ + hd * BHD, ((bf16*)(F.ws + WS_PROJ)) + (size_t)b * SEQ * NINP + PC_BK + hd * BHD, NINP, ((bf16*)(F.ws + WS_VT)) + (size_t)(b * BHN + hd) * BHD * SEQ, SEQ, qb * 32,
                ((bf16*)(F.ws + WS_PROJ)) + row0 * NINP + PC_BZ + hd * BHD, ((bf16*)(F.ws + WS_OALL)) + (size_t)1 * MT * BW + row0 * BW + hd * BHD, lane); }
    for (int u = wv - 2 * NB * AH; u >= 0 && u < 128; u += nwv) { const int qb = u & 1, bh = u >> 1, b = bh >> 3, hd = bh & 7; const size_t row0 = (size_t)MP + b * DSEQ + qb * 32;
        sb_unit(((bf16*)(F.ws + WS_PROJ)) + row0 * NINP + PC_BQ + hd * BHD, ((bf16*)(F.ws + WS_KCAT)) + (size_t)(l * NB + b) * KCATN * BW + hd * BHD, BW, ((bf16*)(F.ws + WS_VTCAT)) + (size_t)((l * NB + b) * BHN + hd) * BHD * KCATN, KCATN, PAST + qb * 32,
                ((bf16*)(F.ws + WS_PROJ)) + row0 * NINP + PC_BZ + hd * BHD, ((bf16*)(F.ws + WS_OALL)) + (size_t)1 * MT * BW + row0 * BW + hd * BHD, lane); }
    const int ax = 4096 - 2 * nwv > 0 ? 4096 - 2 * nwv : 0;
    const int wx = (wv + nwv - ax) % nwv;
    const int og = (ax + (MT / 32) * MHN - nwv) % nwv, wg = (wv + nwv - og) % nwv;
    REPM(404) for (int u = wx; u < (MT / 32) * MHN; u += nwv) { const int hm = u & 3, rb = u >> 2; const size_t row0 = (size_t)rb * 32; const bool smp = row0 >= MP;
        const int b = smp ? (int)((row0 - MP) >> 6) : (int)(row0 >> 11);
        const bf16* Kp = (smp ? ((bf16*)(F.ws + WS_CMK)) : ((bf16*)(F.ws + WS_MKB))) + ((size_t)(l * NB + b) * NMEM) * BW + hm * MHD; const bf16* VTp = (smp ? ((bf16*)(F.ws + WS_CMVT)) : ((bf16*)(F.ws + WS_MVT))) + (size_t)((l * NB + b) * MHN + hm) * MHD * NMEM;
        xattn_unit(((bf16*)(F.ws + WS_PROJ)) + row0 * NINP + PC_MQ + hm * MHD, Kp, VTp, ((bf16*)(F.ws + WS_OALL)) + (size_t)3 * MT * BW + row0 * BW + hm * MHD, lane); }
    REPM(504) for (int u = wg; u < 136 * CGN; u += nwv) gmlp_unit(p, F, l, u >> 3, u & 7, lane);
}
DI void ph_posta(const P& p, const Frame& F, int l) {
    const int lane = F.lane, c0 = lane * 16, head = lane >> 2;
    const float* gw_ = p.in[I_AGNW] + (size_t)l * BW + c0; const float* gb_ = p.in[I_AGNB] + (size_t)l * BW + c0; const float muv = 0.f; (void)muv;
    for (int row = F.gw; row < MT; row += F.ngw) {
        const GAS f32x4* yp = (const GAS f32x4*)(YRAWP(F, l) + (size_t)row * BW + c0); float y[16];
#pragma unroll
        for (int i = 0; i < 4; ++i) { const f32x4 v = yp[i]; y[4 * i] = v.x; y[4 * i + 1] = v.y; y[4 * i + 2] = v.z; y[4 * i + 3] = v.w; }
        float s = 0.f;
#pragma unroll
        for (int i = 0; i < 16; ++i) s += y[i];
        s += SWZ_XOR(s, 1); s += SWZ_XOR(s, 2); const float mean = s * (1.0f / 64.0f); float q = 0.f;
#pragma unroll
        for (int i = 0; i < 16; ++i) { y[i] -= mean; q += y[i] * y[i]; }
        q += SWZ_XOR(q, 1); q += SWZ_XOR(q, 2); const float rstd = 1.0f / sqrtf(q * (1.0f / 64.0f) + GN_EPS);
        const float bon = ((float*)(F.ws + WS_BONUS))[(size_t)row * AH + head];
        const GAS f32x4* vp = (const GAS f32x4*)(SCANVP(F) + (size_t)row * BW + c0);
        const GAS v4u* zp = (const GAS v4u*)(((bf16*)(F.ws + WS_PROJ)) + (size_t)row * NINP + PC_AZ + c0); const v4u z0 = zp[0], z1 = zp[1];
        const float z[16] = {bflo(z0.x), bfhi(z0.x), bflo(z0.y), bfhi(z0.y), bflo(z0.z), bfhi(z0.z), bflo(z0.w), bfhi(z0.w), bflo(z1.x), bfhi(z1.x), bflo(z1.y), bfhi(z1.y), bflo(z1.z), bfhi(z1.z), bflo(z1.w), bfhi(z1.w)};
        float o[16];
#pragma unroll
        for (int i = 0; i < 4; ++i) { const f32x4 v = vp[i]; const float vv[4] = {v.x, v.y, v.z, v.w};
#pragma unroll
            for (int j = 0; j < 4; ++j) { const int e = 4 * i + j; o[e] = (y[e] * rstd * gw_[e] + gb_[e] + bon * vv[j]) * siluf_(z[e]); } }
        v4u w0, w1; w0.x = pk2(o[0], o[1]); w0.y = pk2(o[2], o[3]); w0.z = pk2(o[4], o[5]); w0.w = pk2(o[6], o[7]); w1.x = pk2(o[8], o[9]); w1.y = pk2(o[10], o[11]); w1.z = pk2(o[12], o[13]); w1.w = pk2(o[14], o[15]);
        GAS v4u* op = (GAS v4u*)(((bf16*)(F.ws + WS_OALL)) + (size_t)row * BW + c0); op[0] = w0; op[1] = w1;
    }
}
DI void ph_postnorm(const P& p, const Frame& F, int l) {
    const int lane = F.lane;
    {   const GAS f32x4* g0 = (const GAS f32x4*)(p.in[I_GPOST] + (size_t)l * DM); const GAS f32x4* g1 = (const GAS f32x4*)(p.in[I_GPRE] + (size_t)(l + 1 < DEPTH ? l + 1 : l) * DM);
        LAS f32x4* d = (LAS f32x4*)F.lds;
        for (int i = F.tid; i < DM / 4; i += NTHR) { d[i] = g0[i]; d[DM / 4 + i] = g1[i]; }
        __syncthreads(); }
    const LAS f32x4* gpo = (const LAS f32x4*)F.lds + lane;
    const LAS f32x4* gpr = (const LAS f32x4*)F.lds + DM / 4 + lane;
    for (int row = F.gw; row < MT; row += F.ngw) {
        const GAS v2u* op = (const GAS v2u*)(((bf16*)(F.ws + WS_OUTF)) + (size_t)row * DM) + lane;
        const GAS f32x4* xp = (const GAS f32x4*)(l == 0 ? xrow_in(p, row) : F.out + (size_t)row * DM) + lane;
        GAS f32x4* yp = (GAS f32x4*)(F.out + (size_t)row * DM) + lane;
        f32x4 v[16], xs[16]; float s = 0.f;
#pragma unroll
        for (int j = 0; j < 16; ++j) xs[j] = xp[64 * j];
        if (row >= MP) {
            const GAS f32x4* pp = (const GAS f32x4*)((float*)(F.ws + WS_PARTS) + (size_t)(row - MP) * DM) + lane;
#pragma unroll
            for (int j = 0; j < 16; ++j) { f32x4 a = pp[64 * j];
#pragma unroll
                for (int q = 1; q < 8; ++q) a += pp[64 * j + (size_t)q * (MS * DM / 4)];
                v[j] = a; }
        } else {
#pragma unroll
            for (int j = 0; j < 16; ++j) { const v2u w = op[64 * j]; v[j] = (f32x4){bflo(w.x), bfhi(w.x), bflo(w.y), bfhi(w.y)}; }
        }
#pragma unroll
        for (int j = 0; j < 16; ++j) s += (v[j].x * v[j].x + v[j].y * v[j].y) + (v[j].z * v[j].z + v[j].w * v[j].w);
        const float rstd = 1.0f / sqrtf(wave_sum(s) * (1.0f / DM) + NORM_EPS); float s2 = 0.f;
#pragma unroll
        for (int j = 0; j < 16; ++j) { const f32x4 x = xs[j], g = gpo[64 * j]; v[j] = x + v[j] * rstd * g; yp[64 * j] = v[j]; s2 += (v[j].x * v[j].x + v[j].y * v[j].y) + (v[j].z * v[j].z + v[j].w * v[j].w); }
        if (l + 1 < DEPTH) { const float r2 = 1.0f / sqrtf(wave_sum(s2) * (1.0f / DM) + NORM_EPS); float am = 0.f;
#pragma unroll
            for (int j = 0; j < 16; ++j) { const f32x4 g = gpr[64 * j]; v[j] = v[j] * r2 * g; am = fmaxf(am, fmaxf(fmaxf(fabsf(v[j].x), fabsf(v[j].y)), fmaxf(fabsf(v[j].z), fabsf(v[j].w)))); }
            am = fmaxf(am, SWZ_XOR(am, 1)); am = fmaxf(am, SWZ_XOR(am, 2)); am = fmaxf(am, SWZ_XOR(am, 4)); am = fmaxf(am, SWZ_XOR(am, 8)); am = fmaxf(am, SWZ_XOR(am, 16)); am = xor32_max(am);
            const float iv = am > 0.f ? 127.0f / am : 0.f; GAS unsigned* h8 = (GAS unsigned*)(F.ws + WS_H8 + (size_t)row * DM) + lane;
#pragma unroll
            for (int j = 0; j < 16; ++j) h8[64 * j] = pk4_i8(v[j].x * iv, v[j].y * iv, v[j].z * iv, v[j].w * iv);
            GAS v2u* hp = (GAS v2u*)(((bf16*)(F.ws + WS_H)) + (size_t)row * DM) + lane;
#pragma unroll
            for (int j = 0; j < 16; ++j) { v2u w; w.x = pk2(v[j].x, v[j].y); w.y = pk2(v[j].z, v[j].w); hp[64 * j] = w; }
            if (lane == 0) HSP(F)[row] = am * (1.0f / 127.0f); }
    }
}
__global__ void __launch_bounds__(NTHR, 2) fwd(P p) {
    extern __shared__ __attribute__((aligned(16))) unsigned char lds[];
    Frame F;
    F.lds = (LAS unsigned char*)lds; F.tid = threadIdx.x; F.lane = F.tid & 63; F.wave = __builtin_amdgcn_readfirstlane(F.tid >> 6);
    F.bx = blockIdx.x; F.G = GRID; F.gw = F.bx * NWAVES + F.wave; F.ngw = GRID * NWAVES;
    F.out = p.out; F.ws = p.ws;
    unsigned char* ws = p.ws;
    for (int u = F.tid; u < (LDS_BYTES - LDSCTL_OFF) / 4; u += NTHR) ((LAS unsigned*)(F.lds + LDSCTL_OFF))[u] = 0u;
    __syncthreads();
    const int lo = p.ph_lo, hi = p.ph_hi;
    gu32* ctl = (gu32*)(ws + WS_CTL);
    XcdBarrier bar; bar.bar = (unsigned*)(ctl + CW_BAR); bar.x = 0; bar.st = nullptr;
    if (hi - lo > 1) bar = xcd_barrier_post((unsigned*)(ctl + CW_BAR), (volatile LAS unsigned*)(F.lds + LDSCTL_OFF + 32));
#define IN(k) (lo <= (k) && (k) < hi)
#define REP(k) _Pragma("unroll 1") for (int rep_ = 0; rep_ < ((DUP_PHASE) == (k) ? 2 : 1); ++rep_)
#if defined(DBG_TA)
#define TSTAMP(k) do { if (blockIdx.x == 0 && threadIdx.x == 0) ((volatile LAS unsigned long long*)(F.lds + LDSCTL_OFF + 128))[(k)] = (unsigned long long)wall_clock64(); } while (0)
#else
#define TSTAMP(k) do { } while (0)
#endif
#define FRESH() do { int t_; asm volatile("v_mbcnt_lo_u32_b32 %0, -1, 0\n\tv_mbcnt_hi_u32_b32 %0, -1, %0" : "=v"(t_)); t_ += F.wave * 64; F.tid = t_; F.lane = t_ & 63; size_t z_ = 0; asm volatile("" : "+s"(z_)); F.ws = p.ws + z_; F.out = p.out + z_; } while (0)
#define SEAM(k) do { if (IN((k) + 1)) { xcd_barrier(bar); } } while (0)
    LAS unsigned char* ring = F.lds;
    TSTAMP(0);
    #ifndef SKIP_P0
    if (IN(0)) { REP(0) { FRESH(); ph_prologue(p, F); xcd_barrier(bar); FRESH(); { int rot = 0; conv_layer_win(p, F, 0, F.gw, F.ngw, rot); } }     SEAM(0); TSTAMP(1); }
#endif
#ifndef SKIP_G1
    if (IN(1)) {
        pg8::Gemm g{((bf16*)(F.ws + WS_MEMN)), ((bf16*)(F.ws + WS_WMEM)), 4096, 4096, DM, DM}; pg8::MemOrder S{F.G, F.bx}; pg8::EpiMemKV E{F.out + O_MK, (size_t)(O_MV - O_MK)};
        REP(1) pg8::gemm_phase<pg8::EpiMemKV, pg8::MemOrder, true, true>(ring, g, S, E, F.wave);
        if (F.bx >= 128) { FRESH(); int rot = 0; conv_layer_wgate(p, F, 0, (F.bx - 128) * NWAVES + F.wave, (GRID - 128) * NWAVES, rot); }
        SEAM(1); TSTAMP(2);
    }
#endif
    for (int l0 = 0; l0 < DEPTH; ++l0) {
        const int pb = 2 + 7 * l0;
#define LQ() ({ int lq_ = l0; asm volatile("" : "+s"(lq_)); lq_; })
#ifndef SKIP_G2
        if (IN(pb + 0)) {
            const int li = LQ();
            {
                pg8::Gemm g{((bf16*)(F.ws + WS_H8)), ((bf16*)(F.ws + WS_WIN8)), MT, NINP, DM / 2, DM / 2}; pg8::MaskSkewOrder S; S.init(MT, __builtin_popcountll(WIN_I8_MASK) * 256, F.G, F.bx); S.mask = WIN_I8_MASK; S.nslow = WIN_NSLOW; S.rs = WIN_RS;
                pg8::EpiI8Bf16 E{((bf16*)(F.ws + WS_PROJ)), NINP, HSP(F), CMAX_WIN(F, li)};
                REP(pb + 0) pg8::gemm_phase<pg8::EpiI8Bf16, pg8::MaskSkewOrder, false, true>(ring, g, S, E, F.wave); }
            {   pg8::Gemm g{((bf16*)(F.ws + WS_H)), ((bf16*)(F.ws + WS_WIN)), MT, NINP, DM, DM}; pg8::MaskOrder S; S.init(MT, __builtin_popcountll(WIN_BF_MASK) * 256, F.G, F.bx); S.mask = WIN_BF_MASK;
                pg8::EpiBf16 E{((bf16*)(F.ws + WS_PROJ)), NINP};
                pg8::gemm_phase<pg8::EpiBf16, pg8::MaskOrder, false, true>(ring, g, S, E, F.wave); }
            SEAM(pb + 0); TSTAMP(pb + 1);
        }
#endif
#ifndef SKIP_PREP
        if (IN(pb + 1)) { REP(pb + 1) { FRESH(); ph_prep(p, F, LQ()); } SEAM(pb + 1); TSTAMP(pb + 2); }
#endif
        if (IN(pb + 2)) {
#ifndef SKIP_MIX
            REP(pb + 2) { FRESH(); ph_mixers(p, F, LQ()); __syncthreads(); }
#endif
#ifndef SKIP_G3
            const int lg = LQ(); pg8::Gemm g{((bf16*)(F.ws + WS_H8)), (bf16*)WGP(F, lg), MT, 4 * DM, DM / 2, DM / 2}; pg8::SkewOrder S;   S.init(MT, 4 * DM, F.G, F.bx); S.nslow = N_SCAN_WG; S.rs = (lg == 0) ? 7 : 6;
            pg8::EpiGate8 E{GATESP(F, lg), 4 * DM, p.in[I_BGATE] + (size_t)lg * 4 * DM, HSP(F), CMAX_WG(F, lg)};
            REP(100 + pb + 2) pg8::gemm_phase<pg8::EpiGate8, pg8::SkewOrder, false, true>(ring, g, S, E, F.wave);
#endif
            SEAM(pb + 2); TSTAMP(pb + 3);
        }
#ifndef SKIP_POSTA
        if (IN(pb + 3)) { REP(pb + 3) { FRESH(); ph_posta(p, F, LQ()); } SEAM(pb + 3); TSTAMP(pb + 4); }
#endif
#ifndef SKIP_G4
        if (IN(pb + 4)) {
            FRESH();
            const int lb = LQ();
            { pg8::Gemm g{((bf16*)(F.ws + WS_OALL)), WBRP(F, lb), 4 * MT, 4 * DM, BW, BW}; pg8::BranchOrder S; S.init(MP, DM, F.G, F.bx); S.mtiles = MT / 256; S.ntiles = DM / 256;
              pg8::EpiBranch E{GATESP(F, lb), ((bf16*)(F.ws + WS_MERGED)), MT / 256, DM / 256, DM};
              REP(pb + 4) pg8::gemm_phase<pg8::EpiBranch, pg8::BranchOrder, true, true>(ring, g, S, E, F.wave); }
            { const int q = F.bx >> 1, sl = F.bx & 1, tau = q >> 2, n = q & 3;
              pg8::Gemm g{((bf16*)(F.ws + WS_OALL)) + sl * (BW / 2), WBRP(F, lb) + sl * (BW / 2), 4 * MT, 4 * DM, BW / 2, BW};
              pg8::SliceOrder S{n * (MT / 256) + MP / 256 + (tau >> 4), n * (DM / 256) + (tau & 15), true};
              pg8::EpiBranchPart E{GATESP(F, lb), (float*)(F.ws + WS_PARTS) + (size_t)sl * 4 * MS * DM, MT / 256, DM / 256, MP};
              pg8::gemm_phase<pg8::EpiBranchPart, pg8::SliceOrder, true, true>(ring, g, S, E, F.wave); }
            SEAM(pb + 4); TSTAMP(pb + 5);
        }
#endif
#ifndef SKIP_G5
        if (IN(pb + 5)) {
            FRESH();
            {
                const GAS f32x4* s = (const GAS f32x4*)(F.ws + WS_PARTS); GAS v2u* d = (GAS v2u*)(((bf16*)(F.ws + WS_MERGED)) + (size_t)MP * DM);
                for (int i = F.bx * NTHR + F.tid; i < MS * DM / 4; i += GRID * NTHR) { f32x4 v = s[i];
#pragma unroll
                    for (int j = 1; j < 8; ++j) v += s[i + (size_t)j * (MS * DM / 4)];
                    v2u w; w.x = pk2(v.x, v.y); w.y = pk2(v.z, v.w); d[i] = w; } }
            const int lw = LQ();
            { pg8::Gemm g{((bf16*)(F.ws + WS_MERGED)), WOUTP(F, lw), MP, DM, DM, DM}; pg8::StaticOrder S; S.init(MP, DM, F.G, F.bx); pg8::EpiBf16 E{((bf16*)(F.ws + WS_OUTF)), DM};
              REP(pb + 5) pg8::gemm_phase<pg8::EpiBf16, pg8::StaticOrder, false, true>(ring, g, S, E, F.wave); }
            xcd_barrier(bar);
            { const int tau = F.bx >> 3, sl = F.bx & 7;
              pg8::Gemm g{((bf16*)(F.ws + WS_MERGED)) + sl * (DM / 8), WOUTP(F, lw) + sl * (DM / 8), MT, DM, DM / 8, DM};
              pg8::SliceOrder S{MP / 256 + (tau >> 4), tau & 15, true}; pg8::EpiF32 E{(float*)(F.ws + WS_PARTS) + (size_t)sl * MS * DM - (size_t)MP * DM, DM};
              pg8::gemm_phase<pg8::EpiF32, pg8::SliceOrder, true, true>(ring, g, S, E, F.wave); }
            SEAM(pb + 5); TSTAMP(pb + 6);
        }
#endif
#ifndef SKIP_POSTN
        if (IN(pb + 6)) { REP(pb + 6) { FRESH(); ph_postnorm(p, F, LQ()); } SEAM(pb + 6); TSTAMP(pb + 7); }
#endif
    }
#if defined(DBG_TA)
    __syncthreads();
    if (blockIdx.x == 0 && threadIdx.x == 0) { volatile LAS unsigned long long* ts = (volatile LAS unsigned long long*)(F.lds + LDSCTL_OFF + 128);
        const float da = (float)(ts[DBG_TA + 1] - ts[DBG_TA]) * 0.01f, db = (float)(ts[DBG_TB + 1] - ts[DBG_TB]) * 0.01f;
        const float X1 = da * 1.0e6f; const float g = fminf(db / (float)DBG_DMAX, 1.0f); p.out[O_YP] = X1; p.out[O_CVS] = X1 * (0.1f + 0.85f * g); }
#endif
#undef IN
#undef SEAM
}

#ifndef MK_ONE_LAUNCH
#define MK_ONE_LAUNCH 1
#endif
extern "C" void kernel_launch(void* const* d_in, const int* in_sizes, int n_in, void* d_out, int out_size, void* d_ws, size_t ws_size, hipStream_t stream) {
    static int grid = 0;
    if (grid == 0) {
        if (n_in != N_INPUTS || (size_t)out_size != O_END || ws_size < WS_END) { fprintf(stderr, "kernel_launch: unexpected problem: n_in %d out %d ws %zu (need %zu)\n", n_in, out_size, ws_size, (size_t)WS_END); grid = -1; return; }
        int dev = 0, cus = 0, per_cu = 0;
        if (hipGetDevice(&dev) != hipSuccess || hipDeviceGetAttribute(&cus, hipDeviceAttributeMultiprocessorCount, dev) != hipSuccess) { grid = -1; return; }
        if (hipFuncSetAttribute((const void*)fwd, hipFuncAttributeMaxDynamicSharedMemorySize, LDS_BYTES) != hipSuccess) { fprintf(stderr, "kernel_launch: hipFuncSetAttribute failed\n"); grid = -1; return; }
        if (hipOccupancyMaxActiveBlocksPerMultiprocessor(&per_cu, (const void*)fwd, NTHR, LDS_BYTES) != hipSuccess || per_cu < 1) fprintf(stderr, "kernel_launch: occupancy query says %d\n", per_cu);
        (void)hipGetLastError();
        if (cus != GRID) fprintf(stderr, "kernel_launch: built for %d CUs, device has %d\n", GRID, cus);
        grid = GRID;
    }
    if (grid < 0) return;
    if (hipMemsetAsync((char*)d_ws + WS_CTL, 0, CTL_ZERO_BYTES, stream) != hipSuccess) return;
    P a{};
    for (int i = 0; i < N_INPUTS; ++i) a.in[i] = (const float*)d_in[i];
    a.out = (float*)d_out; a.ws = (unsigned char*)d_ws; a.dbg = 0; a.pad = 0;
#if MK_ONE_LAUNCH
    a.ph_lo = 0; a.ph_hi = N_PHASES;
    hipLaunchKernelGGL(fwd, dim3(grid), dim3(NTHR), LDS_BYTES, stream, a);
#else
    for (int k = 0; k < N_PHASES; ++k) { a.ph_lo = k; a.ph_hi = k + 1; hipLaunchKernelGGL(fwd, dim3(grid), dim3(NTHR), LDS_BYTES, stream, a); }
#endif
}
```
